# Optimizing an MI355X kernel written in HIP

```python
import math
import jax, jax.numpy as jnp
from jax import lax
import numpy as np

D_MODEL = 2048
BATCH = 4
SEQ = 4096
DEPTH = 2

MIX_WIDTH = D_MODEL
DIFF_WIDTH = MIX_WIDTH // 2
RWKV_WIDTH = MIX_WIDTH - DIFF_WIDTH
DIFF_QK_DIM = 64
DIFF_V_DIM = 2 * DIFF_QK_DIM
DIFF_HEADS = DIFF_WIDTH // DIFF_V_DIM
ROPE_DIM = DIFF_QK_DIM // 4
ROPE_THETA = 500000.0
Q_BLOCK = 128
DIFF_NORM_EPS = 1e-5
RWKV_HEAD = 64
RWKV_HEADS = RWKV_WIDTH // RWKV_HEAD
DECAY_LORA = 64
ICLR_LORA = 64
GATE_LORA = 128
DECAY_SCALE = 0.606531
GN_EPS = 64e-5
L2_EPS = 1e-12
N_EXPERTS = 16
N_GROUPS = 4
EXPERTS_PER_GROUP = N_EXPERTS // N_GROUPS
TOP_K = 2
D_FF_EXPERT = D_MODEL // 2
MOE_BLOCK = 128
RMS_EPS = 1e-6
N_MOD = 6
DIFF_COLS = 3 * DIFF_WIDTH
RWKV_COLS = 3 * RWKV_WIDTH + 2 * DECAY_LORA + 2 * ICLR_LORA + GATE_LORA
IN_COLS = DIFF_COLS + RWKV_COLS

kernel_name = "hymba_diffattn_rwkv7_grouped_moe_adaln_encoder"


def rms_norm(x, gain, eps=RMS_EPS):
    xf = x.astype(jnp.float32)
    y = xf * lax.rsqrt(jnp.mean(xf * xf, axis=-1, keepdims=True) + eps)
    return (y * gain.astype(jnp.float32)).astype(x.dtype)


def rope_partial(t, cos, sin):
    half = ROPE_DIM // 2
    r1, r2, rest = t[..., :half], t[..., half:ROPE_DIM], t[..., ROPE_DIM:]
    return jnp.concatenate([r1 * cos - r2 * sin, r2 * cos + r1 * sin, rest], axis=-1)


def diff_attention(q, k, v, lam, lam_init, sub_gain):
    B, S = q.shape[0], q.shape[1]
    nblk = S // Q_BLOCK
    scale = DIFF_QK_DIM ** -0.5
    qb = jnp.moveaxis(q.reshape(B, nblk, Q_BLOCK, DIFF_HEADS, 2, DIFF_QK_DIM), 1, 0)
    kf = k.astype(jnp.float32)
    vf = v.astype(jnp.float32)

    def block(q_blk):
        s = jnp.einsum('bqhcd,bkhcd->bhcqk', q_blk.astype(jnp.float32), kf) * scale
        p = jax.nn.softmax(s, axis=-1)
        w = p[:, :, 0] - lam * p[:, :, 1]
        return jnp.einsum('bhqk,bkhe->bqhe', w, vf)

    o = lax.map(block, qb)
    o = jnp.moveaxis(o, 0, 1).reshape(B, S, DIFF_HEADS, DIFF_V_DIM)
    o = rms_norm(o, sub_gain, DIFF_NORM_EPS) * (1.0 - lam_init)
    return o.reshape(B, S, DIFF_WIDTH).astype(q.dtype)


def centred_shift(p, mu_prev, mu_next):
    prev = jnp.pad(p[:, :-1], ((0, 0), (1, 0), (0, 0)))
    nxt = jnp.pad(p[:, 1:], ((0, 0), (0, 1), (0, 0)))
    return p + mu_prev * (prev - p) + mu_next * (nxt - p)


def rwkv7_step(state, inp):
    r, w, k, v, kk, b = inp
    sa = jnp.einsum('dbhij,dbhj->dbhi', state, -kk)
    state = state * w[..., None, :] + sa[..., :, None] * b[..., None, :] + v[..., :, None] * k[..., None, :]
    y = jnp.einsum('dbhij,dbhj->dbhi', state, r)
    return state, y


def rwkv7_mixer(p, mu_prev, mu_next, w0, w_up, a0, a_up, k_k, k_a, r_k, g_up, gn_gain, gn_bias):
    B, S = p.shape[0], p.shape[1]
    W = RWKV_WIDTH
    dt = p.dtype
    p = centred_shift(p, mu_prev, mu_next).astype(jnp.float32)
    r, k, v = p[..., :W], p[..., W:2 * W], p[..., 2 * W:3 * W]
    o = 3 * W
    wd = p[..., o:o + 2 * DECAY_LORA].reshape(B, S, 2, DECAY_LORA)
    o += 2 * DECAY_LORA
    ad = p[..., o:o + 2 * ICLR_LORA].reshape(B, S, 2, ICLR_LORA)
    o += 2 * ICLR_LORA
    gd = p[..., o:o + GATE_LORA]
    decay = jnp.exp(-DECAY_SCALE * jax.nn.sigmoid(w0 + jnp.einsum('bsdr,drc->bsdc', jnp.tanh(wd), w_up)))
    a = jax.nn.sigmoid(a0 + jnp.einsum('bsdr,drc->bsdc', ad, a_up))
    g = jnp.einsum('bsr,rc->bsc', jax.nn.sigmoid(gd), g_up)
    hd = lambda t: t.reshape(t.shape[:-1] + (RWKV_HEADS, RWKV_HEAD))
    kk = hd(k * k_k)
    kk = kk / jnp.maximum(jnp.sqrt(jnp.sum(kk * kk, axis=-1, keepdims=True)), L2_EPS)
    kk = kk.reshape(B, S, W)
    k_dir = k[:, :, None, :] * (1.0 + (a - 1.0) * k_a)

    def dirs(t):
        t = jnp.stack([t[:, :, 0], jnp.flip(t[:, :, 1], axis=1)], axis=0)
        return jnp.moveaxis(t.reshape(2, B, S, RWKV_HEADS, RWKV_HEAD), 2, 0)

    both = lambda t: jnp.stack([t, t], axis=2)
    xs = (dirs(both(r)), dirs(decay), dirs(k_dir), dirs(both(v)), dirs(both(kk)), dirs(kk[:, :, None, :] * a))
    state0 = jnp.zeros((2, B, RWKV_HEADS, RWKV_HEAD, RWKV_HEAD), jnp.float32)
    _, y = lax.scan(rwkv7_step, state0, xs)
    y = jnp.moveaxis(y, 0, 2)
    y = y[0] + jnp.flip(y[1], axis=1)
    mean = jnp.mean(y, axis=-1, keepdims=True)
    var = jnp.mean(jnp.square(y - mean), axis=-1, keepdims=True)
    yn = ((y - mean) * lax.rsqrt(var + GN_EPS)).reshape(B, S, W) * gn_gain + gn_bias
    bonus = jnp.sum(hd(r) * hd(k_dir[:, :, 0] + k_dir[:, :, 1]) * r_k.reshape(RWKV_HEADS, RWKV_HEAD),
                    axis=-1, keepdims=True) * hd(v)
    return ((yn + bonus.reshape(B, S, W)) * g).astype(dt)


def moe(h, w_router, router_bias, w_gate, w_up, w_down):
    B, S, D = h.shape
    T = B * S
    hf = h.reshape(T, D)
    scores = jax.nn.sigmoid((hf @ w_router).astype(jnp.float32))
    sel = (scores + router_bias.astype(jnp.float32)).reshape(T, N_GROUPS, EXPERTS_PER_GROUP)
    group_score = jnp.sum(lax.top_k(sel, TOP_K)[0], axis=-1)
    grp = jnp.argmax(group_score, axis=-1).astype(jnp.int32)
    in_grp = jnp.take_along_axis(sel, grp[:, None, None], axis=1)[:, 0]
    _, local = lax.top_k(in_grp, TOP_K)
    expert = grp[:, None] * EXPERTS_PER_GROUP + local.astype(jnp.int32)
    gate = jnp.take_along_axis(scores, expert, axis=1)
    gate = gate / jnp.sum(gate, axis=-1, keepdims=True)
    A = T * TOP_K
    flat_e = expert.reshape(A)
    flat_tok = jnp.repeat(jnp.arange(T, dtype=jnp.int32), TOP_K)
    flat_w = gate.reshape(A)
    order = jnp.argsort(flat_e)
    sorted_e = flat_e[order]
    counts = jnp.bincount(flat_e, length=N_EXPERTS).astype(jnp.int32)
    offsets = jnp.cumsum(counts) - counts
    padded = ((counts + MOE_BLOCK - 1) // MOE_BLOCK) * MOE_BLOCK
    padded_ends = jnp.cumsum(padded)
    padded_offsets = padded_ends - padded
    dest = padded_offsets[sorted_e] + jnp.arange(A, dtype=jnp.int32) - offsets[sorted_e]
    P = A + N_EXPERTS * MOE_BLOCK
    nb = P // MOE_BLOCK
    row_tok = jnp.full((P,), T, jnp.int32).at[dest].set(flat_tok[order])
    row_w = jnp.zeros((P,), jnp.float32).at[dest].set(flat_w[order])
    block_start = jnp.arange(nb, dtype=jnp.int32) * MOE_BLOCK
    block_e = jnp.minimum(jnp.searchsorted(padded_ends, block_start, side='right'), N_EXPERTS - 1).astype(jnp.int32)
    h_pad = jnp.concatenate([hf, jnp.zeros((1, D), hf.dtype)], axis=0)
    xr = h_pad[row_tok].reshape(nb, MOE_BLOCK, D)

    def expert_block(args):
        xb, e = args
        return (jax.nn.silu(xb @ w_gate[e]) * (xb @ w_up[e])) @ w_down[e]

    yr = lax.map(expert_block, (xr, block_e)).reshape(P, D)
    y = jax.ops.segment_sum(yr * row_w[:, None], row_tok, num_segments=T + 1)[:T]
    return y.reshape(B, S, D).astype(h.dtype)


def setup_inputs(seed: int = 0) -> dict:
    key = jax.random.key(seed)
    ks = iter(jax.random.split(key, 40))
    nrm = lambda shape, s: jax.random.normal(next(ks), shape, jnp.float32) * s
    W = RWKV_WIDTH
    x = nrm((BATCH, SEQ, D_MODEL), 1.0)
    c = nrm((BATCH, D_MODEL), 1.0)
    positions = (jnp.arange(SEQ, dtype=jnp.int32)[None, :]
                 + jax.random.randint(next(ks), (BATCH, 1), 0, 1024, dtype=jnp.int32))
    return {
        "x": x,
        "c": c,
        "positions": positions,
        "w_ada": nrm((DEPTH, D_MODEL, N_MOD * D_MODEL), 0.5 * D_MODEL ** -0.5),
        "b_ada": nrm((DEPTH, N_MOD * D_MODEL), 0.02),
        "norm_gain": 1.0 + nrm((DEPTH, 2, D_MODEL), 0.02),
        "w_in": nrm((DEPTH, D_MODEL, IN_COLS), D_MODEL ** -0.5),
        "w_out": nrm((DEPTH, MIX_WIDTH, D_MODEL), MIX_WIDTH ** -0.5),
        "mu_prev": jax.random.uniform(next(ks), (DEPTH, RWKV_COLS), jnp.float32, 0.0, 0.5),
        "mu_next": jax.random.uniform(next(ks), (DEPTH, RWKV_COLS), jnp.float32, 0.0, 0.5),
        "decay_w0": nrm((DEPTH, 2, W), 1.0),
        "decay_up": nrm((DEPTH, 2, DECAY_LORA, W), 0.5 * DECAY_LORA ** -0.5),
        "iclr_a0": nrm((DEPTH, 2, W), 0.5),
        "iclr_up": nrm((DEPTH, 2, ICLR_LORA, W), 0.5 * ICLR_LORA ** -0.5),
        "k_k": 0.85 + nrm((DEPTH, W), 0.05),
        "k_a": 1.0 + nrm((DEPTH, W), 0.05),
        "r_k": nrm((DEPTH, W), 0.1),
        "gate_up": nrm((DEPTH, GATE_LORA, W), GATE_LORA ** -0.5),
        "gn_gain": 1.0 + nrm((DEPTH, W), 0.02),
        "gn_bias": nrm((DEPTH, W), 0.02),
        "lam_q1": nrm((DEPTH, DIFF_QK_DIM), 0.1),
        "lam_k1": nrm((DEPTH, DIFF_QK_DIM), 0.1),
        "lam_q2": nrm((DEPTH, DIFF_QK_DIM), 0.1),
        "lam_k2": nrm((DEPTH, DIFF_QK_DIM), 0.1),
        "diff_sub_gain": 1.0 + nrm((DEPTH, DIFF_V_DIM), 0.02),
        "w_router": nrm((D_MODEL, N_EXPERTS), D_MODEL ** -0.5),
        "router_bias": nrm((N_EXPERTS,), 0.01),
        "w_gate": nrm((DEPTH, N_EXPERTS, D_MODEL, D_FF_EXPERT), D_MODEL ** -0.5),
        "w_up": nrm((DEPTH, N_EXPERTS, D_MODEL, D_FF_EXPERT), D_MODEL ** -0.5),
        "w_down": nrm((DEPTH, N_EXPERTS, D_FF_EXPERT, D_MODEL), D_FF_EXPERT ** -0.5),
        "final_gain": 1.0 + nrm((D_MODEL,), 0.02),
    }


def reference(x, c, positions, w_ada, b_ada, norm_gain, w_in, w_out, mu_prev, mu_next,
              decay_w0, decay_up, iclr_a0, iclr_up, k_k, k_a, r_k, gate_up, gn_gain, gn_bias,
              lam_q1, lam_k1, lam_q2, lam_k2, diff_sub_gain, w_router, router_bias,
              w_gate, w_up, w_down, final_gain):
    B, S, D = x.shape
    inv_freq = 1.0 / (ROPE_THETA ** (jnp.arange(0, ROPE_DIM, 2, dtype=jnp.float32) / ROPE_DIM))
    ang = positions.astype(jnp.float32)[..., None] * inv_freq
    cos = jnp.cos(ang)[:, :, None, None, :].astype(x.dtype)
    sin = jnp.sin(ang)[:, :, None, None, :].astype(x.dtype)
    c_act = jax.nn.silu(c)
    for l in range(DEPTH):
        mod = (c_act @ w_ada[l] + b_ada[l])[:, None, :]
        sh1, sc1, g1, sh2, sc2, g2 = jnp.split(mod, N_MOD, axis=-1)
        h = rms_norm(x, norm_gain[l, 0]) * (1.0 + sc1) + sh1
        proj = h @ w_in[l]
        q = proj[..., :DIFF_WIDTH].reshape(B, S, DIFF_HEADS, 2, DIFF_QK_DIM)
        k = proj[..., DIFF_WIDTH:2 * DIFF_WIDTH].reshape(B, S, DIFF_HEADS, 2, DIFF_QK_DIM)
        v = proj[..., 2 * DIFF_WIDTH:DIFF_COLS].reshape(B, S, DIFF_HEADS, DIFF_V_DIM)
        q = rope_partial(q, cos, sin)
        k = rope_partial(k, cos, sin)
        lam_init = 0.8 - 0.6 * math.exp(-0.3 * l)
        lam = (jnp.exp(jnp.sum(lam_q1[l].astype(jnp.float32) * lam_k1[l].astype(jnp.float32)))
               - jnp.exp(jnp.sum(lam_q2[l].astype(jnp.float32) * lam_k2[l].astype(jnp.float32)))
               + lam_init)
        y_diff = diff_attention(q, k, v, lam, lam_init, diff_sub_gain[l])
        y_rwkv = rwkv7_mixer(proj[..., DIFF_COLS:], mu_prev[l], mu_next[l], decay_w0[l], decay_up[l],
                             iclr_a0[l], iclr_up[l], k_k[l], k_a[l], r_k[l], gate_up[l],
                             gn_gain[l], gn_bias[l])
        mix = jnp.concatenate([y_diff, y_rwkv], axis=-1) @ w_out[l]
        x = x + g1 * mix
        h2 = rms_norm(x, norm_gain[l, 1]) * (1.0 + sc2) + sh2
        x = x + g2 * moe(h2, w_router, router_bias, w_gate[l], w_up[l], w_down[l])
    return rms_norm(x, final_gain)
```

```cpp
#include <hip/hip_runtime.h>
#include <cstdio>
#include <cstdint>

#ifndef SCAN_CONVERT
#define SCAN_CONVERT 0
#endif
#ifndef PROJ_FP8
#define PROJ_FP8 1
#endif
#ifndef MK_PER_PHASE
#define MK_PER_PHASE 0
#endif

#define LAS __attribute__((address_space(3)))
typedef unsigned short bf16_t;
typedef short bf16x8 __attribute__((ext_vector_type(8)));
typedef short s16x4 __attribute__((ext_vector_type(4)));
typedef float f32x4 __attribute__((ext_vector_type(4)));
typedef float f32x2 __attribute__((ext_vector_type(2)));
typedef float f32x16 __attribute__((ext_vector_type(16)));
typedef unsigned u32x4 __attribute__((ext_vector_type(4)));
typedef unsigned u32x2 __attribute__((ext_vector_type(2)));

constexpr int BATCH = 4, SEQ = 4096, DM = 2048, MTOK = BATCH * SEQ, DEPTH = 2;
constexpr int NPROJ = 6528, NPROJP = 6656, RW0 = 3072, RWC = 3456;
constexpr int NEXP = 16, DFF = 1024, TOKCAP = 16384;
constexpr int NMOD = 6 * DM;
constexpr int NDYN = 5120, KLA = 384;
constexpr float C2 = 0.18033688011112042f;
constexpr int MAXTILES = 144;
#ifndef WOUT_FP8
#define WOUT_FP8 1
#endif
constexpr float WSC_O = 32.0f, MIXSC = 8.0f;
constexpr float WSC_GU = 32.0f, WSC_D = 16.0f, WSC_IN = 32.0f, YSC = 8.0f;

constexpr size_t MiB = 1u << 20;
constexpr size_t WS_CTL = 0, CTL_BYTES = 1 * MiB;
constexpr size_t WS_MOD = 1 * MiB;
constexpr size_t WS_ROPE = 2 * MiB;
constexpr size_t WS_TOKL = 3 * MiB;
constexpr size_t WS_ASG = 4 * MiB;
constexpr size_t WS_LW = 5 * MiB;
constexpr size_t WS_WIN = 13 * MiB;
constexpr size_t WS_WOUT = 65 * MiB;
constexpr size_t WS_WGU = 81 * MiB;
constexpr size_t WS_WD = 209 * MiB;
constexpr size_t WS_X = 273 * MiB;
constexpr size_t WS_H = 401 * MiB;
constexpr size_t WS_MIX = 466 * MiB;
constexpr size_t WS_PROJ = 530 * MiB;
constexpr size_t WS_SHR = 738 * MiB;
constexpr size_t WS_LA = 866 * MiB;
constexpr size_t WS_DYN = 878 * MiB;
constexpr size_t WS_YS = 1038 * MiB;
constexpr size_t WS_END = 1102 * MiB;
constexpr size_t WS_ACT = 530 * MiB;
constexpr size_t WS_Y = 602 * MiB;
constexpr int CW_BAR = 4096;
constexpr int CW_CNT = 16384;
constexpr int CW_AQ = 24576;

constexpr int LDS_MISC = 131072;
constexpr int LDS_BYTES = 147456;

__device__ __forceinline__ unsigned cvt_pk_bf16(float lo, float hi) { unsigned r; asm volatile("v_cvt_pk_bf16_f32 %0, %1, %2" : "=v"(r) : "v"(lo), "v"(hi)); return r; }
__device__ __forceinline__ float bflo(unsigned w) { return __uint_as_float(w << 16); }
__device__ __forceinline__ float bfhi(unsigned w) { return __uint_as_float(w & 0xffff0000u); }
__device__ __forceinline__ void unpack8(const u32x4 w, float (&f)[8]) { f[0] = bflo(w.x); f[1] = bfhi(w.x); f[2] = bflo(w.y); f[3] = bfhi(w.y); f[4] = bflo(w.z); f[5] = bfhi(w.z); f[6] = bflo(w.w); f[7] = bfhi(w.w); }
__device__ __forceinline__ u32x4 pack8(const float (&f)[8]) { u32x4 w; w.x = cvt_pk_bf16(f[0], f[1]); w.y = cvt_pk_bf16(f[2], f[3]); w.z = cvt_pk_bf16(f[4], f[5]); w.w = cvt_pk_bf16(f[6], f[7]); return w; }
__device__ __forceinline__ float sat8(float x) { return __builtin_amdgcn_fmed3f(x, -448.0f, 448.0f); }
__device__ __forceinline__ int pk4_fp8(float a, float b, float c, float d) { int w = 0; w = __builtin_amdgcn_cvt_pk_fp8_f32(sat8(a), sat8(b), w, false); w = __builtin_amdgcn_cvt_pk_fp8_f32(sat8(c), sat8(d), w, true); return w; }
__device__ __forceinline__ u32x2 pack8_fp8(const float (&f)[8]) { int a = 0, b = 0;
    a = pk4_fp8(f[0], f[1], f[2], f[3]); b = pk4_fp8(f[4], f[5], f[6], f[7]); u32x2 w; w.x = (unsigned)a; w.y = (unsigned)b; return w; }
__device__ __forceinline__ float sigmoidf_(float x) { return __builtin_amdgcn_rcpf(1.0f + __builtin_amdgcn_exp2f(-1.4426950408889634f * x)); }
__device__ __forceinline__ float wave_sum(float v) {
#pragma unroll
    for (int o = 1; o < 64; o <<= 1) v += __shfl_xor(v, o);
    return v;
}
#define LDS_WAIT() asm volatile("s_waitcnt lgkmcnt(0)" ::: "memory")
#define VM_WAIT() asm volatile("s_waitcnt vmcnt(0)" ::: "memory")

#define XB_TMO      128
#define XB_XCNT(j)  (256  + 64 * (j))
#define XB_XSUB(j)  (1280 + 64 * (j))
#define XB_XGEN(j)  (2304 + 64 * (j))
#define XB_TOP      3328
#define XB_TOPGEN   3392
#define XCD_BAR_WORDS 3456
#define XB_SPIN_CAP (1u << 18)

__device__ __forceinline__ unsigned xb_ld(unsigned* p)              { return __hip_atomic_load(p, __ATOMIC_RELAXED, __HIP_MEMORY_SCOPE_AGENT); }
__device__ __forceinline__ unsigned xb_add(unsigned* p, unsigned v) { return __hip_atomic_fetch_add(p, v, __ATOMIC_RELAXED, __HIP_MEMORY_SCOPE_AGENT); }
__device__ __forceinline__ unsigned xb_xcc_id() { return (unsigned)__builtin_amdgcn_s_getreg((3 << 11) | 20) & 0xFu; }
#define XB_SPIN(cond, bar) do { unsigned _sp = 0; while (cond) { __builtin_amdgcn_s_sleep(1); \
    if ((++_sp & 255u) == 0u) { if (xb_ld(&(bar)[XB_TMO])) break; if (_sp > XB_SPIN_CAP) { atomicAdd(&(bar)[XB_TMO], 1u); break; } } } } while (0)

struct XcdBarrier { unsigned* bar; unsigned x; volatile LAS unsigned* st; };

__device__ __forceinline__ XcdBarrier xcd_barrier_post(unsigned* bar, volatile LAS unsigned* st) {
    XcdBarrier b; b.bar = bar; b.x = xb_xcc_id(); b.st = st;
    if (threadIdx.x == 0) (void)xb_add(&bar[XB_XCNT(b.x)], 1u);
    return b;
}
__device__ __forceinline__ void xcd_barrier_complete(unsigned* bar, unsigned x, unsigned& nloc, unsigned& nx) {
    const unsigned G = gridDim.x * gridDim.y * gridDim.z;
    unsigned sum, cnt, mine, sp = 0u;
    for (;;) {
        sum = 0u; cnt = 0u; mine = 0u;
#pragma unroll
        for (unsigned j = 0; j < 16; ++j) { const unsigned c = xb_ld(&bar[XB_XCNT(j)]); sum += c; cnt += (c > 0u) ? 1u : 0u; mine = (j == x) ? c : mine; }
        if (sum == G) break;
        __builtin_amdgcn_s_sleep(1);
        if ((++sp & 255u) == 0u) { if (xb_ld(&bar[XB_TMO])) break; if (sp > XB_SPIN_CAP) { atomicAdd(&bar[XB_TMO], 1u); break; } }
    }
    nloc = mine > 0u ? mine : 1u; nx = cnt > 0u ? cnt : 1u;
}
__device__ __forceinline__ void xcd_barrier(const XcdBarrier& b, int tid_) {
    asm volatile("s_waitcnt vmcnt(0)" ::: "memory");
    __syncthreads();
    if (tid_ == 0) {
        unsigned* bar = b.bar;
        __builtin_amdgcn_s_waitcnt(0);
        unsigned nloc = b.st[0], nx = b.st[1];
        if (nloc == 0u) { xcd_barrier_complete(bar, b.x, nloc, nx); b.st[0] = nloc; b.st[1] = nx; }
        const unsigned old = xb_add(&bar[XB_XSUB(b.x)], 1u);
        const unsigned gen = old / nloc;
        if (old + 1u == (gen + 1u) * nloc) {
            __builtin_amdgcn_fence(__ATOMIC_RELEASE, "agent");
            asm volatile("s_waitcnt vmcnt(0)" ::: "memory");
            const unsigned og = xb_add(&bar[XB_TOP], 1u);
            const unsigned tg = og / nx;
            if (og + 1u == (tg + 1u) * nx) xb_add(&bar[XB_TOPGEN], 1u);
            else XB_SPIN(xb_ld(&bar[XB_TOPGEN]) == tg, bar);
            __builtin_amdgcn_fence(__ATOMIC_ACQUIRE, "agent");
            xb_add(&bar[XB_XGEN(b.x)], 1u);
            asm volatile("s_waitcnt vmcnt(0)" ::: "memory");
        } else {
            XB_SPIN(xb_ld(&bar[XB_XGEN(b.x)]) == gen, bar);
            __builtin_amdgcn_fence(__ATOMIC_ACQUIRE, "agent");
            asm volatile("s_waitcnt vmcnt(0)" ::: "memory");
        }
    }
    __syncthreads();
}

namespace pg8 {
constexpr int BM = 256, BK = 64, HALF = 128, HTB = HALF * BK * 2, STAGE_BYTES = 8 * HTB, NXCD = 8, WGM = 8;
__host__ __device__ __forceinline__ int lds_byte(int r, int c) { const int st = (r >> 4) * 2 + (c >> 5), rr = r & 15, cc = c & 31, ob = rr * 64 + cc * 2; return st * 1024 + (ob ^ (((ob >> 9) & 1) << 5)); }
__host__ __device__ __forceinline__ void stage_rc(int b, int& R, int& C) { const int st = b / 1024, sb = b % 1024, swz = sb ^ (((sb >> 9) & 1) << 5); R = (st >> 1) * 16 + swz / 64; C = (st & 1) * 32 + (swz % 64) / 2; }
__host__ __device__ __forceinline__ int perm32(int rho) { const int n = rho >> 4, i = rho & 15; return 8 * (i >> 2) + 4 * n + (i & 3); }

struct Unit { int pm, pn, e, jl, cnt, koff; };
struct Gemm { const bf16_t* A; const bf16_t* Bt; int K; size_t bstride; const int* tokl; int ntov; };

struct StaticOrder {
    int nM, nN, nwg, G, c;
    __device__ void init(int M, int N, int G_, int c_) { nM = M / BM; nN = N / BM; nwg = nM * nN; G = G_; c = c_; }
    __device__ bool next(int i, Unit& u) const {
        const long L = (long)i * G + c; if (L >= nwg) return false;
        int wgid = (int)L; { const int q = nwg / NXCD, r = nwg % NXCD, xcd = wgid % NXCD, off = wgid / NXCD; wgid = (xcd < r ? xcd * (q + 1) : r * (q + 1) + (xcd - r) * q) + off; }
        const int nig = WGM * nN, gid = wgid / nig, fm = gid * WGM, gsz = (nM - fm) < WGM ? (nM - fm) : WGM;
        u.pm = fm + ((wgid % nig) % gsz); u.pn = (wgid % nig) / gsz; u.e = 0; u.jl = 0; u.cnt = 0; u.koff = 0; return true;
    }
};
struct DynOrder : StaticOrder {
    __device__ bool next(int i, Unit& u) const { if (!StaticOrder::next(i, u)) return false; u.koff = (u.pn < 8 ? 0 : (u.pn < 16 ? 128 : 256)) * 2; return true; }
};
struct MoeOrder {
    const LAS int* tb; const LAS int* cn; int G, c, ntot;
    __device__ bool next(int i, Unit& u) const {
        const long L = (long)i * G + c; if (L >= (long)ntot * 8) return false;
        const int mt = (int)(L >> 3); int e = 0;
#pragma unroll
        for (int k = 1; k < 16; ++k) e += (mt >= tb[k]) ? 1 : 0;
        e = __builtin_amdgcn_readfirstlane(e);
        u.koff = 0; u.pm = mt; u.pn = (int)(L & 7); u.e = e; u.jl = __builtin_amdgcn_readfirstlane(mt - tb[e]); u.cnt = __builtin_amdgcn_readfirstlane(cn[e]); return true;
    }
};

typedef int i32x8 __attribute__((ext_vector_type(8)));
typedef int i32x4_ __attribute__((ext_vector_type(4)));
template <class Epi, class Sched, bool GATHER, bool FP8 = false>
__device__ __forceinline__ void gemm_phase(LAS unsigned char* lds, const Gemm g, const Sched& S, const Epi& E, const int tid) {
    const int wid = __builtin_amdgcn_readfirstlane(tid >> 6), lane = tid & 63, wr = wid >> 2, wc = wid & 3, fr = lane & 15, fq = lane >> 4;
    const int K = FP8 ? (g.K >> 1) : g.K, nt = g.ntov ? g.ntov : K / BK;
    unsigned voffA[2], voffB[2]; int Rr[2], Cc[2];
#pragma unroll
    for (int i = 0; i < 2; ++i) { int R, C; stage_rc(tid * 16 + i * 8192, R, C); const int Rb = Epi::PERM ? ((R & ~31) + perm32(R & 31)) : R;
        voffA[i] = (unsigned)(R * K + C) * 2u; voffB[i] = (unsigned)(Rb * K + C) * 2u; Rr[i] = R; Cc[i] = C; }
    const size_t kstep = (size_t)(BK * 2);
    const size_t hstep = (size_t)HALF * K * 2;
    const size_t tstep = 2 * hstep;
    const unsigned ldsw = (unsigned)wid * 1024u;
    const int aoff = lds_byte(wr * 64 + fr, fq * 8), boff = lds_byte(wc * 32 + fr, fq * 8);
#define PG8_SA(b, h) (((b) * 2 + (h)) * HTB)
#define PG8_SB(b, h) ((4 + (b) * 2 + (h)) * HTB)
#define PG8_STAGE(bufoff, gbase, voff) do { _Pragma("unroll") for (int _i = 0; _i < 2; ++_i) \
        __builtin_amdgcn_global_load_lds((const unsigned*)((const char*)(gbase) + (voff)[_i]), (LAS unsigned*)(lds + (bufoff) + ldsw + _i * 8192), 16, 0, 0); } while (0)
#define PG8_LDA(dst, b, h) do { _Pragma("unroll") for (int m = 0; m < 4; ++m) _Pragma("unroll") for (int k = 0; k < 2; ++k) dst[m][k] = *(const LAS bf16x8*)(lds + PG8_SA(b, h) + aoff + m * 2048 + k * 1024); } while (0)
#define PG8_LDB(dst, b, h) do { _Pragma("unroll") for (int n = 0; n < 2; ++n) _Pragma("unroll") for (int k = 0; k < 2; ++k) dst[n][k] = *(const LAS bf16x8*)(lds + PG8_SB(b, h) + boff + n * 2048 + k * 1024); } while (0)
#define PG8_CAT(x) __builtin_shufflevector(__builtin_bit_cast(i32x4_, (x)[0]), __builtin_bit_cast(i32x4_, (x)[1]), 0, 1, 2, 3, 4, 5, 6, 7)
#define PG8_MMA(ai, bj, At, Bt) do { __builtin_amdgcn_s_setprio(1); \
        if constexpr (FP8) { _Pragma("unroll") for (int m = 0; m < 4; ++m) _Pragma("unroll") for (int n = 0; n < 2; ++n) \
            { const i32x8 b8_ = PG8_CAT(Bt[n]), a8_ = PG8_CAT(At[m]); \
              asm volatile("v_mfma_scale_f32_16x16x128_f8f6f4 %0, %1, %2, %0, %3, %3 op_sel_hi:[0,0,0]" : "+v"(acc[ai][bj][m][n]) : "v"(b8_), "v"(a8_), "v"(0x7F7F7F7F)); } } \
        else { _Pragma("unroll") for (int m = 0; m < 4; ++m) _Pragma("unroll") for (int n = 0; n < 2; ++n) _Pragma("unroll") for (int k = 0; k < 2; ++k) \
            acc[ai][bj][m][n] = __builtin_amdgcn_mfma_f32_16x16x32_bf16(Bt[n][k], At[m][k], acc[ai][bj][m][n], 0, 0, 0); } \
        __builtin_amdgcn_s_setprio(0); } while (0)
#define PG8_WAIT_V(n) asm volatile("s_waitcnt vmcnt(" #n ")" ::: "memory")
#define PG8_WAIT_L(n) asm volatile("s_waitcnt lgkmcnt(" #n ")" ::: "memory")
#define PG8_BAR __builtin_amdgcn_s_barrier()
#define PG8_SCHED __builtin_amdgcn_sched_barrier(0)
#define PG8_GOFF(dst, u) do { _Pragma("unroll") for (int _h = 0; _h < 2; ++_h) _Pragma("unroll") for (int _i = 0; _i < 2; ++_i) { \
        const int _slot = (u).jl * 256 + _h * 128 + Rr[_i]; const int _tok = (_slot < (u).cnt) ? g.tokl[(u).e * TOKCAP + _slot] : 0; dst[_h][_i] = (unsigned)(_tok * K + Cc[_i]) * 2u; } } while (0)
    Unit cur, nxt; int ui = 0;
    if (!S.next(0, cur)) return;
    f32x4 acc[2][2][4][2];
#pragma unroll
    for (int a = 0; a < 2; ++a)
#pragma unroll
        for (int b = 0; b < 2; ++b)
#pragma unroll
            for (int m = 0; m < 4; ++m)
#pragma unroll
                for (int n = 0; n < 2; ++n) acc[a][b][m][n] = (f32x4){0.f, 0.f, 0.f, 0.f};
    bf16x8 At[4][2], B0[2][2], B1[2][2];
    const char* Ab = (const char*)g.A;
    const char* cA = Ab + (size_t)cur.pm * tstep + cur.koff; const char* cB = (const char*)g.Bt + (size_t)cur.e * g.bstride + (size_t)cur.pn * tstep + cur.koff;
    unsigned offc[2][2], offn[2][2];
    if constexpr (GATHER) { PG8_GOFF(offc, cur); }
#define PG8_STA_C(bufoff, h, kb) do { if constexpr (GATHER) { PG8_STAGE(bufoff, Ab + (kb), offc[h]); } else { PG8_STAGE(bufoff, cA + (h) * hstep + (kb), voffA); } } while (0)
    PG8_STAGE(PG8_SB(0, 0), cB, voffB); PG8_STAGE(PG8_SB(0, 1), cB + hstep, voffB); PG8_STA_C(PG8_SA(0, 0), 0, 0); PG8_STA_C(PG8_SA(0, 1), 1, 0);
    if (wr == 1) PG8_BAR;
    PG8_WAIT_V(2); PG8_BAR;
    PG8_STAGE(PG8_SB(1, 0), cB + kstep, voffB); PG8_STA_C(PG8_SA(1, 0), 0, kstep); PG8_STAGE(PG8_SB(1, 1), cB + hstep + kstep, voffB);
    PG8_WAIT_V(6); PG8_BAR;
    for (;;) {
        const bool has_next = S.next(ui + 1, nxt);
        const char* nA = has_next ? Ab + (size_t)nxt.pm * tstep + nxt.koff : cA; const char* nB = has_next ? (const char*)g.Bt + (size_t)nxt.e * g.bstride + (size_t)nxt.pn * tstep + nxt.koff : cB;
        if constexpr (GATHER) {
            if (has_next) { PG8_GOFF(offn, nxt); }
            else {
#pragma unroll
                for (int h = 0; h < 2; ++h)
#pragma unroll
                    for (int i = 0; i < 2; ++i) offn[h][i] = offc[h][i]; }
        }
        for (int t = 0; t < nt; t += 2) {
            const bool last = (t == nt - 2);
            const size_t kb1 = (size_t)(t + 1) * kstep;
            const char* b2 = last ? nB : cB + (size_t)(t + 2) * kstep; const char* b3 = b2 + kstep;
            const char* a2 = last ? nA : cA + (size_t)(t + 2) * kstep; const char* a3 = a2 + kstep;
            unsigned o2[2][2]; size_t kb2 = last ? 0 : (size_t)(t + 2) * kstep;
            if constexpr (GATHER) {
#pragma unroll
                for (int h = 0; h < 2; ++h)
#pragma unroll
                    for (int i = 0; i < 2; ++i) o2[h][i] = last ? offn[h][i] : offc[h][i];
            }
#define PG8_STA_2(bufoff, h, extra) do { if constexpr (GATHER) { PG8_STAGE(bufoff, Ab + kb2 + (extra), o2[h]); } else { PG8_STAGE(bufoff, a2 + (h) * hstep + (extra), voffA); } } while (0)
            PG8_LDB(B0, 0, 0); PG8_LDB(B1, 0, 1); PG8_SCHED; PG8_LDA(At, 0, 0); PG8_STA_C(PG8_SA(1, 1), 1, kb1);
            PG8_WAIT_V(8); PG8_WAIT_L(0); PG8_BAR; PG8_MMA(0, 0, At, B0); PG8_MMA(0, 1, At, B1); PG8_BAR; PG8_SCHED;
            PG8_LDA(At, 0, 1); PG8_STAGE(PG8_SB(0, 0), b2, voffB); PG8_STAGE(PG8_SB(0, 1), b2 + hstep, voffB); PG8_STA_2(PG8_SA(0, 0), 0, 0);
            PG8_WAIT_V(8); PG8_WAIT_L(0); PG8_BAR; PG8_MMA(1, 0, At, B0); PG8_MMA(1, 1, At, B1); PG8_BAR; PG8_SCHED;
            PG8_LDB(B0, 1, 0); PG8_LDB(B1, 1, 1); PG8_SCHED; PG8_LDA(At, 1, 0); PG8_STA_2(PG8_SA(0, 1), 1, 0);
            PG8_WAIT_V(8); PG8_WAIT_L(0); PG8_BAR; PG8_MMA(0, 0, At, B0); PG8_MMA(0, 1, At, B1); PG8_BAR; PG8_SCHED;
            PG8_LDA(At, 1, 1); PG8_STAGE(PG8_SB(1, 0), b3, voffB); PG8_STAGE(PG8_SB(1, 1), b3 + hstep, voffB); PG8_STA_2(PG8_SA(1, 0), 0, kstep);
            PG8_WAIT_V(8); PG8_WAIT_L(0); PG8_BAR; PG8_MMA(1, 0, At, B0); PG8_MMA(1, 1, At, B1); PG8_BAR; PG8_SCHED;
#undef PG8_STA_2
            (void)a3;
        }
        if (wr == 0) PG8_BAR;
        { int l2 = lane; asm volatile("" : "+v"(l2)); E(acc, cur, wr, wc, l2 & 15, l2 >> 4); }
        if (!has_next) break;
#pragma unroll
        for (int a = 0; a < 2; ++a)
#pragma unroll
            for (int b = 0; b < 2; ++b)
#pragma unroll
                for (int m = 0; m < 4; ++m)
#pragma unroll
                    for (int n = 0; n < 2; ++n) acc[a][b][m][n] = (f32x4){0.f, 0.f, 0.f, 0.f};
        cur = nxt; cA = nA; cB = nB; ++ui;
        if constexpr (GATHER) {
#pragma unroll
            for (int h = 0; h < 2; ++h)
#pragma unroll
                for (int i = 0; i < 2; ++i) offc[h][i] = offn[h][i];
        }
        if (wr == 1) PG8_BAR;
    }
    PG8_WAIT_V(0);
    PG8_BAR;
#undef PG8_STA_C
#undef PG8_GOFF
#undef PG8_SA
#undef PG8_SB
#undef PG8_STAGE
#undef PG8_LDA
#undef PG8_LDB
#undef PG8_MMA
#undef PG8_CAT
#undef PG8_WAIT_V
#undef PG8_WAIT_L
#undef PG8_BAR
#undef PG8_SCHED
}

struct EpiProj {
    static constexpr bool PERM = true;
    bf16_t* O; const float* rope; float inv;
    __device__ __forceinline__ void operator()(const f32x4 (&acc)[2][2][4][2], const Unit& u, int wr, int wc, int fr, int fq) const {
        const int row0 = u.pm * BM + wr * 64 + fr, col0 = u.pn * BM + wc * 32 + 8 * fq;
        const bool dorope = (u.pn < 8) && ((wc & 1) == 0) && (fq < 2);
        const float sc = ((u.pn < 4) ? C2 : 1.0f) * inv;
#pragma unroll
        for (int ai = 0; ai < 2; ++ai)
#pragma unroll
            for (int m = 0; m < 4; ++m) {
                const int row = row0 + ai * HALF + m * 16;
                bf16_t* rowp = O + (size_t)row * NPROJP + col0;
                f32x4 cs = (f32x4){1.f, 1.f, 1.f, 1.f}, sn = (f32x4){0.f, 0.f, 0.f, 0.f};
                if (dorope) { cs = *(const f32x4*)(rope + (size_t)row * 16 + 4 * fq); sn = *(const f32x4*)(rope + (size_t)row * 16 + 8 + 4 * fq); }
#pragma unroll
                for (int bj = 0; bj < 2; ++bj) {
                    f32x4 v0 = acc[ai][bj][m][0], v1 = acc[ai][bj][m][1];
                    const f32x4 r0 = (v0 * cs - v1 * sn) * sc, r1 = (v1 * cs + v0 * sn) * sc;
                    u32x4 w; w.x = cvt_pk_bf16(r0[0], r0[1]); w.y = cvt_pk_bf16(r0[2], r0[3]); w.z = cvt_pk_bf16(r1[0], r1[1]); w.w = cvt_pk_bf16(r1[2], r1[3]);
                    *(u32x4*)(rowp + bj * HALF) = w; }
            }
    }
};
struct EpiDyn {
    static constexpr bool PERM = true;
    bf16_t* O; const float* w0; const float* a0;
    __device__ __forceinline__ void operator()(const f32x4 (&acc)[2][2][4][2], const Unit& u, int wr, int wc, int fr, int fq) const {
        const int row0 = u.pm * BM + wr * 64 + fr, col0 = u.pn * BM + wc * 32 + 8 * fq;
        const int kind = u.pn >> 3;
        const float* bsrc = (kind == 0) ? (w0 + col0) : (a0 + (col0 - 2048));
#pragma unroll
        for (int bj = 0; bj < 2; ++bj) {
            f32x4 b0 = (f32x4){0.f, 0.f, 0.f, 0.f}, b1 = b0;
            if (kind < 2) { b0 = *(const f32x4*)(bsrc + bj * HALF); b1 = *(const f32x4*)(bsrc + bj * HALF + 4); }
#pragma unroll
            for (int ai = 0; ai < 2; ++ai)
#pragma unroll
                for (int m = 0; m < 4; ++m) {
                    f32x4 v0 = acc[ai][bj][m][0] + b0, v1 = acc[ai][bj][m][1] + b1;
                    if (kind < 2) {
#pragma unroll
                        for (int j = 0; j < 4; ++j) { float s0 = sigmoidf_(v0[j]), s1 = sigmoidf_(v1[j]);
                            if (kind == 0) { s0 = __builtin_amdgcn_exp2f(-0.875039f * s0); s1 = __builtin_amdgcn_exp2f(-0.875039f * s1); }
                            v0[j] = s0; v1[j] = s1; } }
                    u32x4 w; w.x = cvt_pk_bf16(v0[0], v0[1]); w.y = cvt_pk_bf16(v0[2], v0[3]); w.z = cvt_pk_bf16(v1[0], v1[1]); w.w = cvt_pk_bf16(v1[2], v1[3]);
                    *(u32x4*)(O + (size_t)(row0 + ai * HALF + m * 16) * NDYN + col0 + bj * HALF) = w;
                    __builtin_amdgcn_sched_barrier(0); }
        }
    }
};
struct EpiRes {
    static constexpr bool PERM = true;
    const float* xin32; bf16_t* X; const float* g1; float inv;
    __device__ __forceinline__ void operator()(const f32x4 (&acc)[2][2][4][2], const Unit& u, int wr, int wc, int fr, int fq) const {
        const int row0 = u.pm * BM + wr * 64 + fr, col0 = u.pn * BM + wc * 32 + 8 * fq;
        const int b = (u.pm * BM) / SEQ;
        f32x4 gv[2][2];
#pragma unroll
        for (int bj = 0; bj < 2; ++bj)
#pragma unroll
            for (int n = 0; n < 2; ++n) gv[bj][n] = *(const f32x4*)(g1 + (size_t)b * NMOD + col0 + bj * HALF + 4 * n) * inv;
#pragma unroll
        for (int ai = 0; ai < 2; ++ai)
#pragma unroll
            for (int m = 0; m < 4; ++m) { const size_t off = (size_t)(row0 + ai * HALF + m * 16) * DM + col0;
#pragma unroll
                for (int bj = 0; bj < 2; ++bj) { f32x4 x0, x1;
                    if (xin32) { x0 = *(const f32x4*)(xin32 + off + bj * HALF); x1 = *(const f32x4*)(xin32 + off + bj * HALF + 4); }
                    else { const u32x4 p = *(const u32x4*)(X + off + bj * HALF); x0 = (f32x4){bflo(p.x), bfhi(p.x), bflo(p.y), bfhi(p.y)}; x1 = (f32x4){bflo(p.z), bfhi(p.z), bflo(p.w), bfhi(p.w)}; }
                    const f32x4 r0 = x0 + gv[bj][0] * acc[ai][bj][m][0], r1 = x1 + gv[bj][1] * acc[ai][bj][m][1];
                    u32x4 w; w.x = cvt_pk_bf16(r0[0], r0[1]); w.y = cvt_pk_bf16(r0[2], r0[3]); w.z = cvt_pk_bf16(r1[0], r1[1]); w.w = cvt_pk_bf16(r1[2], r1[3]);
                    *(u32x4*)(X + off + bj * HALF) = w; } }
    }
};
struct EpiGlu {
    static constexpr bool PERM = true;
    unsigned char* O; float inv;
    __device__ __forceinline__ void operator()(const f32x4 (&acc)[2][2][4][2], const Unit& u, int wr, int wc, int fr, int fq) const {
        const int row0 = u.pm * BM + wr * 64 + fr, j0 = u.pn * 128 + wc * 16 + 4 * fq;
#pragma unroll
        for (int ai = 0; ai < 2; ++ai)
#pragma unroll
            for (int m = 0; m < 4; ++m) { unsigned char* rowp = O + (size_t)(row0 + ai * HALF + m * 16) * DFF + j0;
#pragma unroll
                for (int bj = 0; bj < 2; ++bj) { const f32x4 gt = acc[ai][bj][m][0] * inv, up = acc[ai][bj][m][1] * inv; f32x4 r;
#pragma unroll
                    for (int j = 0; j < 4; ++j) r[j] = gt[j] * sigmoidf_(gt[j]) * up[j];
                    *(int*)(rowp + bj * 64) = pk4_fp8(r[0], r[1], r[2], r[3]); } }
    }
};
struct EpiY {
    static constexpr bool PERM = true;
    unsigned char* O; float inv;
    __device__ __forceinline__ void operator()(const f32x4 (&acc)[2][2][4][2], const Unit& u, int wr, int wc, int fr, int fq) const {
        const int row0 = u.pm * BM + wr * 64 + fr, col0 = u.pn * BM + wc * 32 + 8 * fq;
#pragma unroll
        for (int ai = 0; ai < 2; ++ai)
#pragma unroll
            for (int m = 0; m < 4; ++m) { unsigned char* rowp = O + (size_t)(row0 + ai * HALF + m * 16) * DM + col0;
#pragma unroll
                for (int bj = 0; bj < 2; ++bj) { const f32x4 v0 = acc[ai][bj][m][0] * inv, v1 = acc[ai][bj][m][1] * inv;
                    u32x2 w; w.x = (unsigned)pk4_fp8(v0[0], v0[1], v0[2], v0[3]); w.y = (unsigned)pk4_fp8(v1[0], v1[1], v1[2], v1[3]);
                    *(u32x2*)(rowp + bj * HALF) = w; } }
    }
};
}

namespace attn {
constexpr int KVBLK = 64;
constexpr size_t SHM_V = KVBLK * 128 * 2, SHM_K = KVBLK * 128 * 2;
constexpr int WS_OFF = 3 * SHM_V + 3 * SHM_K;
constexpr float THRL = 8.0f;
#define KSWZ(row, colB) ((row) * 256 + ((colB) ^ (((row) & 7) << 4)))
#define SBAR() __builtin_amdgcn_sched_barrier(0)
__device__ __forceinline__ int crow(int r, int hi) { return (r & 3) + 8 * (r >> 2) + 4 * hi; }

__device__ __forceinline__ void partialSM(f32x16& p0, f32x16& p1, float& m_reg, float& mn, float& alpha) {
    float pmax = p0[0];
#pragma unroll
    for (int r = 1; r < 16; ++r) pmax = fmaxf(pmax, p0[r]);
#pragma unroll
    for (int r = 0; r < 16; ++r) pmax = fmaxf(pmax, p1[r]);
    { auto rr = __builtin_amdgcn_permlane32_swap(__float_as_uint(pmax), __float_as_uint(pmax), false, false);
      pmax = fmaxf(__uint_as_float(rr[0]), __uint_as_float(rr[1])); }
    if (__builtin_expect(__all(pmax - m_reg <= THRL), 1)) { mn = m_reg; alpha = 1.f; }
    else { mn = fmaxf(m_reg, pmax); alpha = __builtin_amdgcn_exp2f(m_reg - mn); m_reg = mn; }
#pragma unroll
    for (int r = 0; r < 16; ++r) p0[r] = p0[r] - mn;
#pragma unroll
    for (int r = 0; r < 16; ++r) p1[r] = p1[r] - mn;
#pragma unroll
    for (int r = 0; r < 16; ++r) p0[r] = __builtin_amdgcn_exp2f(p0[r]);
}
__device__ __forceinline__ void finishSM(f32x16& p0, f32x16& p1, float alpha, float& l_reg, bf16x8& pa0, bf16x8& pa1, bf16x8& pa2, bf16x8& pa3) {
#pragma unroll
    for (int r = 0; r < 16; ++r) p1[r] = __builtin_amdgcn_exp2f(p1[r]);
    float ps = 0;
#pragma unroll
    for (int r = 0; r < 16; ++r) ps += p0[r];
#pragma unroll
    for (int r = 0; r < 16; ++r) ps += p1[r];
    { auto rr = __builtin_amdgcn_permlane32_swap(__float_as_uint(ps), __float_as_uint(ps), false, false);
      ps = __uint_as_float(rr[0]) + __uint_as_float(rr[1]); }
    l_reg = l_reg * alpha + ps;
#define PK4(P, BASE, OUT) do { u32x4 w = {cvt_pk_bf16(P[BASE + 0], P[BASE + 1]), cvt_pk_bf16(P[BASE + 2], P[BASE + 3]), cvt_pk_bf16(P[BASE + 4], P[BASE + 5]), cvt_pk_bf16(P[BASE + 6], P[BASE + 7])}; \
    OUT = *reinterpret_cast<bf16x8*>(&w); } while (0)
    PK4(p0, 0, pa0); PK4(p0, 8, pa1); PK4(p1, 0, pa2); PK4(p1, 8, pa3);
#undef PK4
}
__device__ __forceinline__ void qkt(f32x16& p0, f32x16& p1, const char* Ks, const bf16x8* qr, int r32, int hi, int comp) {
    p0 = f32x16{}; p1 = f32x16{};
#pragma unroll
    for (int d0 = 0; d0 < 4; ++d0) { const int cb = ((comp * 4 + d0) * 16 + hi * 8) * 2;
        bf16x8 b0 = *reinterpret_cast<const bf16x8*>(Ks + KSWZ(r32, cb));
        bf16x8 b1 = *reinterpret_cast<const bf16x8*>(Ks + KSWZ(32 + r32, cb));
        p0 = __builtin_amdgcn_mfma_f32_32x32x16_bf16(b0, qr[d0], p0, 0, 0, 0);
        p1 = __builtin_amdgcn_mfma_f32_32x32x16_bf16(b1, qr[d0], p1, 0, 0, 0); }
}
__device__ __forceinline__ void qk_sm(f32x16& n0, f32x16& n1, const char* Ks, const bf16x8* qr, int r32, int hi, int comp,
                                      f32x16& p0, f32x16& p1, float alpha, float& l_reg, bf16x8& pa0, bf16x8& pa1, bf16x8& pa2, bf16x8& pa3) {
#define LDKF(D0, R) *reinterpret_cast<const bf16x8*>(Ks + KSWZ((R), ((comp * 4 + (D0)) * 16 + hi * 8) * 2))
#define EX2(P, B) P[B] = __builtin_amdgcn_exp2f(P[B]); P[B + 1] = __builtin_amdgcn_exp2f(P[B + 1]); asm volatile("" : "+v"(P[B]), "+v"(P[B + 1]))
#define QMF(N, KF, D0) SBAR(); N = __builtin_amdgcn_mfma_f32_32x32x16_bf16(KF, qr[D0], N, 0, 0, 0); SBAR()
    SBAR();
    const bf16x8 k00 = LDKF(0, r32), k01 = LDKF(0, 32 + r32), k10 = LDKF(1, r32), k11 = LDKF(1, 32 + r32);
    SBAR();
    EX2(p1, 0); EX2(p1, 2); EX2(p1, 4); EX2(p1, 6);
    SBAR(); n0 = __builtin_amdgcn_mfma_f32_32x32x16_bf16(k00, qr[0], f32x16{}, 0, 0, 0); SBAR();
    EX2(p1, 8);
    SBAR(); n1 = __builtin_amdgcn_mfma_f32_32x32x16_bf16(k01, qr[0], f32x16{}, 0, 0, 0); SBAR();
    EX2(p1, 10);
    const bf16x8 k20 = LDKF(2, r32), k21 = LDKF(2, 32 + r32);
    QMF(n0, k10, 1); EX2(p1, 12);
    QMF(n1, k11, 1); EX2(p1, 14);
    const bf16x8 k30 = LDKF(3, r32), k31 = LDKF(3, 32 + r32);
    QMF(n0, k20, 2);
    float s0 = p0[0] + p0[1], s1 = p0[2] + p0[3]; s0 += p0[4]; s1 += p0[5]; s0 += p0[6]; s1 += p0[7]; s0 += p0[8]; s1 += p0[9];
    QMF(n1, k21, 2);
    s0 += p0[10]; s1 += p0[11]; s0 += p0[12]; s1 += p0[13]; s0 += p0[14]; s1 += p0[15]; s0 += p1[0]; s1 += p1[1];
    QMF(n0, k30, 3);
    s0 += p1[2]; s1 += p1[3]; s0 += p1[4]; s1 += p1[5]; s0 += p1[6]; s1 += p1[7]; s0 += p1[8]; s1 += p1[9];
    QMF(n1, k31, 3);
    s0 += p1[10]; s1 += p1[11]; s0 += p1[12]; s1 += p1[13]; s0 += p1[14]; s1 += p1[15]; float ps = s0 + s1;
    { auto rr = __builtin_amdgcn_permlane32_swap(__float_as_uint(ps), __float_as_uint(ps), false, false);
      ps = __uint_as_float(rr[0]) + __uint_as_float(rr[1]); }
    l_reg = l_reg * alpha + ps;
#define PK4(P, BASE, OUT) do { u32x4 w = {cvt_pk_bf16(P[BASE + 0], P[BASE + 1]), cvt_pk_bf16(P[BASE + 2], P[BASE + 3]), cvt_pk_bf16(P[BASE + 4], P[BASE + 5]), cvt_pk_bf16(P[BASE + 6], P[BASE + 7])}; \
    OUT = *reinterpret_cast<bf16x8*>(&w); } while (0)
    PK4(p0, 0, pa0); PK4(p0, 8, pa1); PK4(p1, 0, pa2); PK4(p1, 8, pa3);
    SBAR();
#undef PK4
#undef LDKF
#undef EX2
#undef QMF
}
__device__ __forceinline__ int v_st(int k, int c) { const int kk = k; return ((kk >> 3) * 4 + (c >> 5)) * 512 + ((kk & 7) * 32 + (c & 31)) * 2; }
__device__ __forceinline__ int v_rd_base(int lane) { return ((lane & 3) << 3) | (((lane >> 2) & 3) << 6) | (((lane >> 4) & 1) << 5) | (((lane >> 5) & 1) << 8); }
constexpr int v_rd_off(int d0, int ks, int half) { return d0 * 512 + ks * 4096 + half * 2048; }
template <int OFF> __device__ __forceinline__ s16x4 tr_read(int vb) {
    s16x4 r; asm volatile("ds_read_b64_tr_b16 %0, %1 offset:%2" : "=&v"(r) : "v"(vb), "i"(OFF) : "memory"); return r;
}
template <int D0> __device__ __forceinline__ void pv_one(f32x16& od, int vb, bf16x8 pa0, bf16x8 pa1, bf16x8 pa2, bf16x8 pa3) {
    const s16x4 l0 = tr_read<v_rd_off(D0, 0, 0)>(vb), h0 = tr_read<v_rd_off(D0, 0, 1)>(vb), l1 = tr_read<v_rd_off(D0, 1, 0)>(vb), h1 = tr_read<v_rd_off(D0, 1, 1)>(vb);
    const s16x4 l2 = tr_read<v_rd_off(D0, 2, 0)>(vb), h2 = tr_read<v_rd_off(D0, 2, 1)>(vb), l3 = tr_read<v_rd_off(D0, 3, 0)>(vb), h3 = tr_read<v_rd_off(D0, 3, 1)>(vb);
    asm volatile("s_waitcnt lgkmcnt(0)" ::: "memory"); SBAR();
#define PK(L, H) (bf16x8){L[0], L[1], L[2], L[3], H[0], H[1], H[2], H[3]}
    od = __builtin_amdgcn_mfma_f32_32x32x16_bf16(pa0, PK(l0, h0), od, 0, 0, 0);
    od = __builtin_amdgcn_mfma_f32_32x32x16_bf16(pa1, PK(l1, h1), od, 0, 0, 0);
    od = __builtin_amdgcn_mfma_f32_32x32x16_bf16(pa2, PK(l2, h2), od, 0, 0, 0);
    od = __builtin_amdgcn_mfma_f32_32x32x16_bf16(pa3, PK(l3, h3), od, 0, 0, 0);
#undef PK
}
__device__ __forceinline__ void pv_d0(f32x16* o, int vb, bf16x8 pa0, bf16x8 pa1, bf16x8 pa2, bf16x8 pa3) {
    pv_one<0>(o[0], vb, pa0, pa1, pa2, pa3); pv_one<1>(o[1], vb, pa0, pa1, pa2, pa3); pv_one<2>(o[2], vb, pa0, pa1, pa2, pa3); pv_one<3>(o[3], vb, pa0, pa1, pa2, pa3);
}
template <class Mid> __device__ __forceinline__ void pv_sm(f32x16* o, int vb, bf16x8 pa0, bf16x8 pa1, bf16x8 pa2, bf16x8 pa3, f32x16& p0, f32x16& p1, float& m_reg, float& mn, float& alpha, Mid mid) {
#define TRD(D0, KS, H) tr_read<v_rd_off(D0, KS, H)>(vb)
#define PKV(L, H) (bf16x8){L[0], L[1], L[2], L[3], H[0], H[1], H[2], H[3]}
#define MF(D0, PA, L, H) SBAR(); o[D0] = __builtin_amdgcn_mfma_f32_32x32x16_bf16(PA, PKV(L, H), o[D0], 0, 0, 0); SBAR()
#define WAITL(n) asm volatile("s_waitcnt lgkmcnt(" #n ")" ::: "memory")
#define MX3(a, b, c) fmaxf(fmaxf(a, b), c)
#define SUB8(P, B) P[B] -= mn; P[B + 1] -= mn; P[B + 2] -= mn; P[B + 3] -= mn; P[B + 4] -= mn; P[B + 5] -= mn; P[B + 6] -= mn; P[B + 7] -= mn; \
    asm volatile("" : "+v"(P[B]), "+v"(P[B + 1]), "+v"(P[B + 2]), "+v"(P[B + 3]), "+v"(P[B + 4]), "+v"(P[B + 5]), "+v"(P[B + 6]), "+v"(P[B + 7]))
#define EX2(P, B) P[B] = __builtin_amdgcn_exp2f(P[B]); P[B + 1] = __builtin_amdgcn_exp2f(P[B + 1]); asm volatile("" : "+v"(P[B]), "+v"(P[B + 1]))
    s16x4 x0, x1, x2, x3, y0, y1, y2, y3, z0, z1, z2, z3, w0, w1, w2, w3;
#define RD4(P, I) P##0 = TRD(((I) & 1) * 2, (I) >> 1, 0); P##1 = TRD(((I) & 1) * 2, (I) >> 1, 1); P##2 = TRD(((I) & 1) * 2 + 1, (I) >> 1, 0); P##3 = TRD(((I) & 1) * 2 + 1, (I) >> 1, 1)
    RD4(x, 0); RD4(y, 1); RD4(z, 2); RD4(w, 3); WAITL(12);
    MF(0, pa0, x0, x1);
    float t0 = MX3(p0[0], p0[1], p0[2]), t1 = MX3(p0[8], p0[9], p0[10]), t2 = MX3(p1[0], p1[1], p1[2]), t3 = MX3(p1[8], p1[9], p1[10]);
    t0 = MX3(t0, p0[3], p0[4]); t1 = MX3(t1, p0[11], p0[12]); t2 = MX3(t2, p1[3], p1[4]); t3 = MX3(t3, p1[11], p1[12]);
    MF(1, pa0, x2, x3);
    t0 = MX3(t0, p0[5], p0[6]); t1 = MX3(t1, p0[13], p0[14]); t2 = MX3(t2, p1[5], p1[6]); t3 = MX3(t3, p1[13], p1[14]);
    t0 = MX3(t0, p0[7], p0[15]); t2 = MX3(t2, p1[7], p1[15]); t0 = MX3(t0, t1, t2); float pmax = fmaxf(t0, t3);
    SBAR(); RD4(x, 4); WAITL(12);
    MF(2, pa0, y0, y1);
    { auto rr = __builtin_amdgcn_permlane32_swap(__float_as_uint(pmax), __float_as_uint(pmax), false, false);
      pmax = fmaxf(__uint_as_float(rr[0]), __uint_as_float(rr[1])); }
    { const bool ok = __all(pmax - m_reg <= THRL); const float mnew = fmaxf(m_reg, pmax); mn = ok ? m_reg : mnew; alpha = __builtin_amdgcn_exp2f(m_reg - mn); m_reg = mn; }
    MF(3, pa0, y2, y3);
    SBAR(); RD4(y, 5); WAITL(12);
    MF(0, pa1, z0, z1); SUB8(p0, 0);
    MF(1, pa1, z2, z3); SUB8(p0, 8);
    SBAR(); RD4(z, 6); WAITL(12);
    MF(2, pa1, w0, w1); SUB8(p1, 0);
    MF(3, pa1, w2, w3); SUB8(p1, 8);
    SBAR(); mid();
    SBAR(); RD4(w, 7); WAITL(12);
    MF(0, pa2, x0, x1); EX2(p0, 0);
    MF(1, pa2, x2, x3); EX2(p0, 2);
    SBAR(); WAITL(8);
    MF(2, pa2, y0, y1); EX2(p0, 4);
    MF(3, pa2, y2, y3); EX2(p0, 6);
    SBAR(); WAITL(4);
    MF(0, pa3, z0, z1); EX2(p0, 8);
    MF(1, pa3, z2, z3); EX2(p0, 10);
    SBAR(); WAITL(0);
    MF(2, pa3, w0, w1); EX2(p0, 12);
    MF(3, pa3, w2, w3); EX2(p0, 14);
    SBAR();
#undef RD4
#undef TRD
#undef PKV
#undef MF
#undef WAITL
#undef MX3
#undef SUB8
#undef EX2
}

__device__ __forceinline__ void attn_unit(const bf16_t* __restrict__ Qb, const bf16_t* __restrict__ Kh, const bf16_t* __restrict__ Vh, bf16_t* __restrict__ Ob,
                                          float lam, float outscale, const float* __restrict__ sub_gain, char* lds, const int tid) {
    constexpr int LDK = NPROJP, seq = SEQ;
    const int wid = tid >> 6, lane = tid & 63, r32 = lane & 31, hi = lane >> 5;
    const int comp = wid & 1, rb = wid >> 1;
    char* V_lds = lds; char* K_lds = lds + 3 * SHM_V;
    float* ws = (float*)(lds + WS_OFF) + wid * 64; float* li_l = ws; float* al_l = ws + 32;
    float m_reg = -1e30f, l_reg = 0; f32x16 o[4] = {}; bf16x8 qr[4];
    const bf16_t* Qw = Qb + (size_t)(rb * 32 + r32) * LDK + comp * 64 + hi * 8;
#pragma unroll
    for (int d0 = 0; d0 < 4; ++d0) qr[d0] = *reinterpret_cast<const bf16x8*>(Qw + d0 * 16);
    const int sr = tid >> 4, sc = (tid & 15) * 8, vst0 = v_st(sr, sc), vst1 = v_st(32 + sr, sc);
    const int vb0 = (int)(uintptr_t)V_lds + v_rd_base(lane);
    bf16x8 vsA0, vsA1, ksA0, ksA1;
#define SLOAD(S, k0) do { vs##S##0 = *reinterpret_cast<const bf16x8*>(&Vh[(size_t)((k0) + sr) * LDK + sc]); vs##S##1 = *reinterpret_cast<const bf16x8*>(&Vh[(size_t)((k0) + 32 + sr) * LDK + sc]); \
    ks##S##0 = *reinterpret_cast<const bf16x8*>(&Kh[(size_t)((k0) + sr) * LDK + sc]); ks##S##1 = *reinterpret_cast<const bf16x8*>(&Kh[(size_t)((k0) + 32 + sr) * LDK + sc]); } while (0)
#define SWRITE(b, S) do { *(bf16x8*)(V_lds + (b) * SHM_V + vst0) = vs##S##0; *(bf16x8*)(V_lds + (b) * SHM_V + vst1) = vs##S##1; const int kc = sc * 2; \
    *(bf16x8*)(K_lds + (b) * SHM_K + KSWZ(sr, kc)) = ks##S##0; *(bf16x8*)(K_lds + (b) * SHM_K + KSWZ(32 + sr, kc)) = ks##S##1; } while (0)
#define SWAIT() asm volatile("s_waitcnt vmcnt(4)" ::: "memory")
#define RESC(a) do { if (__any((a) < 1.f)) { if (hi == 0) al_l[r32] = (a); asm volatile("s_waitcnt lgkmcnt(0)" ::: "memory"); \
    _Pragma("unroll") for (int d = 0; d < 4; ++d) _Pragma("unroll") for (int r = 0; r < 16; ++r) o[d][r] *= al_l[crow(r, hi)]; } } while (0)
    f32x16 pA0, pA1, pB0, pB1; float mnA, mnB, alA, alB; bf16x8 pa0, pa1, pa2, pa3; const int NT = seq / KVBLK;
#define SW0() asm volatile("s_waitcnt vmcnt(0)" ::: "memory")
    SLOAD(A, 0); SW0(); SWRITE(0, A); SLOAD(A, KVBLK); __syncthreads();
    qkt(pA0, pA1, K_lds, qr, r32, hi, comp); partialSM(pA0, pA1, m_reg, mnA, alA);
    SW0(); SWRITE(1, A); SLOAD(A, 2 * KVBLK); __syncthreads();
    int bj = 1;
    for (int j = 1; j + 1 < NT; j += 2) {
        const int bjm1 = (bj == 0) ? 2 : bj - 1, bjp1 = (bj == 2) ? 0 : bj + 1;
        qk_sm(pB0, pB1, K_lds + bj * SHM_K, qr, r32, hi, comp, pA0, pA1, alA, l_reg, pa0, pa1, pa2, pa3);
        pv_sm(o, vb0 + bjm1 * (int)SHM_V, pa0, pa1, pa2, pa3, pB0, pB1, m_reg, mnB, alB, [&] { SW0(); SWRITE(bjp1, A); SLOAD(A, (j + 2) * KVBLK); });
        RESC(alB); __syncthreads();
        qk_sm(pA0, pA1, K_lds + bjp1 * SHM_K, qr, r32, hi, comp, pB0, pB1, alB, l_reg, pa0, pa1, pa2, pa3);
        pv_sm(o, vb0 + bj * (int)SHM_V, pa0, pa1, pa2, pa3, pA0, pA1, m_reg, mnA, alA, [&] { SW0(); SWRITE(bjm1, A); if (j + 3 < NT) SLOAD(A, (j + 3) * KVBLK); });
        RESC(alA); __syncthreads();
        bj = (bj == 0) ? 2 : bj - 1;
    }
    { const int bjm1 = (bj == 0) ? 2 : bj - 1;
      qk_sm(pB0, pB1, K_lds + bj * SHM_K, qr, r32, hi, comp, pA0, pA1, alA, l_reg, pa0, pa1, pa2, pa3);
      pv_sm(o, vb0 + bjm1 * (int)SHM_V, pa0, pa1, pa2, pa3, pB0, pB1, m_reg, mnB, alB, [] {});
      RESC(alB);
      finishSM(pB0, pB1, alB, l_reg, pa0, pa1, pa2, pa3); SBAR();
      pv_d0(o, vb0 + bj * (int)SHM_V, pa0, pa1, pa2, pa3); }
#undef SW0
    if (hi == 0) li_l[r32] = l_reg; asm volatile("s_waitcnt lgkmcnt(0)" ::: "memory");
    float rli[16];
#pragma unroll
    for (int r = 0; r < 16; ++r) rli[r] = __builtin_amdgcn_rcpf(li_l[crow(r, hi)]);
    __syncthreads();
    float* stg = (float*)lds + rb * 32 * 128;
    if (comp == 1) {
#pragma unroll
        for (int r = 0; r < 16; ++r)
#pragma unroll
            for (int d0 = 0; d0 < 4; ++d0) stg[crow(r, hi) * 128 + d0 * 32 + r32] = o[d0][r] * rli[r];
    }
    __syncthreads();
    if (comp == 0) {
#pragma unroll
        for (int r = 0; r < 16; ++r)
#pragma unroll
            for (int d0 = 0; d0 < 4; ++d0) { const int idx = crow(r, hi) * 128 + d0 * 32 + r32; stg[idx] = o[d0][r] * rli[r] - lam * stg[idx]; }
        asm volatile("s_waitcnt lgkmcnt(0)" ::: "memory");
        const int row = lane >> 1, c0 = (lane & 1) * 64;
        const float* sp = stg + row * 128 + c0;
        float ss = 0.f;
#pragma unroll
        for (int i = 0; i < 16; ++i) { const f32x4 v = *(const f32x4*)(sp + 4 * i); ss += (v[0] * v[0] + v[1] * v[1]) + (v[2] * v[2] + v[3] * v[3]); }
        ss += __shfl_xor(ss, 1);
        const float rs = outscale / sqrtf(ss * (1.0f / 128.0f) + 1e-5f);
        bf16_t* op = Ob + (size_t)(rb * 32 + row) * DM + c0;
#pragma unroll
        for (int i = 0; i < 8; ++i) { const f32x4 v0 = *(const f32x4*)(sp + 8 * i), v1 = *(const f32x4*)(sp + 8 * i + 4);
            const f32x4 g0 = *(const f32x4*)(sub_gain + c0 + 8 * i), g1 = *(const f32x4*)(sub_gain + c0 + 8 * i + 4);
            u32x4 w; w.x = cvt_pk_bf16(v0[0] * rs * g0[0], v0[1] * rs * g0[1]); w.y = cvt_pk_bf16(v0[2] * rs * g0[2], v0[3] * rs * g0[3]);
            w.z = cvt_pk_bf16(v1[0] * rs * g1[0], v1[1] * rs * g1[1]); w.w = cvt_pk_bf16(v1[2] * rs * g1[2], v1[3] * rs * g1[3]);
            *(u32x4*)(op + 8 * i) = w; }
    }
    __syncthreads();
#undef SLOAD
#undef SWRITE
#undef SWAIT
#undef RESC
}

#define PIN(x) asm volatile("" : "+v"(x))
#define MFMA_(a, b, c) __builtin_amdgcn_mfma_f32_32x32x16_bf16(a, b, c, 0, 0, 0)
#define WAIT_BAR(N) asm volatile("s_waitcnt vmcnt(" #N ") lgkmcnt(0)\n\ts_barrier" ::: "memory")
typedef __attribute__((address_space(3))) const char* lds_cptr;
typedef short v4i16_t __attribute__((ext_vector_type(4)));
__device__ __forceinline__ unsigned cvtpk_nv(float lo, float hi) { unsigned r; asm("v_cvt_pk_bf16_f32 %0, %1, %2" : "=v"(r) : "v"(lo), "v"(hi)); return r; }
__device__ __forceinline__ void glds16(const void* g, unsigned lds_base) {
    unsigned sv; asm volatile("s_mov_b32 %0, m0\n\ts_mov_b32 m0, %2\n\ts_nop 0\n\tglobal_load_lds_dwordx4 %1, off\n\ts_mov_b32 m0, %0" : "=&s"(sv) : "v"(g), "s"(lds_base) : "memory"); }
__device__ __forceinline__ void kload2(bf16x8* kf, lds_cptr kp, int kb0, int d0) { const lds_cptr p = kp + (kb0 ^ (d0 << 5));
    kf[2 * d0] = *(const __attribute__((address_space(3))) bf16x8*)(p); kf[2 * d0 + 1] = *(const __attribute__((address_space(3))) bf16x8*)(p + 8192); }
__device__ __forceinline__ s16x4 vtr(lds_cptr p) { return __builtin_bit_cast(s16x4, __builtin_amdgcn_ds_read_tr16_b64_v4i16((__attribute__((address_space(3))) v4i16_t*)p)); }
#define MX3(a, b, c) __builtin_fmaxf(__builtin_fmaxf((a), (b)), (c))
__device__ __forceinline__ float rowmax(const f32x16& p0, const f32x16& p1) {
    float a = MX3(p0[0], p0[1], p1[0]), b = MX3(p0[2], p0[3], p1[1]); a = MX3(a, p1[2], p1[3]);
#pragma unroll
    for (int r = 4; r < 16; r += 4) { a = MX3(a, p0[r], p0[r + 1]); b = MX3(b, p0[r + 2], p0[r + 3]); a = MX3(a, p1[r], p1[r + 1]); b = MX3(b, p1[r + 2], p1[r + 3]); }
    float m = __builtin_fmaxf(a, b); auto rr = __builtin_amdgcn_permlane32_swap(__float_as_uint(m), __float_as_uint(m), false, false);
    return __builtin_fmaxf(__uint_as_float(rr[0]), __uint_as_float(rr[1])); }
#undef MX3

__device__ __forceinline__ void attn_unit2(const bf16_t* __restrict__ Qb, const bf16_t* __restrict__ Kh, const bf16_t* __restrict__ Vh, unsigned char* __restrict__ Ob,
                                           float lam, float outscale, const float* __restrict__ sub_gain, char* lds, const int tid) {
    constexpr int LDK = NPROJP, NT = SEQ / KVBLK, SLOTB = 16384, LDS_K = 0, LDS_V = 3 * SLOTB;
    const int lane = tid & 63, r32 = lane & 31, hi = lane >> 5; const int wid = __builtin_amdgcn_readfirstlane(tid >> 6); const int comp = wid & 1, rb = wid >> 1;
    const unsigned lds0 = (unsigned)(uintptr_t)lds; float* wsf = (float*)(lds + WS_OFF) + wid * 64;
    const bf16_t* ksrc = Kh + (size_t)(8 * wid + (lane >> 4)) * LDK + ((lane & 15) ^ (lane >> 4)) * 8;
    const bf16_t* ksrc2 = Kh + (size_t)(8 * wid + 4 + (lane >> 4)) * LDK + ((lane & 15) ^ ((lane >> 4) + 4)) * 8;
    const bf16_t* vsrc = Vh + (size_t)(32 * (wid & 1) + (lane >> 2)) * LDK + (wid >> 1) * 32 + (lane & 3) * 8;
    const unsigned kdst = lds0 + LDS_K + wid * 2048, vdst = lds0 + LDS_V + (wid >> 1) * 4096 + (wid & 1) * 2048;
#define DMA_K(t, slot) do { const unsigned d_ = (unsigned)__builtin_amdgcn_readfirstlane(kdst + (slot)); glds16(ksrc + (size_t)(t) * KVBLK * LDK, d_); glds16(ksrc2 + (size_t)(t) * KVBLK * LDK, d_ + 1024); } while (0)
#define DMA_V(t, slot) do { const bf16_t* s_ = vsrc + (size_t)(t) * KVBLK * LDK; const unsigned d_ = (unsigned)__builtin_amdgcn_readfirstlane(vdst + (slot)); glds16(s_, d_); glds16(s_ + (size_t)16 * LDK, d_ + 1024); } while (0)
    const lds_cptr vp0 = (lds_cptr)lds + LDS_V + ((lane >> 4) & 1) * 32 + (lane & 3) * 8 + (4 * hi + ((lane & 15) >> 2)) * 64;
    const int kb0 = r32 * 256 + ((comp * 128 + hi * 16) ^ ((r32 & 7) << 4));
    const lds_cptr kp0 = (lds_cptr)lds + LDS_K;
    DMA_K(0, 0); DMA_V(0, 0); DMA_K(1, SLOTB);
    bf16x8 qr[4];
    { const bf16_t* Qw = Qb + (size_t)(rb * 32 + r32) * LDK + comp * 64 + hi * 8;
#pragma unroll
      for (int d0 = 0; d0 < 4; ++d0) qr[d0] = *reinterpret_cast<const bf16x8*>(Qw + d0 * 16); }
    float mhat = 0.f, l_reg = 0.f; f32x16 o[4] = {};
    bool resc = false;
    f32x16 pA0, pA1, pB0, pB1; bf16x8 kf[8]; s16x4 vlo[8], vhi[8]; u32x4 pw0, pw1, pw2, pw3;
    int sl_prev = 0, sl_cur = 0, sl_next = SLOTB;
#define ROT() do { sl_prev = sl_cur; sl_cur = sl_next; sl_next = (sl_next == 2 * SLOTB) ? 0 : sl_next + SLOTB; } while (0)
#define EX(v) __builtin_amdgcn_exp2f((v) + nmh)
#define RESC2() do { if (resc) { _Pragma("unroll") for (int d_ = 0; d_ < 4; ++d_) _Pragma("unroll") for (int r = 0; r < 16; ++r) o[d_][r] *= wsf[crow(r, hi)]; } } while (0)
    DMA_K(2, 2 * SLOTB);
    WAIT_BAR(6);
    _Pragma("unroll") for (int d0 = 0; d0 < 4; ++d0) kload2(kf, kp0, kb0, d0);
    pA0 = MFMA_(kf[0], qr[0], f32x16{}); pA1 = MFMA_(kf[1], qr[0], f32x16{}); pA0 = MFMA_(kf[2], qr[1], pA0); pA1 = MFMA_(kf[3], qr[1], pA1);
    pA0 = MFMA_(kf[4], qr[2], pA0); pA1 = MFMA_(kf[5], qr[2], pA1); pA0 = MFMA_(kf[6], qr[3], pA0); pA1 = MFMA_(kf[7], qr[3], pA1);
    { mhat = rowmax(pA0, pA1); const float nmh = -mhat;
#pragma unroll
      for (int r = 0; r < 16; ++r) { pA0[r] = EX(pA0[r]); pA1[r] = EX(pA1[r]); } }
    WAIT_BAR(0);
    DMA_K(3, 0); DMA_V(1, SLOTB); ROT();
    _Pragma("unroll") for (int d0 = 0; d0 < 4; ++d0) kload2(kf, kp0 + sl_cur, kb0, d0);
    WAIT_BAR(4);
#define PKW(P, i) cvtpk_nv(P[i], P[i + 1])
#define PAF(k) __builtin_bit_cast(bf16x8, pw##k)
#define VFR(i) (bf16x8){vlo[i][0], vlo[i][1], vlo[i][2], vlo[i][3], vhi[i][0], vhi[i][1], vhi[i][2], vhi[i][3]}
#define VRD(i, f) do { vlo[i] = vtr(vp_ + (((f) & 3) * 4096 + ((f) >> 2) * 1024)); vhi[i] = vtr(vp_ + (((f) & 3) * 4096 + ((f) >> 2) * 1024 + 512)); } while (0)
#define KRD(G, d0) do { if (G) { kload2(kf, kp0 + sl_next, kb0, d0); SBAR(); } } while (0)
#define GAPA(MF, a0, a1, a2, a3, W0, W1, PW) do { MF; sacc += a0; sacc += a1; sacc += a2; sacc += a3; W0; W1; PIN(PW); PIN(sacc); SBAR(); } while (0)
#define GAPB(MF, X, i) do { MF; X[i] = EX(X[i]); X[i + 1] = EX(X[i + 1]); PIN(X); SBAR(); } while (0)
#define STEP(C0, C1, P0, P1, t, GK, GV, GL) do { SBAR(); \
    const lds_cptr vp_ = vp0 + sl_prev; \
    VRD(0, 0); SBAR(); float sacc = P0[0] + P0[1]; \
                       GAPA(C0 = MFMA_(kf[0], qr[0], f32x16{}), P0[2], P0[3], P0[4], P0[5],     pw0[0] = PKW(P0, 0),  pw0[1] = PKW(P0, 2),  pw0); \
    VRD(1, 1); SBAR(); GAPA(C1 = MFMA_(kf[1], qr[0], f32x16{}), P0[6], P0[7], P0[8], P0[9],     pw0[2] = PKW(P0, 4),  pw0[3] = PKW(P0, 6),  pw0); \
    VRD(2, 2); SBAR(); GAPA(C0 = MFMA_(kf[2], qr[1], C0),       P0[10], P0[11], P0[12], P0[13], pw1[0] = PKW(P0, 8),  pw1[1] = PKW(P0, 10), pw1); \
    VRD(3, 3); SBAR(); GAPA(C1 = MFMA_(kf[3], qr[1], C1),       P0[14], P0[15], P1[0], P1[1],   pw1[2] = PKW(P0, 12), pw1[3] = PKW(P0, 14), pw1); \
    VRD(4, 4); SBAR(); GAPA(C0 = MFMA_(kf[4], qr[2], C0),       P1[2], P1[3], P1[4], P1[5],     pw2[0] = PKW(P1, 0),  pw2[1] = PKW(P1, 2),  pw2); \
    VRD(5, 5); SBAR(); GAPA(C1 = MFMA_(kf[5], qr[2], C1),       P1[6], P1[7], P1[8], P1[9],     pw2[2] = PKW(P1, 4),  pw2[3] = PKW(P1, 6),  pw2); \
    VRD(6, 6); SBAR(); GAPA(C0 = MFMA_(kf[6], qr[3], C0),       P1[10], P1[11], P1[12], P1[13], pw3[0] = PKW(P1, 8),  pw3[1] = PKW(P1, 10), pw3); \
    VRD(7, 7); SBAR(); GAPA(C1 = MFMA_(kf[7], qr[3], C1),       P1[14], P1[15], 0.f, 0.f,       pw3[2] = PKW(P1, 12), pw3[3] = PKW(P1, 14), pw3); \
    l_reg += sacc; \
    if (GK) DMA_K((t) + 3, sl_cur); if (GV) DMA_V((t) + 1, sl_next); \
    { const float rm = rowmax(C0, C1) - mhat; resc = false; \
      if (__builtin_expect(__any(rm > THRL), 0)) { const float dl = __builtin_fmaxf(rm, 0.f); mhat += dl; \
          const float f = __builtin_amdgcn_exp2f(-dl); l_reg *= f; if (hi == 0) wsf[r32] = f; resc = true; } } \
    const float nmh = -mhat; SBAR(); \
    KRD(GL, 0); GAPB(o[0] = MFMA_(PAF(0), VFR(0), o[0]), C0, 0);   KRD(GL, 1); GAPB(o[1] = MFMA_(PAF(0), VFR(1), o[1]), C0, 2); \
    KRD(GL, 2); GAPB(o[2] = MFMA_(PAF(0), VFR(2), o[2]), C0, 4);   KRD(GL, 3); GAPB(o[3] = MFMA_(PAF(0), VFR(3), o[3]), C0, 6); \
    VRD(0, 8);  SBAR(); GAPB(o[0] = MFMA_(PAF(1), VFR(4), o[0]), C0, 8);   VRD(1, 9);  SBAR(); GAPB(o[1] = MFMA_(PAF(1), VFR(5), o[1]), C0, 10); \
    VRD(2, 10); SBAR(); GAPB(o[2] = MFMA_(PAF(1), VFR(6), o[2]), C0, 12);  VRD(3, 11); SBAR(); GAPB(o[3] = MFMA_(PAF(1), VFR(7), o[3]), C0, 14); \
    VRD(4, 12); SBAR(); GAPB(o[0] = MFMA_(PAF(2), VFR(0), o[0]), C1, 0);   VRD(5, 13); SBAR(); GAPB(o[1] = MFMA_(PAF(2), VFR(1), o[1]), C1, 2); \
    VRD(6, 14); SBAR(); GAPB(o[2] = MFMA_(PAF(2), VFR(2), o[2]), C1, 4);   VRD(7, 15); SBAR(); GAPB(o[3] = MFMA_(PAF(2), VFR(3), o[3]), C1, 6); \
    GAPB(o[0] = MFMA_(PAF(3), VFR(4), o[0]), C1, 8);   GAPB(o[1] = MFMA_(PAF(3), VFR(5), o[1]), C1, 10); \
    GAPB(o[2] = MFMA_(PAF(3), VFR(6), o[2]), C1, 12);  GAPB(o[3] = MFMA_(PAF(3), VFR(7), o[3]), C1, 14); \
    } while (0)
    int t = 1;
    for (; t + 5 < NT; t += 2) {
        STEP(pB0, pB1, pA0, pA1, t, true, true, true);     WAIT_BAR(4); RESC2(); ROT();
        STEP(pA0, pA1, pB0, pB1, t + 1, true, true, true); WAIT_BAR(4); RESC2(); ROT();
    }
#define ENDW(tt) do { if ((tt) + 3 < NT) { WAIT_BAR(4); } else if ((tt) + 2 < NT) { WAIT_BAR(2); } else { WAIT_BAR(0); } } while (0)
    for (; t + 1 < NT; t += 2) {
        STEP(pB0, pB1, pA0, pA1, t, (t + 3 < NT), (t + 1 < NT), (t + 1 < NT));         ENDW(t);     RESC2(); ROT();
        STEP(pA0, pA1, pB0, pB1, t + 1, (t + 4 < NT), (t + 2 < NT), (t + 2 < NT));     ENDW(t + 1); RESC2(); ROT();
    }
    STEP(pB0, pB1, pA0, pA1, NT - 1, false, false, false); RESC2();
    { float sacc = pB0[0] + pB0[1];
#pragma unroll
      for (int r = 2; r < 16; ++r) sacc += pB0[r];
#pragma unroll
      for (int r = 0; r < 16; ++r) sacc += pB1[r];
      l_reg += sacc;
      pw0 = (u32x4){PKW(pB0, 0), PKW(pB0, 2), PKW(pB0, 4), PKW(pB0, 6)}; pw1 = (u32x4){PKW(pB0, 8), PKW(pB0, 10), PKW(pB0, 12), PKW(pB0, 14)};
      pw2 = (u32x4){PKW(pB1, 0), PKW(pB1, 2), PKW(pB1, 4), PKW(pB1, 6)}; pw3 = (u32x4){PKW(pB1, 8), PKW(pB1, 10), PKW(pB1, 12), PKW(pB1, 14)};
      const lds_cptr vp_ = vp0 + sl_cur;
      _Pragma("unroll") for (int i = 0; i < 8; ++i) VRD(i, i);
      o[0] = MFMA_(PAF(0), VFR(0), o[0]); o[1] = MFMA_(PAF(0), VFR(1), o[1]); o[2] = MFMA_(PAF(0), VFR(2), o[2]); o[3] = MFMA_(PAF(0), VFR(3), o[3]);
      o[0] = MFMA_(PAF(1), VFR(4), o[0]); o[1] = MFMA_(PAF(1), VFR(5), o[1]); o[2] = MFMA_(PAF(1), VFR(6), o[2]); o[3] = MFMA_(PAF(1), VFR(7), o[3]);
      SBAR();
      _Pragma("unroll") for (int i = 0; i < 8; ++i) VRD(i, 8 + i);
      o[0] = MFMA_(PAF(2), VFR(0), o[0]); o[1] = MFMA_(PAF(2), VFR(1), o[1]); o[2] = MFMA_(PAF(2), VFR(2), o[2]); o[3] = MFMA_(PAF(2), VFR(3), o[3]);
      o[0] = MFMA_(PAF(3), VFR(4), o[0]); o[1] = MFMA_(PAF(3), VFR(5), o[1]); o[2] = MFMA_(PAF(3), VFR(6), o[2]); o[3] = MFMA_(PAF(3), VFR(7), o[3]); }
    { auto rr = __builtin_amdgcn_permlane32_swap(__float_as_uint(l_reg), __float_as_uint(l_reg), false, false); l_reg = __uint_as_float(rr[0]) + __uint_as_float(rr[1]); }
    float* li_l = wsf + 32;
    if (hi == 0) li_l[r32] = l_reg; asm volatile("s_waitcnt lgkmcnt(0)" ::: "memory");
    float rli[16];
#pragma unroll
    for (int r = 0; r < 16; ++r) rli[r] = __builtin_amdgcn_rcpf(li_l[crow(r, hi)]);
    __syncthreads();
    float* stg = (float*)lds + rb * 32 * 128;
    if (comp == 1) {
#pragma unroll
        for (int r = 0; r < 16; ++r)
#pragma unroll
            for (int d0 = 0; d0 < 4; ++d0) stg[crow(r, hi) * 128 + d0 * 32 + r32] = o[d0][r] * rli[r];
    }
    __syncthreads();
    if (comp == 0) {
#pragma unroll
        for (int r = 0; r < 16; ++r)
#pragma unroll
            for (int d0 = 0; d0 < 4; ++d0) { const int idx = crow(r, hi) * 128 + d0 * 32 + r32; stg[idx] = o[d0][r] * rli[r] - lam * stg[idx]; }
        asm volatile("s_waitcnt lgkmcnt(0)" ::: "memory");
        const int row = lane >> 1, c0 = (lane & 1) * 64;
        const float* sp = stg + row * 128 + c0;
        float ss = 0.f;
#pragma unroll
        for (int i = 0; i < 16; ++i) { const f32x4 v = *(const f32x4*)(sp + 4 * i); ss += (v[0] * v[0] + v[1] * v[1]) + (v[2] * v[2] + v[3] * v[3]); }
        ss += __shfl_xor(ss, 1);
        const float rs = outscale / sqrtf(ss * (1.0f / 128.0f) + 1e-5f);
        unsigned char* op = Ob + ((size_t)(rb * 32 + row) * DM + c0) * (WOUT_FP8 ? 1 : 2);
#pragma unroll
        for (int i = 0; i < 8; ++i) { const f32x4 v0 = *(const f32x4*)(sp + 8 * i), v1 = *(const f32x4*)(sp + 8 * i + 4);
            const f32x4 g0 = *(const f32x4*)(sub_gain + c0 + 8 * i), g1 = *(const f32x4*)(sub_gain + c0 + 8 * i + 4);
            if (WOUT_FP8) { const float rq = rs * MIXSC; const float f[8] = {v0[0] * rq * g0[0], v0[1] * rq * g0[1], v0[2] * rq * g0[2], v0[3] * rq * g0[3], v1[0] * rq * g1[0], v1[1] * rq * g1[1], v1[2] * rq * g1[2], v1[3] * rq * g1[3]};
                *(u32x2*)(op + 8 * i) = pack8_fp8(f); }
            else { u32x4 w; w.x = cvt_pk_bf16(v0[0] * rs * g0[0], v0[1] * rs * g0[1]); w.y = cvt_pk_bf16(v0[2] * rs * g0[2], v0[3] * rs * g0[3]);
                w.z = cvt_pk_bf16(v1[0] * rs * g1[0], v1[1] * rs * g1[1]); w.w = cvt_pk_bf16(v1[2] * rs * g1[2], v1[3] * rs * g1[3]);
                *(u32x4*)(op + 16 * i) = w; } }
    }
    __syncthreads();
#undef DMA_K
#undef DMA_V
#undef ROT
#undef EX
#undef RESC2
#undef PKW
#undef PAF
#undef VFR
#undef VRD
#undef KRD
#undef ENDW
#undef GAPA
#undef GAPB
#undef STEP
}
#undef PIN
#undef MFMA_
#undef WAIT_BAR
}

struct Args { const void* in[31]; float* out; unsigned char* ws; int ph_lo, ph_hi; };
typedef const __attribute__((address_space(4))) Args* ArgsP;
__device__ __forceinline__ int launder_v(int x) { asm volatile("" : "+v"(x)); return x; }
__device__ __forceinline__ int phase_tid(int wave) { int l; asm volatile("v_mbcnt_lo_u32_b32 %0, -1, 0\n\tv_mbcnt_hi_u32_b32 %0, -1, %0" : "=v"(l)); return wave * 64 + l; }
__device__ __forceinline__ ArgsP phase_args() { ArgsP p = (ArgsP)__builtin_amdgcn_kernarg_segment_ptr(); asm volatile("" : "+s"(p)); return p; }
enum { I_X = 0, I_C, I_POS, I_WADA, I_BADA, I_NGAIN, I_WIN, I_WOUT, I_MUP, I_MUN, I_DW0, I_DUP, I_A0, I_AUP, I_KK, I_KA, I_RK, I_GUP, I_GNG, I_GNB,
       I_LQ1, I_LK1, I_LQ2, I_LK2, I_SUBG, I_WR, I_RB, I_WG, I_WU, I_WDN, I_FG };

__device__ const double INVF[8] = {1.0, 0.1939227447486858, 0.03760603093086394, 0.007292664737217109, 0.0014142135623730957, 0.00027424817567620724, 5.318295896944988e-05, 1.0313385377212461e-05};

enum { MAP_ID = 0, MAP_QK = 1, MAP_GATE = 2, MAP_UP = 3 };
template <int MAP> __device__ __forceinline__ int map_row(int n) {
    if (MAP == MAP_QK) { if (n < 2048) { const int d = n & 63; if (d < 16) return (n & ~63) | (d & 3) | ((d & 8) >> 1) | ((d & 4) << 1); } return n; }
    if (MAP == MAP_GATE) return ((n >> 2) << 3) | (n & 3);
    if (MAP == MAP_UP) return ((n >> 2) << 3) | 4 | (n & 3);
    return n;
}
template <int MAP, bool F8 = false> __device__ __forceinline__ void transpose_item(const float* __restrict__ W, int K, int N, bf16_t* __restrict__ WT, LAS float* scr, int item, int lane, float scale = 1.0f) {
    const int nblk = N / 32, kb = item / nblk, nb = item % nblk, k0 = 64 * kb, n0 = 32 * nb;
#pragma unroll 8
    for (int i = 0; i < 32; ++i) { const int kk = 2 * i + (lane >> 5); scr[kk * 33 + (lane & 31)] = W[(size_t)(k0 + kk) * N + n0 + (lane & 31)]; }
    LDS_WAIT(); asm volatile("" ::: "memory");
    const int c = lane & 7;
#pragma unroll
    for (int j = 0; j < 4; ++j) { const int n = (lane >> 3) + 8 * j; const LAS float* s = scr + (8 * c) * 33 + n;
        if constexpr (F8) { int w0 = 0, w1 = 0;
            w0 = pk4_fp8(s[0 * 33] * scale, s[1 * 33] * scale, s[2 * 33] * scale, s[3 * 33] * scale);
            w1 = pk4_fp8(s[4 * 33] * scale, s[5 * 33] * scale, s[6 * 33] * scale, s[7 * 33] * scale);
            u32x2 o; o.x = (unsigned)w0; o.y = (unsigned)w1;
            *(u32x2*)((unsigned char*)WT + (size_t)map_row<MAP>(n0 + n) * K + k0 + 8 * c) = o; }
        else { u32x4 o; o.x = cvt_pk_bf16(s[0 * 33], s[1 * 33]); o.y = cvt_pk_bf16(s[2 * 33], s[3 * 33]); o.z = cvt_pk_bf16(s[4 * 33], s[5 * 33]); o.w = cvt_pk_bf16(s[6 * 33], s[7 * 33]);
            *(u32x4*)(WT + (size_t)map_row<MAP>(n0 + n) * K + k0 + 8 * c) = o; } }
    LDS_WAIT(); asm volatile("" ::: "memory");
}
template <int MAP> __device__ __forceinline__ void transpose_item128(const float* __restrict__ W, int K, int N, unsigned char* __restrict__ WT, LAS float* scr, int item, int lane, float scale) {
    const int nblk = N / 32, kb = item / nblk, nb = item % nblk, k0 = 128 * kb, n0 = 32 * nb;
    const int lr = lane >> 3, lc = lane & 7;
    f32x4 t[16];
    const float* src = W + (size_t)(k0 + lr) * N + n0 + 4 * lc;
#pragma unroll
    for (int j = 0; j < 16; ++j) t[j] = *(const f32x4*)(src + (size_t)(8 * j) * N);
#pragma unroll
    for (int j = 0; j < 16; ++j) { const int k = 8 * j + lr; *(LAS f32x4*)(scr + k * 32 + ((lc ^ (k >> 4)) << 2)) = t[j]; }
    LDS_WAIT(); asm volatile("" ::: "memory");
    const int nr = lane >> 3, c = lane & 7;
#pragma unroll
    for (int jj = 0; jj < 4; ++jj) { const int n = 8 * jj + nr; const LAS float* sp = scr + (16 * c) * 32 + ((((n >> 2) ^ c) << 2) | (n & 3));
        float f0[8], f1[8];
#pragma unroll
        for (int e = 0; e < 8; ++e) { f0[e] = sp[e * 32] * scale; f1[e] = sp[(8 + e) * 32] * scale; }
        const u32x2 a = pack8_fp8(f0), b = pack8_fp8(f1); u32x4 o; o.x = a.x; o.y = a.y; o.z = b.x; o.w = b.y;
        *(u32x4*)(WT + (size_t)map_row<MAP>(n0 + n) * K + k0 + 16 * c) = o; }
    LDS_WAIT(); asm volatile("" ::: "memory");
}
template <int MAP> __device__ __forceinline__ void transpose_piece_f8(const float* __restrict__ W, int K, int N, unsigned char* __restrict__ WT, LAS float* scr, int piece, int lane, float scale) {
    const int nblk = N / 32, kb = piece / nblk, nb = piece % nblk, k0 = 32 * kb, n0 = 32 * nb;
    float t[16];
#pragma unroll
    for (int i = 0; i < 16; ++i) t[i] = W[(size_t)(k0 + 2 * i + (lane >> 5)) * N + n0 + (lane & 31)];
#pragma unroll
    for (int i = 0; i < 16; ++i) scr[(2 * i + (lane >> 5)) * 33 + (lane & 31)] = t[i];
    LDS_WAIT(); asm volatile("" ::: "memory");
    const int c = lane & 3;
#pragma unroll
    for (int j = 0; j < 2; ++j) { const int n = (lane >> 2) + 16 * j; const LAS float* s = scr + (8 * c) * 33 + n;
        const float f[8] = {s[0 * 33] * scale, s[1 * 33] * scale, s[2 * 33] * scale, s[3 * 33] * scale, s[4 * 33] * scale, s[5 * 33] * scale, s[6 * 33] * scale, s[7 * 33] * scale};
        *(u32x2*)(WT + (size_t)map_row<MAP>(n0 + n) * K + k0 + 8 * c) = pack8_fp8(f); }
    LDS_WAIT(); asm volatile("" ::: "memory");
}
constexpr int MOE_PIECES = NEXP * 3 * 2048;
__device__ __forceinline__ void convert_moe_piece(ArgsP A, int l, LAS float* scr, int lane, int piece) {
    const int e = piece / 6144; int r = piece % 6144;
    unsigned char* WGU = A->ws + WS_WGU + (size_t)e * 2048 * DM; unsigned char* WD = A->ws + WS_WD + (size_t)e * DM * DFF;
    if (r < 2048) { transpose_piece_f8<MAP_GATE>((const float*)A->in[I_WG] + ((size_t)l * NEXP + e) * DM * DFF, DM, DFF, WGU, scr, r, lane, WSC_GU); return; } r -= 2048;
    if (r < 2048) { transpose_piece_f8<MAP_UP>((const float*)A->in[I_WU] + ((size_t)l * NEXP + e) * DM * DFF, DM, DFF, WGU, scr, r, lane, WSC_GU); return; } r -= 2048;
    transpose_piece_f8<MAP_ID>((const float*)A->in[I_WDN] + ((size_t)l * NEXP + e) * DFF * DM, DFF, DM, WD, scr, r, lane, WSC_D);
}
__device__ __forceinline__ void convert_moe(ArgsP A, int l, LAS unsigned char* lds, int lane, int wave, int gw, int NGW) {
    LAS float* scr = (LAS float*)(lds + wave * 16384);
    unsigned char* WGU = A->ws + WS_WGU; unsigned char* WD = A->ws + WS_WD;
    const float* wg = (const float*)A->in[I_WG] + (size_t)l * NEXP * DM * DFF;
    const float* wu = (const float*)A->in[I_WU] + (size_t)l * NEXP * DM * DFF;
    const float* wd = (const float*)A->in[I_WDN] + (size_t)l * NEXP * DFF * DM;
    constexpr int IG = (DM / 128) * (DFF / 32);
    constexpr int ID = (DFF / 128) * (DM / 32);
    for (int it = gw; it < NEXP * (2 * IG + ID); it += NGW) {
        const int e = it / (2 * IG + ID); int r = it % (2 * IG + ID);
        if (r < IG) { transpose_item128<MAP_GATE>(wg + (size_t)e * DM * DFF, DM, DFF, WGU + (size_t)e * 2048 * DM, scr, r, lane, WSC_GU); continue; } r -= IG;
        if (r < IG) { transpose_item128<MAP_UP>(wu + (size_t)e * DM * DFF, DM, DFF, WGU + (size_t)e * 2048 * DM, scr, r, lane, WSC_GU); continue; } r -= IG;
        transpose_item128<MAP_ID>(wd + (size_t)e * DFF * DM, DFF, DM, WD + (size_t)e * DM * DFF, scr, r, lane, WSC_D);
    }
}

__device__ __forceinline__ void phase_prologue(ArgsP A, LAS unsigned char* lds, int tid, int lane, int wave, int bx, int G) {
    float* MOD = (float*)(A->ws + WS_MOD);
    __syncthreads();
    if (bx < 192) {
        LAS float* sc = (LAS float*)lds; LAS float* red = (LAS float*)(lds + 32768);
        const float* c = (const float*)A->in[I_C];
        for (int i = tid; i < BATCH * DM; i += 512) { const float v = c[i]; sc[i] = v / (1.f + __expf(-v)); }
        __syncthreads();
        const int l = bx / 96, n0 = (bx % 96) * 128, half = lane >> 5, cg = lane & 31;
        const float* wp = (const float*)A->in[I_WADA] + (size_t)l * DM * NMOD + (size_t)(256 * wave + half) * NMOD + n0 + 4 * cg;
        f32x4 a0 = {0.f, 0.f, 0.f, 0.f}, a1 = a0, a2 = a0, a3 = a0;
#pragma unroll 8
        for (int kk = 0; kk < 128; ++kk) { const int k = 256 * wave + 2 * kk + half; const f32x4 wv = *(const f32x4*)(wp + (size_t)(2 * kk) * NMOD);
            a0 += wv * sc[k]; a1 += wv * sc[DM + k]; a2 += wv * sc[2 * DM + k]; a3 += wv * sc[3 * DM + k]; }
#pragma unroll
        for (int j = 0; j < 4; ++j) { a0[j] += __shfl_xor(a0[j], 32); a1[j] += __shfl_xor(a1[j], 32); a2[j] += __shfl_xor(a2[j], 32); a3[j] += __shfl_xor(a3[j], 32); }
        if (half == 0) { *(LAS f32x4*)(red + (wave * 4 + 0) * 128 + 4 * cg) = a0; *(LAS f32x4*)(red + (wave * 4 + 1) * 128 + 4 * cg) = a1;
                         *(LAS f32x4*)(red + (wave * 4 + 2) * 128 + 4 * cg) = a2; *(LAS f32x4*)(red + (wave * 4 + 3) * 128 + 4 * cg) = a3; }
        __syncthreads();
        { const int b = tid >> 7, col = tid & 127; float s = 0.f;
#pragma unroll
          for (int w = 0; w < 8; ++w) s += red[(w * 4 + b) * 128 + col];
          MOD[(size_t)(l * 4 + b) * NMOD + n0 + col] = s + ((const float*)A->in[I_BADA])[l * NMOD + n0 + col]; }
        __syncthreads();
    }
    { float* ROPE = (float*)(A->ws + WS_ROPE); const int* pos = (const int*)A->in[I_POS];
      for (int it = bx * 512 + tid; it < MTOK * 8; it += G * 512) { const int tok = it >> 3, j = it & 7;
          const double x = (double)pos[tok] * INVF[j]; const double n = rint(x * 0.15915494309189535); const float r = (float)(x - n * 6.283185307179586);
          ROPE[tok * 16 + j] = cosf(r); ROPE[tok * 16 + 8 + j] = sinf(r); } }
    const int gw = bx * 8 + wave, NGW = G * 8;
    { LAS float* scr = (LAS float*)(lds + wave * 16384);
      static_assert(PROJ_FP8 && WOUT_FP8, "the 128 x 32 converter writes fp8");
      constexpr int I_IN = (DM / 128) * (NPROJ / 32), I_OUT = (DM / 128) * (DM / 32);
      for (int it = gw; it < DEPTH * (I_IN + I_OUT); it += NGW) { const int l = it / (I_IN + I_OUT); int r = it % (I_IN + I_OUT);
          if (r < I_IN) transpose_item128<MAP_QK>((const float*)A->in[I_WIN] + (size_t)l * DM * NPROJ, DM, NPROJ, A->ws + WS_WIN + (size_t)l * NPROJP * DM, scr, r, lane, WSC_IN);
          else transpose_item128<MAP_ID>((const float*)A->in[I_WOUT] + (size_t)l * DM * DM, DM, DM, A->ws + WS_WOUT + (size_t)l * DM * DM, scr, r - I_IN, lane, WSC_O); } }
    { const int gt = bx * 512 + tid; constexpr int EB = PROJ_FP8 ? 1 : 2; constexpr int PER = (NPROJP - NPROJ) * DM * EB / 16;
      for (int it = gt; it < DEPTH * PER; it += G * 512) { const int l = it / PER, r = it % PER;
          *(u32x4*)(A->ws + WS_WIN + ((size_t)l * NPROJP * DM + (size_t)NPROJ * DM) * EB + (size_t)r * 16) = (u32x4){0u, 0u, 0u, 0u}; } }
    { const int gt = bx * 512 + tid; bf16_t* LW = (bf16_t*)(A->ws + WS_LW);
      for (int it = gt; it < DEPTH * 48 * NDYN; it += G * 512) { const int c = it % NDYN, kc = (it / NDYN) % 48, l = it / (NDYN * 48);
          const int kind = c >> 10, cc = c & 1023; float v[8];
#pragma unroll
          for (int j = 0; j < 8; ++j) { const int k = 8 * kc + j; float x = 0.f;
              if (kind < 2) { const int r = k - 64 * kind; if (r >= 0 && r < 64) x = ((const float*)A->in[I_DUP])[((size_t)(l * 2 + kind) * 64 + r) * 1024 + cc]; }
              else if (kind < 4) { const int r = k - 128 - 64 * (kind - 2); if (r >= 0 && r < 64) x = ((const float*)A->in[I_AUP])[((size_t)(l * 2 + kind - 2) * 64 + r) * 1024 + cc]; }
              else { const int r = k - 256; if (r >= 0 && r < 128) x = ((const float*)A->in[I_GUP])[((size_t)l * 128 + r) * 1024 + cc]; }
              v[j] = x; }
          *(u32x4*)(LW + ((size_t)l * NDYN + c) * KLA + 8 * kc) = pack8(v); } }
#if !SCAN_CONVERT
    convert_moe(A, 0, lds, lane, wave, gw, NGW);
#endif
}

__device__ __forceinline__ void load_moe_table(ArgsP A, int l, LAS unsigned char* lds, int tid) {
    LAS int* tb = (LAS int*)(lds + LDS_MISC + 64); LAS int* cn = (LAS int*)(lds + LDS_MISC + 192);
    if (tid == 0) { unsigned* ctl = (unsigned*)(A->ws + WS_CTL); int s = 0;
        for (int e = 0; e < NEXP; ++e) { int c = (int)__hip_atomic_load(ctl + CW_CNT + (l * 16 + e) * 64, __ATOMIC_RELAXED, __HIP_MEMORY_SCOPE_AGENT); if (c > TOKCAP) c = TOKCAP; cn[e] = c; tb[e] = s; s += (c + 255) >> 8; }
        tb[16] = s; }
    __syncthreads();
}

template <int MODE> __device__ __forceinline__ void phase_norm1(ArgsP A, int l, LAS unsigned char* lds, int tid, int lane, int wave, int bx, int G) {
    const float* MOD = (const float*)(A->ws + WS_MOD);
    bf16_t* X = (bf16_t*)(A->ws + WS_X); bf16_t* H = (bf16_t*)(A->ws + WS_H);
    const unsigned char* Y = A->ws + WS_Y; const u32x4* ASG = (const u32x4*)(A->ws + WS_ASG);
    const LAS int* tb = (const LAS int*)(lds + LDS_MISC + 64);
    if (MODE != 0) load_moe_table(A, l - 1, lds, tid);
    const int gw = bx * 8 + wave, NGW = G * 8;
    for (int b = 0; b < BATCH; ++b) {
        f32x4 mulv[8], addv[8], g2v[8];
#pragma unroll
        for (int j = 0; j < 8; ++j) { const int c = 4 * (lane + 64 * j);
            if (MODE == 2) { mulv[j] = *(const f32x4*)((const float*)A->in[I_FG] + c); addv[j] = (f32x4){0.f, 0.f, 0.f, 0.f}; }
            else { const float* mo = MOD + (size_t)(l * 4 + b) * NMOD; const f32x4 gn = *(const f32x4*)((const float*)A->in[I_NGAIN] + (size_t)(l * 2 + 0) * DM + c);
                   mulv[j] = gn * (*(const f32x4*)(mo + 1 * DM + c) + 1.0f); addv[j] = *(const f32x4*)(mo + 0 * DM + c); }
            if (MODE != 0) g2v[j] = *(const f32x4*)(MOD + (size_t)((l - 1) * 4 + b) * NMOD + 5 * DM + c); }
        for (int row = b * SEQ + gw; row < (b + 1) * SEQ; row += NGW) {
            f32x4 v[8];
            if (MODE == 0) { const f32x4* xr = (const f32x4*)((const float*)A->in[I_X] + (size_t)row * DM) + lane;
#pragma unroll
                for (int j = 0; j < 8; ++j) v[j] = xr[64 * j]; }
            else { const u32x2* xr = (const u32x2*)(X + (size_t)row * DM) + lane;
#pragma unroll
                for (int j = 0; j < 8; ++j) { const u32x2 p = xr[64 * j]; v[j] = (f32x4){bflo(p.x), bfhi(p.x), bflo(p.y), bfhi(p.y)}; } }
            if (MODE != 0) {
                const u32x4 as = ASG[row];
                const int e0 = __builtin_amdgcn_readfirstlane((int)(as.x >> 20)), s0 = __builtin_amdgcn_readfirstlane((int)(as.x & 0xfffffu));
                const int e1 = __builtin_amdgcn_readfirstlane((int)(as.y >> 20)), s1 = __builtin_amdgcn_readfirstlane((int)(as.y & 0xfffffu));
                const float w0 = __uint_as_float(as.z) * (1.0f / YSC), w1 = __uint_as_float(as.w) * (1.0f / YSC);
                const int* y0 = (const int*)(Y + ((size_t)tb[e0] * 256 + s0) * DM) + lane; const int* y1 = (const int*)(Y + ((size_t)tb[e1] * 256 + s1) * DM) + lane;
#pragma unroll
                for (int j = 0; j < 8; ++j) { const int p = y0[64 * j], q = y1[64 * j];
                    f32x4 m; m[0] = w0 * __builtin_amdgcn_cvt_f32_fp8(p, 0) + w1 * __builtin_amdgcn_cvt_f32_fp8(q, 0); m[1] = w0 * __builtin_amdgcn_cvt_f32_fp8(p, 1) + w1 * __builtin_amdgcn_cvt_f32_fp8(q, 1);
                    m[2] = w0 * __builtin_amdgcn_cvt_f32_fp8(p, 2) + w1 * __builtin_amdgcn_cvt_f32_fp8(q, 2); m[3] = w0 * __builtin_amdgcn_cvt_f32_fp8(p, 3) + w1 * __builtin_amdgcn_cvt_f32_fp8(q, 3);
                    v[j] = v[j] + g2v[j] * m; }
                if (MODE == 1) { u32x2* xw = (u32x2*)(X + (size_t)row * DM) + lane;
#pragma unroll
                    for (int j = 0; j < 8; ++j) { u32x2 w; w.x = cvt_pk_bf16(v[j][0], v[j][1]); w.y = cvt_pk_bf16(v[j][2], v[j][3]); xw[64 * j] = w; } }
            }
            float ss = 0.f;
#pragma unroll
            for (int j = 0; j < 8; ++j) ss += (v[j][0] * v[j][0] + v[j][1] * v[j][1]) + (v[j][2] * v[j][2] + v[j][3] * v[j][3]);
            const float rstd = 1.0f / sqrtf(wave_sum(ss) * (1.0f / DM) + 1e-6f);
            if (MODE == 2) { f32x4* ow = (f32x4*)(A->out + (size_t)row * DM) + lane;
#pragma unroll
                for (int j = 0; j < 8; ++j) ow[64 * j] = v[j] * rstd * mulv[j];
            } else {
#if PROJ_FP8
                int* hw = (int*)((unsigned char*)H + (size_t)row * DM) + lane;
#pragma unroll
                for (int j = 0; j < 8; ++j) { const f32x4 h = v[j] * rstd * mulv[j] + addv[j]; hw[64 * j] = pk4_fp8(h[0], h[1], h[2], h[3]); }
#else
                u32x2* hw = (u32x2*)(H + (size_t)row * DM) + lane;
#pragma unroll
                for (int j = 0; j < 8; ++j) { const f32x4 h = v[j] * rstd * mulv[j] + addv[j]; u32x2 w; w.x = cvt_pk_bf16(h[0], h[1]); w.y = cvt_pk_bf16(h[2], h[3]); hw[64 * j] = w; }
#endif
            }
        }
    }
#if !SCAN_CONVERT
    if (MODE == 1) { VM_WAIT(); __syncthreads(); convert_moe(A, l, lds, lane, wave, gw, NGW); }
#endif
}

__device__ __forceinline__ void phase_norm2_router(ArgsP A, int l, LAS unsigned char* lds, int tid, int lane, int wave, int bx, int G, int dry) {
    const float* MOD = (const float*)(A->ws + WS_MOD);
    const bf16_t* X = (const bf16_t*)(A->ws + WS_X); bf16_t* H = (bf16_t*)(A->ws + WS_H);
    LAS float* wr_l = (LAS float*)lds;
    LAS int* l_e = (LAS int*)(lds + LDS_MISC + 512);
    LAS float* l_g = (LAS float*)(lds + LDS_MISC + 1024);
    LAS int* l_cnt = (LAS int*)(lds + LDS_MISC + 1536);
    LAS int* l_base = (LAS int*)(lds + LDS_MISC + 1600);
    LAS int* l_loc = (LAS int*)(lds + LDS_MISC + 1664);
    { const f32x4* src = (const f32x4*)A->in[I_WR]; for (int t = tid; t < DM * NEXP / 4; t += 512) { const int c = t >> 2, q = t & 3, L = (c >> 2) & 63, j = c >> 8, i = c & 3;
        *(LAS f32x4*)(wr_l + 4 * ((((j * 4 + i) * 4 + q) * 64) + L)) = src[t]; } }
    if (tid < 16) l_cnt[tid] = 0;
    __syncthreads();
    for (int rblk = bx; rblk < MTOK / 64; rblk += G) {
        const int b = (rblk * 64) / SEQ;
        const float* mo = MOD + (size_t)(l * 4 + b) * NMOD;
        const float* gnp = (const float*)A->in[I_NGAIN] + (size_t)(l * 2 + 1) * DM;
        for (int rr = 0; rr < 8; rr += 2) {
            const int rl = wave * 8 + rr, row = rblk * 64 + rl;
            u32x2 p0[8], p1[8];
            { const u32x2* x0 = (const u32x2*)(X + (size_t)row * DM) + lane; const u32x2* x1 = x0 + DM / 4;
#pragma unroll
              for (int j = 0; j < 8; ++j) { p0[j] = x0[64 * j]; p1[j] = x1[64 * j]; } }
#define UNP(p) (f32x4){bflo((p).x), bfhi((p).x), bflo((p).y), bfhi((p).y)}
            float ss0 = 0.f, ss1 = 0.f;
#pragma unroll
            for (int j = 0; j < 8; ++j) { const f32x4 a = UNP(p0[j]), b = UNP(p1[j]);
                ss0 += (a[0] * a[0] + a[1] * a[1]) + (a[2] * a[2] + a[3] * a[3]); ss1 += (b[0] * b[0] + b[1] * b[1]) + (b[2] * b[2] + b[3] * b[3]); }
            const float rstd0 = 1.0f / sqrtf(wave_sum(ss0) * (1.0f / DM) + 1e-6f), rstd1 = 1.0f / sqrtf(wave_sum(ss1) * (1.0f / DM) + 1e-6f);
            float lg0[16], lg1[16];
#pragma unroll
            for (int e = 0; e < 16; ++e) { lg0[e] = 0.f; lg1[e] = 0.f; }
            int* hw0 = (int*)((unsigned char*)H + (size_t)row * DM) + lane;
            int* hw1 = hw0 + DM / 4;
#pragma unroll
            for (int j = 0; j < 8; ++j) { const int cj = 4 * (lane + 64 * j);
                const f32x4 mulj = *(const f32x4*)(gnp + cj) * (*(const f32x4*)(mo + 4 * DM + cj) + 1.0f), addj = *(const f32x4*)(mo + 3 * DM + cj);
                const f32x4 h0 = UNP(p0[j]) * rstd0 * mulj + addj, h1 = UNP(p1[j]) * rstd1 * mulj + addj;
                hw0[64 * j] = pk4_fp8(h0[0], h0[1], h0[2], h0[3]); hw1[64 * j] = pk4_fp8(h1[0], h1[1], h1[2], h1[3]);
#pragma unroll
                for (int i = 0; i < 4; ++i) { const LAS f32x4* wp = (const LAS f32x4*)wr_l + (j * 4 + i) * 4 * 64 + lane;
#pragma unroll
                    for (int q = 0; q < 4; ++q) { const f32x4 ww = wp[q * 64];
                        lg0[4 * q + 0] += h0[i] * ww[0]; lg0[4 * q + 1] += h0[i] * ww[1]; lg0[4 * q + 2] += h0[i] * ww[2]; lg0[4 * q + 3] += h0[i] * ww[3];
                        lg1[4 * q + 0] += h1[i] * ww[0]; lg1[4 * q + 1] += h1[i] * ww[1]; lg1[4 * q + 2] += h1[i] * ww[2]; lg1[4 * q + 3] += h1[i] * ww[3]; } }
                __builtin_amdgcn_sched_barrier(0); }
#undef UNP
            float lg[16];
#pragma unroll
            for (int e = 0; e < 16; ++e) { const float a = wave_sum(lg0[e]), b = wave_sum(lg1[e]); lg[e] = (lane == 1) ? b : a; }
            if (lane < 2) {
                const int rl2 = rl + lane;
                float sc[16], sel[16]; const float* rb = (const float*)A->in[I_RB];
#pragma unroll
                for (int e = 0; e < 16; ++e) { sc[e] = sigmoidf_(lg[e]); sel[e] = sc[e] + rb[e]; }
                int bg = 0; float bgs = -1e30f;
#pragma unroll
                for (int g = 0; g < 4; ++g) { float m1 = -1e30f, m2 = -1e30f;
#pragma unroll
                    for (int i = 0; i < 4; ++i) { const float s = sel[4 * g + i]; if (s > m1) { m2 = m1; m1 = s; } else if (s > m2) m2 = s; }
                    const float gs = m1 + m2; if (gs > bgs) { bgs = gs; bg = g; } }
                int i1 = 0; float m1 = -1e30f;
#pragma unroll
                for (int g = 0; g < 4; ++g) if (g == bg) {
#pragma unroll
                    for (int i = 0; i < 4; ++i) if (sel[4 * g + i] > m1) { m1 = sel[4 * g + i]; i1 = i; } }
                int i2 = 0; float m2 = -1e30f;
#pragma unroll
                for (int g = 0; g < 4; ++g) if (g == bg) {
#pragma unroll
                    for (int i = 0; i < 4; ++i) if (i != i1 && sel[4 * g + i] > m2) { m2 = sel[4 * g + i]; i2 = i; } }
                const int e1 = 4 * bg + i1, e2 = 4 * bg + i2; float s1 = 0.f, s2 = 0.f;
#pragma unroll
                for (int e = 0; e < 16; ++e) { if (e == e1) s1 = sc[e]; if (e == e2) s2 = sc[e]; }
                const float inv = 1.0f / (s1 + s2);
                l_e[2 * rl2] = e1; l_e[2 * rl2 + 1] = e2; l_g[2 * rl2] = s1 * inv; l_g[2 * rl2 + 1] = s2 * inv;
            }
        }
        __syncthreads();
        { const int tid2 = launder_v(tid);
        if (tid2 < 128) l_loc[tid2] = atomicAdd((int*)&l_cnt[l_e[tid2]], 1);
        __syncthreads();
        if (tid2 < 16) { unsigned* ctl = (unsigned*)(A->ws + WS_CTL); const int c = l_cnt[tid2];
            l_base[tid2] = c ? (int)__hip_atomic_fetch_add(ctl + CW_CNT + ((l + 2 * dry) * 16 + tid2) * 64, (unsigned)c, __ATOMIC_RELAXED, __HIP_MEMORY_SCOPE_AGENT) : 0; }
        __syncthreads();
        if (tid2 < 128) { const int e = l_e[tid2]; const int slot = l_base[e] + l_loc[tid2]; const int row = rblk * 64 + (tid2 >> 1);
            int* tokl = (int*)(A->ws + WS_TOKL); if (slot < TOKCAP && !dry) tokl[e * TOKCAP + slot] = row;
            unsigned* asg = (unsigned*)(A->ws + WS_ASG) + (size_t)row * 4; if (!dry) asg[tid2 & 1] = ((unsigned)e << 20) | (unsigned)slot; if (!dry) asg[2 + (tid2 & 1)] = __float_as_uint(l_g[tid2]); }
        __syncthreads();
        }
        if (tid < 16) l_cnt[tid] = 0;
        __syncthreads();
    }
}

__device__ __forceinline__ void phase_prep(ArgsP A, int l, int lane, int wave, int bx, int G) {
    const bf16_t* PROJ = (const bf16_t*)(A->ws + WS_PROJ); bf16_t* SHR = (bf16_t*)(A->ws + WS_SHR); bf16_t* LA = (bf16_t*)(A->ws + WS_LA);
    const int gw = bx * 8 + wave, NGW = G * 8;
    for (int it = gw; it < 7 * (MTOK / 64); it += NGW) {
        const int strip = it % 7, run = it / 7;
        if (strip == 6 && lane >= 48) continue;
        const int c = strip * 512 + 8 * lane;
        float mup[8], mun[8], kkv[8];
#pragma unroll
        for (int j = 0; j < 8; ++j) { mup[j] = ((const float*)A->in[I_MUP])[l * RWC + c + j]; mun[j] = ((const float*)A->in[I_MUN])[l * RWC + c + j];
            kkv[j] = (strip == 2 || strip == 3) ? ((const float*)A->in[I_KK])[l * 1024 + (c - 1024) + j] : 0.f; }
        const int t0 = run * 64, tl0 = t0 % SEQ;
        const bf16_t* pp = PROJ + (size_t)t0 * NPROJP + RW0 + c;
        float prev[8], cur[8], nxt[8];
        if (tl0 == 0) {
#pragma unroll
            for (int j = 0; j < 8; ++j) prev[j] = 0.f; } else unpack8(*(const u32x4*)(pp - NPROJP), prev);
        unpack8(*(const u32x4*)pp, cur);
        for (int i0 = 0; i0 < 64; i0 += 8) {
            u32x4 raw[8];
#pragma unroll
            for (int q = 0; q < 8; ++q) raw[q] = *(const u32x4*)(pp + (size_t)(i0 + q + 1) * NPROJP);
#pragma unroll
            for (int q = 0; q < 8; ++q) {
            const int i = i0 + q; const int row = t0 + i;
            unpack8(raw[q], nxt);
            if (tl0 + i == SEQ - 1) {
#pragma unroll
                for (int j = 0; j < 8; ++j) nxt[j] = 0.f; }
            float ps[8];
#pragma unroll
            for (int j = 0; j < 8; ++j) ps[j] = cur[j] + mup[j] * (prev[j] - cur[j]) + mun[j] * (nxt[j] - cur[j]);
            if (strip < 6) {
                const int reg = strip >> 1, cc = (strip & 1) * 512 + 8 * lane;
                *(u32x4*)(SHR + (size_t)row * 4096 + reg * 1024 + cc) = pack8(ps);
                if (reg == 1) { float x[8]; float ss = 0.f;
#pragma unroll
                    for (int j = 0; j < 8; ++j) { x[j] = ps[j] * kkv[j]; ss += x[j] * x[j]; }
                    ss += __shfl_xor(ss, 1); ss += __shfl_xor(ss, 2); ss += __shfl_xor(ss, 4);
                    const float inv = 1.0f / fmaxf(sqrtf(ss), 1e-12f);
#pragma unroll
                    for (int j = 0; j < 8; ++j) x[j] *= inv;
                    *(u32x4*)(SHR + (size_t)row * 4096 + 3072 + cc) = pack8(x); }
            } else {
                const int ty = lane >> 4; float o[8];
#pragma unroll
                for (int j = 0; j < 8; ++j) o[j] = (ty == 0) ? (1.0f - 2.0f / (1.0f + __expf(2.0f * ps[j]))) : (ty == 1) ? ps[j] : sigmoidf_(ps[j]);
                *(u32x4*)(LA + (size_t)row * KLA + 8 * lane) = pack8(o);
            }
#pragma unroll
            for (int j = 0; j < 8; ++j) { prev[j] = cur[j]; cur[j] = nxt[j]; }
            }
        }
    }
}

__device__ __forceinline__ float rowsum16(float x) {
    x += __builtin_bit_cast(float, __builtin_amdgcn_update_dpp(0, __builtin_bit_cast(int, x), 0x128, 0xf, 0xf, false));
    x += __builtin_bit_cast(float, __builtin_amdgcn_update_dpp(0, __builtin_bit_cast(int, x), 0x124, 0xf, 0xf, false));
    x += __builtin_bit_cast(float, __builtin_amdgcn_update_dpp(0, __builtin_bit_cast(int, x), 0x122, 0xf, 0xf, false));
    x += __builtin_bit_cast(float, __builtin_amdgcn_update_dpp(0, __builtin_bit_cast(int, x), 0x121, 0xf, 0xf, false));
    return x;
}
namespace rs {
constexpr int M = 16, NCH = SEQ / M;
constexpr int SLOT = 21248, O_AR = 0, O_BK = 5632, O_BKT = 10240, O_VT = 15360, O_MRB = 18432, O_LAB = 19968, O_GAM = 20992;
constexpr int P_AR = 176, P_BK = 144, P_BKT = 80, P_VT = 48, P_MRB = 48;
constexpr int O_YB = 3 * SLOT, O_CV = O_YB + 8192;
__device__ __forceinline__ float bfu(unsigned short x) { return __uint_as_float(((unsigned)x) << 16); }
__device__ __forceinline__ unsigned cvtpk(float lo, float hi) { unsigned r; asm("v_cvt_pk_bf16_f32 %0, %1, %2" : "=v"(r) : "v"(lo), "v"(hi)); return r; }
__device__ __forceinline__ unsigned short f2bf(float f) { return (unsigned short)(cvtpk(f, 0.f) & 0xffffu); }
__device__ __forceinline__ bf16x8 pack_bf8(float a, float b, float c, float d, float e, float f, float g, float h) {
    u32x4 w; w.x = cvtpk(a, b); w.y = cvtpk(c, d); w.z = cvtpk(e, f); w.w = cvtpk(g, h); return __builtin_bit_cast(bf16x8, w); }
}
__device__ __forceinline__ void phase_scan(ArgsP A, int l, LAS unsigned char* lds, int tid, int bx, int G) {
    using namespace rs;
    const bf16_t* SHR = (const bf16_t*)(A->ws + WS_SHR); const bf16_t* DYN = (const bf16_t*)(A->ws + WS_DYN); bf16_t* YS = (bf16_t*)(A->ws + WS_YS);
    const int wid = __builtin_amdgcn_readfirstlane(tid >> 6), lane = tid & 63, l31 = lane & 31, hh = lane >> 5;
    const bool xsplit = (G == 256);
    for (int chain = xsplit ? (((bx >> 3) & 1) ? 128 : ((bx >> 4) * 8 + (bx & 7))) : bx; chain < 128; chain += xsplit ? 128 : G) {
        const int d = chain >> 6, b = (chain >> 4) & 3, h = chain & 15; const int hf = (wid == 7) ? 1 : 0;
#define RS_ROW(c, t) ((size_t)b * SEQ + (d ? (SEQ - 1 - ((c) * M + (t))) : ((c) * M + (t))))
        f32x16 ST0 = {}, ST1 = {};
        u32x4 q0a, q0b, q1a, q1b, q2a, q2b, q3a, q3b;
        float kaj = 0.f;
        const int cpos = (lane >> 4) * 32 + ((lane >> 2) & 1) * 16 + ((((lane >> 3) & 1) << 2) | (lane & 3)) * 2;
        const bool e1 = (wid == 2) || (wid == 5), e2 = (wid == 3) || (wid == 6); const int epar = (wid >= 5) ? 1 : 0;
        const int ew = (wid == 2) ? 0 : (wid == 3) ? 1 : (wid == 5) ? 2 : 3;
        LAS unsigned char* stg = lds + O_CV + ew * 8192;
        if (e2) kaj = ((const float*)A->in[I_KA])[l * 1024 + h * 64 + lane];
#define RS_LOAD(c) do { const size_t ra_ = RS_ROW(c, lane >> 3), rb_ = RS_ROW(c, 8 + (lane >> 3)); const int cg_ = 8 * (lane & 7); \
            const bf16_t* sa_ = SHR + ra_ * 4096 + h * 64 + cg_; const bf16_t* sb_ = SHR + rb_ * 4096 + h * 64 + cg_; \
            const bf16_t* da_ = DYN + ra_ * NDYN + d * 1024 + h * 64 + cg_; const bf16_t* db_ = DYN + rb_ * NDYN + d * 1024 + h * 64 + cg_; \
            q0a = *(const u32x4*)da_; q0b = *(const u32x4*)db_; q1a = *(const u32x4*)(sa_ + 3072); q1b = *(const u32x4*)(sb_ + 3072); \
            if (e1) { q2a = *(const u32x4*)sa_; q2b = *(const u32x4*)sb_; q3a = *(const u32x4*)(sa_ + 2048); q3b = *(const u32x4*)(sb_ + 2048); } \
            else { q2a = *(const u32x4*)(da_ + 2048); q2b = *(const u32x4*)(db_ + 2048); q3a = *(const u32x4*)(sa_ + 1024); q3b = *(const u32x4*)(sb_ + 1024); } } while (0)
#define RS_STAGE() do { const int o_ = ((lane >> 3) * 64 + 8 * (lane & 7)) * 2; \
            *(LAS u32x4*)(stg + o_) = q0a; *(LAS u32x4*)(stg + 1024 + o_) = q0b; *(LAS u32x4*)(stg + 2048 + o_) = q1a; *(LAS u32x4*)(stg + 3072 + o_) = q1b; \
            *(LAS u32x4*)(stg + 4096 + o_) = q2a; *(LAS u32x4*)(stg + 5120 + o_) = q2b; \
            *(LAS u32x4*)(stg + 6144 + o_) = q3a; *(LAS u32x4*)(stg + 7168 + o_) = q3b; \
            asm volatile("s_waitcnt lgkmcnt(0)" ::: "memory"); } while (0)
#define RS_GET(arr, t_) bfu(*(const LAS unsigned short*)(stg + (arr) * 2048 + (t_) * 128 + 2 * lane))
        if ((e1 || e2) && epar == 0) RS_LOAD(0);
        for (int n = 0; n < NCH + 3; ++n) {
            if (wid == 0 || wid == 7) {
                const int c = n - 2;
                if (c >= 0 && c < NCH) {
                    LAS unsigned char* sl = lds + (c % 3) * SLOT;
                    f32x16 D = {};
                    const LAS unsigned char* arp = sl + O_AR + l31 * P_AR + hh * 16;
                    {   bf16x8 a0 = *(const LAS bf16x8*)(arp), a1 = *(const LAS bf16x8*)(arp + 32), a2 = *(const LAS bf16x8*)(arp + 64), a3 = *(const LAS bf16x8*)(arp + 96), a4 = *(const LAS bf16x8*)(arp + 128);
                        const bf16x8 bv = *(const LAS bf16x8*)(sl + O_VT + (32 * hf + l31) * P_VT + hh * 16);
                        const bf16x8 b0 = pack_bf8(ST0[0], ST0[1], ST0[2], ST0[3], ST0[4], ST0[5], ST0[6], ST0[7]), b1 = pack_bf8(ST0[8], ST0[9], ST0[10], ST0[11], ST0[12], ST0[13], ST0[14], ST0[15]);
                        const bf16x8 b2 = pack_bf8(ST1[0], ST1[1], ST1[2], ST1[3], ST1[4], ST1[5], ST1[6], ST1[7]), b3 = pack_bf8(ST1[8], ST1[9], ST1[10], ST1[11], ST1[12], ST1[13], ST1[14], ST1[15]);
                        D = __builtin_amdgcn_mfma_f32_32x32x16_bf16(a0, b0, D, 0, 0, 0); D = __builtin_amdgcn_mfma_f32_32x32x16_bf16(a1, b1, D, 0, 0, 0);
                        D = __builtin_amdgcn_mfma_f32_32x32x16_bf16(a2, b2, D, 0, 0, 0); D = __builtin_amdgcn_mfma_f32_32x32x16_bf16(a3, b3, D, 0, 0, 0);
                        D = __builtin_amdgcn_mfma_f32_32x32x16_bf16(a4, bv, D, 0, 0, 0);
                        float da[16];
#pragma unroll
                        for (int r = 0; r < 8; ++r) { auto rr = __builtin_amdgcn_permlane32_swap(__float_as_uint(D[r]), __float_as_uint(D[r]), false, false);
                            const int t0 = (r & 3) + 8 * (r >> 2); da[t0] = __uint_as_float(rr[0]); da[t0 + 4] = __uint_as_float(rr[1]); }
                        const LAS float* lab = (const LAS float*)(sl + O_LAB);
#pragma unroll
                        for (int s_ = 0; s_ < 15; ++s_) {
                            const f32x4 c0 = *(const LAS f32x4*)(lab + s_ * 16), c1 = *(const LAS f32x4*)(lab + s_ * 16 + 4), c2 = *(const LAS f32x4*)(lab + s_ * 16 + 8), c3 = *(const LAS f32x4*)(lab + s_ * 16 + 12);
                            const float cf[16] = {c0[0], c0[1], c0[2], c0[3], c1[0], c1[1], c1[2], c1[3], c2[0], c2[1], c2[2], c2[3], c3[0], c3[1], c3[2], c3[3]};
#pragma unroll
                            for (int t_ = s_ + 1; t_ < 16; ++t_) da[t_] += da[s_] * cf[t_];
                        }
                        const bf16x8 bu = hh ? pack_bf8(da[8], da[9], da[10], da[11], da[12], da[13], da[14], da[15]) : pack_bf8(da[0], da[1], da[2], da[3], da[4], da[5], da[6], da[7]);
                        const bf16x8 am = *(const LAS bf16x8*)(sl + O_MRB + l31 * P_MRB + hh * 16);
                        D = __builtin_amdgcn_mfma_f32_32x32x16_bf16(am, bu, D, 0, 0, 0);
                        LAS float* yb = (LAS float*)(lds + O_YB + (c & 1) * 4096);
#pragma unroll
                        for (int r = 8; r < 16; ++r) yb[((r & 3) + 8 * ((r >> 2) - 2) + 4 * hh) * 64 + 32 * hf + l31] = D[r];
                        const LAS unsigned char* bk0 = sl + O_BKT + l31 * P_BKT + hh * 16; const LAS unsigned char* bk1 = bk0 + 32 * P_BKT;
                        ST0 = __builtin_amdgcn_mfma_f32_32x32x16_bf16(*(const LAS bf16x8*)(bk0), bu, ST0, 0, 0, 0); ST0 = __builtin_amdgcn_mfma_f32_32x32x16_bf16(*(const LAS bf16x8*)(bk0 + 32), bv, ST0, 0, 0, 0);
                        ST1 = __builtin_amdgcn_mfma_f32_32x32x16_bf16(*(const LAS bf16x8*)(bk1), bu, ST1, 0, 0, 0); ST1 = __builtin_amdgcn_mfma_f32_32x32x16_bf16(*(const LAS bf16x8*)(bk1 + 32), bv, ST1, 0, 0, 0);
                        const LAS float* gam = (const LAS float*)(sl + O_GAM) + 4 * hh;
#pragma unroll
                        for (int g4 = 0; g4 < 4; ++g4) { const f32x4 g0 = *(const LAS f32x4*)(gam + 8 * g4), g1 = *(const LAS f32x4*)(gam + 32 + 8 * g4);
#pragma unroll
                            for (int i_ = 0; i_ < 4; ++i_) { ST0[4 * g4 + i_] *= g0[i_]; ST1[4 * g4 + i_] *= g1[i_]; } }
                    }
                }
            } else if (wid == 1) {
                const int c = n - 1;
                if (c >= 0 && c < NCH) {
                    LAS unsigned char* sl = lds + (c % 3) * SLOT;
                    f32x16 Lm = {};
                    const LAS unsigned char* ap = sl + O_BK + l31 * P_BK + hh * 16; const LAS unsigned char* bp = sl + O_AR + l31 * P_AR + hh * 16;
#pragma unroll
                    for (int q = 0; q < 4; ++q) Lm = __builtin_amdgcn_mfma_f32_32x32x16_bf16(*(const LAS bf16x8*)(ap + 32 * q), *(const LAS bf16x8*)(bp + 32 * q), Lm, 0, 0, 0);
                    const int tp = l31, tq = tp & 15; const bool isr = tp >= 16;
                    LAS float* lab = (LAS float*)(sl + O_LAB);
                    float lo[8], hi[8];
#pragma unroll
                    for (int r = 0; r < 8; ++r) { const int s_ = (r & 3) + 8 * (r >> 2) + 4 * hh; const bool keep = isr ? (s_ <= tq) : (s_ < tq);
                        lo[r] = keep ? Lm[r] : 0.f; hi[r] = keep ? Lm[8 + r] : 0.f; }
                    if (!isr) {
#pragma unroll
                        for (int r = 0; r < 8; ++r) lab[((r & 3) + 8 * (r >> 2) + 4 * hh) * 16 + tp] = lo[r]; }
                    { u32x2 w0, w1; w0.x = isr ? cvtpk(lo[0], lo[1]) : 0u; w0.y = isr ? cvtpk(lo[2], lo[3]) : 0u; w1.x = isr ? cvtpk(lo[4], lo[5]) : 0u; w1.y = isr ? cvtpk(lo[6], lo[7]) : 0u;
                      LAS unsigned char* mp = sl + O_MRB + tp * P_MRB + hh * 8; *(LAS u32x2*)(mp) = w0; *(LAS u32x2*)(mp + 16) = w1; }
                    { u32x2 w0, w1; w0.x = cvtpk(hi[0], hi[1]); w0.y = cvtpk(hi[2], hi[3]); w1.x = cvtpk(hi[4], hi[5]); w1.y = cvtpk(hi[6], hi[7]);
                      LAS unsigned char* qp = sl + O_AR + tp * P_AR + 128 + hh * 8; *(LAS u32x2*)(qp) = w0; *(LAS u32x2*)(qp + 16) = w1; }
                }
            } else if (e1) {
                if ((n & 1) != epar) { if (n + 1 < NCH) RS_LOAD(n + 1); }
                else if (n < NCH) {
                    LAS unsigned char* sl = lds + (n % 3) * SLOT;
                    RS_STAGE();
                    float g = 1.0f; float xw[16], xk[16], xr[16];
#pragma unroll
                    for (int t_ = 0; t_ < M; ++t_) { xw[t_] = RS_GET(0, t_); xk[t_] = RS_GET(1, t_); xr[t_] = RS_GET(2, t_); }
#pragma unroll
                    for (int t_ = 0; t_ < M; ++t_) { const float gp = g; g *= xw[t_];
                        *(LAS unsigned short*)(sl + O_AR + t_ * P_AR + cpos) = f2bf(-xk[t_] * gp);
                        *(LAS unsigned short*)(sl + O_AR + (16 + t_) * P_AR + cpos) = f2bf(xr[t_] * g); }
                    *(LAS float*)(sl + O_GAM + 4 * lane) = g;
                    { unsigned short vv[16];
#pragma unroll
                        for (int s_ = 0; s_ < 16; ++s_) vv[s_] = *(const LAS unsigned short*)(stg + 6144 + (s_ * 64 + lane) * 2);
                        u32x4 v0, v1; v0.x = vv[0] | ((unsigned)vv[1] << 16); v0.y = vv[2] | ((unsigned)vv[3] << 16); v0.z = vv[4] | ((unsigned)vv[5] << 16); v0.w = vv[6] | ((unsigned)vv[7] << 16);
                        v1.x = vv[8] | ((unsigned)vv[9] << 16); v1.y = vv[10] | ((unsigned)vv[11] << 16); v1.z = vv[12] | ((unsigned)vv[13] << 16); v1.w = vv[14] | ((unsigned)vv[15] << 16);
                        *(LAS u32x4*)(sl + O_VT + lane * P_VT) = v0; *(LAS u32x4*)(sl + O_VT + lane * P_VT + 16) = v1; }
                }
            } else if (e2) {
                if ((n & 1) != epar) { if (n + 1 < NCH) RS_LOAD(n + 1); }
                else if (n < NCH) {
                    LAS unsigned char* sl = lds + (n % 3) * SLOT;
                    RS_STAGE();
                    float g = 1.0f; float bq[16], kq[16], xw[16], xa[16];
#pragma unroll
                    for (int t_ = 0; t_ < M; ++t_) { xw[t_] = RS_GET(0, t_); xa[t_] = RS_GET(2, t_); bq[t_] = RS_GET(1, t_); kq[t_] = RS_GET(3, t_); }
#pragma unroll
                    for (int t_ = 0; t_ < M; ++t_) { g *= xw[t_]; const float rg = __builtin_amdgcn_rcpf(g); const float al = xa[t_];
                        bq[t_] = bq[t_] * al * rg; kq[t_] = kq[t_] * (1.0f + (al - 1.0f) * kaj) * rg;
                        *(LAS unsigned short*)(sl + O_BK + t_ * P_BK + cpos) = f2bf(bq[t_]);
                        *(LAS unsigned short*)(sl + O_BK + (16 + t_) * P_BK + cpos) = f2bf(kq[t_]); }
                    LAS unsigned char* tp_ = sl + O_BKT + lane * P_BKT;
                    *(LAS bf16x8*)(tp_) = pack_bf8(bq[0], bq[1], bq[2], bq[3], bq[4], bq[5], bq[6], bq[7]); *(LAS bf16x8*)(tp_ + 16) = pack_bf8(bq[8], bq[9], bq[10], bq[11], bq[12], bq[13], bq[14], bq[15]);
                    *(LAS bf16x8*)(tp_ + 32) = pack_bf8(kq[0], kq[1], kq[2], kq[3], kq[4], kq[5], kq[6], kq[7]); *(LAS bf16x8*)(tp_ + 48) = pack_bf8(kq[8], kq[9], kq[10], kq[11], kq[12], kq[13], kq[14], kq[15]);
                }
            } else {
                const int c = n - 3;
                if (wid == 4)
                if (c >= 0 && c < NCH) { const LAS float* yb = (const LAS float*)(lds + O_YB + (c & 1) * 4096); const int t_ = lane >> 2, q_ = lane & 3;
                    const f32x4 y0 = *(const LAS f32x4*)(yb + t_ * 64 + 16 * q_), y1 = *(const LAS f32x4*)(yb + t_ * 64 + 16 * q_ + 4), y2 = *(const LAS f32x4*)(yb + t_ * 64 + 16 * q_ + 8), y3 = *(const LAS f32x4*)(yb + t_ * 64 + 16 * q_ + 12);
                    u32x4 w, w2; w.x = cvt_pk_bf16(y0[0], y0[1]); w.y = cvt_pk_bf16(y0[2], y0[3]); w.z = cvt_pk_bf16(y1[0], y1[1]); w.w = cvt_pk_bf16(y1[2], y1[3]);
                    w2.x = cvt_pk_bf16(y2[0], y2[1]); w2.y = cvt_pk_bf16(y2[2], y2[3]); w2.z = cvt_pk_bf16(y3[0], y3[1]); w2.w = cvt_pk_bf16(y3[2], y3[3]);
                    bf16_t* yp = YS + ((size_t)d * MTOK + RS_ROW(c, t_)) * 1024 + h * 64 + 16 * q_; *(u32x4*)yp = w; *(u32x4*)(yp + 8) = w2; }
#if SCAN_CONVERT
                if (n < NCH) { const int cw = (wid == 7) ? 1 : 0; const int piece = (bx * 2 + cw) + n * (G * 2);
                    if (piece < MOE_PIECES) convert_moe_piece(A, l, (LAS float*)(lds + O_CV + 32768 + cw * 4352), lane, piece); }
#endif
            }
            asm volatile("s_waitcnt lgkmcnt(0)" ::: "memory");
            __builtin_amdgcn_s_barrier();
            asm volatile("" ::: "memory");
        }
#undef RS_LOAD
#undef RS_STAGE
#undef RS_GET
#undef RS_ROW
    }
}

__device__ __forceinline__ void phase_attn(ArgsP A, int l, LAS unsigned char* lds, int tid, int bx, int G) {
    const bf16_t* PROJ = (const bf16_t*)(A->ws + WS_PROJ); bf16_t* MIX = (bf16_t*)(A->ws + WS_MIX);
    float s1 = 0.f, s2 = 0.f;
    for (int i = 0; i < 64; ++i) { s1 += ((const float*)A->in[I_LQ1])[l * 64 + i] * ((const float*)A->in[I_LK1])[l * 64 + i]; s2 += ((const float*)A->in[I_LQ2])[l * 64 + i] * ((const float*)A->in[I_LK2])[l * 64 + i]; }
    const float lam_init = 0.8f - 0.6f * expf(-0.3f * (float)l);
    const float lam = expf(s1) - expf(s2) + lam_init;
    unsigned* ctl = (unsigned*)(A->ws + WS_CTL);
    LAS int* uslot = (LAS int*)(lds + LDS_MISC + 2304);
    const int myx = (int)(xb_xcc_id() & 7u);
    for (int qi = 0; qi < 8; ++qi) {
        const int x = (myx + qi) & 7;
        for (;;) {
            if (tid == 0) *uslot = (int)__hip_atomic_fetch_add(ctl + CW_AQ + (l * 8 + x) * 64, 1u, __ATOMIC_RELAXED, __HIP_MEMORY_SCOPE_AGENT);
            __syncthreads();
            const int k = __builtin_amdgcn_readfirstlane(*uslot);
            __syncthreads();
            if (k >= 128) break;
            const int bh = 4 * x + (k >> 5), qb = k & 31;
            const int b = bh >> 3, h = bh & 7;
            const bf16_t* Qb = PROJ + ((size_t)b * SEQ + qb * 128) * NPROJP + h * 128;
            const bf16_t* Kh = PROJ + ((size_t)b * SEQ) * NPROJP + 1024 + h * 128;
            const bf16_t* Vh = PROJ + ((size_t)b * SEQ) * NPROJP + 2048 + h * 128;
            unsigned char* Ob = (unsigned char*)MIX + (((size_t)b * SEQ + qb * 128) * DM + h * 128) * (WOUT_FP8 ? 1 : 2);
            attn::attn_unit2(Qb, Kh, Vh, Ob, lam, 1.0f - lam_init, (const float*)A->in[I_SUBG] + l * 128, (char*)lds, tid);
        }
    }
}

__device__ __forceinline__ void phase_post(ArgsP A, int l, int lane, int wave, int bx, int G) {
    const bf16_t* SHR = (const bf16_t*)(A->ws + WS_SHR); const bf16_t* DYN = (const bf16_t*)(A->ws + WS_DYN); const bf16_t* YS = (const bf16_t*)(A->ws + WS_YS);
    bf16_t* MIX = (bf16_t*)(A->ws + WS_MIX);
    const int gw = bx * 8 + wave, NGW = G * 8, c = 16 * lane;
    float kav[16], rkv[16], gng[16], gnb[16];
#pragma unroll
    for (int j = 0; j < 16; ++j) { kav[j] = ((const float*)A->in[I_KA])[l * 1024 + c + j]; rkv[j] = ((const float*)A->in[I_RK])[l * 1024 + c + j];
        gng[j] = ((const float*)A->in[I_GNG])[l * 1024 + c + j]; gnb[j] = ((const float*)A->in[I_GNB])[l * 1024 + c + j]; }
    for (int row = gw; row < MTOK; row += NGW) {
        float y[16], t[16], r[16], k[16], v[16], a0[16], a1[16], g[16];
#define LD16(dst, ptr) do { float lo_[8], hi_[8]; unpack8(*(const u32x4*)(ptr), lo_); unpack8(*(const u32x4*)((ptr) + 8), hi_); _Pragma("unroll") for (int j_ = 0; j_ < 8; ++j_) { dst[j_] = lo_[j_]; dst[8 + j_] = hi_[j_]; } } while (0)
        LD16(y, YS + (size_t)row * 1024 + c); LD16(t, YS + ((size_t)MTOK + row) * 1024 + c);
        LD16(r, SHR + (size_t)row * 4096 + c); LD16(k, SHR + (size_t)row * 4096 + 1024 + c); LD16(v, SHR + (size_t)row * 4096 + 2048 + c);
        LD16(a0, DYN + (size_t)row * NDYN + 2048 + c); LD16(a1, DYN + (size_t)row * NDYN + 3072 + c); LD16(g, DYN + (size_t)row * NDYN + 4096 + c);
#undef LD16
        float s = 0.f, bo = 0.f;
#pragma unroll
        for (int j = 0; j < 16; ++j) { y[j] += t[j]; s += y[j]; bo += r[j] * (k[j] * (2.0f + (a0[j] + a1[j] - 2.0f) * kav[j])) * rkv[j]; }
        s += __shfl_xor(s, 1); s += __shfl_xor(s, 2); bo += __shfl_xor(bo, 1); bo += __shfl_xor(bo, 2);
        const float mean = s * (1.0f / 64.0f); float q = 0.f;
#pragma unroll
        for (int j = 0; j < 16; ++j) { y[j] -= mean; q += y[j] * y[j]; }
        q += __shfl_xor(q, 1); q += __shfl_xor(q, 2);
        const float rstd = 1.0f / sqrtf(q * (1.0f / 64.0f) + 64e-5f);
        float o[16];
#pragma unroll
        for (int j = 0; j < 16; ++j) o[j] = (y[j] * rstd * gng[j] + gnb[j] + bo * v[j]) * g[j];
        float o0[8], o1[8];
#pragma unroll
        for (int j = 0; j < 8; ++j) { o0[j] = o[j]; o1[j] = o[8 + j]; }
        if (WOUT_FP8) {
#pragma unroll
            for (int j = 0; j < 8; ++j) { o0[j] *= MIXSC; o1[j] *= MIXSC; }
            unsigned char* mp = (unsigned char*)MIX + (size_t)row * DM + 1024 + c; *(u32x2*)mp = pack8_fp8(o0); *(u32x2*)(mp + 8) = pack8_fp8(o1); }
        else { *(u32x4*)(MIX + (size_t)row * DM + 1024 + c) = pack8(o0); *(u32x4*)(MIX + (size_t)row * DM + 1024 + c + 8) = pack8(o1); }
    }
}

constexpr int NPL = 11, NPHASE = 1 + DEPTH * NPL + 1;
#ifndef ONLY_PHASE
#define ONLY_PHASE -1
#endif
#define PH_ON(k) (ONLY_PHASE < 0 || ONLY_PHASE == (k))
#ifndef REPEAT_PHASE
#define REPEAT_PHASE -1
#endif
#define REP(k, cond) for (int rep_ = 0; rep_ < ((REPEAT_PHASE == (k) && (cond)) ? 2 : 1); ++rep_)
__global__ void __launch_bounds__(512, 2) fwd(Args args) {
    extern __shared__ __attribute__((aligned(16))) unsigned char lds_raw[];
    LAS unsigned char* lds = (LAS unsigned char*)lds_raw;
    const int tid = threadIdx.x, lane = tid & 63, wave = __builtin_amdgcn_readfirstlane(tid >> 6), bx = blockIdx.x, G = gridDim.x;
    if (tid < 4) ((LAS unsigned*)(lds + LDS_MISC))[tid] = 0u;
    __syncthreads();
#if MK_PER_PHASE
#define GRID_BAR() do { } while (0)
#else
    XcdBarrier bar = xcd_barrier_post((unsigned*)(args.ws + WS_CTL) + CW_BAR, (volatile LAS unsigned*)(lds + LDS_MISC));
#define GRID_BAR() xcd_barrier(bar, phase_tid(wave))
#endif
    const int lo = args.ph_lo, hi = args.ph_hi;
#define IN(k) (lo <= (k) && (k) < hi)
#define SEAM(k) do { if (IN(k) && IN((k) + 1)) GRID_BAR(); } while (0)
    if (PH_ON(0) && IN(0)) REP(0, true) { asm volatile("; MARK_PHASE_0"); ArgsP A = phase_args(); const int tl = phase_tid(wave), ll = tl & 63, wl = __builtin_amdgcn_readfirstlane(tl >> 6); phase_prologue(A, lds, tl, ll, wl, bx, G); } SEAM(0);
    for (int l = 0; l < DEPTH; ++l) {
        const int p0 = 1 + l * NPL;
        if (PH_ON(1) && IN(p0 + 0)) REP(1, l == 0) { asm volatile("; MARK_PHASE_1"); ArgsP A = phase_args(); const int tl = phase_tid(wave), ll = tl & 63, wl = __builtin_amdgcn_readfirstlane(tl >> 6); if (l == 0) phase_norm1<0>(A, l, lds, tl, ll, wl, bx, G); else phase_norm1<1>(A, l, lds, tl, ll, wl, bx, G); } SEAM(p0 + 0);
        if (PH_ON(2) && IN(p0 + 1)) REP(2, true) {
            asm volatile("; MARK_PHASE_2"); ArgsP A = phase_args(); const int tl = phase_tid(wave), ll = tl & 63, wl = __builtin_amdgcn_readfirstlane(tl >> 6); unsigned char* ws = A->ws;
            int kk_ = DM; asm volatile("" : "+s"(kk_));
            pg8::Gemm g{(const bf16_t*)(ws + WS_H), (const bf16_t*)(ws + WS_WIN + (size_t)l * NPROJP * DM * (PROJ_FP8 ? 1 : 2)), kk_, 0, nullptr, 0};
            pg8::StaticOrder S; S.init(MTOK, NPROJP, G, bx);
            pg8::EpiProj E{(bf16_t*)(ws + WS_PROJ), (const float*)(ws + WS_ROPE), PROJ_FP8 ? 1.0f / WSC_IN : 1.0f};
            pg8::gemm_phase<pg8::EpiProj, pg8::StaticOrder, false, PROJ_FP8 != 0>(lds, g, S, E, tl);
        } SEAM(p0 + 1);
        if (PH_ON(3) && IN(p0 + 2)) REP(3, true) { asm volatile("; MARK_PHASE_3"); ArgsP A = phase_args(); const int tl = phase_tid(wave), ll = tl & 63, wl = __builtin_amdgcn_readfirstlane(tl >> 6); phase_prep(A, l, ll, wl, bx, G); } SEAM(p0 + 2);
        if (PH_ON(4) && IN(p0 + 3)) REP(4, true) {
            asm volatile("; MARK_PHASE_4"); ArgsP A = phase_args(); const int tl = phase_tid(wave), ll = tl & 63, wl = __builtin_amdgcn_readfirstlane(tl >> 6); unsigned char* ws = A->ws;
            int kla = KLA; asm volatile("" : "+s"(kla));
            int ntw = 2; asm volatile("" : "+s"(ntw));
            pg8::Gemm g{(const bf16_t*)(ws + WS_LA), (const bf16_t*)(ws + WS_LW) + (size_t)l * NDYN * KLA, kla, 0, nullptr, ntw};
            pg8::DynOrder S; S.init(MTOK, NDYN, G, bx);
            pg8::EpiDyn E{(bf16_t*)(ws + WS_DYN), (const float*)A->in[I_DW0] + l * 2048, (const float*)A->in[I_A0] + l * 2048};
            pg8::gemm_phase<pg8::EpiDyn, pg8::DynOrder, false>(lds, g, S, E, tl);
        } SEAM(p0 + 3);
        if (PH_ON(5) && IN(p0 + 4)) REP(5, true) { asm volatile("; MARK_PHASE_5"); ArgsP A = phase_args(); const int tl = phase_tid(wave), ll = tl & 63, wl = __builtin_amdgcn_readfirstlane(tl >> 6); phase_scan(A, l, lds, tl, bx, G); }
#if MK_PER_PHASE
        SEAM(p0 + 4);
#endif
        if (PH_ON(6) && IN(p0 + 5)) REP(6, true) { asm volatile("; MARK_PHASE_6"); ArgsP A = phase_args(); const int tl = phase_tid(wave), ll = tl & 63, wl = __builtin_amdgcn_readfirstlane(tl >> 6); phase_attn(A, l, lds, tl, bx, G); } SEAM(p0 + 5);
        if (PH_ON(7) && IN(p0 + 6)) REP(7, true) { asm volatile("; MARK_PHASE_7"); ArgsP A = phase_args(); const int tl = phase_tid(wave), ll = tl & 63, wl = __builtin_amdgcn_readfirstlane(tl >> 6); phase_post(A, l, ll, wl, bx, G); } SEAM(p0 + 6);
        if (PH_ON(8) && IN(p0 + 7)) REP(8, l == 0) {
            asm volatile("; MARK_PHASE_8"); ArgsP A = phase_args(); const int tl = phase_tid(wave), ll = tl & 63, wl = __builtin_amdgcn_readfirstlane(tl >> 6); unsigned char* ws = A->ws;
            int kk_ = DM; asm volatile("" : "+s"(kk_));
            pg8::Gemm g{(const bf16_t*)(ws + WS_MIX), (const bf16_t*)(ws + WS_WOUT + (size_t)l * DM * DM * (WOUT_FP8 ? 1 : 2)), kk_, 0, nullptr, 0};
            pg8::StaticOrder S; S.init(MTOK, DM, G, bx);
            pg8::EpiRes E{l == 0 ? (const float*)A->in[I_X] : (const float*)nullptr, (bf16_t*)(ws + WS_X), (const float*)(ws + WS_MOD) + (size_t)l * 4 * NMOD + 2 * DM, WOUT_FP8 ? 1.0f / (WSC_O * MIXSC) : 1.0f};
            pg8::gemm_phase<pg8::EpiRes, pg8::StaticOrder, false, WOUT_FP8 != 0>(lds, g, S, E, tl);
        } SEAM(p0 + 7);
        if (PH_ON(9) && IN(p0 + 8)) REP(9, true) { asm volatile("; MARK_PHASE_9"); ArgsP A = phase_args(); const int tl = phase_tid(wave), ll = tl & 63, wl = __builtin_amdgcn_readfirstlane(tl >> 6); phase_norm2_router(A, l, lds, tl, ll, wl, bx, G, rep_); } SEAM(p0 + 8);
        if (PH_ON(10) && IN(p0 + 9)) REP(10, true) {
            asm volatile("; MARK_PHASE_10"); ArgsP A = phase_args(); const int tl = phase_tid(wave), ll = tl & 63, wl = __builtin_amdgcn_readfirstlane(tl >> 6); unsigned char* ws = A->ws;
            load_moe_table(A, l, lds, tl);
            int kk_ = DM; asm volatile("" : "+s"(kk_));
            pg8::Gemm g{(const bf16_t*)(ws + WS_H), (const bf16_t*)(ws + WS_WGU), kk_, (size_t)2048 * DM, (const int*)(ws + WS_TOKL), 0};
            pg8::MoeOrder S{(const LAS int*)(lds + LDS_MISC + 64), (const LAS int*)(lds + LDS_MISC + 192), G, bx, __builtin_amdgcn_readfirstlane(((const LAS int*)(lds + LDS_MISC + 64))[16])};
            pg8::EpiGlu E{ws + WS_ACT, 1.0f / WSC_GU};
            pg8::gemm_phase<pg8::EpiGlu, pg8::MoeOrder, true, true>(lds, g, S, E, tl);
        } SEAM(p0 + 9);
        if (PH_ON(11) && IN(p0 + 10)) REP(11, true) {
            asm volatile("; MARK_PHASE_11"); ArgsP A = phase_args(); const int tl = phase_tid(wave), ll = tl & 63, wl = __builtin_amdgcn_readfirstlane(tl >> 6); unsigned char* ws = A->ws;
            load_moe_table(A, l, lds, tl);
            int kk_ = DFF; asm volatile("" : "+s"(kk_));
            pg8::Gemm g{(const bf16_t*)(ws + WS_ACT), (const bf16_t*)(ws + WS_WD), kk_, (size_t)DM * DFF, nullptr, 0};
            pg8::MoeOrder S{(const LAS int*)(lds + LDS_MISC + 64), (const LAS int*)(lds + LDS_MISC + 192), G, bx, __builtin_amdgcn_readfirstlane(((const LAS int*)(lds + LDS_MISC + 64))[16])};
            pg8::EpiY E{ws + WS_Y, YSC / WSC_D};
            pg8::gemm_phase<pg8::EpiY, pg8::MoeOrder, false, true>(lds, g, S, E, tl);
        } SEAM(p0 + 10);
    }
    if (PH_ON(12) && IN(NPHASE - 1)) { asm volatile("; MARK_PHASE_12"); ArgsP A = phase_args(); const int tl = phase_tid(wave), ll = tl & 63, wl = __builtin_amdgcn_readfirstlane(tl >> 6); phase_norm1<2>(A, DEPTH, lds, tl, ll, wl, bx, G); }
#undef IN
#undef SEAM
}

extern "C" void kernel_launch(void* const* d_in, const int* in_sizes, int n_in, void* d_out, int out_size, void* d_ws, size_t ws_size, hipStream_t stream) {
    static int grid = 0;
    if (grid == 0) {
        if (n_in != 31 || out_size != MTOK * DM || ws_size < WS_END) { fprintf(stderr, "kernel_launch: unexpected shapes (n_in %d out %d ws %zu, need %zu)\n", n_in, out_size, ws_size, (size_t)WS_END); grid = -1; return; }
        int dev = 0, cus = 0;
        if (hipGetDevice(&dev) != hipSuccess || hipDeviceGetAttribute(&cus, hipDeviceAttributeMultiprocessorCount, dev) != hipSuccess) { grid = -1; return; }
        if (hipFuncSetAttribute((const void*)fwd, hipFuncAttributeMaxDynamicSharedMemorySize, LDS_BYTES) != hipSuccess) { fprintf(stderr, "kernel_launch: hipFuncSetAttribute failed\n"); grid = -1; return; }
        int per_cu = 0;
        if (hipOccupancyMaxActiveBlocksPerMultiprocessor(&per_cu, (const void*)fwd, 512, LDS_BYTES) != hipSuccess || per_cu < 1) fprintf(stderr, "kernel_launch: occupancy query says %d\n", per_cu);
        (void)hipGetLastError();
        grid = cus;
    }
    if (grid < 0) return;
    (void)hipMemsetAsync((char*)d_ws + WS_CTL, 0, CTL_BYTES, stream);
    Args a{};
    for (int i = 0; i < 31; ++i) a.in[i] = d_in[i];
    a.out = (float*)d_out; a.ws = (unsigned char*)d_ws;
#if MK_PER_PHASE
    for (int p = 0; p < NPHASE; ++p) { a.ph_lo = p; a.ph_hi = p + 1; hipLaunchKernelGGL(fwd, dim3(grid), dim3(512), LDS_BYTES, stream, a); }
#else
    a.ph_lo = 0; a.ph_hi = NPHASE; hipLaunchKernelGGL(fwd, dim3(grid), dim3(512), LDS_BYTES, stream, a);
#endif
    const hipError_t le = hipPeekAtLastError();
    if (le != hipSuccess) fprintf(stderr, "kernel_launch: launch failed: %s\n", hipGetErrorName(le));
}
```

```cpp
#include <hip/hip_runtime.h>
#include <cstdio>
#include <cstdint>

#ifndef SCAN_CONVERT
#define SCAN_CONVERT 0
#endif
#ifndef PROJ_FP8
#define PROJ_FP8 1
#endif
#ifndef MK_PER_PHASE
#define MK_PER_PHASE 0
#endif

#define LAS __attribute__((address_space(3)))
typedef unsigned short bf16_t;
typedef short bf16x8 __attribute__((ext_vector_type(8)));
typedef short s16x4 __attribute__((ext_vector_type(4)));
typedef float f32x4 __attribute__((ext_vector_type(4)));
typedef float f32x2 __attribute__((ext_vector_type(2)));
typedef float f32x16 __attribute__((ext_vector_type(16)));
typedef unsigned u32x4 __attribute__((ext_vector_type(4)));
typedef unsigned u32x2 __attribute__((ext_vector_type(2)));

constexpr int BATCH = 4, SEQ = 4096, DM = 2048, MTOK = BATCH * SEQ, DEPTH = 2;
constexpr int NPROJ = 6528, NPROJP = 6656, RW0 = 3072, RWC = 3456;
constexpr int NEXP = 16, DFF = 1024, TOKCAP = 16384;
constexpr int NMOD = 6 * DM;
constexpr int NDYN = 5120, KLA = 384;
constexpr float C2 = 0.18033688011112042f;
constexpr int MAXTILES = 144;
#ifndef WOUT_FP8
#define WOUT_FP8 1
#endif
constexpr float WSC_O = 32.0f, MIXSC = 8.0f;
constexpr float WSC_GU = 32.0f, WSC_D = 16.0f, WSC_IN = 32.0f, YSC = 8.0f;

constexpr size_t MiB = 1u << 20;
constexpr size_t WS_CTL = 0, CTL_BYTES = 1 * MiB;
constexpr size_t WS_MOD = 1 * MiB;
constexpr size_t WS_ROPE = 2 * MiB;
constexpr size_t WS_TOKL = 3 * MiB;
constexpr size_t WS_ASG = 4 * MiB;
constexpr size_t WS_LW = 5 * MiB;
constexpr size_t WS_WIN = 13 * MiB;
constexpr size_t WS_WOUT = 65 * MiB;
constexpr size_t WS_WGU = 81 * MiB;
constexpr size_t WS_WD = 209 * MiB;
constexpr size_t WS_X = 273 * MiB;
constexpr size_t WS_H = 401 * MiB;
constexpr size_t WS_MIX = 466 * MiB;
constexpr size_t WS_PROJ = 530 * MiB;
constexpr size_t WS_SHR = 738 * MiB;
constexpr size_t WS_LA = 866 * MiB;
constexpr size_t WS_DYN = 878 * MiB;
constexpr size_t WS_YS = 1038 * MiB;
constexpr size_t WS_END = 1102 * MiB;
constexpr size_t WS_ACT = 530 * MiB;
constexpr size_t WS_Y = 602 * MiB;
constexpr int CW_BAR = 4096;
constexpr int CW_CNT = 16384;
constexpr int CW_AQ = 24576;

constexpr int LDS_MISC = 131072;
constexpr int LDS_BYTES = 147456;

__device__ __forceinline__ unsigned cvt_pk_bf16(float lo, float hi) { unsigned r; asm volatile("v_cvt_pk_bf16_f32 %0, %1, %2" : "=v"(r) : "v"(lo), "v"(hi)); return r; }
__device__ __forceinline__ float bflo(unsigned w) { return __uint_as_float(w << 16); }
__device__ __forceinline__ float bfhi(unsigned w) { return __uint_as_float(w & 0xffff0000u); }
__device__ __forceinline__ void unpack8(const u32x4 w, float (&f)[8]) { f[0] = bflo(w.x); f[1] = bfhi(w.x); f[2] = bflo(w.y); f[3] = bfhi(w.y); f[4] = bflo(w.z); f[5] = bfhi(w.z); f[6] = bflo(w.w); f[7] = bfhi(w.w); }
__device__ __forceinline__ u32x4 pack8(const float (&f)[8]) { u32x4 w; w.x = cvt_pk_bf16(f[0], f[1]); w.y = cvt_pk_bf16(f[2], f[3]); w.z = cvt_pk_bf16(f[4], f[5]); w.w = cvt_pk_bf16(f[6], f[7]); return w; }
__device__ __forceinline__ float sat8(float x) { return __builtin_amdgcn_fmed3f(x, -448.0f, 448.0f); }
__device__ __forceinline__ int pk4_fp8(float a, float b, float c, float d) { int w = 0; w = __builtin_amdgcn_cvt_pk_fp8_f32(sat8(a), sat8(b), w, false); w = __builtin_amdgcn_cvt_pk_fp8_f32(sat8(c), sat8(d), w, true); return w; }
__device__ __forceinline__ u32x2 pack8_fp8(const float (&f)[8]) { int a = 0, b = 0;
    a = pk4_fp8(f[0], f[1], f[2], f[3]); b = pk4_fp8(f[4], f[5], f[6], f[7]); u32x2 w; w.x = (unsigned)a; w.y = (unsigned)b; return w; }
__device__ __forceinline__ float sigmoidf_(float x) { return __builtin_amdgcn_rcpf(1.0f + __builtin_amdgcn_exp2f(-1.4426950408889634f * x)); }
__device__ __forceinline__ float wave_sum(float v) {
#pragma unroll
    for (int o = 1; o < 64; o <<= 1) v += __shfl_xor(v, o);
    return v;
}
#define LDS_WAIT() asm volatile("s_waitcnt lgkmcnt(0)" ::: "memory")
#define VM_WAIT() asm volatile("s_waitcnt vmcnt(0)" ::: "memory")

#define XB_TMO      128
#define XB_XCNT(j)  (256  + 64 * (j))
#define XB_XSUB(j)  (1280 + 64 * (j))
#define XB_XGEN(j)  (2304 + 64 * (j))
#define XB_TOP      3328
#define XB_TOPGEN   3392
#define XCD_BAR_WORDS 3456
#define XB_SPIN_CAP (1u << 18)

__device__ __forceinline__ unsigned xb_ld(unsigned* p)              { return __hip_atomic_load(p, __ATOMIC_RELAXED, __HIP_MEMORY_SCOPE_AGENT); }
__device__ __forceinline__ unsigned xb_add(unsigned* p, unsigned v) { return __hip_atomic_fetch_add(p, v, __ATOMIC_RELAXED, __HIP_MEMORY_SCOPE_AGENT); }
__device__ __forceinline__ unsigned xb_xcc_id() { return (unsigned)__builtin_amdgcn_s_getreg((3 << 11) | 20) & 0xFu; }
#define XB_SPIN(cond, bar) do { unsigned _sp = 0; while (cond) { __builtin_amdgcn_s_sleep(1); \
    if ((++_sp & 255u) == 0u) { if (xb_ld(&(bar)[XB_TMO])) break; if (_sp > XB_SPIN_CAP) { atomicAdd(&(bar)[XB_TMO], 1u); break; } } } } while (0)

struct XcdBarrier { unsigned* bar; unsigned x; volatile LAS unsigned* st; };

__device__ __forceinline__ XcdBarrier xcd_barrier_post(unsigned* bar, volatile LAS unsigned* st) {
    XcdBarrier b; b.bar = bar; b.x = xb_xcc_id(); b.st = st;
    if (threadIdx.x == 0) (void)xb_add(&bar[XB_XCNT(b.x)], 1u);
    return b;
}
__device__ __forceinline__ void xcd_barrier_complete(unsigned* bar, unsigned x, unsigned& nloc, unsigned& nx) {
    const unsigned G = gridDim.x * gridDim.y * gridDim.z;
    unsigned sum, cnt, mine, sp = 0u;
    for (;;) {
        sum = 0u; cnt = 0u; mine = 0u;
#pragma unroll
        for (unsigned j = 0; j < 16; ++j) { const unsigned c = xb_ld(&bar[XB_XCNT(j)]); sum += c; cnt += (c > 0u) ? 1u : 0u; mine = (j == x) ? c : mine; }
        if (sum == G) break;
        __builtin_amdgcn_s_sleep(1);
        if ((++sp & 255u) == 0u) { if (xb_ld(&bar[XB_TMO])) break; if (sp > XB_SPIN_CAP) { atomicAdd(&bar[XB_TMO], 1u); break; } }
    }
    nloc = mine > 0u ? mine : 1u; nx = cnt > 0u ? cnt : 1u;
}
__device__ __forceinline__ void xcd_barrier(const XcdBarrier& b, int tid_) {
    asm volatile("s_waitcnt vmcnt(0)" ::: "memory");
    __syncthreads();
    if (tid_ == 0) {
        unsigned* bar = b.bar;
        __builtin_amdgcn_s_waitcnt(0);
        unsigned nloc = b.st[0], nx = b.st[1];
        if (nloc == 0u) { xcd_barrier_complete(bar, b.x, nloc, nx); b.st[0] = nloc; b.st[1] = nx; }
        const unsigned old = xb_add(&bar[XB_XSUB(b.x)], 1u);
        const unsigned gen = old / nloc;
        if (old + 1u == (gen + 1u) * nloc) {
            __builtin_amdgcn_fence(__ATOMIC_RELEASE, "agent");
            asm volatile("s_waitcnt vmcnt(0)" ::: "memory");
            const unsigned og = xb_add(&bar[XB_TOP], 1u);
            const unsigned tg = og / nx;
            if (og + 1u == (tg + 1u) * nx) xb_add(&bar[XB_TOPGEN], 1u);
            else XB_SPIN(xb_ld(&bar[XB_TOPGEN]) == tg, bar);
            __builtin_amdgcn_fence(__ATOMIC_ACQUIRE, "agent");
            xb_add(&bar[XB_XGEN(b.x)], 1u);
            asm volatile("s_waitcnt vmcnt(0)" ::: "memory");
        } else {
            XB_SPIN(xb_ld(&bar[XB_XGEN(b.x)]) == gen, bar);
            __builtin_amdgcn_fence(__ATOMIC_ACQUIRE, "agent");
            asm volatile("s_waitcnt vmcnt(0)" ::: "memory");
        }
    }
    __syncthreads();
}

namespace pg8 {
constexpr int BM = 256, BK = 64, HALF = 128, HTB = HALF * BK * 2, STAGE_BYTES = 8 * HTB, NXCD = 8, WGM = 8;
__host__ __device__ __forceinline__ int lds_byte(int r, int c) { const int st = (r >> 4) * 2 + (c >> 5), rr = r & 15, cc = c & 31, ob = rr * 64 + cc * 2; return st * 1024 + (ob ^ (((ob >> 9) & 1) << 5)); }
__host__ __device__ __forceinline__ void stage_rc(int b, int& R, int& C) { const int st = b / 1024, sb = b % 1024, swz = sb ^ (((sb >> 9) & 1) << 5); R = (st >> 1) * 16 + swz / 64; C = (st & 1) * 32 + (swz % 64) / 2; }
__host__ __device__ __forceinline__ int perm32(int rho) { const int n = rho >> 4, i = rho & 15; return 8 * (i >> 2) + 4 * n + (i & 3); }

struct Unit { int pm, pn, e, jl, cnt, koff; };
struct Gemm { const bf16_t* A; const bf16_t* Bt; int K; size_t bstride; const int* tokl; int ntov; };

struct StaticOrder {
    int nM, nN, nwg, G, c;
    __device__ void init(int M, int N, int G_, int c_) { nM = M / BM; nN = N / BM; nwg = nM * nN; G = G_; c = c_; }
    __device__ bool next(int i, Unit& u) const {
        const long L = (long)i * G + c; if (L >= nwg) return false;
        int wgid = (int)L; { const int q = nwg / NXCD, r = nwg % NXCD, xcd = wgid % NXCD, off = wgid / NXCD; wgid = (xcd < r ? xcd * (q + 1) : r * (q + 1) + (xcd - r) * q) + off; }
        const int nig = WGM * nN, gid = wgid / nig, fm = gid * WGM, gsz = (nM - fm) < WGM ? (nM - fm) : WGM;
        u.pm = fm + ((wgid % nig) % gsz); u.pn = (wgid % nig) / gsz; u.e = 0; u.jl = 0; u.cnt = 0; u.koff = 0; return true;
    }
};
struct DynOrder : StaticOrder {
    __device__ bool next(int i, Unit& u) const { if (!StaticOrder::next(i, u)) return false; u.koff = (u.pn < 8 ? 0 : (u.pn < 16 ? 128 : 256)) * 2; return true; }
};
struct MoeOrder {
    const LAS int* tb; const LAS int* cn; int G, c, ntot;
    __device__ bool next(int i, Unit& u) const {
        const long L = (long)i * G + c; if (L >= (long)ntot * 8) return false;
        const int mt = (int)(L >> 3); int e = 0;
#pragma unroll
        for (int k = 1; k < 16; ++k) e += (mt >= tb[k]) ? 1 : 0;
        e = __builtin_amdgcn_readfirstlane(e);
        u.koff = 0; u.pm = mt; u.pn = (int)(L & 7); u.e = e; u.jl = __builtin_amdgcn_readfirstlane(mt - tb[e]); u.cnt = __builtin_amdgcn_readfirstlane(cn[e]); return true;
    }
};

typedef int i32x8 __attribute__((ext_vector_type(8)));
typedef int i32x4_ __attribute__((ext_vector_type(4)));
template <class Epi, class Sched, bool GATHER, bool FP8 = false>
__device__ __forceinline__ void gemm_phase(LAS unsigned char* lds, const Gemm g, const Sched& S, const Epi& E, const int tid) {
    const int wid = __builtin_amdgcn_readfirstlane(tid >> 6), lane = tid & 63, wr = wid >> 2, wc = wid & 3, fr = lane & 15, fq = lane >> 4;
    const int K = FP8 ? (g.K >> 1) : g.K, nt = g.ntov ? g.ntov : K / BK;
    unsigned voffA[2], voffB[2]; int Rr[2], Cc[2];
#pragma unroll
    for (int i = 0; i < 2; ++i) { int R, C; stage_rc(tid * 16 + i * 8192, R, C); const int Rb = Epi::PERM ? ((R & ~31) + perm32(R & 31)) : R;
        voffA[i] = (unsigned)(R * K + C) * 2u; voffB[i] = (unsigned)(Rb * K + C) * 2u; Rr[i] = R; Cc[i] = C; }
    const size_t kstep = (size_t)(BK * 2);
    const size_t hstep = (size_t)HALF * K * 2;
    const size_t tstep = 2 * hstep;
    const unsigned ldsw = (unsigned)wid * 1024u;
    const int aoff = lds_byte(wr * 64 + fr, fq * 8), boff = lds_byte(wc * 32 + fr, fq * 8);
#define PG8_SA(b, h) (((b) * 2 + (h)) * HTB)
#define PG8_SB(b, h) ((4 + (b) * 2 + (h)) * HTB)
#define PG8_STAGE(bufoff, gbase, voff) do { _Pragma("unroll") for (int _i = 0; _i < 2; ++_i) \
        __builtin_amdgcn_global_load_lds((const unsigned*)((const char*)(gbase) + (voff)[_i]), (LAS unsigned*)(lds + (bufoff) + ldsw + _i * 8192), 16, 0, 0); } while (0)
#define PG8_LDA(dst, b, h) do { _Pragma("unroll") for (int m = 0; m < 4; ++m) _Pragma("unroll") for (int k = 0; k < 2; ++k) dst[m][k] = *(const LAS bf16x8*)(lds + PG8_SA(b, h) + aoff + m * 2048 + k * 1024); } while (0)
#define PG8_LDB(dst, b, h) do { _Pragma("unroll") for (int n = 0; n < 2; ++n) _Pragma("unroll") for (int k = 0; k < 2; ++k) dst[n][k] = *(const LAS bf16x8*)(lds + PG8_SB(b, h) + boff + n * 2048 + k * 1024); } while (0)
#define PG8_CAT(x) __builtin_shufflevector(__builtin_bit_cast(i32x4_, (x)[0]), __builtin_bit_cast(i32x4_, (x)[1]), 0, 1, 2, 3, 4, 5, 6, 7)
#define PG8_MMA(ai, bj, At, Bt) do { __builtin_amdgcn_s_setprio(1); \
        if constexpr (FP8) { _Pragma("unroll") for (int m = 0; m < 4; ++m) _Pragma("unroll") for (int n = 0; n < 2; ++n) \
            { const i32x8 b8_ = PG8_CAT(Bt[n]), a8_ = PG8_CAT(At[m]); \
              asm volatile("v_mfma_scale_f32_16x16x128_f8f6f4 %0, %1, %2, %0, %3, %3 op_sel_hi:[0,0,0]" : "+v"(acc[ai][bj][m][n]) : "v"(b8_), "v"(a8_), "v"(0x7F7F7F7F)); } } \
        else { _Pragma("unroll") for (int m = 0; m < 4; ++m) _Pragma("unroll") for (int n = 0; n < 2; ++n) _Pragma("unroll") for (int k = 0; k < 2; ++k) \
            acc[ai][bj][m][n] = __builtin_amdgcn_mfma_f32_16x16x32_bf16(Bt[n][k], At[m][k], acc[ai][bj][m][n], 0, 0, 0); } \
        __builtin_amdgcn_s_setprio(0); } while (0)
#define PG8_WAIT_V(n) asm volatile("s_waitcnt vmcnt(" #n ")" ::: "memory")
#define PG8_WAIT_L(n) asm volatile("s_waitcnt lgkmcnt(" #n ")" ::: "memory")
#define PG8_BAR __builtin_amdgcn_s_barrier()
#define PG8_SCHED __builtin_amdgcn_sched_barrier(0)
#define PG8_GOFF(dst, u) do { _Pragma("unroll") for (int _h = 0; _h < 2; ++_h) _Pragma("unroll") for (int _i = 0; _i < 2; ++_i) { \
        const int _slot = (u).jl * 256 + _h * 128 + Rr[_i]; const int _tok = (_slot < (u).cnt) ? g.tokl[(u).e * TOKCAP + _slot] : 0; dst[_h][_i] = (unsigned)(_tok * K + Cc[_i]) * 2u; } } while (0)
    Unit cur, nxt; int ui = 0;
    if (!S.next(0, cur)) return;
    f32x4 acc[2][2][4][2];
#pragma unroll
    for (int a = 0; a < 2; ++a)
#pragma unroll
        for (int b = 0; b < 2; ++b)
#pragma unroll
            for (int m = 0; m < 4; ++m)
#pragma unroll
                for (int n = 0; n < 2; ++n) acc[a][b][m][n] = (f32x4){0.f, 0.f, 0.f, 0.f};
    bf16x8 At[4][2], B0[2][2], B1[2][2];
    const char* Ab = (const char*)g.A;
    const char* cA = Ab + (size_t)cur.pm * tstep + cur.koff; const char* cB = (const char*)g.Bt + (size_t)cur.e * g.bstride + (size_t)cur.pn * tstep + cur.koff;
    unsigned offc[2][2], offn[2][2];
    if constexpr (GATHER) { PG8_GOFF(offc, cur); }
#define PG8_STA_C(bufoff, h, kb) do { if constexpr (GATHER) { PG8_STAGE(bufoff, Ab + (kb), offc[h]); } else { PG8_STAGE(bufoff, cA + (h) * hstep + (kb), voffA); } } while (0)
    PG8_STAGE(PG8_SB(0, 0), cB, voffB); PG8_STAGE(PG8_SB(0, 1), cB + hstep, voffB); PG8_STA_C(PG8_SA(0, 0), 0, 0); PG8_STA_C(PG8_SA(0, 1), 1, 0);
    if (wr == 1) PG8_BAR;
    PG8_WAIT_V(2); PG8_BAR;
    PG8_STAGE(PG8_SB(1, 0), cB + kstep, voffB); PG8_STA_C(PG8_SA(1, 0), 0, kstep); PG8_STAGE(PG8_SB(1, 1), cB + hstep + kstep, voffB);
    PG8_WAIT_V(6); PG8_BAR;
    for (;;) {
        const bool has_next = S.next(ui + 1, nxt);
        const char* nA = has_next ? Ab + (size_t)nxt.pm * tstep + nxt.koff : cA; const char* nB = has_next ? (const char*)g.Bt + (size_t)nxt.e * g.bstride + (size_t)nxt.pn * tstep + nxt.koff : cB;
        if constexpr (GATHER) {
            if (has_next) { PG8_GOFF(offn, nxt); }
            else {
#pragma unroll
                for (int h = 0; h < 2; ++h)
#pragma unroll
                    for (int i = 0; i < 2; ++i) offn[h][i] = offc[h][i]; }
        }
        for (int t = 0; t < nt; t += 2) {
            const bool last = (t == nt - 2);
            const size_t kb1 = (size_t)(t + 1) * kstep;
            const char* b2 = last ? nB : cB + (size_t)(t + 2) * kstep; const char* b3 = b2 + kstep;
            const char* a2 = last ? nA : cA + (size_t)(t + 2) * kstep; const char* a3 = a2 + kstep;
            unsigned o2[2][2]; size_t kb2 = last ? 0 : (size_t)(t + 2) * kstep;
            if constexpr (GATHER) {
#pragma unroll
                for (int h = 0; h < 2; ++h)
#pragma unroll
                    for (int i = 0; i < 2; ++i) o2[h][i] = last ? offn[h][i] : offc[h][i];
            }
#define PG8_STA_2(bufoff, h, extra) do { if constexpr (GATHER) { PG8_STAGE(bufoff, Ab + kb2 + (extra), o2[h]); } else { PG8_STAGE(bufoff, a2 + (h) * hstep + (extra), voffA); } } while (0)
            PG8_LDB(B0, 0, 0); PG8_LDB(B1, 0, 1); PG8_SCHED; PG8_LDA(At, 0, 0); PG8_STA_C(PG8_SA(1, 1), 1, kb1);
            PG8_WAIT_V(8); PG8_WAIT_L(0); PG8_BAR; PG8_MMA(0, 0, At, B0); PG8_MMA(0, 1, At, B1); PG8_BAR; PG8_SCHED;
            PG8_LDA(At, 0, 1); PG8_STAGE(PG8_SB(0, 0), b2, voffB); PG8_STAGE(PG8_SB(0, 1), b2 + hstep, voffB); PG8_STA_2(PG8_SA(0, 0), 0, 0);
            PG8_WAIT_V(8); PG8_WAIT_L(0); PG8_BAR; PG8_MMA(1, 0, At, B0); PG8_MMA(1, 1, At, B1); PG8_BAR; PG8_SCHED;
            PG8_LDB(B0, 1, 0); PG8_LDB(B1, 1, 1); PG8_SCHED; PG8_LDA(At, 1, 0); PG8_STA_2(PG8_SA(0, 1), 1, 0);
            PG8_WAIT_V(8); PG8_WAIT_L(0); PG8_BAR; PG8_MMA(0, 0, At, B0); PG8_MMA(0, 1, At, B1); PG8_BAR; PG8_SCHED;
            PG8_LDA(At, 1, 1); PG8_STAGE(PG8_SB(1, 0), b3, voffB); PG8_STAGE(PG8_SB(1, 1), b3 + hstep, voffB); PG8_STA_2(PG8_SA(1, 0), 0, kstep);
            PG8_WAIT_V(8); PG8_WAIT_L(0); PG8_BAR; PG8_MMA(1, 0, At, B0); PG8_MMA(1, 1, At, B1); PG8_BAR; PG8_SCHED;
#undef PG8_STA_2
            (void)a3;
        }
        if (wr == 0) PG8_BAR;
        { int l2 = lane; asm volatile("" : "+v"(l2)); E(acc, cur, wr, wc, l2 & 15, l2 >> 4); }
        if (!has_next) break;
#pragma unroll
        for (int a = 0; a < 2; ++a)
#pragma unroll
            for (int b = 0; b < 2; ++b)
#pragma unroll
                for (int m = 0; m < 4; ++m)
#pragma unroll
                    for (int n = 0; n < 2; ++n) acc[a][b][m][n] = (f32x4){0.f, 0.f, 0.f, 0.f};
        cur = nxt; cA = nA; cB = nB; ++ui;
        if constexpr (GATHER) {
#pragma unroll
            for (int h = 0; h < 2; ++h)
#pragma unroll
                for (int i = 0; i < 2; ++i) offc[h][i] = offn[h][i];
        }
        if (wr == 1) PG8_BAR;
    }
    PG8_WAIT_V(0);
    PG8_BAR;
#undef PG8_STA_C
#undef PG8_GOFF
#undef PG8_SA
#undef PG8_SB
#undef PG8_STAGE
#undef PG8_LDA
#undef PG8_LDB
#undef PG8_MMA
#undef PG8_CAT
#undef PG8_WAIT_V
#undef PG8_WAIT_L
#undef PG8_BAR
#undef PG8_SCHED
}

struct EpiProj {
    static constexpr bool PERM = true;
    bf16_t* O; const float* rope; float inv;
    __device__ __forceinline__ void operator()(const f32x4 (&acc)[2][2][4][2], const Unit& u, int wr, int wc, int fr, int fq) const {
        const int row0 = u.pm * BM + wr * 64 + fr, col0 = u.pn * BM + wc * 32 + 8 * fq;
        const bool dorope = (u.pn < 8) && ((wc & 1) == 0) && (fq < 2);
        const float sc = ((u.pn < 4) ? C2 : 1.0f) * inv;
#pragma unroll
        for (int ai = 0; ai < 2; ++ai)
#pragma unroll
            for (int m = 0; m < 4; ++m) {
                const int row = row0 + ai * HALF + m * 16;
                bf16_t* rowp = O + (size_t)row * NPROJP + col0;
                f32x4 cs = (f32x4){1.f, 1.f, 1.f, 1.f}, sn = (f32x4){0.f, 0.f, 0.f, 0.f};
                if (dorope) { cs = *(const f32x4*)(rope + (size_t)row * 16 + 4 * fq); sn = *(const f32x4*)(rope + (size_t)row * 16 + 8 + 4 * fq); }
#pragma unroll
                for (int bj = 0; bj < 2; ++bj) {
                    f32x4 v0 = acc[ai][bj][m][0], v1 = acc[ai][bj][m][1];
                    const f32x4 r0 = (v0 * cs - v1 * sn) * sc, r1 = (v1 * cs + v0 * sn) * sc;
                    u32x4 w; w.x = cvt_pk_bf16(r0[0], r0[1]); w.y = cvt_pk_bf16(r0[2], r0[3]); w.z = cvt_pk_bf16(r1[0], r1[1]); w.w = cvt_pk_bf16(r1[2], r1[3]);
                    *(u32x4*)(rowp + bj * HALF) = w; }
            }
    }
};
struct EpiDyn {
    static constexpr bool PERM = true;
    bf16_t* O; const float* w0; const float* a0;
    __device__ __forceinline__ void operator()(const f32x4 (&acc)[2][2][4][2], const Unit& u, int wr, int wc, int fr, int fq) const {
        const int row0 = u.pm * BM + wr * 64 + fr, col0 = u.pn * BM + wc * 32 + 8 * fq;
        const int kind = u.pn >> 3;
        const float* bsrc = (kind == 0) ? (w0 + col0) : (a0 + (col0 - 2048));
#pragma unroll
        for (int bj = 0; bj < 2; ++bj) {
            f32x4 b0 = (f32x4){0.f, 0.f, 0.f, 0.f}, b1 = b0;
            if (kind < 2) { b0 = *(const f32x4*)(bsrc + bj * HALF); b1 = *(const f32x4*)(bsrc + bj * HALF + 4); }
#pragma unroll
            for (int ai = 0; ai < 2; ++ai)
#pragma unroll
                for (int m = 0; m < 4; ++m) {
                    f32x4 v0 = acc[ai][bj][m][0] + b0, v1 = acc[ai][bj][m][1] + b1;
                    if (kind < 2) {
#pragma unroll
                        for (int j = 0; j < 4; ++j) { float s0 = sigmoidf_(v0[j]), s1 = sigmoidf_(v1[j]);
                            if (kind == 0) { s0 = __builtin_amdgcn_exp2f(-0.875039f * s0); s1 = __builtin_amdgcn_exp2f(-0.875039f * s1); }
                            v0[j] = s0; v1[j] = s1; } }
                    u32x4 w; w.x = cvt_pk_bf16(v0[0], v0[1]); w.y = cvt_pk_bf16(v0[2], v0[3]); w.z = cvt_pk_bf16(v1[0], v1[1]); w.w = cvt_pk_bf16(v1[2], v1[3]);
                    *(u32x4*)(O + (size_t)(row0 + ai * HALF + m * 16) * NDYN + col0 + bj * HALF) = w;
                    __builtin_amdgcn_sched_barrier(0); }
        }
    }
};
struct EpiRes {
    static constexpr bool PERM = true;
    const float* xin32; bf16_t* X; const float* g1; float inv;
    __device__ __forceinline__ void operator()(const f32x4 (&acc)[2][2][4][2], const Unit& u, int wr, int wc, int fr, int fq) const {
        const int row0 = u.pm * BM + wr * 64 + fr, col0 = u.pn * BM + wc * 32 + 8 * fq;
        const int b = (u.pm * BM) / SEQ;
        f32x4 gv[2][2];
#pragma unroll
        for (int bj = 0; bj < 2; ++bj)
#pragma unroll
            for (int n = 0; n < 2; ++n) gv[bj][n] = *(const f32x4*)(g1 + (size_t)b * NMOD + col0 + bj * HALF + 4 * n) * inv;
#pragma unroll
        for (int ai = 0; ai < 2; ++ai)
#pragma unroll
            for (int m = 0; m < 4; ++m) { const size_t off = (size_t)(row0 + ai * HALF + m * 16) * DM + col0;
#pragma unroll
                for (int bj = 0; bj < 2; ++bj) { f32x4 x0, x1;
                    if (xin32) { x0 = *(const f32x4*)(xin32 + off + bj * HALF); x1 = *(const f32x4*)(xin32 + off + bj * HALF + 4); }
                    else { const u32x4 p = *(const u32x4*)(X + off + bj * HALF); x0 = (f32x4){bflo(p.x), bfhi(p.x), bflo(p.y), bfhi(p.y)}; x1 = (f32x4){bflo(p.z), bfhi(p.z), bflo(p.w), bfhi(p.w)}; }
                    const f32x4 r0 = x0 + gv[bj][0] * acc[ai][bj][m][0], r1 = x1 + gv[bj][1] * acc[ai][bj][m][1];
                    u32x4 w; w.x = cvt_pk_bf16(r0[0], r0[1]); w.y = cvt_pk_bf16(r0[2], r0[3]); w.z = cvt_pk_bf16(r1[0], r1[1]); w.w = cvt_pk_bf16(r1[2], r1[3]);
                    *(u32x4*)(X + off + bj * HALF) = w; } }
    }
};
struct EpiGlu {
    static constexpr bool PERM = true;
    unsigned char* O; float inv;
    __device__ __forceinline__ void operator()(const f32x4 (&acc)[2][2][4][2], const Unit& u, int wr, int wc, int fr, int fq) const {
        const int row0 = u.pm * BM + wr * 64 + fr, j0 = u.pn * 128 + wc * 16 + 4 * fq;
#pragma unroll
        for (int ai = 0; ai < 2; ++ai)
#pragma unroll
            for (int m = 0; m < 4; ++m) { unsigned char* rowp = O + (size_t)(row0 + ai * HALF + m * 16) * DFF + j0;
#pragma unroll
                for (int bj = 0; bj < 2; ++bj) { const f32x4 gt = acc[ai][bj][m][0] * inv, up = acc[ai][bj][m][1] * inv; f32x4 r;
#pragma unroll
                    for (int j = 0; j < 4; ++j) r[j] = gt[j] * sigmoidf_(gt[j]) * up[j];
                    *(int*)(rowp + bj * 64) = pk4_fp8(r[0], r[1], r[2], r[3]); } }
    }
};
struct EpiY {
    static constexpr bool PERM = true;
    unsigned char* O; float inv;
    __device__ __forceinline__ void operator()(const f32x4 (&acc)[2][2][4][2], const Unit& u, int wr, int wc, int fr, int fq) const {
        const int row0 = u.pm * BM + wr * 64 + fr, col0 = u.pn * BM + wc * 32 + 8 * fq;
#pragma unroll
        for (int ai = 0; ai < 2; ++ai)
#pragma unroll
            for (int m = 0; m < 4; ++m) { unsigned char* rowp = O + (size_t)(row0 + ai * HALF + m * 16) * DM + col0;
#pragma unroll
                for (int bj = 0; bj < 2; ++bj) { const f32x4 v0 = acc[ai][bj][m][0] * inv, v1 = acc[ai][bj][m][1] * inv;
                    u32x2 w; w.x = (unsigned)pk4_fp8(v0[0], v0[1], v0[2], v0[3]); w.y = (unsigned)pk4_fp8(v1[0], v1[1], v1[2], v1[3]);
                    *(u32x2*)(rowp + bj * HALF) = w; } }
    }
};
}

namespace attn {
constexpr int KVBLK = 64;
constexpr size_t SHM_V = KVBLK * 128 * 2, SHM_K = KVBLK * 128 * 2;
constexpr int WS_OFF = 3 * SHM_V + 3 * SHM_K;
constexpr float THRL = 8.0f;
#define KSWZ(row, colB) ((row) * 256 + ((colB) ^ (((row) & 7) << 4)))
#define SBAR() __builtin_amdgcn_sched_barrier(0)
__device__ __forceinline__ int crow(int r, int hi) { return (r & 3) + 8 * (r >> 2) + 4 * hi; }

__device__ __forceinline__ void partialSM(f32x16& p0, f32x16& p1, float& m_reg, float& mn, float& alpha) {
    float pmax = p0[0];
#pragma unroll
    for (int r = 1; r < 16; ++r) pmax = fmaxf(pmax, p0[r]);
#pragma unroll
    for (int r = 0; r < 16; ++r) pmax = fmaxf(pmax, p1[r]);
    { auto rr = __builtin_amdgcn_permlane32_swap(__float_as_uint(pmax), __float_as_uint(pmax), false, false);
      pmax = fmaxf(__uint_as_float(rr[0]), __uint_as_float(rr[1])); }
    if (__builtin_expect(__all(pmax - m_reg <= THRL), 1)) { mn = m_reg; alpha = 1.f; }
    else { mn = fmaxf(m_reg, pmax); alpha = __builtin_amdgcn_exp2f(m_reg - mn); m_reg = mn; }
#pragma unroll
    for (int r = 0; r < 16; ++r) p0[r] = p0[r] - mn;
#pragma unroll
    for (int r = 0; r < 16; ++r) p1[r] = p1[r] - mn;
#pragma unroll
    for (int r = 0; r < 16; ++r) p0[r] = __builtin_amdgcn_exp2f(p0[r]);
}
__device__ __forceinline__ void finishSM(f32x16& p0, f32x16& p1, float alpha, float& l_reg, bf16x8& pa0, bf16x8& pa1, bf16x8& pa2, bf16x8& pa3) {
#pragma unroll
    for (int r = 0; r < 16; ++r) p1[r] = __builtin_amdgcn_exp2f(p1[r]);
    float ps = 0;
#pragma unroll
    for (int r = 0; r < 16; ++r) ps += p0[r];
#pragma unroll
    for (int r = 0; r < 16; ++r) ps += p1[r];
    { auto rr = __builtin_amdgcn_permlane32_swap(__float_as_uint(ps), __float_as_uint(ps), false, false);
      ps = __uint_as_float(rr[0]) + __uint_as_float(rr[1]); }
    l_reg = l_reg * alpha + ps;
#define PK4(P, BASE, OUT) do { u32x4 w = {cvt_pk_bf16(P[BASE + 0], P[BASE + 1]), cvt_pk_bf16(P[BASE + 2], P[BASE + 3]), cvt_pk_bf16(P[BASE + 4], P[BASE + 5]), cvt_pk_bf16(P[BASE + 6], P[BASE + 7])}; \
    OUT = *reinterpret_cast<bf16x8*>(&w); } while (0)
    PK4(p0, 0, pa0); PK4(p0, 8, pa1); PK4(p1, 0, pa2); PK4(p1, 8, pa3);
#undef PK4
}
__device__ __forceinline__ void qkt(f32x16& p0, f32x16& p1, const char* Ks, const bf16x8* qr, int r32, int hi, int comp) {
    p0 = f32x16{}; p1 = f32x16{};
#pragma unroll
    for (int d0 = 0; d0 < 4; ++d0) { const int cb = ((comp * 4 + d0) * 16 + hi * 8) * 2;
        bf16x8 b0 = *reinterpret_cast<const bf16x8*>(Ks + KSWZ(r32, cb));
        bf16x8 b1 = *reinterpret_cast<const bf16x8*>(Ks + KSWZ(32 + r32, cb));
        p0 = __builtin_amdgcn_mfma_f32_32x32x16_bf16(b0, qr[d0], p0, 0, 0, 0);
        p1 = __builtin_amdgcn_mfma_f32_32x32x16_bf16(b1, qr[d0], p1, 0, 0, 0); }
}
__device__ __forceinline__ void qk_sm(f32x16& n0, f32x16& n1, const char* Ks, const bf16x8* qr, int r32, int hi, int comp,
                                      f32x16& p0, f32x16& p1, float alpha, float& l_reg, bf16x8& pa0, bf16x8& pa1, bf16x8& pa2, bf16x8& pa3) {
#define LDKF(D0, R) *reinterpret_cast<const bf16x8*>(Ks + KSWZ((R), ((comp * 4 + (D0)) * 16 + hi * 8) * 2))
#define EX2(P, B) P[B] = __builtin_amdgcn_exp2f(P[B]); P[B + 1] = __builtin_amdgcn_exp2f(P[B + 1]); asm volatile("" : "+v"(P[B]), "+v"(P[B + 1]))
#define QMF(N, KF, D0) SBAR(); N = __builtin_amdgcn_mfma_f32_32x32x16_bf16(KF, qr[D0], N, 0, 0, 0); SBAR()
    SBAR();
    const bf16x8 k00 = LDKF(0, r32), k01 = LDKF(0, 32 + r32), k10 = LDKF(1, r32), k11 = LDKF(1, 32 + r32);
    SBAR();
    EX2(p1, 0); EX2(p1, 2); EX2(p1, 4); EX2(p1, 6);
    SBAR(); n0 = __builtin_amdgcn_mfma_f32_32x32x16_bf16(k00, qr[0], f32x16{}, 0, 0, 0); SBAR();
    EX2(p1, 8);
    SBAR(); n1 = __builtin_amdgcn_mfma_f32_32x32x16_bf16(k01, qr[0], f32x16{}, 0, 0, 0); SBAR();
    EX2(p1, 10);
    const bf16x8 k20 = LDKF(2, r32), k21 = LDKF(2, 32 + r32);
    QMF(n0, k10, 1); EX2(p1, 12);
    QMF(n1, k11, 1); EX2(p1, 14);
    const bf16x8 k30 = LDKF(3, r32), k31 = LDKF(3, 32 + r32);
    QMF(n0, k20, 2);
    float s0 = p0[0] + p0[1], s1 = p0[2] + p0[3]; s0 += p0[4]; s1 += p0[5]; s0 += p0[6]; s1 += p0[7]; s0 += p0[8]; s1 += p0[9];
    QMF(n1, k21, 2);
    s0 += p0[10]; s1 += p0[11]; s0 += p0[12]; s1 += p0[13]; s0 += p0[14]; s1 += p0[15]; s0 += p1[0]; s1 += p1[1];
    QMF(n0, k30, 3);
    s0 += p1[2]; s1 += p1[3]; s0 += p1[4]; s1 += p1[5]; s0 += p1[6]; s1 += p1[7]; s0 += p1[8]; s1 += p1[9];
    QMF(n1, k31, 3);
    s0 += p1[10]; s1 += p1[11]; s0 += p1[12]; s1 += p1[13]; s0 += p1[14]; s1 += p1[15]; float ps = s0 + s1;
    { auto rr = __builtin_amdgcn_permlane32_swap(__float_as_uint(ps), __float_as_uint(ps), false, false);
      ps = __uint_as_float(rr[0]) + __uint_as_float(rr[1]); }
    l_reg = l_reg * alpha + ps;
#define PK4(P, BASE, OUT) do { u32x4 w = {cvt_pk_bf16(P[BASE + 0], P[BASE + 1]), cvt_pk_bf16(P[BASE + 2], P[BASE + 3]), cvt_pk_bf16(P[BASE + 4], P[BASE + 5]), cvt_pk_bf16(P[BASE + 6], P[BASE + 7])}; \
    OUT = *reinterpret_cast<bf16x8*>(&w); } while (0)
    PK4(p0, 0, pa0); PK4(p0, 8, pa1); PK4(p1, 0, pa2); PK4(p1, 8, pa3);
    SBAR();
#undef PK4
#undef LDKF
#undef EX2
#undef QMF
}
__device__ __forceinline__ int v_st(int k, int c) { const int kk = k; return ((kk >> 3) * 4 + (c >> 5)) * 512 + ((kk & 7) * 32 + (c & 31)) * 2; }
__device__ __forceinline__ int v_rd_base(int lane) { return ((lane & 3) << 3) | (((lane >> 2) & 3) << 6) | (((lane >> 4) & 1) << 5) | (((lane >> 5) & 1) << 8); }
constexpr int v_rd_off(int d0, int ks, int half) { return d0 * 512 + ks * 4096 + half * 2048; }
template <int OFF> __device__ __forceinline__ s16x4 tr_read(int vb) {
    s16x4 r; asm volatile("ds_read_b64_tr_b16 %0, %1 offset:%2" : "=&v"(r) : "v"(vb), "i"(OFF) : "memory"); return r;
}
template <int D0> __device__ __forceinline__ void pv_one(f32x16& od, int vb, bf16x8 pa0, bf16x8 pa1, bf16x8 pa2, bf16x8 pa3) {
    const s16x4 l0 = tr_read<v_rd_off(D0, 0, 0)>(vb), h0 = tr_read<v_rd_off(D0, 0, 1)>(vb), l1 = tr_read<v_rd_off(D0, 1, 0)>(vb), h1 = tr_read<v_rd_off(D0, 1, 1)>(vb);
    const s16x4 l2 = tr_read<v_rd_off(D0, 2, 0)>(vb), h2 = tr_read<v_rd_off(D0, 2, 1)>(vb), l3 = tr_read<v_rd_off(D0, 3, 0)>(vb), h3 = tr_read<v_rd_off(D0, 3, 1)>(vb);
    asm volatile("s_waitcnt lgkmcnt(0)" ::: "memory"); SBAR();
#define PK(L, H) (bf16x8){L[0], L[1], L[2], L[3], H[0], H[1], H[2], H[3]}
    od = __builtin_amdgcn_mfma_f32_32x32x16_bf16(pa0, PK(l0, h0), od, 0, 0, 0);
    od = __builtin_amdgcn_mfma_f32_32x32x16_bf16(pa1, PK(l1, h1), od, 0, 0, 0);
    od = __builtin_amdgcn_mfma_f32_32x32x16_bf16(pa2, PK(l2, h2), od, 0, 0, 0);
    od = __builtin_amdgcn_mfma_f32_32x32x16_bf16(pa3, PK(l3, h3), od, 0, 0, 0);
#undef PK
}
__device__ __forceinline__ void pv_d0(f32x16* o, int vb, bf16x8 pa0, bf16x8 pa1, bf16x8 pa2, bf16x8 pa3) {
    pv_one<0>(o[0], vb, pa0, pa1, pa2, pa3); pv_one<1>(o[1], vb, pa0, pa1, pa2, pa3); pv_one<2>(o[2], vb, pa0, pa1, pa2, pa3); pv_one<3>(o[3], vb, pa0, pa1, pa2, pa3);
}
template <class Mid> __device__ __forceinline__ void pv_sm(f32x16* o, int vb, bf16x8 pa0, bf16x8 pa1, bf16x8 pa2, bf16x8 pa3, f32x16& p0, f32x16& p1, float& m_reg, float& mn, float& alpha, Mid mid) {
#define TRD(D0, KS, H) tr_read<v_rd_off(D0, KS, H)>(vb)
#define PKV(L, H) (bf16x8){L[0], L[1], L[2], L[3], H[0], H[1], H[2], H[3]}
#define MF(D0, PA, L, H) SBAR(); o[D0] = __builtin_amdgcn_mfma_f32_32x32x16_bf16(PA, PKV(L, H), o[D0], 0, 0, 0); SBAR()
#define WAITL(n) asm volatile("s_waitcnt lgkmcnt(" #n ")" ::: "memory")
#define MX3(a, b, c) fmaxf(fmaxf(a, b), c)
#define SUB8(P, B) P[B] -= mn; P[B + 1] -= mn; P[B + 2] -= mn; P[B + 3] -= mn; P[B + 4] -= mn; P[B + 5] -= mn; P[B + 6] -= mn; P[B + 7] -= mn; \
    asm volatile("" : "+v"(P[B]), "+v"(P[B + 1]), "+v"(P[B + 2]), "+v"(P[B + 3]), "+v"(P[B + 4]), "+v"(P[B + 5]), "+v"(P[B + 6]), "+v"(P[B + 7]))
#define EX2(P, B) P[B] = __builtin_amdgcn_exp2f(P[B]); P[B + 1] = __builtin_amdgcn_exp2f(P[B + 1]); asm volatile("" : "+v"(P[B]), "+v"(P[B + 1]))
    s16x4 x0, x1, x2, x3, y0, y1, y2, y3, z0, z1, z2, z3, w0, w1, w2, w3;
#define RD4(P, I) P##0 = TRD(((I) & 1) * 2, (I) >> 1, 0); P##1 = TRD(((I) & 1) * 2, (I) >> 1, 1); P##2 = TRD(((I) & 1) * 2 + 1, (I) >> 1, 0); P##3 = TRD(((I) & 1) * 2 + 1, (I) >> 1, 1)
    RD4(x, 0); RD4(y, 1); RD4(z, 2); RD4(w, 3); WAITL(12);
    MF(0, pa0, x0, x1);
    float t0 = MX3(p0[0], p0[1], p0[2]), t1 = MX3(p0[8], p0[9], p0[10]), t2 = MX3(p1[0], p1[1], p1[2]), t3 = MX3(p1[8], p1[9], p1[10]);
    t0 = MX3(t0, p0[3], p0[4]); t1 = MX3(t1, p0[11], p0[12]); t2 = MX3(t2, p1[3], p1[4]); t3 = MX3(t3, p1[11], p1[12]);
    MF(1, pa0, x2, x3);
    t0 = MX3(t0, p0[5], p0[6]); t1 = MX3(t1, p0[13], p0[14]); t2 = MX3(t2, p1[5], p1[6]); t3 = MX3(t3, p1[13], p1[14]);
    t0 = MX3(t0, p0[7], p0[15]); t2 = MX3(t2, p1[7], p1[15]); t0 = MX3(t0, t1, t2); float pmax = fmaxf(t0, t3);
    SBAR(); RD4(x, 4); WAITL(12);
    MF(2, pa0, y0, y1);
    { auto rr = __builtin_amdgcn_permlane32_swap(__float_as_uint(pmax), __float_as_uint(pmax), false, false);
      pmax = fmaxf(__uint_as_float(rr[0]), __uint_as_float(rr[1])); }
    { const bool ok = __all(pmax - m_reg <= THRL); const float mnew = fmaxf(m_reg, pmax); mn = ok ? m_reg : mnew; alpha = __builtin_amdgcn_exp2f(m_reg - mn); m_reg = mn; }
    MF(3, pa0, y2, y3);
    SBAR(); RD4(y, 5); WAITL(12);
    MF(0, pa1, z0, z1); SUB8(p0, 0);
    MF(1, pa1, z2, z3); SUB8(p0, 8);
    SBAR(); RD4(z, 6); WAITL(12);
    MF(2, pa1, w0, w1); SUB8(p1, 0);
    MF(3, pa1, w2, w3); SUB8(p1, 8);
    SBAR(); mid();
    SBAR(); RD4(w, 7); WAITL(12);
    MF(0, pa2, x0, x1); EX2(p0, 0);
    MF(1, pa2, x2, x3); EX2(p0, 2);
    SBAR(); WAITL(8);
    MF(2, pa2, y0, y1); EX2(p0, 4);
    MF(3, pa2, y2, y3); EX2(p0, 6);
    SBAR(); WAITL(4);
    MF(0, pa3, z0, z1); EX2(p0, 8);
    MF(1, pa3, z2, z3); EX2(p0, 10);
    SBAR(); WAITL(0);
    MF(2, pa3, w0, w1); EX2(p0, 12);
    MF(3, pa3, w2, w3); EX2(p0, 14);
    SBAR();
#undef RD4
#undef TRD
#undef PKV
#undef MF
#undef WAITL
#undef MX3
#undef SUB8
#undef EX2
}

__device__ __forceinline__ void attn_unit(const bf16_t* __restrict__ Qb, const bf16_t* __restrict__ Kh, const bf16_t* __restrict__ Vh, bf16_t* __restrict__ Ob,
                                          float lam, float outscale, const float* __restrict__ sub_gain, char* lds, const int tid) {
    constexpr int LDK = NPROJP, seq = SEQ;
    const int wid = tid >> 6, lane = tid & 63, r32 = lane & 31, hi = lane >> 5;
    const int comp = wid & 1, rb = wid >> 1;
    char* V_lds = lds; char* K_lds = lds + 3 * SHM_V;
    float* ws = (float*)(lds + WS_OFF) + wid * 64; float* li_l = ws; float* al_l = ws + 32;
    float m_reg = -1e30f, l_reg = 0; f32x16 o[4] = {}; bf16x8 qr[4];
    const bf16_t* Qw = Qb + (size_t)(rb * 32 + r32) * LDK + comp * 64 + hi * 8;
#pragma unroll
    for (int d0 = 0; d0 < 4; ++d0) qr[d0] = *reinterpret_cast<const bf16x8*>(Qw + d0 * 16);
    const int sr = tid >> 4, sc = (tid & 15) * 8, vst0 = v_st(sr, sc), vst1 = v_st(32 + sr, sc);
    const int vb0 = (int)(uintptr_t)V_lds + v_rd_base(lane);
    bf16x8 vsA0, vsA1, ksA0, ksA1;
#define SLOAD(S, k0) do { vs##S##0 = *reinterpret_cast<const bf16x8*>(&Vh[(size_t)((k0) + sr) * LDK + sc]); vs##S##1 = *reinterpret_cast<const bf16x8*>(&Vh[(size_t)((k0) + 32 + sr) * LDK + sc]); \
    ks##S##0 = *reinterpret_cast<const bf16x8*>(&Kh[(size_t)((k0) + sr) * LDK + sc]); ks##S##1 = *reinterpret_cast<const bf16x8*>(&Kh[(size_t)((k0) + 32 + sr) * LDK + sc]); } while (0)
#define SWRITE(b, S) do { *(bf16x8*)(V_lds + (b) * SHM_V + vst0) = vs##S##0; *(bf16x8*)(V_lds + (b) * SHM_V + vst1) = vs##S##1; const int kc = sc * 2; \
    *(bf16x8*)(K_lds + (b) * SHM_K + KSWZ(sr, kc)) = ks##S##0; *(bf16x8*)(K_lds + (b) * SHM_K + KSWZ(32 + sr, kc)) = ks##S##1; } while (0)
#define SWAIT() asm volatile("s_waitcnt vmcnt(4)" ::: "memory")
#define RESC(a) do { if (__any((a) < 1.f)) { if (hi == 0) al_l[r32] = (a); asm volatile("s_waitcnt lgkmcnt(0)" ::: "memory"); \
    _Pragma("unroll") for (int d = 0; d < 4; ++d) _Pragma("unroll") for (int r = 0; r < 16; ++r) o[d][r] *= al_l[crow(r, hi)]; } } while (0)
    f32x16 pA0, pA1, pB0, pB1; float mnA, mnB, alA, alB; bf16x8 pa0, pa1, pa2, pa3; const int NT = seq / KVBLK;
#define SW0() asm volatile("s_waitcnt vmcnt(0)" ::: "memory")
    SLOAD(A, 0); SW0(); SWRITE(0, A); SLOAD(A, KVBLK); __syncthreads();
    qkt(pA0, pA1, K_lds, qr, r32, hi, comp); partialSM(pA0, pA1, m_reg, mnA, alA);
    SW0(); SWRITE(1, A); SLOAD(A, 2 * KVBLK); __syncthreads();
    int bj = 1;
    for (int j = 1; j + 1 < NT; j += 2) {
        const int bjm1 = (bj == 0) ? 2 : bj - 1, bjp1 = (bj == 2) ? 0 : bj + 1;
        qk_sm(pB0, pB1, K_lds + bj * SHM_K, qr, r32, hi, comp, pA0, pA1, alA, l_reg, pa0, pa1, pa2, pa3);
        pv_sm(o, vb0 + bjm1 * (int)SHM_V, pa0, pa1, pa2, pa3, pB0, pB1, m_reg, mnB, alB, [&] { SW0(); SWRITE(bjp1, A); SLOAD(A, (j + 2) * KVBLK); });
        RESC(alB); __syncthreads();
        qk_sm(pA0, pA1, K_lds + bjp1 * SHM_K, qr, r32, hi, comp, pB0, pB1, alB, l_reg, pa0, pa1, pa2, pa3);
        pv_sm(o, vb0 + bj * (int)SHM_V, pa0, pa1, pa2, pa3, pA0, pA1, m_reg, mnA, alA, [&] { SW0(); SWRITE(bjm1, A); if (j + 3 < NT) SLOAD(A, (j + 3) * KVBLK); });
        RESC(alA); __syncthreads();
        bj = (bj == 0) ? 2 : bj - 1;
    }
    { const int bjm1 = (bj == 0) ? 2 : bj - 1;
      qk_sm(pB0, pB1, K_lds + bj * SHM_K, qr, r32, hi, comp, pA0, pA1, alA, l_reg, pa0, pa1, pa2, pa3);
      pv_sm(o, vb0 + bjm1 * (int)SHM_V, pa0, pa1, pa2, pa3, pB0, pB1, m_reg, mnB, alB, [] {});
      RESC(alB);
      finishSM(pB0, pB1, alB, l_reg, pa0, pa1, pa2, pa3); SBAR();
      pv_d0(o, vb0 + bj * (int)SHM_V, pa0, pa1, pa2, pa3); }
#undef SW0
    if (hi == 0) li_l[r32] = l_reg; asm volatile("s_waitcnt lgkmcnt(0)" ::: "memory");
    float rli[16];
#pragma unroll
    for (int r = 0; r < 16; ++r) rli[r] = __builtin_amdgcn_rcpf(li_l[crow(r, hi)]);
    __syncthreads();
    float* stg = (float*)lds + rb * 32 * 128;
    if (comp == 1) {
#pragma unroll
        for (int r = 0; r < 16; ++r)
#pragma unroll
            for (int d0 = 0; d0 < 4; ++d0) stg[crow(r, hi) * 128 + d0 * 32 + r32] = o[d0][r] * rli[r];
    }
    __syncthreads();
    if (comp == 0) {
#pragma unroll
        for (int r = 0; r < 16; ++r)
#pragma unroll
            for (int d0 = 0; d0 < 4; ++d0) { const int idx = crow(r, hi) * 128 + d0 * 32 + r32; stg[idx] = o[d0][r] * rli[r] - lam * stg[idx]; }
        asm volatile("s_waitcnt lgkmcnt(0)" ::: "memory");
        const int row = lane >> 1, c0 = (lane & 1) * 64;
        const float* sp = stg + row * 128 + c0;
        float ss = 0.f;
#pragma unroll
        for (int i = 0; i < 16; ++i) { const f32x4 v = *(const f32x4*)(sp + 4 * i); ss += (v[0] * v[0] + v[1] * v[1]) + (v[2] * v[2] + v[3] * v[3]); }
        ss += __shfl_xor(ss, 1);
        const float rs = outscale / sqrtf(ss * (1.0f / 128.0f) + 1e-5f);
        bf16_t* op = Ob + (size_t)(rb * 32 + row) * DM + c0;
#pragma unroll
        for (int i = 0; i < 8; ++i) { const f32x4 v0 = *(const f32x4*)(sp + 8 * i), v1 = *(const f32x4*)(sp + 8 * i + 4);
            const f32x4 g0 = *(const f32x4*)(sub_gain + c0 + 8 * i), g1 = *(const f32x4*)(sub_gain + c0 + 8 * i + 4);
            u32x4 w; w.x = cvt_pk_bf16(v0[0] * rs * g0[0], v0[1] * rs * g0[1]); w.y = cvt_pk_bf16(v0[2] * rs * g0[2], v0[3] * rs * g0[3]);
            w.z = cvt_pk_bf16(v1[0] * rs * g1[0], v1[1] * rs * g1[1]); w.w = cvt_pk_bf16(v1[2] * rs * g1[2], v1[3] * rs * g1[3]);
            *(u32x4*)(op + 8 * i) = w; }
    }
    __syncthreads();
#undef SLOAD
#undef SWRITE
#undef SWAIT
#undef RESC
}

#define PIN(x) asm volatile("" : "+v"(x))
#define MFMA_(a, b, c) __builtin_amdgcn_mfma_f32_32x32x16_bf16(a, b, c, 0, 0, 0)
#define WAIT_BAR(N) asm volatile("s_waitcnt vmcnt(" #N ") lgkmcnt(0)\n\ts_barrier" ::: "memory")
typedef __attribute__((address_space(3))) const char* lds_cptr;
typedef short v4i16_t __attribute__((ext_vector_type(4)));
__device__ __forceinline__ unsigned cvtpk_nv(float lo, float hi) { unsigned r; asm("v_cvt_pk_bf16_f32 %0, %1, %2" : "=v"(r) : "v"(lo), "v"(hi)); return r; }
__device__ __forceinline__ void glds16(const void* g, unsigned lds_base) {
    unsigned sv; asm volatile("s_mov_b32 %0, m0\n\ts_mov_b32 m0, %2\n\ts_nop 0\n\tglobal_load_lds_dwordx4 %1, off\n\ts_mov_b32 m0, %0" : "=&s"(sv) : "v"(g), "s"(lds_base) : "memory"); }
__device__ __forceinline__ void kload2(bf16x8* kf, lds_cptr kp, int kb0, int d0) { const lds_cptr p = kp + (kb0 ^ (d0 << 5));
    kf[2 * d0] = *(const __attribute__((address_space(3))) bf16x8*)(p); kf[2 * d0 + 1] = *(const __attribute__((address_space(3))) bf16x8*)(p + 8192); }
__device__ __forceinline__ s16x4 vtr(lds_cptr p) { return __builtin_bit_cast(s16x4, __builtin_amdgcn_ds_read_tr16_b64_v4i16((__attribute__((address_space(3))) v4i16_t*)p)); }
#define MX3(a, b, c) __builtin_fmaxf(__builtin_fmaxf((a), (b)), (c))
__device__ __forceinline__ float rowmax(const f32x16& p0, const f32x16& p1) {
    float a = MX3(p0[0], p0[1], p1[0]), b = MX3(p0[2], p0[3], p1[1]); a = MX3(a, p1[2], p1[3]);
#pragma unroll
    for (int r = 4; r < 16; r += 4) { a = MX3(a, p0[r], p0[r + 1]); b = MX3(b, p0[r + 2], p0[r + 3]); a = MX3(a, p1[r], p1[r + 1]); b = MX3(b, p1[r + 2], p1[r + 3]); }
    float m = __builtin_fmaxf(a, b); auto rr = __builtin_amdgcn_permlane32_swap(__float_as_uint(m), __float_as_uint(m), false, false);
    return __builtin_fmaxf(__uint_as_float(rr[0]), __uint_as_float(rr[1])); }
#undef MX3

__device__ __forceinline__ void attn_unit2(const bf16_t* __restrict__ Qb, const bf16_t* __restrict__ Kh, const bf16_t* __restrict__ Vh, unsigned char* __restrict__ Ob,
                                           float lam, float outscale, const float* __restrict__ sub_gain, char* lds, const int tid) {
    constexpr int LDK = NPROJP, NT = SEQ / KVBLK, SLOTB = 16384, LDS_K = 0, LDS_V = 3 * SLOTB;
    const int lane = tid & 63, r32 = lane & 31, hi = lane >> 5; const int wid = __builtin_amdgcn_readfirstlane(tid >> 6); const int comp = wid & 1, rb = wid >> 1;
    const unsigned lds0 = (unsigned)(uintptr_t)lds; float* wsf = (float*)(lds + WS_OFF) + wid * 64;
    const bf16_t* ksrc = Kh + (size_t)(8 * wid + (lane >> 4)) * LDK + ((lane & 15) ^ (lane >> 4)) * 8;
    const bf16_t* ksrc2 = Kh + (size_t)(8 * wid + 4 + (lane >> 4)) * LDK + ((lane & 15) ^ ((lane >> 4) + 4)) * 8;
    const bf16_t* vsrc = Vh + (size_t)(32 * (wid & 1) + (lane >> 2)) * LDK + (wid >> 1) * 32 + (lane & 3) * 8;
    const unsigned kdst = lds0 + LDS_K + wid * 2048, vdst = lds0 + LDS_V + (wid >> 1) * 4096 + (wid & 1) * 2048;
#define DMA_K(t, slot) do { const unsigned d_ = (unsigned)__builtin_amdgcn_readfirstlane(kdst + (slot)); glds16(ksrc + (size_t)(t) * KVBLK * LDK, d_); glds16(ksrc2 + (size_t)(t) * KVBLK * LDK, d_ + 1024); } while (0)
#define DMA_V(t, slot) do { const bf16_t* s_ = vsrc + (size_t)(t) * KVBLK * LDK; const unsigned d_ = (unsigned)__builtin_amdgcn_readfirstlane(vdst + (slot)); glds16(s_, d_); glds16(s_ + (size_t)16 * LDK, d_ + 1024); } while (0)
    const lds_cptr vp0 = (lds_cptr)lds + LDS_V + ((lane >> 4) & 1) * 32 + (lane & 3) * 8 + (4 * hi + ((lane & 15) >> 2)) * 64;
    const int kb0 = r32 * 256 + ((comp * 128 + hi * 16) ^ ((r32 & 7) << 4));
    const lds_cptr kp0 = (lds_cptr)lds + LDS_K;
    DMA_K(0, 0); DMA_V(0, 0); DMA_K(1, SLOTB);
    bf16x8 qr[4];
    { const bf16_t* Qw = Qb + (size_t)(rb * 32 + r32) * LDK + comp * 64 + hi * 8;
#pragma unroll
      for (int d0 = 0; d0 < 4; ++d0) qr[d0] = *reinterpret_cast<const bf16x8*>(Qw + d0 * 16); }
    float mhat = 0.f, l_reg = 0.f; f32x16 o[4] = {};
    bool resc = false;
    f32x16 pA0, pA1, pB0, pB1; bf16x8 kf[8]; s16x4 vlo[8], vhi[8]; u32x4 pw0, pw1, pw2, pw3;
    int sl_prev = 0, sl_cur = 0, sl_next = SLOTB;
#define ROT() do { sl_prev = sl_cur; sl_cur = sl_next; sl_next = (sl_next == 2 * SLOTB) ? 0 : sl_next + SLOTB; } while (0)
#define EX(v) __builtin_amdgcn_exp2f((v) + nmh)
#define RESC2() do { if (resc) { _Pragma("unroll") for (int d_ = 0; d_ < 4; ++d_) _Pragma("unroll") for (int r = 0; r < 16; ++r) o[d_][r] *= wsf[crow(r, hi)]; } } while (0)
    DMA_K(2, 2 * SLOTB);
    WAIT_BAR(6);
    _Pragma("unroll") for (int d0 = 0; d0 < 4; ++d0) kload2(kf, kp0, kb0, d0);
    pA0 = MFMA_(kf[0], qr[0], f32x16{}); pA1 = MFMA_(kf[1], qr[0], f32x16{}); pA0 = MFMA_(kf[2], qr[1], pA0); pA1 = MFMA_(kf[3], qr[1], pA1);
    pA0 = MFMA_(kf[4], qr[2], pA0); pA1 = MFMA_(kf[5], qr[2], pA1); pA0 = MFMA_(kf[6], qr[3], pA0); pA1 = MFMA_(kf[7], qr[3], pA1);
    { mhat = rowmax(pA0, pA1); const float nmh = -mhat;
#pragma unroll
      for (int r = 0; r < 16; ++r) { pA0[r] = EX(pA0[r]); pA1[r] = EX(pA1[r]); } }
    WAIT_BAR(0);
    DMA_K(3, 0); DMA_V(1, SLOTB); ROT();
    _Pragma("unroll") for (int d0 = 0; d0 < 4; ++d0) kload2(kf, kp0 + sl_cur, kb0, d0);
    WAIT_BAR(4);
#define PKW(P, i) cvtpk_nv(P[i], P[i + 1])
#define PAF(k) __builtin_bit_cast(bf16x8, pw##k)
#define VFR(i) (bf16x8){vlo[i][0], vlo[i][1], vlo[i][2], vlo[i][3], vhi[i][0], vhi[i][1], vhi[i][2], vhi[i][3]}
#define VRD(i, f) do { vlo[i] = vtr(vp_ + (((f) & 3) * 4096 + ((f) >> 2) * 1024)); vhi[i] = vtr(vp_ + (((f) & 3) * 4096 + ((f) >> 2) * 1024 + 512)); } while (0)
#define KRD(G, d0) do { if (G) { kload2(kf, kp0 + sl_next, kb0, d0); SBAR(); } } while (0)
#define GAPA(MF, a0, a1, a2, a3, W0, W1, PW) do { MF; sacc += a0; sacc += a1; sacc += a2; sacc += a3; W0; W1; PIN(PW); PIN(sacc); SBAR(); } while (0)
#define GAPB(MF, X, i) do { MF; X[i] = EX(X[i]); X[i + 1] = EX(X[i + 1]); PIN(X); SBAR(); } while (0)
#define STEP(C0, C1, P0, P1, t, GK, GV, GL) do { SBAR(); \
    const lds_cptr vp_ = vp0 + sl_prev; \
    VRD(0, 0); SBAR(); float sacc = P0[0] + P0[1]; \
                       GAPA(C0 = MFMA_(kf[0], qr[0], f32x16{}), P0[2], P0[3], P0[4], P0[5],     pw0[0] = PKW(P0, 0),  pw0[1] = PKW(P0, 2),  pw0); \
    VRD(1, 1); SBAR(); GAPA(C1 = MFMA_(kf[1], qr[0], f32x16{}), P0[6], P0[7], P0[8], P0[9],     pw0[2] = PKW(P0, 4),  pw0[3] = PKW(P0, 6),  pw0); \
    VRD(2, 2); SBAR(); GAPA(C0 = MFMA_(kf[2], qr[1], C0),       P0[10], P0[11], P0[12], P0[13], pw1[0] = PKW(P0, 8),  pw1[1] = PKW(P0, 10), pw1); \
    VRD(3, 3); SBAR(); GAPA(C1 = MFMA_(kf[3], qr[1], C1),       P0[14], P0[15], P1[0], P1[1],   pw1[2] = PKW(P0, 12), pw1[3] = PKW(P0, 14), pw1); \
    VRD(4, 4); SBAR(); GAPA(C0 = MFMA_(kf[4], qr[2], C0),       P1[2], P1[3], P1[4], P1[5],     pw2[0] = PKW(P1, 0),  pw2[1] = PKW(P1, 2),  pw2); \
    VRD(5, 5); SBAR(); GAPA(C1 = MFMA_(kf[5], qr[2], C1),       P1[6], P1[7], P1[8], P1[9],     pw2[2] = PKW(P1, 4),  pw2[3] = PKW(P1, 6),  pw2); \
    VRD(6, 6); SBAR(); GAPA(C0 = MFMA_(kf[6], qr[3], C0),       P1[10], P1[11], P1[12], P1[13], pw3[0] = PKW(P1, 8),  pw3[1] = PKW(P1, 10), pw3); \
    VRD(7, 7); SBAR(); GAPA(C1 = MFMA_(kf[7], qr[3], C1),       P1[14], P1[15], 0.f, 0.f,       pw3[2] = PKW(P1, 12), pw3[3] = PKW(P1, 14), pw3); \
    l_reg += sacc; \
    if (GK) DMA_K((t) + 3, sl_cur); if (GV) DMA_V((t) + 1, sl_next); \
    { const float rm = rowmax(C0, C1) - mhat; resc = false; \
      if (__builtin_expect(__any(rm > THRL), 0)) { const float dl = __builtin_fmaxf(rm, 0.f); mhat += dl; \
          const float f = __builtin_amdgcn_exp2f(-dl); l_reg *= f; if (hi == 0) wsf[r32] = f; resc = true; } } \
    const float nmh = -mhat; SBAR(); \
    KRD(GL, 0); GAPB(o[0] = MFMA_(PAF(0), VFR(0), o[0]), C0, 0);   KRD(GL, 1); GAPB(o[1] = MFMA_(PAF(0), VFR(1), o[1]), C0, 2); \
    KRD(GL, 2); GAPB(o[2] = MFMA_(PAF(0), VFR(2), o[2]), C0, 4);   KRD(GL, 3); GAPB(o[3] = MFMA_(PAF(0), VFR(3), o[3]), C0, 6); \
    VRD(0, 8);  SBAR(); GAPB(o[0] = MFMA_(PAF(1), VFR(4), o[0]), C0, 8);   VRD(1, 9);  SBAR(); GAPB(o[1] = MFMA_(PAF(1), VFR(5), o[1]), C0, 10); \
    VRD(2, 10); SBAR(); GAPB(o[2] = MFMA_(PAF(1), VFR(6), o[2]), C0, 12);  VRD(3, 11); SBAR(); GAPB(o[3] = MFMA_(PAF(1), VFR(7), o[3]), C0, 14); \
    VRD(4, 12); SBAR(); GAPB(o[0] = MFMA_(PAF(2), VFR(0), o[0]), C1, 0);   VRD(5, 13); SBAR(); GAPB(o[1] = MFMA_(PAF(2), VFR(1), o[1]), C1, 2); \
    VRD(6, 14); SBAR(); GAPB(o[2] = MFMA_(PAF(2), VFR(2), o[2]), C1, 4);   VRD(7, 15); SBAR(); GAPB(o[3] = MFMA_(PAF(2), VFR(3), o[3]), C1, 6); \
    GAPB(o[0] = MFMA_(PAF(3), VFR(4), o[0]), C1, 8);   GAPB(o[1] = MFMA_(PAF(3), VFR(5), o[1]), C1, 10); \
    GAPB(o[2] = MFMA_(PAF(3), VFR(6), o[2]), C1, 12);  GAPB(o[3] = MFMA_(PAF(3), VFR(7), o[3]), C1, 14); \
    } while (0)
    int t = 1;
    for (; t + 5 < NT; t += 2) {
        STEP(pB0, pB1, pA0, pA1, t, true, true, true);     WAIT_BAR(4); RESC2(); ROT();
        STEP(pA0, pA1, pB0, pB1, t + 1, true, true, true); WAIT_BAR(4); RESC2(); ROT();
    }
#define ENDW(tt) do { if ((tt) + 3 < NT) { WAIT_BAR(4); } else if ((tt) + 2 < NT) { WAIT_BAR(2); } else { WAIT_BAR(0); } } while (0)
    for (; t + 1 < NT; t += 2) {
        STEP(pB0, pB1, pA0, pA1, t, (t + 3 < NT), (t + 1 < NT), (t + 1 < NT));         ENDW(t);     RESC2(); ROT();
        STEP(pA0, pA1, pB0, pB1, t + 1, (t + 4 < NT), (t + 2 < NT), (t + 2 < NT));     ENDW(t + 1); RESC2(); ROT();
    }
    STEP(pB0, pB1, pA0, pA1, NT - 1, false, false, false); RESC2();
    { float sacc = pB0[0] + pB0[1];
#pragma unroll
      for (int r = 2; r < 16; ++r) sacc += pB0[r];
#pragma unroll
      for (int r = 0; r < 16; ++r) sacc += pB1[r];
      l_reg += sacc;
      pw0 = (u32x4){PKW(pB0, 0), PKW(pB0, 2), PKW(pB0, 4), PKW(pB0, 6)}; pw1 = (u32x4){PKW(pB0, 8), PKW(pB0, 10), PKW(pB0, 12), PKW(pB0, 14)};
      pw2 = (u32x4){PKW(pB1, 0), PKW(pB1, 2), PKW(pB1, 4), PKW(pB1, 6)}; pw3 = (u32x4){PKW(pB1, 8), PKW(pB1, 10), PKW(pB1, 12), PKW(pB1, 14)};
      const lds_cptr vp_ = vp0 + sl_cur;
      _Pragma("unroll") for (int i = 0; i < 8; ++i) VRD(i, i);
      o[0] = MFMA_(PAF(0), VFR(0), o[0]); o[1] = MFMA_(PAF(0), VFR(1), o[1]); o[2] = MFMA_(PAF(0), VFR(2), o[2]); o[3] = MFMA_(PAF(0), VFR(3), o[3]);
      o[0] = MFMA_(PAF(1), VFR(4), o[0]); o[1] = MFMA_(PAF(1), VFR(5), o[1]); o[2] = MFMA_(PAF(1), VFR(6), o[2]); o[3] = MFMA_(PAF(1), VFR(7), o[3]);
      SBAR();
      _Pragma("unroll") for (int i = 0; i < 8; ++i) VRD(i, 8 + i);
      o[0] = MFMA_(PAF(2), VFR(0), o[0]); o[1] = MFMA_(PAF(2), VFR(1), o[1]); o[2] = MFMA_(PAF(2), VFR(2), o[2]); o[3] = MFMA_(PAF(2), VFR(3), o[3]);
      o[0] = MFMA_(PAF(3), VFR(4), o[0]); o[1] = MFMA_(PAF(3), VFR(5), o[1]); o[2] = MFMA_(PAF(3), VFR(6), o[2]); o[3] = MFMA_(PAF(3), VFR(7), o[3]); }
    { auto rr = __builtin_amdgcn_permlane32_swap(__float_as_uint(l_reg), __float_as_uint(l_reg), false, false); l_reg = __uint_as_float(rr[0]) + __uint_as_float(rr[1]); }
    float* li_l = wsf + 32;
    if (hi == 0) li_l[r32] = l_reg; asm volatile("s_waitcnt lgkmcnt(0)" ::: "memory");
    float rli[16];
#pragma unroll
    for (int r = 0; r < 16; ++r) rli[r] = __builtin_amdgcn_rcpf(li_l[crow(r, hi)]);
    __syncthreads();
    float* stg = (float*)lds + rb * 32 * 128;
    if (comp == 1) {
#pragma unroll
        for (int r = 0; r < 16; ++r)
#pragma unroll
            for (int d0 = 0; d0 < 4; ++d0) stg[crow(r, hi) * 128 + d0 * 32 + r32] = o[d0][r] * rli[r];
    }
    __syncthreads();
    if (comp == 0) {
#pragma unroll
        for (int r = 0; r < 16; ++r)
#pragma unroll
            for (int d0 = 0; d0 < 4; ++d0) { const int idx = crow(r, hi) * 128 + d0 * 32 + r32; stg[idx] = o[d0][r] * rli[r] - lam * stg[idx]; }
        asm volatile("s_waitcnt lgkmcnt(0)" ::: "memory");
        const int row = lane >> 1, c0 = (lane & 1) * 64;
        const float* sp = stg + row * 128 + c0;
        float ss = 0.f;
#pragma unroll
        for (int i = 0; i < 16; ++i) { const f32x4 v = *(const f32x4*)(sp + 4 * i); ss += (v[0] * v[0] + v[1] * v[1]) + (v[2] * v[2] + v[3] * v[3]); }
        ss += __shfl_xor(ss, 1);
        const float rs = outscale / sqrtf(ss * (1.0f / 128.0f) + 1e-5f);
        unsigned char* op = Ob + ((size_t)(rb * 32 + row) * DM + c0) * (WOUT_FP8 ? 1 : 2);
#pragma unroll
        for (int i = 0; i < 8; ++i) { const f32x4 v0 = *(const f32x4*)(sp + 8 * i), v1 = *(const f32x4*)(sp + 8 * i + 4);
            const f32x4 g0 = *(const f32x4*)(sub_gain + c0 + 8 * i), g1 = *(const f32x4*)(sub_gain + c0 + 8 * i + 4);
            if (WOUT_FP8) { const float rq = rs * MIXSC; const float f[8] = {v0[0] * rq * g0[0], v0[1] * rq * g0[1], v0[2] * rq * g0[2], v0[3] * rq * g0[3], v1[0] * rq * g1[0], v1[1] * rq * g1[1], v1[2] * rq * g1[2], v1[3] * rq * g1[3]};
                *(u32x2*)(op + 8 * i) = pack8_fp8(f); }
            else { u32x4 w; w.x = cvt_pk_bf16(v0[0] * rs * g0[0], v0[1] * rs * g0[1]); w.y = cvt_pk_bf16(v0[2] * rs * g0[2], v0[3] * rs * g0[3]);
                w.z = cvt_pk_bf16(v1[0] * rs * g1[0], v1[1] * rs * g1[1]); w.w = cvt_pk_bf16(v1[2] * rs * g1[2], v1[3] * rs * g1[3]);
                *(u32x4*)(op + 16 * i) = w; } }
    }
    __syncthreads();
#undef DMA_K
#undef DMA_V
#undef ROT
#undef EX
#undef RESC2
#undef PKW
#undef PAF
#undef VFR
#undef VRD
#undef KRD
#undef ENDW
#undef GAPA
#undef GAPB
#undef STEP
}
#undef PIN
#undef MFMA_
#undef WAIT_BAR
}

struct Args { const void* in[31]; float* out; unsigned char* ws; int ph_lo, ph_hi; };
typedef const __attribute__((address_space(4))) Args* ArgsP;
__device__ __forceinline__ int launder_v(int x) { asm volatile("" : "+v"(x)); return x; }
__device__ __forceinline__ int phase_tid(int wave) { int l; asm volatile("v_mbcnt_lo_u32_b32 %0, -1, 0\n\tv_mbcnt_hi_u32_b32 %0, -1, %0" : "=v"(l)); return wave * 64 + l; }
__device__ __forceinline__ ArgsP phase_args() { ArgsP p = (ArgsP)__builtin_amdgcn_kernarg_segment_ptr(); asm volatile("" : "+s"(p)); return p; }
enum { I_X = 0, I_C, I_POS, I_WADA, I_BADA, I_NGAIN, I_WIN, I_WOUT, I_MUP, I_MUN, I_DW0, I_DUP, I_A0, I_AUP, I_KK, I_KA, I_RK, I_GUP, I_GNG, I_GNB,
       I_LQ1, I_LK1, I_LQ2, I_LK2, I_SUBG, I_WR, I_RB, I_WG, I_WU, I_WDN, I_FG };

__device__ const double INVF[8] = {1.0, 0.1939227447486858, 0.03760603093086394, 0.007292664737217109, 0.0014142135623730957, 0.00027424817567620724, 5.318295896944988e-05, 1.0313385377212461e-05};

enum { MAP_ID = 0, MAP_QK = 1, MAP_GATE = 2, MAP_UP = 3 };
template <int MAP> __device__ __forceinline__ int map_row(int n) {
    if (MAP == MAP_QK) { if (n < 2048) { const int d = n & 63; if (d < 16) return (n & ~63) | (d & 3) | ((d & 8) >> 1) | ((d & 4) << 1); } return n; }
    if (MAP == MAP_GATE) return ((n >> 2) << 3) | (n & 3);
    if (MAP == MAP_UP) return ((n >> 2) << 3) | 4 | (n & 3);
    return n;
}
template <int MAP, bool F8 = false> __device__ __forceinline__ void transpose_item(const float* __restrict__ W, int K, int N, bf16_t* __restrict__ WT, LAS float* scr, int item, int lane, float scale = 1.0f) {
    const int nblk = N / 32, kb = item / nblk, nb = item % nblk, k0 = 64 * kb, n0 = 32 * nb;
#pragma unroll 8
    for (int i = 0; i < 32; ++i) { const int kk = 2 * i + (lane >> 5); scr[kk * 33 + (lane & 31)] = W[(size_t)(k0 + kk) * N + n0 + (lane & 31)]; }
    LDS_WAIT(); asm volatile("" ::: "memory");
    const int c = lane & 7;
#pragma unroll
    for (int j = 0; j < 4; ++j) { const int n = (lane >> 3) + 8 * j; const LAS float* s = scr + (8 * c) * 33 + n;
        if constexpr (F8) { int w0 = 0, w1 = 0;
            w0 = pk4_fp8(s[0 * 33] * scale, s[1 * 33] * scale, s[2 * 33] * scale, s[3 * 33] * scale);
            w1 = pk4_fp8(s[4 * 33] * scale, s[5 * 33] * scale, s[6 * 33] * scale, s[7 * 33] * scale);
            u32x2 o; o.x = (unsigned)w0; o.y = (unsigned)w1;
            *(u32x2*)((unsigned char*)WT + (size_t)map_row<MAP>(n0 + n) * K + k0 + 8 * c) = o; }
        else { u32x4 o; o.x = cvt_pk_bf16(s[0 * 33], s[1 * 33]); o.y = cvt_pk_bf16(s[2 * 33], s[3 * 33]); o.z = cvt_pk_bf16(s[4 * 33], s[5 * 33]); o.w = cvt_pk_bf16(s[6 * 33], s[7 * 33]);
            *(u32x4*)(WT + (size_t)map_row<MAP>(n0 + n) * K + k0 + 8 * c) = o; } }
    LDS_WAIT(); asm volatile("" ::: "memory");
}
template <int MAP> __device__ __forceinline__ void transpose_item128(const float* __restrict__ W, int K, int N, unsigned char* __restrict__ WT, LAS float* scr, int item, int lane, float scale) {
    const int nblk = N / 32, kb = item / nblk, nb = item % nblk, k0 = 128 * kb, n0 = 32 * nb;
    const int lr = lane >> 3, lc = lane & 7;
    f32x4 t[16];
    const float* src = W + (size_t)(k0 + lr) * N + n0 + 4 * lc;
#pragma unroll
    for (int j = 0; j < 16; ++j) t[j] = *(const f32x4*)(src + (size_t)(8 * j) * N);
#pragma unroll
    for (int j = 0; j < 16; ++j) { const int k = 8 * j + lr; *(LAS f32x4*)(scr + k * 32 + ((lc ^ (k >> 4)) << 2)) = t[j]; }
    LDS_WAIT(); asm volatile("" ::: "memory");
    const int nr = lane >> 3, c = lane & 7;
#pragma unroll
    for (int jj = 0; jj < 4; ++jj) { const int n = 8 * jj + nr; const LAS float* sp = scr + (16 * c) * 32 + ((((n >> 2) ^ c) << 2) | (n & 3));
        float f0[8], f1[8];
#pragma unroll
        for (int e = 0; e < 8; ++e) { f0[e] = sp[e * 32] * scale; f1[e] = sp[(8 + e) * 32] * scale; }
        const u32x2 a = pack8_fp8(f0), b = pack8_fp8(f1); u32x4 o; o.x = a.x; o.y = a.y; o.z = b.x; o.w = b.y;
        *(u32x4*)(WT + (size_t)map_row<MAP>(n0 + n) * K + k0 + 16 * c) = o; }
    LDS_WAIT(); asm volatile("" ::: "memory");
}
template <int MAP> __device__ __forceinline__ void transpose_piece_f8(const float* __restrict__ W, int K, int N, unsigned char* __restrict__ WT, LAS float* scr, int piece, int lane, float scale) {
    const int nblk = N / 32, kb = piece / nblk, nb = piece % nblk, k0 = 32 * kb, n0 = 32 * nb;
    float t[16];
#pragma unroll
    for (int i = 0; i < 16; ++i) t[i] = W[(size_t)(k0 + 2 * i + (lane >> 5)) * N + n0 + (lane & 31)];
#pragma unroll
    for (int i = 0; i < 16; ++i) scr[(2 * i + (lane >> 5)) * 33 + (lane & 31)] = t[i];
    LDS_WAIT(); asm volatile("" ::: "memory");
    const int c = lane & 3;
#pragma unroll
    for (int j = 0; j < 2; ++j) { const int n = (lane >> 2) + 16 * j; const LAS float* s = scr + (8 * c) * 33 + n;
        const float f[8] = {s[0 * 33] * scale, s[1 * 33] * scale, s[2 * 33] * scale, s[3 * 33] * scale, s[4 * 33] * scale, s[5 * 33] * scale, s[6 * 33] * scale, s[7 * 33] * scale};
        *(u32x2*)(WT + (size_t)map_row<MAP>(n0 + n) * K + k0 + 8 * c) = pack8_fp8(f); }
    LDS_WAIT(); asm volatile("" ::: "memory");
}
constexpr int MOE_PIECES = NEXP * 3 * 2048;
__device__ __forceinline__ void convert_moe_piece(ArgsP A, int l, LAS float* scr, int lane, int piece) {
    const int e = piece / 6144; int r = piece % 6144;
    unsigned char* WGU = A->ws + WS_WGU + (size_t)e * 2048 * DM; unsigned char* WD = A->ws + WS_WD + (size_t)e * DM * DFF;
    if (r < 2048) { transpose_piece_f8<MAP_GATE>((const float*)A->in[I_WG] + ((size_t)l * NEXP + e) * DM * DFF, DM, DFF, WGU, scr, r, lane, WSC_GU); return; } r -= 2048;
    if (r < 2048) { transpose_piece_f8<MAP_UP>((const float*)A->in[I_WU] + ((size_t)l * NEXP + e) * DM * DFF, DM, DFF, WGU, scr, r, lane, WSC_GU); return; } r -= 2048;
    transpose_piece_f8<MAP_ID>((const float*)A->in[I_WDN] + ((size_t)l * NEXP + e) * DFF * DM, DFF, DM, WD, scr, r, lane, WSC_D);
}
__device__ __forceinline__ void convert_moe(ArgsP A, int l, LAS unsigned char* lds, int lane, int wave, int gw, int NGW) {
    LAS float* scr = (LAS float*)(lds + wave * 16384);
    unsigned char* WGU = A->ws + WS_WGU; unsigned char* WD = A->ws + WS_WD;
    const float* wg = (const float*)A->in[I_WG] + (size_t)l * NEXP * DM * DFF;
    const float* wu = (const float*)A->in[I_WU] + (size_t)l * NEXP * DM * DFF;
    const float* wd = (const float*)A->in[I_WDN] + (size_t)l * NEXP * DFF * DM;
    constexpr int IG = (DM / 128) * (DFF / 32);
    constexpr int ID = (DFF / 128) * (DM / 32);
    for (int it = gw; it < NEXP * (2 * IG + ID); it += NGW) {
        const int e = it / (2 * IG + ID); int r = it % (2 * IG + ID);
        if (r < IG) { transpose_item128<MAP_GATE>(wg + (size_t)e * DM * DFF, DM, DFF, WGU + (size_t)e * 2048 * DM, scr, r, lane, WSC_GU); continue; } r -= IG;
        if (r < IG) { transpose_item128<MAP_UP>(wu + (size_t)e * DM * DFF, DM, DFF, WGU + (size_t)e * 2048 * DM, scr, r, lane, WSC_GU); continue; } r -= IG;
        transpose_item128<MAP_ID>(wd + (size_t)e * DFF * DM, DFF, DM, WD + (size_t)e * DM * DFF, scr, r, lane, WSC_D);
    }
}

__device__ __forceinline__ void phase_prologue(ArgsP A, LAS unsigned char* lds, int tid, int lane, int wave, int bx, int G) {
    float* MOD = (float*)(A->ws + WS_MOD);
    __syncthreads();
    if (bx < 192) {
        LAS float* sc = (LAS float*)lds; LAS float* red = (LAS float*)(lds + 32768);
        const float* c = (const float*)A->in[I_C];
        for (int i = tid; i < BATCH * DM; i += 512) { const float v = c[i]; sc[i] = v / (1.f + __expf(-v)); }
        __syncthreads();
        const int l = bx / 96, n0 = (bx % 96) * 128, half = lane >> 5, cg = lane & 31;
        const float* wp = (const float*)A->in[I_WADA] + (size_t)l * DM * NMOD + (size_t)(256 * wave + half) * NMOD + n0 + 4 * cg;
        f32x4 a0 = {0.f, 0.f, 0.f, 0.f}, a1 = a0, a2 = a0, a3 = a0;
#pragma unroll 8
        for (int kk = 0; kk < 128; ++kk) { const int k = 256 * wave + 2 * kk + half; const f32x4 wv = *(const f32x4*)(wp + (size_t)(2 * kk) * NMOD);
            a0 += wv * sc[k]; a1 += wv * sc[DM + k]; a2 += wv * sc[2 * DM + k]; a3 += wv * sc[3 * DM + k]; }
#pragma unroll
        for (int j = 0; j < 4; ++j) { a0[j] += __shfl_xor(a0[j], 32); a1[j] += __shfl_xor(a1[j], 32); a2[j] += __shfl_xor(a2[j], 32); a3[j] += __shfl_xor(a3[j], 32); }
        if (half == 0) { *(LAS f32x4*)(red + (wave * 4 + 0) * 128 + 4 * cg) = a0; *(LAS f32x4*)(red + (wave * 4 + 1) * 128 + 4 * cg) = a1;
                         *(LAS f32x4*)(red + (wave * 4 + 2) * 128 + 4 * cg) = a2; *(LAS f32x4*)(red + (wave * 4 + 3) * 128 + 4 * cg) = a3; }
        __syncthreads();
        { const int b = tid >> 7, col = tid & 127; float s = 0.f;
#pragma unroll
          for (int w = 0; w < 8; ++w) s += red[(w * 4 + b) * 128 + col];
          MOD[(size_t)(l * 4 + b) * NMOD + n0 + col] = s + ((const float*)A->in[I_BADA])[l * NMOD + n0 + col]; }
        __syncthreads();
    }
    { float* ROPE = (float*)(A->ws + WS_ROPE); const int* pos = (const int*)A->in[I_POS];
      for (int it = bx * 512 + tid; it < MTOK * 8; it += G * 512) { const int tok = it >> 3, j = it & 7;
          const double x = (double)pos[tok] * INVF[j]; const double n = rint(x * 0.15915494309189535); const float r = (float)(x - n * 6.283185307179586);
          ROPE[tok * 16 + j] = cosf(r); ROPE[tok * 16 + 8 + j] = sinf(r); } }
    const int gw = bx * 8 + wave, NGW = G * 8;
    { LAS float* scr = (LAS float*)(lds + wave * 16384);
      static_assert(PROJ_FP8 && WOUT_FP8, "the 128 x 32 converter writes fp8");
      constexpr int I_IN = (DM / 128) * (NPROJ / 32), I_OUT = (DM / 128) * (DM / 32);
      for (int it = gw; it < DEPTH * (I_IN + I_OUT); it += NGW) { const int l = it / (I_IN + I_OUT); int r = it % (I_IN + I_OUT);
          if (r < I_IN) transpose_item128<MAP_QK>((const float*)A->in[I_WIN] + (size_t)l * DM * NPROJ, DM, NPROJ, A->ws + WS_WIN + (size_t)l * NPROJP * DM, scr, r, lane, WSC_IN);
          else transpose_item128<MAP_ID>((const float*)A->in[I_WOUT] + (size_t)l * DM * DM, DM, DM, A->ws + WS_WOUT + (size_t)l * DM * DM, scr, r - I_IN, lane, WSC_O); } }
    { const int gt = bx * 512 + tid; constexpr int EB = PROJ_FP8 ? 1 : 2; constexpr int PER = (NPROJP - NPROJ) * DM * EB / 16;
      for (int it = gt; it < DEPTH * PER; it += G * 512) { const int l = it / PER, r = it % PER;
          *(u32x4*)(A->ws + WS_WIN + ((size_t)l * NPROJP * DM + (size_t)NPROJ * DM) * EB + (size_t)r * 16) = (u32x4){0u, 0u, 0u, 0u}; } }
    { const int gt = bx * 512 + tid; bf16_t* LW = (bf16_t*)(A->ws + WS_LW);
      for (int it = gt; it < DEPTH * 48 * NDYN; it += G * 512) { const int c = it % NDYN, kc = (it / NDYN) % 48, l = it / (NDYN * 48);
          const int kind = c >> 10, cc = c & 1023; float v[8];
#pragma unroll
          for (int j = 0; j < 8; ++j) { const int k = 8 * kc + j; float x = 0.f;
              if (kind < 2) { const int r = k - 64 * kind; if (r >= 0 && r < 64) x = ((const float*)A->in[I_DUP])[((size_t)(l * 2 + kind) * 64 + r) * 1024 + cc]; }
              else if (kind < 4) { const int r = k - 128 - 64 * (kind - 2); if (r >= 0 && r < 64) x = ((const float*)A->in[I_AUP])[((size_t)(l * 2 + kind - 2) * 64 + r) * 1024 + cc]; }
              else { const int r = k - 256; if (r >= 0 && r < 128) x = ((const float*)A->in[I_GUP])[((size_t)l * 128 + r) * 1024 + cc]; }
              v[j] = x; }
          *(u32x4*)(LW + ((size_t)l * NDYN + c) * KLA + 8 * kc) = pack8(v); } }
#if !SCAN_CONVERT
    convert_moe(A, 0, lds, lane, wave, gw, NGW);
#endif
}

__device__ __forceinline__ void load_moe_table(ArgsP A, int l, LAS unsigned char* lds, int tid) {
    LAS int* tb = (LAS int*)(lds + LDS_MISC + 64); LAS int* cn = (LAS int*)(lds + LDS_MISC + 192);
    if (tid == 0) { unsigned* ctl = (unsigned*)(A->ws + WS_CTL); int s = 0;
        for (int e = 0; e < NEXP; ++e) { int c = (int)__hip_atomic_load(ctl + CW_CNT + (l * 16 + e) * 64, __ATOMIC_RELAXED, __HIP_MEMORY_SCOPE_AGENT); if (c > TOKCAP) c = TOKCAP; cn[e] = c; tb[e] = s; s += (c + 255) >> 8; }
        tb[16] = s; }
    __syncthreads();
}

template <int MODE> __device__ __forceinline__ void phase_norm1(ArgsP A, int l, LAS unsigned char* lds, int tid, int lane, int wave, int bx, int G) {
    const float* MOD = (const float*)(A->ws + WS_MOD);
    bf16_t* X = (bf16_t*)(A->ws + WS_X); bf16_t* H = (bf16_t*)(A->ws + WS_H);
    const unsigned char* Y = A->ws + WS_Y; const u32x4* ASG = (const u32x4*)(A->ws + WS_ASG);
    const LAS int* tb = (const LAS int*)(lds + LDS_MISC + 64);
    if (MODE != 0) load_moe_table(A, l - 1, lds, tid);
    const int gw = bx * 8 + wave, NGW = G * 8;
    for (int b = 0; b < BATCH; ++b) {
        f32x4 mulv[8], addv[8], g2v[8];
#pragma unroll
        for (int j = 0; j < 8; ++j) { const int c = 4 * (lane + 64 * j);
            if (MODE == 2) { mulv[j] = *(const f32x4*)((const float*)A->in[I_FG] + c); addv[j] = (f32x4){0.f, 0.f, 0.f, 0.f}; }
            else { const float* mo = MOD + (size_t)(l * 4 + b) * NMOD; const f32x4 gn = *(const f32x4*)((const float*)A->in[I_NGAIN] + (size_t)(l * 2 + 0) * DM + c);
                   mulv[j] = gn * (*(const f32x4*)(mo + 1 * DM + c) + 1.0f); addv[j] = *(const f32x4*)(mo + 0 * DM + c); }
            if (MODE != 0) g2v[j] = *(const f32x4*)(MOD + (size_t)((l - 1) * 4 + b) * NMOD + 5 * DM + c); }
        for (int row = b * SEQ + gw; row < (b + 1) * SEQ; row += NGW) {
            f32x4 v[8];
            if (MODE == 0) { const f32x4* xr = (const f32x4*)((const float*)A->in[I_X] + (size_t)row * DM) + lane;
#pragma unroll
                for (int j = 0; j < 8; ++j) v[j] = xr[64 * j]; }
            else { const u32x2* xr = (const u32x2*)(X + (size_t)row * DM) + lane;
#pragma unroll
                for (int j = 0; j < 8; ++j) { const u32x2 p = xr[64 * j]; v[j] = (f32x4){bflo(p.x), bfhi(p.x), bflo(p.y), bfhi(p.y)}; } }
            if (MODE != 0) {
                const u32x4 as = ASG[row];
                const int e0 = __builtin_amdgcn_readfirstlane((int)(as.x >> 20)), s0 = __builtin_amdgcn_readfirstlane((int)(as.x & 0xfffffu));
                const int e1 = __builtin_amdgcn_readfirstlane((int)(as.y >> 20)), s1 = __builtin_amdgcn_readfirstlane((int)(as.y & 0xfffffu));
                const float w0 = __uint_as_float(as.z) * (1.0f / YSC), w1 = __uint_as_float(as.w) * (1.0f / YSC);
                const int* y0 = (const int*)(Y + ((size_t)tb[e0] * 256 + s0) * DM) + lane; const int* y1 = (const int*)(Y + ((size_t)tb[e1] * 256 + s1) * DM) + lane;
#pragma unroll
                for (int j = 0; j < 8; ++j) { const int p = y0[64 * j], q = y1[64 * j];
                    f32x4 m; m[0] = w0 * __builtin_amdgcn_cvt_f32_fp8(p, 0) + w1 * __builtin_amdgcn_cvt_f32_fp8(q, 0); m[1] = w0 * __builtin_amdgcn_cvt_f32_fp8(p, 1) + w1 * __builtin_amdgcn_cvt_f32_fp8(q, 1);
                    m[2] = w0 * __builtin_amdgcn_cvt_f32_fp8(p, 2) + w1 * __builtin_amdgcn_cvt_f32_fp8(q, 2); m[3] = w0 * __builtin_amdgcn_cvt_f32_fp8(p, 3) + w1 * __builtin_amdgcn_cvt_f32_fp8(q, 3);
                    v[j] = v[j] + g2v[j] * m; }
                if (MODE == 1) { u32x2* xw = (u32x2*)(X + (size_t)row * DM) + lane;
#pragma unroll
                    for (int j = 0; j < 8; ++j) { u32x2 w; w.x = cvt_pk_bf16(v[j][0], v[j][1]); w.y = cvt_pk_bf16(v[j][2], v[j][3]); xw[64 * j] = w; } }
            }
            float ss = 0.f;
#pragma unroll
            for (int j = 0; j < 8; ++j) ss += (v[j][0] * v[j][0] + v[j][1] * v[j][1]) + (v[j][2] * v[j][2] + v[j][3] * v[j][3]);
            const float rstd = 1.0f / sqrtf(wave_sum(ss) * (1.0f / DM) + 1e-6f);
            if (MODE == 2) { f32x4* ow = (f32x4*)(A->out + (size_t)row * DM) + lane;
#pragma unroll
                for (int j = 0; j < 8; ++j) ow[64 * j] = v[j] * rstd * mulv[j];
            } else {
#if PROJ_FP8
                int* hw = (int*)((unsigned char*)H + (size_t)row * DM) + lane;
#pragma unroll
                for (int j = 0; j < 8; ++j) { const f32x4 h = v[j] * rstd * mulv[j] + addv[j]; hw[64 * j] = pk4_fp8(h[0], h[1], h[2], h[3]); }
#else
                u32x2* hw = (u32x2*)(H + (size_t)row * DM) + lane;
#pragma unroll
                for (int j = 0; j < 8; ++j) { const f32x4 h = v[j] * rstd * mulv[j] + addv[j]; u32x2 w; w.x = cvt_pk_bf16(h[0], h[1]); w.y = cvt_pk_bf16(h[2], h[3]); hw[64 * j] = w; }
#endif
            }
        }
    }
#if !SCAN_CONVERT
    if (MODE == 1) { VM_WAIT(); __syncthreads(); convert_moe(A, l, lds, lane, wave, gw, NGW); }
#endif
}

__device__ __forceinline__ void phase_norm2_router(ArgsP A, int l, LAS unsigned char* lds, int tid, int lane, int wave, int bx, int G, int dry) {
    const float* MOD = (const float*)(A->ws + WS_MOD);
    const bf16_t* X = (const bf16_t*)(A->ws + WS_X); bf16_t* H = (bf16_t*)(A->ws + WS_H);
    LAS float* wr_l = (LAS float*)lds;
    LAS int* l_e = (LAS int*)(lds + LDS_MISC + 512);
    LAS float* l_g = (LAS float*)(lds + LDS_MISC + 1024);
    LAS int* l_cnt = (LAS int*)(lds + LDS_MISC + 1536);
    LAS int* l_base = (LAS int*)(lds + LDS_MISC + 1600);
    LAS int* l_loc = (LAS int*)(lds + LDS_MISC + 1664);
    { const f32x4* src = (const f32x4*)A->in[I_WR]; for (int t = tid; t < DM * NEXP / 4; t += 512) { const int c = t >> 2, q = t & 3, L = (c >> 2) & 63, j = c >> 8, i = c & 3;
        *(LAS f32x4*)(wr_l + 4 * ((((j * 4 + i) * 4 + q) * 64) + L)) = src[t]; } }
    if (tid < 16) l_cnt[tid] = 0;
    __syncthreads();
    for (int rblk = bx; rblk < MTOK / 64; rblk += G) {
        const int b = (rblk * 64) / SEQ;
        const float* mo = MOD + (size_t)(l * 4 + b) * NMOD;
        const float* gnp = (const float*)A->in[I_NGAIN] + (size_t)(l * 2 + 1) * DM;
        for (int rr = 0; rr < 8; rr += 2) {
            const int rl = wave * 8 + rr, row = rblk * 64 + rl;
            u32x2 p0[8], p1[8];
            { const u32x2* x0 = (const u32x2*)(X + (size_t)row * DM) + lane; const u32x2* x1 = x0 + DM / 4;
#pragma unroll
              for (int j = 0; j < 8; ++j) { p0[j] = x0[64 * j]; p1[j] = x1[64 * j]; } }
#define UNP(p) (f32x4){bflo((p).x), bfhi((p).x), bflo((p).y), bfhi((p).y)}
            float ss0 = 0.f, ss1 = 0.f;
#pragma unroll
            for (int j = 0; j < 8; ++j) { const f32x4 a = UNP(p0[j]), b = UNP(p1[j]);
                ss0 += (a[0] * a[0] + a[1] * a[1]) + (a[2] * a[2] + a[3] * a[3]); ss1 += (b[0] * b[0] + b[1] * b[1]) + (b[2] * b[2] + b[3] * b[3]); }
            const float rstd0 = 1.0f / sqrtf(wave_sum(ss0) * (1.0f / DM) + 1e-6f), rstd1 = 1.0f / sqrtf(wave_sum(ss1) * (1.0f / DM) + 1e-6f);
            float lg0[16], lg1[16];
#pragma unroll
            for (int e = 0; e < 16; ++e) { lg0[e] = 0.f; lg1[e] = 0.f; }
            int* hw0 = (int*)((unsigned char*)H + (size_t)row * DM) + lane;
            int* hw1 = hw0 + DM / 4;
#pragma unroll
            for (int j = 0; j < 8; ++j) { const int cj = 4 * (lane + 64 * j);
                const f32x4 mulj = *(const f32x4*)(gnp + cj) * (*(const f32x4*)(mo + 4 * DM + cj) + 1.0f), addj = *(const f32x4*)(mo + 3 * DM + cj);
                const f32x4 h0 = UNP(p0[j]) * rstd0 * mulj + addj, h1 = UNP(p1[j]) * rstd1 * mulj + addj;
                hw0[64 * j] = pk4_fp8(h0[0], h0[1], h0[2], h0[3]); hw1[64 * j] = pk4_fp8(h1[0], h1[1], h1[2], h1[3]);
#pragma unroll
                for (int i = 0; i < 4; ++i) { const LAS f32x4* wp = (const LAS f32x4*)wr_l + (j * 4 + i) * 4 * 64 + lane;
#pragma unroll
                    for (int q = 0; q < 4; ++q) { const f32x4 ww = wp[q * 64];
                        lg0[4 * q + 0] += h0[i] * ww[0]; lg0[4 * q + 1] += h0[i] * ww[1]; lg0[4 * q + 2] += h0[i] * ww[2]; lg0[4 * q + 3] += h0[i] * ww[3];
                        lg1[4 * q + 0] += h1[i] * ww[0]; lg1[4 * q + 1] += h1[i] * ww[1]; lg1[4 * q + 2] += h1[i] * ww[2]; lg1[4 * q + 3] += h1[i] * ww[3]; } }
                __builtin_amdgcn_sched_barrier(0); }
#undef UNP
            float lg[16];
#pragma unroll
            for (int e = 0; e < 16; ++e) { const float a = wave_sum(lg0[e]), b = wave_sum(lg1[e]); lg[e] = (lane == 1) ? b : a; }
            if (lane < 2) {
                const int rl2 = rl + lane;
                float sc[16], sel[16]; const float* rb = (const float*)A->in[I_RB];
#pragma unroll
                for (int e = 0; e < 16; ++e) { sc[e] = sigmoidf_(lg[e]); sel[e] = sc[e] + rb[e]; }
                int bg = 0; float bgs = -1e30f;
#pragma unroll
                for (int g = 0; g < 4; ++g) { float m1 = -1e30f, m2 = -1e30f;
#pragma unroll
                    for (int i = 0; i < 4; ++i) { const float s = sel[4 * g + i]; if (s > m1) { m2 = m1; m1 = s; } else if (s > m2) m2 = s; }
                    const float gs = m1 + m2; if (gs > bgs) { bgs = gs; bg = g; } }
                int i1 = 0; float m1 = -1e30f;
#pragma unroll
                for (int g = 0; g < 4; ++g) if (g == bg) {
#pragma unroll
                    for (int i = 0; i < 4; ++i) if (sel[4 * g + i] > m1) { m1 = sel[4 * g + i]; i1 = i; } }
                int i2 = 0; float m2 = -1e30f;
#pragma unroll
                for (int g = 0; g < 4; ++g) if (g == bg) {
#pragma unroll
                    for (int i = 0; i < 4; ++i) if (i != i1 && sel[4 * g + i] > m2) { m2 = sel[4 * g + i]; i2 = i; } }
                const int e1 = 4 * bg + i1, e2 = 4 * bg + i2; float s1 = 0.f, s2 = 0.f;
#pragma unroll
                for (int e = 0; e < 16; ++e) { if (e == e1) s1 = sc[e]; if (e == e2) s2 = sc[e]; }
                const float inv = 1.0f / (s1 + s2);
                l_e[2 * rl2] = e1; l_e[2 * rl2 + 1] = e2; l_g[2 * rl2] = s1 * inv; l_g[2 * rl2 + 1] = s2 * inv;
            }
        }
        __syncthreads();
        { const int tid2 = launder_v(tid);
        if (tid2 < 128) l_loc[tid2] = atomicAdd((int*)&l_cnt[l_e[tid2]], 1);
        __syncthreads();
        if (tid2 < 16) { unsigned* ctl = (unsigned*)(A->ws + WS_CTL); const int c = l_cnt[tid2];
            l_base[tid2] = c ? (int)__hip_atomic_fetch_add(ctl + CW_CNT + ((l + 2 * dry) * 16 + tid2) * 64, (unsigned)c, __ATOMIC_RELAXED, __HIP_MEMORY_SCOPE_AGENT) : 0; }
        __syncthreads();
        if (tid2 < 128) { const int e = l_e[tid2]; const int slot = l_base[e] + l_loc[tid2]; const int row = rblk * 64 + (tid2 >> 1);
            int* tokl = (int*)(A->ws + WS_TOKL); if (slot < TOKCAP && !dry) tokl[e * TOKCAP + slot] = row;
            unsigned* asg = (unsigned*)(A->ws + WS_ASG) + (size_t)row * 4; if (!dry) asg[tid2 & 1] = ((unsigned)e << 20) | (unsigned)slot; if (!dry) asg[2 + (tid2 & 1)] = __float_as_uint(l_g[tid2]); }
        __syncthreads();
        }
        if (tid < 16) l_cnt[tid] = 0;
        __syncthreads();
    }
}

__device__ __forceinline__ void phase_prep(ArgsP A, int l, int lane, int wave, int bx, int G) {
    const bf16_t* PROJ = (const bf16_t*)(A->ws + WS_PROJ); bf16_t* SHR = (bf16_t*)(A->ws + WS_SHR); bf16_t* LA = (bf16_t*)(A->ws + WS_LA);
    const int gw = bx * 8 + wave, NGW = G * 8;
    for (int it = gw; it < 7 * (MTOK / 64); it += NGW) {
        const int strip = it % 7, run = it / 7;
        if (strip == 6 && lane >= 48) continue;
        const int c = strip * 512 + 8 * lane;
        float mup[8], mun[8], kkv[8];
#pragma unroll
        for (int j = 0; j < 8; ++j) { mup[j] = ((const float*)A->in[I_MUP])[l * RWC + c + j]; mun[j] = ((const float*)A->in[I_MUN])[l * RWC + c + j];
            kkv[j] = (strip == 2 || strip == 3) ? ((const float*)A->in[I_KK])[l * 1024 + (c - 1024) + j] : 0.f; }
        const int t0 = run * 64, tl0 = t0 % SEQ;
        const bf16_t* pp = PROJ + (size_t)t0 * NPROJP + RW0 + c;
        float prev[8], cur[8], nxt[8];
        if (tl0 == 0) {
#pragma unroll
            for (int j = 0; j < 8; ++j) prev[j] = 0.f; } else unpack8(*(const u32x4*)(pp - NPROJP), prev);
        unpack8(*(const u32x4*)pp, cur);
        u32x4 rawn[8];
#pragma unroll
        for (int q = 0; q < 8; ++q) rawn[q] = *(const u32x4*)(pp + (size_t)(q + 1) * NPROJP);
        for (int i0 = 0; i0 < 64; i0 += 8) {
            u32x4 raw[8];
#pragma unroll
            for (int q = 0; q < 8; ++q) raw[q] = rawn[q];
            if (i0 + 8 < 64) {
#pragma unroll
                for (int q = 0; q < 8; ++q) rawn[q] = *(const u32x4*)(pp + (size_t)(i0 + 8 + q + 1) * NPROJP); }
#pragma unroll
            for (int q = 0; q < 8; ++q) {
            const int i = i0 + q; const int row = t0 + i;
            unpack8(raw[q], nxt);
            if (tl0 + i == SEQ - 1) {
#pragma unroll
                for (int j = 0; j < 8; ++j) nxt[j] = 0.f; }
            float ps[8];
#pragma unroll
            for (int j = 0; j < 8; ++j) ps[j] = cur[j] + mup[j] * (prev[j] - cur[j]) + mun[j] * (nxt[j] - cur[j]);
            if (strip < 6) {
                const int reg = strip >> 1, cc = (strip & 1) * 512 + 8 * lane;
                *(u32x4*)(SHR + (size_t)row * 4096 + reg * 1024 + cc) = pack8(ps);
                if (reg == 1) { float x[8]; float ss = 0.f;
#pragma unroll
                    for (int j = 0; j < 8; ++j) { x[j] = ps[j] * kkv[j]; ss += x[j] * x[j]; }
                    ss += __shfl_xor(ss, 1); ss += __shfl_xor(ss, 2); ss += __shfl_xor(ss, 4);
                    const float inv = 1.0f / fmaxf(sqrtf(ss), 1e-12f);
#pragma unroll
                    for (int j = 0; j < 8; ++j) x[j] *= inv;
                    *(u32x4*)(SHR + (size_t)row * 4096 + 3072 + cc) = pack8(x); }
            } else {
                const int ty = lane >> 4; float o[8];
#pragma unroll
                for (int j = 0; j < 8; ++j) o[j] = (ty == 0) ? (1.0f - 2.0f / (1.0f + __expf(2.0f * ps[j]))) : (ty == 1) ? ps[j] : sigmoidf_(ps[j]);
                *(u32x4*)(LA + (size_t)row * KLA + 8 * lane) = pack8(o);
            }
#pragma unroll
            for (int j = 0; j < 8; ++j) { prev[j] = cur[j]; cur[j] = nxt[j]; }
            }
        }
    }
}

__device__ __forceinline__ float rowsum16(float x) {
    x += __builtin_bit_cast(float, __builtin_amdgcn_update_dpp(0, __builtin_bit_cast(int, x), 0x128, 0xf, 0xf, false));
    x += __builtin_bit_cast(float, __builtin_amdgcn_update_dpp(0, __builtin_bit_cast(int, x), 0x124, 0xf, 0xf, false));
    x += __builtin_bit_cast(float, __builtin_amdgcn_update_dpp(0, __builtin_bit_cast(int, x), 0x122, 0xf, 0xf, false));
    x += __builtin_bit_cast(float, __builtin_amdgcn_update_dpp(0, __builtin_bit_cast(int, x), 0x121, 0xf, 0xf, false));
    return x;
}
namespace rs {
constexpr int M = 16, NCH = SEQ / M;
constexpr int SLOT = 21248, O_AR = 0, O_BK = 5632, O_BKT = 10240, O_VT = 15360, O_MRB = 18432, O_LAB = 19968, O_GAM = 20992;
constexpr int P_AR = 176, P_BK = 144, P_BKT = 80, P_VT = 48, P_MRB = 48;
constexpr int O_YB = 3 * SLOT, O_CV = O_YB + 8192;
__device__ __forceinline__ float bfu(unsigned short x) { return __uint_as_float(((unsigned)x) << 16); }
__device__ __forceinline__ unsigned cvtpk(float lo, float hi) { unsigned r; asm("v_cvt_pk_bf16_f32 %0, %1, %2" : "=v"(r) : "v"(lo), "v"(hi)); return r; }
__device__ __forceinline__ unsigned short f2bf(float f) { return (unsigned short)(cvtpk(f, 0.f) & 0xffffu); }
__device__ __forceinline__ bf16x8 pack_bf8(float a, float b, float c, float d, float e, float f, float g, float h) {
    u32x4 w; w.x = cvtpk(a, b); w.y = cvtpk(c, d); w.z = cvtpk(e, f); w.w = cvtpk(g, h); return __builtin_bit_cast(bf16x8, w); }
}
__device__ __forceinline__ void phase_scan(ArgsP A, int l, LAS unsigned char* lds, int tid, int bx, int G) {
    using namespace rs;
    const bf16_t* SHR = (const bf16_t*)(A->ws + WS_SHR); const bf16_t* DYN = (const bf16_t*)(A->ws + WS_DYN); bf16_t* YS = (bf16_t*)(A->ws + WS_YS);
    const int wid = __builtin_amdgcn_readfirstlane(tid >> 6), lane = tid & 63, l31 = lane & 31, hh = lane >> 5;
    const bool xsplit = (G == 256);
    for (int chain = xsplit ? (((bx >> 3) & 1) ? 128 : ((bx >> 4) * 8 + (bx & 7))) : bx; chain < 128; chain += xsplit ? 128 : G) {
        const int d = chain >> 6, b = (chain >> 4) & 3, h = chain & 15; const int hf = (wid == 7) ? 1 : 0;
#define RS_ROW(c, t) ((size_t)b * SEQ + (d ? (SEQ - 1 - ((c) * M + (t))) : ((c) * M + (t))))
        f32x16 ST0 = {}, ST1 = {};
        u32x4 q0a, q0b, q1a, q1b, q2a, q2b, q3a, q3b;
        float kaj = 0.f;
        const int cpos = (lane >> 4) * 32 + ((lane >> 2) & 1) * 16 + ((((lane >> 3) & 1) << 2) | (lane & 3)) * 2;
        const bool e1 = (wid == 2) || (wid == 5), e2 = (wid == 3) || (wid == 6); const int epar = (wid >= 5) ? 1 : 0;
        const int ew = (wid == 2) ? 0 : (wid == 3) ? 1 : (wid == 5) ? 2 : 3;
        LAS unsigned char* stg = lds + O_CV + ew * 8192;
        if (e2) kaj = ((const float*)A->in[I_KA])[l * 1024 + h * 64 + lane];
#define RS_LOAD(c) do { const size_t ra_ = RS_ROW(c, lane >> 3), rb_ = RS_ROW(c, 8 + (lane >> 3)); const int cg_ = 8 * (lane & 7); \
            const bf16_t* sa_ = SHR + ra_ * 4096 + h * 64 + cg_; const bf16_t* sb_ = SHR + rb_ * 4096 + h * 64 + cg_; \
            const bf16_t* da_ = DYN + ra_ * NDYN + d * 1024 + h * 64 + cg_; const bf16_t* db_ = DYN + rb_ * NDYN + d * 1024 + h * 64 + cg_; \
            q0a = *(const u32x4*)da_; q0b = *(const u32x4*)db_; q1a = *(const u32x4*)(sa_ + 3072); q1b = *(const u32x4*)(sb_ + 3072); \
            if (e1) { q2a = *(const u32x4*)sa_; q2b = *(const u32x4*)sb_; q3a = *(const u32x4*)(sa_ + 2048); q3b = *(const u32x4*)(sb_ + 2048); } \
            else { q2a = *(const u32x4*)(da_ + 2048); q2b = *(const u32x4*)(db_ + 2048); q3a = *(const u32x4*)(sa_ + 1024); q3b = *(const u32x4*)(sb_ + 1024); } } while (0)
#define RS_STAGE() do { const int o_ = ((lane >> 3) * 64 + 8 * (lane & 7)) * 2; \
            *(LAS u32x4*)(stg + o_) = q0a; *(LAS u32x4*)(stg + 1024 + o_) = q0b; *(LAS u32x4*)(stg + 2048 + o_) = q1a; *(LAS u32x4*)(stg + 3072 + o_) = q1b; \
            *(LAS u32x4*)(stg + 4096 + o_) = q2a; *(LAS u32x4*)(stg + 5120 + o_) = q2b; \
            *(LAS u32x4*)(stg + 6144 + o_) = q3a; *(LAS u32x4*)(stg + 7168 + o_) = q3b; \
            asm volatile("s_waitcnt lgkmcnt(0)" ::: "memory"); } while (0)
#define RS_GET(arr, t_) bfu(*(const LAS unsigned short*)(stg + (arr) * 2048 + (t_) * 128 + 2 * lane))
        if ((e1 || e2) && epar == 0) RS_LOAD(0);
        for (int n = 0; n < NCH + 3; ++n) {
            if (wid == 0 || wid == 7) {
                const int c = n - 2;
                if (c >= 0 && c < NCH) {
                    LAS unsigned char* sl = lds + (c % 3) * SLOT;
                    f32x16 D = {};
                    const LAS unsigned char* arp = sl + O_AR + l31 * P_AR + hh * 16;
                    {   bf16x8 a0 = *(const LAS bf16x8*)(arp), a1 = *(const LAS bf16x8*)(arp + 32), a2 = *(const LAS bf16x8*)(arp + 64), a3 = *(const LAS bf16x8*)(arp + 96), a4 = *(const LAS bf16x8*)(arp + 128);
                        const bf16x8 bv = *(const LAS bf16x8*)(sl + O_VT + (32 * hf + l31) * P_VT + hh * 16);
                        const bf16x8 b0 = pack_bf8(ST0[0], ST0[1], ST0[2], ST0[3], ST0[4], ST0[5], ST0[6], ST0[7]), b1 = pack_bf8(ST0[8], ST0[9], ST0[10], ST0[11], ST0[12], ST0[13], ST0[14], ST0[15]);
                        const bf16x8 b2 = pack_bf8(ST1[0], ST1[1], ST1[2], ST1[3], ST1[4], ST1[5], ST1[6], ST1[7]), b3 = pack_bf8(ST1[8], ST1[9], ST1[10], ST1[11], ST1[12], ST1[13], ST1[14], ST1[15]);
                        D = __builtin_amdgcn_mfma_f32_32x32x16_bf16(a0, b0, D, 0, 0, 0); D = __builtin_amdgcn_mfma_f32_32x32x16_bf16(a1, b1, D, 0, 0, 0);
                        D = __builtin_amdgcn_mfma_f32_32x32x16_bf16(a2, b2, D, 0, 0, 0); D = __builtin_amdgcn_mfma_f32_32x32x16_bf16(a3, b3, D, 0, 0, 0);
                        D = __builtin_amdgcn_mfma_f32_32x32x16_bf16(a4, bv, D, 0, 0, 0);
                        float da[16];
#pragma unroll
                        for (int r = 0; r < 8; ++r) { auto rr = __builtin_amdgcn_permlane32_swap(__float_as_uint(D[r]), __float_as_uint(D[r]), false, false);
                            const int t0 = (r & 3) + 8 * (r >> 2); da[t0] = __uint_as_float(rr[0]); da[t0 + 4] = __uint_as_float(rr[1]); }
                        const LAS float* lab = (const LAS float*)(sl + O_LAB);
#pragma unroll
                        for (int s_ = 0; s_ < 15; ++s_) {
                            const f32x4 c0 = *(const LAS f32x4*)(lab + s_ * 16), c1 = *(const LAS f32x4*)(lab + s_ * 16 + 4), c2 = *(const LAS f32x4*)(lab + s_ * 16 + 8), c3 = *(const LAS f32x4*)(lab + s_ * 16 + 12);
                            const float cf[16] = {c0[0], c0[1], c0[2], c0[3], c1[0], c1[1], c1[2], c1[3], c2[0], c2[1], c2[2], c2[3], c3[0], c3[1], c3[2], c3[3]};
#pragma unroll
                            for (int t_ = s_ + 1; t_ < 16; ++t_) da[t_] += da[s_] * cf[t_];
                        }
                        const bf16x8 bu = hh ? pack_bf8(da[8], da[9], da[10], da[11], da[12], da[13], da[14], da[15]) : pack_bf8(da[0], da[1], da[2], da[3], da[4], da[5], da[6], da[7]);
                        const bf16x8 am = *(const LAS bf16x8*)(sl + O_MRB + l31 * P_MRB + hh * 16);
                        D = __builtin_amdgcn_mfma_f32_32x32x16_bf16(am, bu, D, 0, 0, 0);
                        LAS float* yb = (LAS float*)(lds + O_YB + (c & 1) * 4096);
#pragma unroll
                        for (int r = 8; r < 16; ++r) yb[((r & 3) + 8 * ((r >> 2) - 2) + 4 * hh) * 64 + 32 * hf + l31] = D[r];
                        const LAS unsigned char* bk0 = sl + O_BKT + l31 * P_BKT + hh * 16; const LAS unsigned char* bk1 = bk0 + 32 * P_BKT;
                        ST0 = __builtin_amdgcn_mfma_f32_32x32x16_bf16(*(const LAS bf16x8*)(bk0), bu, ST0, 0, 0, 0); ST0 = __builtin_amdgcn_mfma_f32_32x32x16_bf16(*(const LAS bf16x8*)(bk0 + 32), bv, ST0, 0, 0, 0);
                        ST1 = __builtin_amdgcn_mfma_f32_32x32x16_bf16(*(const LAS bf16x8*)(bk1), bu, ST1, 0, 0, 0); ST1 = __builtin_amdgcn_mfma_f32_32x32x16_bf16(*(const LAS bf16x8*)(bk1 + 32), bv, ST1, 0, 0, 0);
                        const LAS float* gam = (const LAS float*)(sl + O_GAM) + 4 * hh;
#pragma unroll
                        for (int g4 = 0; g4 < 4; ++g4) { const f32x4 g0 = *(const LAS f32x4*)(gam + 8 * g4), g1 = *(const LAS f32x4*)(gam + 32 + 8 * g4);
#pragma unroll
                            for (int i_ = 0; i_ < 4; ++i_) { ST0[4 * g4 + i_] *= g0[i_]; ST1[4 * g4 + i_] *= g1[i_]; } }
                    }
                }
            } else if (wid == 1) {
                const int c = n - 1;
                if (c >= 0 && c < NCH) {
                    LAS unsigned char* sl = lds + (c % 3) * SLOT;
                    f32x16 Lm = {};
                    const LAS unsigned char* ap = sl + O_BK + l31 * P_BK + hh * 16; const LAS unsigned char* bp = sl + O_AR + l31 * P_AR + hh * 16;
#pragma unroll
                    for (int q = 0; q < 4; ++q) Lm = __builtin_amdgcn_mfma_f32_32x32x16_bf16(*(const LAS bf16x8*)(ap + 32 * q), *(const LAS bf16x8*)(bp + 32 * q), Lm, 0, 0, 0);
                    const int tp = l31, tq = tp & 15; const bool isr = tp >= 16;
                    LAS float* lab = (LAS float*)(sl + O_LAB);
                    float lo[8], hi[8];
#pragma unroll
                    for (int r = 0; r < 8; ++r) { const int s_ = (r & 3) + 8 * (r >> 2) + 4 * hh; const bool keep = isr ? (s_ <= tq) : (s_ < tq);
                        lo[r] = keep ? Lm[r] : 0.f; hi[r] = keep ? Lm[8 + r] : 0.f; }
                    if (!isr) {
#pragma unroll
                        for (int r = 0; r < 8; ++r) lab[((r & 3) + 8 * (r >> 2) + 4 * hh) * 16 + tp] = lo[r]; }
                    { u32x2 w0, w1; w0.x = isr ? cvtpk(lo[0], lo[1]) : 0u; w0.y = isr ? cvtpk(lo[2], lo[3]) : 0u; w1.x = isr ? cvtpk(lo[4], lo[5]) : 0u; w1.y = isr ? cvtpk(lo[6], lo[7]) : 0u;
                      LAS unsigned char* mp = sl + O_MRB + tp * P_MRB + hh * 8; *(LAS u32x2*)(mp) = w0; *(LAS u32x2*)(mp + 16) = w1; }
                    { u32x2 w0, w1; w0.x = cvtpk(hi[0], hi[1]); w0.y = cvtpk(hi[2], hi[3]); w1.x = cvtpk(hi[4], hi[5]); w1.y = cvtpk(hi[6], hi[7]);
                      LAS unsigned char* qp = sl + O_AR + tp * P_AR + 128 + hh * 8; *(LAS u32x2*)(qp) = w0; *(LAS u32x2*)(qp + 16) = w1; }
                }
            } else if (e1) {
                if ((n & 1) != epar) { if (n + 1 < NCH) RS_LOAD(n + 1); }
                else if (n < NCH) {
                    LAS unsigned char* sl = lds + (n % 3) * SLOT;
                    RS_STAGE();
                    float g = 1.0f; float xw[16], xk[16], xr[16];
#pragma unroll
                    for (int t_ = 0; t_ < M; ++t_) { xw[t_] = RS_GET(0, t_); xk[t_] = RS_GET(1, t_); xr[t_] = RS_GET(2, t_); }
#pragma unroll
                    for (int t_ = 0; t_ < M; ++t_) { const float gp = g; g *= xw[t_];
                        *(LAS unsigned short*)(sl + O_AR + t_ * P_AR + cpos) = f2bf(-xk[t_] * gp);
                        *(LAS unsigned short*)(sl + O_AR + (16 + t_) * P_AR + cpos) = f2bf(xr[t_] * g); }
                    *(LAS float*)(sl + O_GAM + 4 * lane) = g;
                    { unsigned short vv[16];
#pragma unroll
                        for (int s_ = 0; s_ < 16; ++s_) vv[s_] = *(const LAS unsigned short*)(stg + 6144 + (s_ * 64 + lane) * 2);
                        u32x4 v0, v1; v0.x = vv[0] | ((unsigned)vv[1] << 16); v0.y = vv[2] | ((unsigned)vv[3] << 16); v0.z = vv[4] | ((unsigned)vv[5] << 16); v0.w = vv[6] | ((unsigned)vv[7] << 16);
                        v1.x = vv[8] | ((unsigned)vv[9] << 16); v1.y = vv[10] | ((unsigned)vv[11] << 16); v1.z = vv[12] | ((unsigned)vv[13] << 16); v1.w = vv[14] | ((unsigned)vv[15] << 16);
                        *(LAS u32x4*)(sl + O_VT + lane * P_VT) = v0; *(LAS u32x4*)(sl + O_VT + lane * P_VT + 16) = v1; }
                }
            } else if (e2) {
                if ((n & 1) != epar) { if (n + 1 < NCH) RS_LOAD(n + 1); }
                else if (n < NCH) {
                    LAS unsigned char* sl = lds + (n % 3) * SLOT;
                    RS_STAGE();
                    float g = 1.0f; float bq[16], kq[16], xw[16], xa[16];
#pragma unroll
                    for (int t_ = 0; t_ < M; ++t_) { xw[t_] = RS_GET(0, t_); xa[t_] = RS_GET(2, t_); bq[t_] = RS_GET(1, t_); kq[t_] = RS_GET(3, t_); }
#pragma unroll
                    for (int t_ = 0; t_ < M; ++t_) { g *= xw[t_]; const float rg = __builtin_amdgcn_rcpf(g); const float al = xa[t_];
                        bq[t_] = bq[t_] * al * rg; kq[t_] = kq[t_] * (1.0f + (al - 1.0f) * kaj) * rg;
                        *(LAS unsigned short*)(sl + O_BK + t_ * P_BK + cpos) = f2bf(bq[t_]);
                        *(LAS unsigned short*)(sl + O_BK + (16 + t_) * P_BK + cpos) = f2bf(kq[t_]); }
                    LAS unsigned char* tp_ = sl + O_BKT + lane * P_BKT;
                    *(LAS bf16x8*)(tp_) = pack_bf8(bq[0], bq[1], bq[2], bq[3], bq[4], bq[5], bq[6], bq[7]); *(LAS bf16x8*)(tp_ + 16) = pack_bf8(bq[8], bq[9], bq[10], bq[11], bq[12], bq[13], bq[14], bq[15]);
                    *(LAS bf16x8*)(tp_ + 32) = pack_bf8(kq[0], kq[1], kq[2], kq[3], kq[4], kq[5], kq[6], kq[7]); *(LAS bf16x8*)(tp_ + 48) = pack_bf8(kq[8], kq[9], kq[10], kq[11], kq[12], kq[13], kq[14], kq[15]);
                }
            } else {
                const int c = n - 3;
                if (wid == 4)
                if (c >= 0 && c < NCH) { const LAS float* yb = (const LAS float*)(lds + O_YB + (c & 1) * 4096); const int t_ = lane >> 2, q_ = lane & 3;
                    const f32x4 y0 = *(const LAS f32x4*)(yb + t_ * 64 + 16 * q_), y1 = *(const LAS f32x4*)(yb + t_ * 64 + 16 * q_ + 4), y2 = *(const LAS f32x4*)(yb + t_ * 64 + 16 * q_ + 8), y3 = *(const LAS f32x4*)(yb + t_ * 64 + 16 * q_ + 12);
                    u32x4 w, w2; w.x = cvt_pk_bf16(y0[0], y0[1]); w.y = cvt_pk_bf16(y0[2], y0[3]); w.z = cvt_pk_bf16(y1[0], y1[1]); w.w = cvt_pk_bf16(y1[2], y1[3]);
                    w2.x = cvt_pk_bf16(y2[0], y2[1]); w2.y = cvt_pk_bf16(y2[2], y2[3]); w2.z = cvt_pk_bf16(y3[0], y3[1]); w2.w = cvt_pk_bf16(y3[2], y3[3]);
                    bf16_t* yp = YS + ((size_t)d * MTOK + RS_ROW(c, t_)) * 1024 + h * 64 + 16 * q_; *(u32x4*)yp = w; *(u32x4*)(yp + 8) = w2; }
#if SCAN_CONVERT
                if (n < NCH) { const int cw = (wid == 7) ? 1 : 0; const int piece = (bx * 2 + cw) + n * (G * 2);
                    if (piece < MOE_PIECES) convert_moe_piece(A, l, (LAS float*)(lds + O_CV + 32768 + cw * 4352), lane, piece); }
#endif
            }
            asm volatile("s_waitcnt lgkmcnt(0)" ::: "memory");
            __builtin_amdgcn_s_barrier();
            asm volatile("" ::: "memory");
        }
#undef RS_LOAD
#undef RS_STAGE
#undef RS_GET
#undef RS_ROW
    }
}

__device__ __forceinline__ void phase_attn(ArgsP A, int l, LAS unsigned char* lds, int tid, int bx, int G) {
    const bf16_t* PROJ = (const bf16_t*)(A->ws + WS_PROJ); bf16_t* MIX = (bf16_t*)(A->ws + WS_MIX);
    float s1 = 0.f, s2 = 0.f;
    for (int i = 0; i < 64; ++i) { s1 += ((const float*)A->in[I_LQ1])[l * 64 + i] * ((const float*)A->in[I_LK1])[l * 64 + i]; s2 += ((const float*)A->in[I_LQ2])[l * 64 + i] * ((const float*)A->in[I_LK2])[l * 64 + i]; }
    const float lam_init = 0.8f - 0.6f * expf(-0.3f * (float)l);
    const float lam = expf(s1) - expf(s2) + lam_init;
    unsigned* ctl = (unsigned*)(A->ws + WS_CTL);
    LAS int* uslot = (LAS int*)(lds + LDS_MISC + 2304);
    const int myx = (int)(xb_xcc_id() & 7u);
    for (int qi = 0; qi < 8; ++qi) {
        const int x = (myx + qi) & 7;
        for (;;) {
            if (tid == 0) *uslot = (int)__hip_atomic_fetch_add(ctl + CW_AQ + (l * 8 + x) * 64, 1u, __ATOMIC_RELAXED, __HIP_MEMORY_SCOPE_AGENT);
            __syncthreads();
            const int k = __builtin_amdgcn_readfirstlane(*uslot);
            __syncthreads();
            if (k >= 128) break;
            const int bh = 4 * x + (k >> 5), qb = k & 31;
            const int b = bh >> 3, h = bh & 7;
            const bf16_t* Qb = PROJ + ((size_t)b * SEQ + qb * 128) * NPROJP + h * 128;
            const bf16_t* Kh = PROJ + ((size_t)b * SEQ) * NPROJP + 1024 + h * 128;
            const bf16_t* Vh = PROJ + ((size_t)b * SEQ) * NPROJP + 2048 + h * 128;
            unsigned char* Ob = (unsigned char*)MIX + (((size_t)b * SEQ + qb * 128) * DM + h * 128) * (WOUT_FP8 ? 1 : 2);
            attn::attn_unit2(Qb, Kh, Vh, Ob, lam, 1.0f - lam_init, (const float*)A->in[I_SUBG] + l * 128, (char*)lds, tid);
        }
    }
}

__device__ __forceinline__ void phase_post(ArgsP A, int l, int lane, int wave, int bx, int G) {
    const bf16_t* SHR = (const bf16_t*)(A->ws + WS_SHR); const bf16_t* DYN = (const bf16_t*)(A->ws + WS_DYN); const bf16_t* YS = (const bf16_t*)(A->ws + WS_YS);
    bf16_t* MIX = (bf16_t*)(A->ws + WS_MIX);
    const int gw = bx * 8 + wave, NGW = G * 8, c = 16 * lane;
    float kav[16], rkv[16], gng[16], gnb[16];
#pragma unroll
    for (int j = 0; j < 16; ++j) { kav[j] = ((const float*)A->in[I_KA])[l * 1024 + c + j]; rkv[j] = ((const float*)A->in[I_RK])[l * 1024 + c + j];
        gng[j] = ((const float*)A->in[I_GNG])[l * 1024 + c + j]; gnb[j] = ((const float*)A->in[I_GNB])[l * 1024 + c + j]; }
    for (int row = gw; row < MTOK; row += NGW) {
        float y[16], t[16], r[16], k[16], v[16], a0[16], a1[16], g[16];
#define LD16(dst, ptr) do { float lo_[8], hi_[8]; unpack8(*(const u32x4*)(ptr), lo_); unpack8(*(const u32x4*)((ptr) + 8), hi_); _Pragma("unroll") for (int j_ = 0; j_ < 8; ++j_) { dst[j_] = lo_[j_]; dst[8 + j_] = hi_[j_]; } } while (0)
        LD16(y, YS + (size_t)row * 1024 + c); LD16(t, YS + ((size_t)MTOK + row) * 1024 + c);
        LD16(r, SHR + (size_t)row * 4096 + c); LD16(k, SHR + (size_t)row * 4096 + 1024 + c); LD16(v, SHR + (size_t)row * 4096 + 2048 + c);
        LD16(a0, DYN + (size_t)row * NDYN + 2048 + c); LD16(a1, DYN + (size_t)row * NDYN + 3072 + c); LD16(g, DYN + (size_t)row * NDYN + 4096 + c);
#undef LD16
        float s = 0.f, bo = 0.f;
#pragma unroll
        for (int j = 0; j < 16; ++j) { y[j] += t[j]; s += y[j]; bo += r[j] * (k[j] * (2.0f + (a0[j] + a1[j] - 2.0f) * kav[j])) * rkv[j]; }
        s += __shfl_xor(s, 1); s += __shfl_xor(s, 2); bo += __shfl_xor(bo, 1); bo += __shfl_xor(bo, 2);
        const float mean = s * (1.0f / 64.0f); float q = 0.f;
#pragma unroll
        for (int j = 0; j < 16; ++j) { y[j] -= mean; q += y[j] * y[j]; }
        q += __shfl_xor(q, 1); q += __shfl_xor(q, 2);
        const float rstd = 1.0f / sqrtf(q * (1.0f / 64.0f) + 64e-5f);
        float o[16];
#pragma unroll
        for (int j = 0; j < 16; ++j) o[j] = (y[j] * rstd * gng[j] + gnb[j] + bo * v[j]) * g[j];
        float o0[8], o1[8];
#pragma unroll
        for (int j = 0; j < 8; ++j) { o0[j] = o[j]; o1[j] = o[8 + j]; }
        if (WOUT_FP8) {
#pragma unroll
            for (int j = 0; j < 8; ++j) { o0[j] *= MIXSC; o1[j] *= MIXSC; }
            unsigned char* mp = (unsigned char*)MIX + (size_t)row * DM + 1024 + c; *(u32x2*)mp = pack8_fp8(o0); *(u32x2*)(mp + 8) = pack8_fp8(o1); }
        else { *(u32x4*)(MIX + (size_t)row * DM + 1024 + c) = pack8(o0); *(u32x4*)(MIX + (size_t)row * DM + 1024 + c + 8) = pack8(o1); }
    }
}

constexpr int NPL = 11, NPHASE = 1 + DEPTH * NPL + 1;
#ifndef ONLY_PHASE
#define ONLY_PHASE -1
#endif
#define PH_ON(k) (ONLY_PHASE < 0 || ONLY_PHASE == (k))
#ifndef REPEAT_PHASE
#define REPEAT_PHASE -1
#endif
#define REP(k, cond) for (int rep_ = 0; rep_ < ((REPEAT_PHASE == (k) && (cond)) ? 2 : 1); ++rep_)
__global__ void __launch_bounds__(512, 2) fwd(Args args) {
    extern __shared__ __attribute__((aligned(16))) unsigned char lds_raw[];
    LAS unsigned char* lds = (LAS unsigned char*)lds_raw;
    const int tid = threadIdx.x, lane = tid & 63, wave = __builtin_amdgcn_readfirstlane(tid >> 6), bx = blockIdx.x, G = gridDim.x;
    if (tid < 4) ((LAS unsigned*)(lds + LDS_MISC))[tid] = 0u;
    __syncthreads();
#if MK_PER_PHASE
#define GRID_BAR() do { } while (0)
#else
    XcdBarrier bar = xcd_barrier_post((unsigned*)(args.ws + WS_CTL) + CW_BAR, (volatile LAS unsigned*)(lds + LDS_MISC));
#define GRID_BAR() xcd_barrier(bar, phase_tid(wave))
#endif
    const int lo = args.ph_lo, hi = args.ph_hi;
#define IN(k) (lo <= (k) && (k) < hi)
#define SEAM(k) do { if (IN(k) && IN((k) + 1)) GRID_BAR(); } while (0)
    if (PH_ON(0) && IN(0)) REP(0, true) { asm volatile("; MARK_PHASE_0"); ArgsP A = phase_args(); const int tl = phase_tid(wave), ll = tl & 63, wl = __builtin_amdgcn_readfirstlane(tl >> 6); phase_prologue(A, lds, tl, ll, wl, bx, G); } SEAM(0);
    for (int l = 0; l < DEPTH; ++l) {
        const int p0 = 1 + l * NPL;
        if (PH_ON(1) && IN(p0 + 0)) REP(1, l == 0) { asm volatile("; MARK_PHASE_1"); ArgsP A = phase_args(); const int tl = phase_tid(wave), ll = tl & 63, wl = __builtin_amdgcn_readfirstlane(tl >> 6); if (l == 0) phase_norm1<0>(A, l, lds, tl, ll, wl, bx, G); else phase_norm1<1>(A, l, lds, tl, ll, wl, bx, G); } SEAM(p0 + 0);
        if (PH_ON(2) && IN(p0 + 1)) REP(2, true) {
            asm volatile("; MARK_PHASE_2"); ArgsP A = phase_args(); const int tl = phase_tid(wave), ll = tl & 63, wl = __builtin_amdgcn_readfirstlane(tl >> 6); unsigned char* ws = A->ws;
            int kk_ = DM; asm volatile("" : "+s"(kk_));
            pg8::Gemm g{(const bf16_t*)(ws + WS_H), (const bf16_t*)(ws + WS_WIN + (size_t)l * NPROJP * DM * (PROJ_FP8 ? 1 : 2)), kk_, 0, nullptr, 0};
            pg8::StaticOrder S; S.init(MTOK, NPROJP, G, bx);
            pg8::EpiProj E{(bf16_t*)(ws + WS_PROJ), (const float*)(ws + WS_ROPE), PROJ_FP8 ? 1.0f / WSC_IN : 1.0f};
            pg8::gemm_phase<pg8::EpiProj, pg8::StaticOrder, false, PROJ_FP8 != 0>(lds, g, S, E, tl);
        } SEAM(p0 + 1);
        if (PH_ON(3) && IN(p0 + 2)) REP(3, true) { asm volatile("; MARK_PHASE_3"); ArgsP A = phase_args(); const int tl = phase_tid(wave), ll = tl & 63, wl = __builtin_amdgcn_readfirstlane(tl >> 6); phase_prep(A, l, ll, wl, bx, G); } SEAM(p0 + 2);
        if (PH_ON(4) && IN(p0 + 3)) REP(4, true) {
            asm volatile("; MARK_PHASE_4"); ArgsP A = phase_args(); const int tl = phase_tid(wave), ll = tl & 63, wl = __builtin_amdgcn_readfirstlane(tl >> 6); unsigned char* ws = A->ws;
            int kla = KLA; asm volatile("" : "+s"(kla));
            int ntw = 2; asm volatile("" : "+s"(ntw));
            pg8::Gemm g{(const bf16_t*)(ws + WS_LA), (const bf16_t*)(ws + WS_LW) + (size_t)l * NDYN * KLA, kla, 0, nullptr, ntw};
            pg8::DynOrder S; S.init(MTOK, NDYN, G, bx);
            pg8::EpiDyn E{(bf16_t*)(ws + WS_DYN), (const float*)A->in[I_DW0] + l * 2048, (const float*)A->in[I_A0] + l * 2048};
            pg8::gemm_phase<pg8::EpiDyn, pg8::DynOrder, false>(lds, g, S, E, tl);
        } SEAM(p0 + 3);
        if (PH_ON(5) && IN(p0 + 4)) REP(5, true) { asm volatile("; MARK_PHASE_5"); ArgsP A = phase_args(); const int tl = phase_tid(wave), ll = tl & 63, wl = __builtin_amdgcn_readfirstlane(tl >> 6); phase_scan(A, l, lds, tl, bx, G); }
#if MK_PER_PHASE
        SEAM(p0 + 4);
#endif
        if (PH_ON(6) && IN(p0 + 5)) REP(6, true) { asm volatile("; MARK_PHASE_6"); ArgsP A = phase_args(); const int tl = phase_tid(wave), ll = tl & 63, wl = __builtin_amdgcn_readfirstlane(tl >> 6); phase_attn(A, l, lds, tl, bx, G); } SEAM(p0 + 5);
        if (PH_ON(7) && IN(p0 + 6)) REP(7, true) { asm volatile("; MARK_PHASE_7"); ArgsP A = phase_args(); const int tl = phase_tid(wave), ll = tl & 63, wl = __builtin_amdgcn_readfirstlane(tl >> 6); phase_post(A, l, ll, wl, bx, G); } SEAM(p0 + 6);
        if (PH_ON(8) && IN(p0 + 7)) REP(8, l == 0) {
            asm volatile("; MARK_PHASE_8"); ArgsP A = phase_args(); const int tl = phase_tid(wave), ll = tl & 63, wl = __builtin_amdgcn_readfirstlane(tl >> 6); unsigned char* ws = A->ws;
            int kk_ = DM; asm volatile("" : "+s"(kk_));
            pg8::Gemm g{(const bf16_t*)(ws + WS_MIX), (const bf16_t*)(ws + WS_WOUT + (size_t)l * DM * DM * (WOUT_FP8 ? 1 : 2)), kk_, 0, nullptr, 0};
            pg8::StaticOrder S; S.init(MTOK, DM, G, bx);
            pg8::EpiRes E{l == 0 ? (const float*)A->in[I_X] : (const float*)nullptr, (bf16_t*)(ws + WS_X), (const float*)(ws + WS_MOD) + (size_t)l * 4 * NMOD + 2 * DM, WOUT_FP8 ? 1.0f / (WSC_O * MIXSC) : 1.0f};
            pg8::gemm_phase<pg8::EpiRes, pg8::StaticOrder, false, WOUT_FP8 != 0>(lds, g, S, E, tl);
        } SEAM(p0 + 7);
        if (PH_ON(9) && IN(p0 + 8)) REP(9, true) { asm volatile("; MARK_PHASE_9"); ArgsP A = phase_args(); const int tl = phase_tid(wave), ll = tl & 63, wl = __builtin_amdgcn_readfirstlane(tl >> 6); phase_norm2_router(A, l, lds, tl, ll, wl, bx, G, rep_); } SEAM(p0 + 8);
        if (PH_ON(10) && IN(p0 + 9)) REP(10, true) {
            asm volatile("; MARK_PHASE_10"); ArgsP A = phase_args(); const int tl = phase_tid(wave), ll = tl & 63, wl = __builtin_amdgcn_readfirstlane(tl >> 6); unsigned char* ws = A->ws;
            load_moe_table(A, l, lds, tl);
            int kk_ = DM; asm volatile("" : "+s"(kk_));
            pg8::Gemm g{(const bf16_t*)(ws + WS_H), (const bf16_t*)(ws + WS_WGU), kk_, (size_t)2048 * DM, (const int*)(ws + WS_TOKL), 0};
            pg8::MoeOrder S{(const LAS int*)(lds + LDS_MISC + 64), (const LAS int*)(lds + LDS_MISC + 192), G, bx, __builtin_amdgcn_readfirstlane(((const LAS int*)(lds + LDS_MISC + 64))[16])};
            pg8::EpiGlu E{ws + WS_ACT, 1.0f / WSC_GU};
            pg8::gemm_phase<pg8::EpiGlu, pg8::MoeOrder, true, true>(lds, g, S, E, tl);
        } SEAM(p0 + 9);
        if (PH_ON(11) && IN(p0 + 10)) REP(11, true) {
            asm volatile("; MARK_PHASE_11"); ArgsP A = phase_args(); const int tl = phase_tid(wave), ll = tl & 63, wl = __builtin_amdgcn_readfirstlane(tl >> 6); unsigned char* ws = A->ws;
            load_moe_table(A, l, lds, tl);
            int kk_ = DFF; asm volatile("" : "+s"(kk_));
            pg8::Gemm g{(const bf16_t*)(ws + WS_ACT), (const bf16_t*)(ws + WS_WD), kk_, (size_t)DM * DFF, nullptr, 0};
            pg8::MoeOrder S{(const LAS int*)(lds + LDS_MISC + 64), (const LAS int*)(lds + LDS_MISC + 192), G, bx, __builtin_amdgcn_readfirstlane(((const LAS int*)(lds + LDS_MISC + 64))[16])};
            pg8::EpiY E{ws + WS_Y, YSC / WSC_D};
            pg8::gemm_phase<pg8::EpiY, pg8::MoeOrder, false, true>(lds, g, S, E, tl);
        } SEAM(p0 + 10);
    }
    if (PH_ON(12) && IN(NPHASE - 1)) { asm volatile("; MARK_PHASE_12"); ArgsP A = phase_args(); const int tl = phase_tid(wave), ll = tl & 63, wl = __builtin_amdgcn_readfirstlane(tl >> 6); phase_norm1<2>(A, DEPTH, lds, tl, ll, wl, bx, G); }
#undef IN
#undef SEAM
}

extern "C" void kernel_launch(void* const* d_in, const int* in_sizes, int n_in, void* d_out, int out_size, void* d_ws, size_t ws_size, hipStream_t stream) {
    static int grid = 0;
    if (grid == 0) {
        if (n_in != 31 || out_size != MTOK * DM || ws_size < WS_END) { fprintf(stderr, "kernel_launch: unexpected shapes (n_in %d out %d ws %zu, need %zu)\n", n_in, out_size, ws_size, (size_t)WS_END); grid = -1; return; }
        int dev = 0, cus = 0;
        if (hipGetDevice(&dev) != hipSuccess || hipDeviceGetAttribute(&cus, hipDeviceAttributeMultiprocessorCount, dev) != hipSuccess) { grid = -1; return; }
        if (hipFuncSetAttribute((const void*)fwd, hipFuncAttributeMaxDynamicSharedMemorySize, LDS_BYTES) != hipSuccess) { fprintf(stderr, "kernel_launch: hipFuncSetAttribute failed\n"); grid = -1; return; }
        int per_cu = 0;
        if (hipOccupancyMaxActiveBlocksPerMultiprocessor(&per_cu, (const void*)fwd, 512, LDS_BYTES) != hipSuccess || per_cu < 1) fprintf(stderr, "kernel_launch: occupancy query says %d\n", per_cu);
        (void)hipGetLastError();
        grid = cus;
    }
    if (grid < 0) return;
    (void)hipMemsetAsync((char*)d_ws + WS_CTL, 0, CTL_BYTES, stream);
    Args a{};
    for (int i = 0; i < 31; ++i) a.in[i] = d_in[i];
    a.out = (float*)d_out; a.ws = (unsigned char*)d_ws;
#if MK_PER_PHASE
    for (int p = 0; p < NPHASE; ++p) { a.ph_lo = p; a.ph_hi = p + 1; hipLaunchKernelGGL(fwd, dim3(grid), dim3(512), LDS_BYTES, stream, a); }
#else
    a.ph_lo = 0; a.ph_hi = NPHASE; hipLaunchKernelGGL(fwd, dim3(grid), dim3(512), LDS_BYTES, stream, a);
#endif
    const hipError_t le = hipPeekAtLastError();
    if (le != hipSuccess) fprintf(stderr, "kernel_launch: launch failed: %s\n", hipGetErrorName(le));
}
```

```cpp
#include <hip/hip_runtime.h>
#include <cstdio>
#include <cstdint>

#ifndef SCAN_CONVERT
#define SCAN_CONVERT 0
#endif
#ifndef PROJ_FP8
#define PROJ_FP8 1
#endif
#ifndef MK_PER_PHASE
#define MK_PER_PHASE 0
#endif

#define LAS __attribute__((address_space(3)))
typedef unsigned short bf16_t;
typedef short bf16x8 __attribute__((ext_vector_type(8)));
typedef short s16x4 __attribute__((ext_vector_type(4)));
typedef float f32x4 __attribute__((ext_vector_type(4)));
typedef float f32x2 __attribute__((ext_vector_type(2)));
typedef float f32x16 __attribute__((ext_vector_type(16)));
typedef unsigned u32x4 __attribute__((ext_vector_type(4)));
typedef unsigned u32x2 __attribute__((ext_vector_type(2)));

constexpr int BATCH = 4, SEQ = 4096, DM = 2048, MTOK = BATCH * SEQ, DEPTH = 2;
constexpr int NPROJ = 6528, NPROJP = 6656, RW0 = 3072, RWC = 3456;
constexpr int NEXP = 16, DFF = 1024, TOKCAP = 16384;
constexpr int NMOD = 6 * DM;
constexpr int NDYN = 5120, KLA = 384;
constexpr float C2 = 0.18033688011112042f;
constexpr int MAXTILES = 144;
#ifndef WOUT_FP8
#define WOUT_FP8 1
#endif
constexpr float WSC_O = 32.0f, MIXSC = 8.0f;
constexpr float WSC_GU = 32.0f, WSC_D = 16.0f, WSC_IN = 32.0f, YSC = 8.0f;

constexpr size_t MiB = 1u << 20;
constexpr size_t WS_CTL = 0, CTL_BYTES = 1 * MiB;
constexpr size_t WS_MOD = 1 * MiB;
constexpr size_t WS_ROPE = 2 * MiB;
constexpr size_t WS_TOKL = 3 * MiB;
constexpr size_t WS_ASG = 4 * MiB;
constexpr size_t WS_LW = 5 * MiB;
constexpr size_t WS_WIN = 13 * MiB;
constexpr size_t WS_WOUT = 65 * MiB;
constexpr size_t WS_WGU = 81 * MiB;
constexpr size_t WS_WD = 209 * MiB;
constexpr size_t WS_X = 273 * MiB;
constexpr size_t WS_H = 401 * MiB;
constexpr size_t WS_MIX = 466 * MiB;
constexpr size_t WS_PROJ = 530 * MiB;
constexpr size_t WS_SHR = 738 * MiB;
constexpr size_t WS_LA = 866 * MiB;
constexpr size_t WS_DYN = 878 * MiB;
constexpr size_t WS_YS = 1038 * MiB;
constexpr size_t WS_END = 1102 * MiB;
constexpr size_t WS_ACT = 530 * MiB;
constexpr size_t WS_Y = 602 * MiB;
constexpr int CW_BAR = 4096;
constexpr int CW_CNT = 16384;
constexpr int CW_AQ = 24576;

constexpr int LDS_MISC = 131072;
constexpr int LDS_BYTES = 147456;

__device__ __forceinline__ unsigned cvt_pk_bf16(float lo, float hi) { unsigned r; asm volatile("v_cvt_pk_bf16_f32 %0, %1, %2" : "=v"(r) : "v"(lo), "v"(hi)); return r; }
__device__ __forceinline__ float bflo(unsigned w) { return __uint_as_float(w << 16); }
__device__ __forceinline__ float bfhi(unsigned w) { return __uint_as_float(w & 0xffff0000u); }
__device__ __forceinline__ void unpack8(const u32x4 w, float (&f)[8]) { f[0] = bflo(w.x); f[1] = bfhi(w.x); f[2] = bflo(w.y); f[3] = bfhi(w.y); f[4] = bflo(w.z); f[5] = bfhi(w.z); f[6] = bflo(w.w); f[7] = bfhi(w.w); }
__device__ __forceinline__ u32x4 pack8(const float (&f)[8]) { u32x4 w; w.x = cvt_pk_bf16(f[0], f[1]); w.y = cvt_pk_bf16(f[2], f[3]); w.z = cvt_pk_bf16(f[4], f[5]); w.w = cvt_pk_bf16(f[6], f[7]); return w; }
__device__ __forceinline__ float sat8(float x) { return __builtin_amdgcn_fmed3f(x, -448.0f, 448.0f); }
__device__ __forceinline__ int pk4_fp8(float a, float b, float c, float d) { int w = 0; w = __builtin_amdgcn_cvt_pk_fp8_f32(sat8(a), sat8(b), w, false); w = __builtin_amdgcn_cvt_pk_fp8_f32(sat8(c), sat8(d), w, true); return w; }
__device__ __forceinline__ u32x2 pack8_fp8(const float (&f)[8]) { int a = 0, b = 0;
    a = pk4_fp8(f[0], f[1], f[2], f[3]); b = pk4_fp8(f[4], f[5], f[6], f[7]); u32x2 w; w.x = (unsigned)a; w.y = (unsigned)b; return w; }
__device__ __forceinline__ float sigmoidf_(float x) { return __builtin_amdgcn_rcpf(1.0f + __builtin_amdgcn_exp2f(-1.4426950408889634f * x)); }
__device__ __forceinline__ float wave_sum(float v) {
#pragma unroll
    for (int o = 1; o < 64; o <<= 1) v += __shfl_xor(v, o);
    return v;
}
#define LDS_WAIT() asm volatile("s_waitcnt lgkmcnt(0)" ::: "memory")
#define VM_WAIT() asm volatile("s_waitcnt vmcnt(0)" ::: "memory")

#define XB_TMO      128
#define XB_XCNT(j)  (256  + 64 * (j))
#define XB_XSUB(j)  (1280 + 64 * (j))
#define XB_XGEN(j)  (2304 + 64 * (j))
#define XB_TOP      3328
#define XB_TOPGEN   3392
#define XCD_BAR_WORDS 3456
#define XB_SPIN_CAP (1u << 18)

__device__ __forceinline__ unsigned xb_ld(unsigned* p)              { return __hip_atomic_load(p, __ATOMIC_RELAXED, __HIP_MEMORY_SCOPE_AGENT); }
__device__ __forceinline__ unsigned xb_add(unsigned* p, unsigned v) { return __hip_atomic_fetch_add(p, v, __ATOMIC_RELAXED, __HIP_MEMORY_SCOPE_AGENT); }
__device__ __forceinline__ unsigned xb_xcc_id() { return (unsigned)__builtin_amdgcn_s_getreg((3 << 11) | 20) & 0xFu; }
#define XB_SPIN(cond, bar) do { unsigned _sp = 0; while (cond) { __builtin_amdgcn_s_sleep(1); \
    if ((++_sp & 255u) == 0u) { if (xb_ld(&(bar)[XB_TMO])) break; if (_sp > XB_SPIN_CAP) { atomicAdd(&(bar)[XB_TMO], 1u); break; } } } } while (0)

struct XcdBarrier { unsigned* bar; unsigned x; volatile LAS unsigned* st; };

__device__ __forceinline__ XcdBarrier xcd_barrier_post(unsigned* bar, volatile LAS unsigned* st) {
    XcdBarrier b; b.bar = bar; b.x = xb_xcc_id(); b.st = st;
    if (threadIdx.x == 0) (void)xb_add(&bar[XB_XCNT(b.x)], 1u);
    return b;
}
__device__ __forceinline__ void xcd_barrier_complete(unsigned* bar, unsigned x, unsigned& nloc, unsigned& nx) {
    const unsigned G = gridDim.x * gridDim.y * gridDim.z;
    unsigned sum, cnt, mine, sp = 0u;
    for (;;) {
        sum = 0u; cnt = 0u; mine = 0u;
#pragma unroll
        for (unsigned j = 0; j < 16; ++j) { const unsigned c = xb_ld(&bar[XB_XCNT(j)]); sum += c; cnt += (c > 0u) ? 1u : 0u; mine = (j == x) ? c : mine; }
        if (sum == G) break;
        __builtin_amdgcn_s_sleep(1);
        if ((++sp & 255u) == 0u) { if (xb_ld(&bar[XB_TMO])) break; if (sp > XB_SPIN_CAP) { atomicAdd(&bar[XB_TMO], 1u); break; } }
    }
    nloc = mine > 0u ? mine : 1u; nx = cnt > 0u ? cnt : 1u;
}
__device__ __forceinline__ void xcd_barrier(const XcdBarrier& b, int tid_) {
    asm volatile("s_waitcnt vmcnt(0)" ::: "memory");
    __syncthreads();
    if (tid_ == 0) {
        unsigned* bar = b.bar;
        __builtin_amdgcn_s_waitcnt(0);
        unsigned nloc = b.st[0], nx = b.st[1];
        if (nloc == 0u) { xcd_barrier_complete(bar, b.x, nloc, nx); b.st[0] = nloc; b.st[1] = nx; }
        const unsigned old = xb_add(&bar[XB_XSUB(b.x)], 1u);
        const unsigned gen = old / nloc;
        if (old + 1u == (gen + 1u) * nloc) {
            __builtin_amdgcn_fence(__ATOMIC_RELEASE, "agent");
            asm volatile("s_waitcnt vmcnt(0)" ::: "memory");
            const unsigned og = xb_add(&bar[XB_TOP], 1u);
            const unsigned tg = og / nx;
            if (og + 1u == (tg + 1u) * nx) xb_add(&bar[XB_TOPGEN], 1u);
            else XB_SPIN(xb_ld(&bar[XB_TOPGEN]) == tg, bar);
            __builtin_amdgcn_fence(__ATOMIC_ACQUIRE, "agent");
            xb_add(&bar[XB_XGEN(b.x)], 1u);
            asm volatile("s_waitcnt vmcnt(0)" ::: "memory");
        } else {
            XB_SPIN(xb_ld(&bar[XB_XGEN(b.x)]) == gen, bar);
            __builtin_amdgcn_fence(__ATOMIC_ACQUIRE, "agent");
            asm volatile("s_waitcnt vmcnt(0)" ::: "memory");
        }
    }
    __syncthreads();
}

namespace pg8 {
constexpr int BM = 256, BK = 64, HALF = 128, HTB = HALF * BK * 2, STAGE_BYTES = 8 * HTB, NXCD = 8, WGM = 8;
__host__ __device__ __forceinline__ int lds_byte(int r, int c) { const int st = (r >> 4) * 2 + (c >> 5), rr = r & 15, cc = c & 31, ob = rr * 64 + cc * 2; return st * 1024 + (ob ^ (((ob >> 9) & 1) << 5)); }
__host__ __device__ __forceinline__ void stage_rc(int b, int& R, int& C) { const int st = b / 1024, sb = b % 1024, swz = sb ^ (((sb >> 9) & 1) << 5); R = (st >> 1) * 16 + swz / 64; C = (st & 1) * 32 + (swz % 64) / 2; }
__host__ __device__ __forceinline__ int perm32(int rho) { const int n = rho >> 4, i = rho & 15; return 8 * (i >> 2) + 4 * n + (i & 3); }

struct Unit { int pm, pn, e, jl, cnt, koff; };
struct Gemm { const bf16_t* A; const bf16_t* Bt; int K; size_t bstride; const int* tokl; int ntov; };

struct StaticOrder {
    int nM, nN, nwg, G, c;
    __device__ void init(int M, int N, int G_, int c_) { nM = M / BM; nN = N / BM; nwg = nM * nN; G = G_; c = c_; }
    __device__ bool next(int i, Unit& u) const {
        const long L = (long)i * G + c; if (L >= nwg) return false;
        int wgid = (int)L; { const int q = nwg / NXCD, r = nwg % NXCD, xcd = wgid % NXCD, off = wgid / NXCD; wgid = (xcd < r ? xcd * (q + 1) : r * (q + 1) + (xcd - r) * q) + off; }
        const int nig = WGM * nN, gid = wgid / nig, fm = gid * WGM, gsz = (nM - fm) < WGM ? (nM - fm) : WGM;
        u.pm = fm + ((wgid % nig) % gsz); u.pn = (wgid % nig) / gsz; u.e = 0; u.jl = 0; u.cnt = 0; u.koff = 0; return true;
    }
};
struct DynOrder : StaticOrder {
    __device__ bool next(int i, Unit& u) const { if (!StaticOrder::next(i, u)) return false; u.koff = (u.pn < 8 ? 0 : (u.pn < 16 ? 128 : 256)) * 2; return true; }
};
struct MoeOrder {
    const LAS int* tb; const LAS int* cn; int G, c, ntot;
    __device__ bool next(int i, Unit& u) const {
        const long L = (long)i * G + c; if (L >= (long)ntot * 8) return false;
        const int mt = (int)(L >> 3); int e = 0;
#pragma unroll
        for (int k = 1; k < 16; ++k) e += (mt >= tb[k]) ? 1 : 0;
        e = __builtin_amdgcn_readfirstlane(e);
        u.koff = 0; u.pm = mt; u.pn = (int)(L & 7); u.e = e; u.jl = __builtin_amdgcn_readfirstlane(mt - tb[e]); u.cnt = __builtin_amdgcn_readfirstlane(cn[e]); return true;
    }
};

typedef int i32x8 __attribute__((ext_vector_type(8)));
typedef int i32x4_ __attribute__((ext_vector_type(4)));
template <class Epi, class Sched, bool GATHER, bool FP8 = false>
__device__ __forceinline__ void gemm_phase(LAS unsigned char* lds, const Gemm g, const Sched& S, const Epi& E, const int tid) {
    const int wid = __builtin_amdgcn_readfirstlane(tid >> 6), lane = tid & 63, wr = wid >> 2, wc = wid & 3, fr = lane & 15, fq = lane >> 4;
    const int K = FP8 ? (g.K >> 1) : g.K, nt = g.ntov ? g.ntov : K / BK;
    unsigned voffA[2], voffB[2]; int Rr[2], Cc[2];
#pragma unroll
    for (int i = 0; i < 2; ++i) { int R, C; stage_rc(tid * 16 + i * 8192, R, C); const int Rb = Epi::PERM ? ((R & ~31) + perm32(R & 31)) : R;
        voffA[i] = (unsigned)(R * K + C) * 2u; voffB[i] = (unsigned)(Rb * K + C) * 2u; Rr[i] = R; Cc[i] = C; }
    const size_t kstep = (size_t)(BK * 2);
    const size_t hstep = (size_t)HALF * K * 2;
    const size_t tstep = 2 * hstep;
    const unsigned ldsw = (unsigned)wid * 1024u;
    const int aoff = lds_byte(wr * 64 + fr, fq * 8), boff = lds_byte(wc * 32 + fr, fq * 8);
#define PG8_SA(b, h) (((b) * 2 + (h)) * HTB)
#define PG8_SB(b, h) ((4 + (b) * 2 + (h)) * HTB)
#define PG8_STAGE(bufoff, gbase, voff) do { _Pragma("unroll") for (int _i = 0; _i < 2; ++_i) \
        __builtin_amdgcn_global_load_lds((const unsigned*)((const char*)(gbase) + (voff)[_i]), (LAS unsigned*)(lds + (bufoff) + ldsw + _i * 8192), 16, 0, 0); } while (0)
#define PG8_LDA(dst, b, h) do { _Pragma("unroll") for (int m = 0; m < 4; ++m) _Pragma("unroll") for (int k = 0; k < 2; ++k) dst[m][k] = *(const LAS bf16x8*)(lds + PG8_SA(b, h) + aoff + m * 2048 + k * 1024); } while (0)
#define PG8_LDB(dst, b, h) do { _Pragma("unroll") for (int n = 0; n < 2; ++n) _Pragma("unroll") for (int k = 0; k < 2; ++k) dst[n][k] = *(const LAS bf16x8*)(lds + PG8_SB(b, h) + boff + n * 2048 + k * 1024); } while (0)
#define PG8_CAT(x) __builtin_shufflevector(__builtin_bit_cast(i32x4_, (x)[0]), __builtin_bit_cast(i32x4_, (x)[1]), 0, 1, 2, 3, 4, 5, 6, 7)
#define PG8_MMA(ai, bj, At, Bt) do { __builtin_amdgcn_s_setprio(1); \
        if constexpr (FP8) { _Pragma("unroll") for (int m = 0; m < 4; ++m) _Pragma("unroll") for (int n = 0; n < 2; ++n) \
            { const i32x8 b8_ = PG8_CAT(Bt[n]), a8_ = PG8_CAT(At[m]); \
              asm volatile("v_mfma_scale_f32_16x16x128_f8f6f4 %0, %1, %2, %0, %3, %3 op_sel_hi:[0,0,0]" : "+v"(acc[ai][bj][m][n]) : "v"(b8_), "v"(a8_), "v"(0x7F7F7F7F)); } } \
        else { _Pragma("unroll") for (int m = 0; m < 4; ++m) _Pragma("unroll") for (int n = 0; n < 2; ++n) _Pragma("unroll") for (int k = 0; k < 2; ++k) \
            acc[ai][bj][m][n] = __builtin_amdgcn_mfma_f32_16x16x32_bf16(Bt[n][k], At[m][k], acc[ai][bj][m][n], 0, 0, 0); } \
        __builtin_amdgcn_s_setprio(0); } while (0)
#define PG8_WAIT_V(n) asm volatile("s_waitcnt vmcnt(" #n ")" ::: "memory")
#define PG8_WAIT_L(n) asm volatile("s_waitcnt lgkmcnt(" #n ")" ::: "memory")
#define PG8_BAR __builtin_amdgcn_s_barrier()
#define PG8_SCHED __builtin_amdgcn_sched_barrier(0)
#define PG8_GOFF(dst, u) do { _Pragma("unroll") for (int _h = 0; _h < 2; ++_h) _Pragma("unroll") for (int _i = 0; _i < 2; ++_i) { \
        const int _slot = (u).jl * 256 + _h * 128 + Rr[_i]; const int _tok = (_slot < (u).cnt) ? g.tokl[(u).e * TOKCAP + _slot] : 0; dst[_h][_i] = (unsigned)(_tok * K + Cc[_i]) * 2u; } } while (0)
    Unit cur, nxt; int ui = 0;
    if (!S.next(0, cur)) return;
    f32x4 acc[2][2][4][2];
#pragma unroll
    for (int a = 0; a < 2; ++a)
#pragma unroll
        for (int b = 0; b < 2; ++b)
#pragma unroll
            for (int m = 0; m < 4; ++m)
#pragma unroll
                for (int n = 0; n < 2; ++n) acc[a][b][m][n] = (f32x4){0.f, 0.f, 0.f, 0.f};
    bf16x8 At[4][2], B0[2][2], B1[2][2];
    const char* Ab = (const char*)g.A;
    const char* cA = Ab + (size_t)cur.pm * tstep + cur.koff; const char* cB = (const char*)g.Bt + (size_t)cur.e * g.bstride + (size_t)cur.pn * tstep + cur.koff;
    unsigned offc[2][2], offn[2][2];
    if constexpr (GATHER) { PG8_GOFF(offc, cur); }
#define PG8_STA_C(bufoff, h, kb) do { if constexpr (GATHER) { PG8_STAGE(bufoff, Ab + (kb), offc[h]); } else { PG8_STAGE(bufoff, cA + (h) * hstep + (kb), voffA); } } while (0)
    PG8_STAGE(PG8_SB(0, 0), cB, voffB); PG8_STAGE(PG8_SB(0, 1), cB + hstep, voffB); PG8_STA_C(PG8_SA(0, 0), 0, 0); PG8_STA_C(PG8_SA(0, 1), 1, 0);
    if (wr == 1) PG8_BAR;
    PG8_WAIT_V(2); PG8_BAR;
    PG8_STAGE(PG8_SB(1, 0), cB + kstep, voffB); PG8_STA_C(PG8_SA(1, 0), 0, kstep); PG8_STAGE(PG8_SB(1, 1), cB + hstep + kstep, voffB);
    PG8_WAIT_V(6); PG8_BAR;
    for (;;) {
        const bool has_next = S.next(ui + 1, nxt);
        const char* nA = has_next ? Ab + (size_t)nxt.pm * tstep + nxt.koff : cA; const char* nB = has_next ? (const char*)g.Bt + (size_t)nxt.e * g.bstride + (size_t)nxt.pn * tstep + nxt.koff : cB;
        if constexpr (GATHER) {
            if (has_next) { PG8_GOFF(offn, nxt); }
            else {
#pragma unroll
                for (int h = 0; h < 2; ++h)
#pragma unroll
                    for (int i = 0; i < 2; ++i) offn[h][i] = offc[h][i]; }
        }
        for (int t = 0; t < nt; t += 2) {
            const bool last = (t == nt - 2);
            const size_t kb1 = (size_t)(t + 1) * kstep;
            const char* b2 = last ? nB : cB + (size_t)(t + 2) * kstep; const char* b3 = b2 + kstep;
            const char* a2 = last ? nA : cA + (size_t)(t + 2) * kstep; const char* a3 = a2 + kstep;
            unsigned o2[2][2]; size_t kb2 = last ? 0 : (size_t)(t + 2) * kstep;
            if constexpr (GATHER) {
#pragma unroll
                for (int h = 0; h < 2; ++h)
#pragma unroll
                    for (int i = 0; i < 2; ++i) o2[h][i] = last ? offn[h][i] : offc[h][i];
            }
#define PG8_STA_2(bufoff, h, extra) do { if constexpr (GATHER) { PG8_STAGE(bufoff, Ab + kb2 + (extra), o2[h]); } else { PG8_STAGE(bufoff, a2 + (h) * hstep + (extra), voffA); } } while (0)
            PG8_LDB(B0, 0, 0); PG8_LDB(B1, 0, 1); PG8_SCHED; PG8_LDA(At, 0, 0); PG8_STA_C(PG8_SA(1, 1), 1, kb1);
            PG8_WAIT_V(8); PG8_WAIT_L(0); PG8_BAR; PG8_MMA(0, 0, At, B0); PG8_MMA(0, 1, At, B1); PG8_BAR; PG8_SCHED;
            PG8_LDA(At, 0, 1); PG8_STAGE(PG8_SB(0, 0), b2, voffB); PG8_STAGE(PG8_SB(0, 1), b2 + hstep, voffB); PG8_STA_2(PG8_SA(0, 0), 0, 0);
            PG8_WAIT_V(8); PG8_WAIT_L(0); PG8_BAR; PG8_MMA(1, 0, At, B0); PG8_MMA(1, 1, At, B1); PG8_BAR; PG8_SCHED;
            PG8_LDB(B0, 1, 0); PG8_LDB(B1, 1, 1); PG8_SCHED; PG8_LDA(At, 1, 0); PG8_STA_2(PG8_SA(0, 1), 1, 0);
            PG8_WAIT_V(8); PG8_WAIT_L(0); PG8_BAR; PG8_MMA(0, 0, At, B0); PG8_MMA(0, 1, At, B1); PG8_BAR; PG8_SCHED;
            PG8_LDA(At, 1, 1); PG8_STAGE(PG8_SB(1, 0), b3, voffB); PG8_STAGE(PG8_SB(1, 1), b3 + hstep, voffB); PG8_STA_2(PG8_SA(1, 0), 0, kstep);
            PG8_WAIT_V(8); PG8_WAIT_L(0); PG8_BAR; PG8_MMA(1, 0, At, B0); PG8_MMA(1, 1, At, B1); PG8_BAR; PG8_SCHED;
#undef PG8_STA_2
            (void)a3;
        }
        if (wr == 0) PG8_BAR;
        { int l2 = lane; asm volatile("" : "+v"(l2)); E(acc, cur, wr, wc, l2 & 15, l2 >> 4); }
        if (!has_next) break;
#pragma unroll
        for (int a = 0; a < 2; ++a)
#pragma unroll
            for (int b = 0; b < 2; ++b)
#pragma unroll
                for (int m = 0; m < 4; ++m)
#pragma unroll
                    for (int n = 0; n < 2; ++n) acc[a][b][m][n] = (f32x4){0.f, 0.f, 0.f, 0.f};
        cur = nxt; cA = nA; cB = nB; ++ui;
        if constexpr (GATHER) {
#pragma unroll
            for (int h = 0; h < 2; ++h)
#pragma unroll
                for (int i = 0; i < 2; ++i) offc[h][i] = offn[h][i];
        }
        if (wr == 1) PG8_BAR;
    }
    PG8_WAIT_V(0);
    PG8_BAR;
#undef PG8_STA_C
#undef PG8_GOFF
#undef PG8_SA
#undef PG8_SB
#undef PG8_STAGE
#undef PG8_LDA
#undef PG8_LDB
#undef PG8_MMA
#undef PG8_CAT
#undef PG8_WAIT_V
#undef PG8_WAIT_L
#undef PG8_BAR
#undef PG8_SCHED
}

struct EpiProj {
    static constexpr bool PERM = true;
    bf16_t* O; const float* rope; float inv;
    __device__ __forceinline__ void operator()(const f32x4 (&acc)[2][2][4][2], const Unit& u, int wr, int wc, int fr, int fq) const {
        const int row0 = u.pm * BM + wr * 64 + fr, col0 = u.pn * BM + wc * 32 + 8 * fq;
        const bool dorope = (u.pn < 8) && ((wc & 1) == 0) && (fq < 2);
        const float sc = ((u.pn < 4) ? C2 : 1.0f) * inv;
#pragma unroll
        for (int ai = 0; ai < 2; ++ai)
#pragma unroll
            for (int m = 0; m < 4; ++m) {
                const int row = row0 + ai * HALF + m * 16;
                bf16_t* rowp = O + (size_t)row * NPROJP + col0;
                f32x4 cs = (f32x4){1.f, 1.f, 1.f, 1.f}, sn = (f32x4){0.f, 0.f, 0.f, 0.f};
                if (dorope) { cs = *(const f32x4*)(rope + (size_t)row * 16 + 4 * fq); sn = *(const f32x4*)(rope + (size_t)row * 16 + 8 + 4 * fq); }
#pragma unroll
                for (int bj = 0; bj < 2; ++bj) {
                    f32x4 v0 = acc[ai][bj][m][0], v1 = acc[ai][bj][m][1];
                    const f32x4 r0 = (v0 * cs - v1 * sn) * sc, r1 = (v1 * cs + v0 * sn) * sc;
                    u32x4 w; w.x = cvt_pk_bf16(r0[0], r0[1]); w.y = cvt_pk_bf16(r0[2], r0[3]); w.z = cvt_pk_bf16(r1[0], r1[1]); w.w = cvt_pk_bf16(r1[2], r1[3]);
                    *(u32x4*)(rowp + bj * HALF) = w; }
            }
    }
};
struct EpiDyn {
    static constexpr bool PERM = true;
    bf16_t* O; const float* w0; const float* a0;
    __device__ __forceinline__ void operator()(const f32x4 (&acc)[2][2][4][2], const Unit& u, int wr, int wc, int fr, int fq) const {
        const int row0 = u.pm * BM + wr * 64 + fr, col0 = u.pn * BM + wc * 32 + 8 * fq;
        const int kind = u.pn >> 3;
        const float* bsrc = (kind == 0) ? (w0 + col0) : (a0 + (col0 - 2048));
#pragma unroll
        for (int bj = 0; bj < 2; ++bj) {
            f32x4 b0 = (f32x4){0.f, 0.f, 0.f, 0.f}, b1 = b0;
            if (kind < 2) { b0 = *(const f32x4*)(bsrc + bj * HALF); b1 = *(const f32x4*)(bsrc + bj * HALF + 4); }
#pragma unroll
            for (int ai = 0; ai < 2; ++ai)
#pragma unroll
                for (int m = 0; m < 4; ++m) {
                    f32x4 v0 = acc[ai][bj][m][0] + b0, v1 = acc[ai][bj][m][1] + b1;
                    if (kind < 2) {
#pragma unroll
                        for (int j = 0; j < 4; ++j) { float s0 = sigmoidf_(v0[j]), s1 = sigmoidf_(v1[j]);
                            if (kind == 0) { s0 = __builtin_amdgcn_exp2f(-0.875039f * s0); s1 = __builtin_amdgcn_exp2f(-0.875039f * s1); }
                            v0[j] = s0; v1[j] = s1; } }
                    u32x4 w; w.x = cvt_pk_bf16(v0[0], v0[1]); w.y = cvt_pk_bf16(v0[2], v0[3]); w.z = cvt_pk_bf16(v1[0], v1[1]); w.w = cvt_pk_bf16(v1[2], v1[3]);
                    *(u32x4*)(O + (size_t)(row0 + ai * HALF + m * 16) * NDYN + col0 + bj * HALF) = w;
                    __builtin_amdgcn_sched_barrier(0); }
        }
    }
};
struct EpiRes {
    static constexpr bool PERM = true;
    const float* xin32; bf16_t* X; const float* g1; float inv;
    __device__ __forceinline__ void operator()(const f32x4 (&acc)[2][2][4][2], const Unit& u, int wr, int wc, int fr, int fq) const {
        const int row0 = u.pm * BM + wr * 64 + fr, col0 = u.pn * BM + wc * 32 + 8 * fq;
        const int b = (u.pm * BM) / SEQ;
        f32x4 gv[2][2];
#pragma unroll
        for (int bj = 0; bj < 2; ++bj)
#pragma unroll
            for (int n = 0; n < 2; ++n) gv[bj][n] = *(const f32x4*)(g1 + (size_t)b * NMOD + col0 + bj * HALF + 4 * n) * inv;
#pragma unroll
        for (int ai = 0; ai < 2; ++ai)
#pragma unroll
            for (int m = 0; m < 4; ++m) { const size_t off = (size_t)(row0 + ai * HALF + m * 16) * DM + col0;
#pragma unroll
                for (int bj = 0; bj < 2; ++bj) { f32x4 x0, x1;
                    if (xin32) { x0 = *(const f32x4*)(xin32 + off + bj * HALF); x1 = *(const f32x4*)(xin32 + off + bj * HALF + 4); }
                    else { const u32x4 p = *(const u32x4*)(X + off + bj * HALF); x0 = (f32x4){bflo(p.x), bfhi(p.x), bflo(p.y), bfhi(p.y)}; x1 = (f32x4){bflo(p.z), bfhi(p.z), bflo(p.w), bfhi(p.w)}; }
                    const f32x4 r0 = x0 + gv[bj][0] * acc[ai][bj][m][0], r1 = x1 + gv[bj][1] * acc[ai][bj][m][1];
                    u32x4 w; w.x = cvt_pk_bf16(r0[0], r0[1]); w.y = cvt_pk_bf16(r0[2], r0[3]); w.z = cvt_pk_bf16(r1[0], r1[1]); w.w = cvt_pk_bf16(r1[2], r1[3]);
                    *(u32x4*)(X + off + bj * HALF) = w; } }
    }
};
struct EpiGlu {
    static constexpr bool PERM = true;
    unsigned char* O; float inv;
    __device__ __forceinline__ void operator()(const f32x4 (&acc)[2][2][4][2], const Unit& u, int wr, int wc, int fr, int fq) const {
        const int row0 = u.pm * BM + wr * 64 + fr, j0 = u.pn * 128 + wc * 16 + 4 * fq;
#pragma unroll
        for (int ai = 0; ai < 2; ++ai)
#pragma unroll
            for (int m = 0; m < 4; ++m) { unsigned char* rowp = O + (size_t)(row0 + ai * HALF + m * 16) * DFF + j0;
#pragma unroll
                for (int bj = 0; bj < 2; ++bj) { const f32x4 gt = acc[ai][bj][m][0] * inv, up = acc[ai][bj][m][1] * inv; f32x4 r;
#pragma unroll
                    for (int j = 0; j < 4; ++j) r[j] = gt[j] * sigmoidf_(gt[j]) * up[j];
                    *(int*)(rowp + bj * 64) = pk4_fp8(r[0], r[1], r[2], r[3]); } }
    }
};
struct EpiY {
    static constexpr bool PERM = true;
    unsigned char* O; float inv;
    __device__ __forceinline__ void operator()(const f32x4 (&acc)[2][2][4][2], const Unit& u, int wr, int wc, int fr, int fq) const {
        const int row0 = u.pm * BM + wr * 64 + fr, col0 = u.pn * BM + wc * 32 + 8 * fq;
#pragma unroll
        for (int ai = 0; ai < 2; ++ai)
#pragma unroll
            for (int m = 0; m < 4; ++m) { unsigned char* rowp = O + (size_t)(row0 + ai * HALF + m * 16) * DM + col0;
#pragma unroll
                for (int bj = 0; bj < 2; ++bj) { const f32x4 v0 = acc[ai][bj][m][0] * inv, v1 = acc[ai][bj][m][1] * inv;
                    u32x2 w; w.x = (unsigned)pk4_fp8(v0[0], v0[1], v0[2], v0[3]); w.y = (unsigned)pk4_fp8(v1[0], v1[1], v1[2], v1[3]);
                    *(u32x2*)(rowp + bj * HALF) = w; } }
    }
};
}

namespace attn {
constexpr int KVBLK = 64;
constexpr size_t SHM_V = KVBLK * 128 * 2, SHM_K = KVBLK * 128 * 2;
constexpr int WS_OFF = 3 * SHM_V + 3 * SHM_K;
constexpr float THRL = 8.0f;
#define KSWZ(row, colB) ((row) * 256 + ((colB) ^ (((row) & 7) << 4)))
#define SBAR() __builtin_amdgcn_sched_barrier(0)
__device__ __forceinline__ int crow(int r, int hi) { return (r & 3) + 8 * (r >> 2) + 4 * hi; }

__device__ __forceinline__ void partialSM(f32x16& p0, f32x16& p1, float& m_reg, float& mn, float& alpha) {
    float pmax = p0[0];
#pragma unroll
    for (int r = 1; r < 16; ++r) pmax = fmaxf(pmax, p0[r]);
#pragma unroll
    for (int r = 0; r < 16; ++r) pmax = fmaxf(pmax, p1[r]);
    { auto rr = __builtin_amdgcn_permlane32_swap(__float_as_uint(pmax), __float_as_uint(pmax), false, false);
      pmax = fmaxf(__uint_as_float(rr[0]), __uint_as_float(rr[1])); }
    if (__builtin_expect(__all(pmax - m_reg <= THRL), 1)) { mn = m_reg; alpha = 1.f; }
    else { mn = fmaxf(m_reg, pmax); alpha = __builtin_amdgcn_exp2f(m_reg - mn); m_reg = mn; }
#pragma unroll
    for (int r = 0; r < 16; ++r) p0[r] = p0[r] - mn;
#pragma unroll
    for (int r = 0; r < 16; ++r) p1[r] = p1[r] - mn;
#pragma unroll
    for (int r = 0; r < 16; ++r) p0[r] = __builtin_amdgcn_exp2f(p0[r]);
}
__device__ __forceinline__ void finishSM(f32x16& p0, f32x16& p1, float alpha, float& l_reg, bf16x8& pa0, bf16x8& pa1, bf16x8& pa2, bf16x8& pa3) {
#pragma unroll
    for (int r = 0; r < 16; ++r) p1[r] = __builtin_amdgcn_exp2f(p1[r]);
    float ps = 0;
#pragma unroll
    for (int r = 0; r < 16; ++r) ps += p0[r];
#pragma unroll
    for (int r = 0; r < 16; ++r) ps += p1[r];
    { auto rr = __builtin_amdgcn_permlane32_swap(__float_as_uint(ps), __float_as_uint(ps), false, false);
      ps = __uint_as_float(rr[0]) + __uint_as_float(rr[1]); }
    l_reg = l_reg * alpha + ps;
#define PK4(P, BASE, OUT) do { u32x4 w = {cvt_pk_bf16(P[BASE + 0], P[BASE + 1]), cvt_pk_bf16(P[BASE + 2], P[BASE + 3]), cvt_pk_bf16(P[BASE + 4], P[BASE + 5]), cvt_pk_bf16(P[BASE + 6], P[BASE + 7])}; \
    OUT = *reinterpret_cast<bf16x8*>(&w); } while (0)
    PK4(p0, 0, pa0); PK4(p0, 8, pa1); PK4(p1, 0, pa2); PK4(p1, 8, pa3);
#undef PK4
}
__device__ __forceinline__ void qkt(f32x16& p0, f32x16& p1, const char* Ks, const bf16x8* qr, int r32, int hi, int comp) {
    p0 = f32x16{}; p1 = f32x16{};
#pragma unroll
    for (int d0 = 0; d0 < 4; ++d0) { const int cb = ((comp * 4 + d0) * 16 + hi * 8) * 2;
        bf16x8 b0 = *reinterpret_cast<const bf16x8*>(Ks + KSWZ(r32, cb));
        bf16x8 b1 = *reinterpret_cast<const bf16x8*>(Ks + KSWZ(32 + r32, cb));
        p0 = __builtin_amdgcn_mfma_f32_32x32x16_bf16(b0, qr[d0], p0, 0, 0, 0);
        p1 = __builtin_amdgcn_mfma_f32_32x32x16_bf16(b1, qr[d0], p1, 0, 0, 0); }
}
__device__ __forceinline__ void qk_sm(f32x16& n0, f32x16& n1, const char* Ks, const bf16x8* qr, int r32, int hi, int comp,
                                      f32x16& p0, f32x16& p1, float alpha, float& l_reg, bf16x8& pa0, bf16x8& pa1, bf16x8& pa2, bf16x8& pa3) {
#define LDKF(D0, R) *reinterpret_cast<const bf16x8*>(Ks + KSWZ((R), ((comp * 4 + (D0)) * 16 + hi * 8) * 2))
#define EX2(P, B) P[B] = __builtin_amdgcn_exp2f(P[B]); P[B + 1] = __builtin_amdgcn_exp2f(P[B + 1]); asm volatile("" : "+v"(P[B]), "+v"(P[B + 1]))
#define QMF(N, KF, D0) SBAR(); N = __builtin_amdgcn_mfma_f32_32x32x16_bf16(KF, qr[D0], N, 0, 0, 0); SBAR()
    SBAR();
    const bf16x8 k00 = LDKF(0, r32), k01 = LDKF(0, 32 + r32), k10 = LDKF(1, r32), k11 = LDKF(1, 32 + r32);
    SBAR();
    EX2(p1, 0); EX2(p1, 2); EX2(p1, 4); EX2(p1, 6);
    SBAR(); n0 = __builtin_amdgcn_mfma_f32_32x32x16_bf16(k00, qr[0], f32x16{}, 0, 0, 0); SBAR();
    EX2(p1, 8);
    SBAR(); n1 = __builtin_amdgcn_mfma_f32_32x32x16_bf16(k01, qr[0], f32x16{}, 0, 0, 0); SBAR();
    EX2(p1, 10);
    const bf16x8 k20 = LDKF(2, r32), k21 = LDKF(2, 32 + r32);
    QMF(n0, k10, 1); EX2(p1, 12);
    QMF(n1, k11, 1); EX2(p1, 14);
    const bf16x8 k30 = LDKF(3, r32), k31 = LDKF(3, 32 + r32);
    QMF(n0, k20, 2);
    float s0 = p0[0] + p0[1], s1 = p0[2] + p0[3]; s0 += p0[4]; s1 += p0[5]; s0 += p0[6]; s1 += p0[7]; s0 += p0[8]; s1 += p0[9];
    QMF(n1, k21, 2);
    s0 += p0[10]; s1 += p0[11]; s0 += p0[12]; s1 += p0[13]; s0 += p0[14]; s1 += p0[15]; s0 += p1[0]; s1 += p1[1];
    QMF(n0, k30, 3);
    s0 += p1[2]; s1 += p1[3]; s0 += p1[4]; s1 += p1[5]; s0 += p1[6]; s1 += p1[7]; s0 += p1[8]; s1 += p1[9];
    QMF(n1, k31, 3);
    s0 += p1[10]; s1 += p1[11]; s0 += p1[12]; s1 += p1[13]; s0 += p1[14]; s1 += p1[15]; float ps = s0 + s1;
    { auto rr = __builtin_amdgcn_permlane32_swap(__float_as_uint(ps), __float_as_uint(ps), false, false);
      ps = __uint_as_float(rr[0]) + __uint_as_float(rr[1]); }
    l_reg = l_reg * alpha + ps;
#define PK4(P, BASE, OUT) do { u32x4 w = {cvt_pk_bf16(P[BASE + 0], P[BASE + 1]), cvt_pk_bf16(P[BASE + 2], P[BASE + 3]), cvt_pk_bf16(P[BASE + 4], P[BASE + 5]), cvt_pk_bf16(P[BASE + 6], P[BASE + 7])}; \
    OUT = *reinterpret_cast<bf16x8*>(&w); } while (0)
    PK4(p0, 0, pa0); PK4(p0, 8, pa1); PK4(p1, 0, pa2); PK4(p1, 8, pa3);
    SBAR();
#undef PK4
#undef LDKF
#undef EX2
#undef QMF
}
__device__ __forceinline__ int v_st(int k, int c) { const int kk = k; return ((kk >> 3) * 4 + (c >> 5)) * 512 + ((kk & 7) * 32 + (c & 31)) * 2; }
__device__ __forceinline__ int v_rd_base(int lane) { return ((lane & 3) << 3) | (((lane >> 2) & 3) << 6) | (((lane >> 4) & 1) << 5) | (((lane >> 5) & 1) << 8); }
constexpr int v_rd_off(int d0, int ks, int half) { return d0 * 512 + ks * 4096 + half * 2048; }
template <int OFF> __device__ __forceinline__ s16x4 tr_read(int vb) {
    s16x4 r; asm volatile("ds_read_b64_tr_b16 %0, %1 offset:%2" : "=&v"(r) : "v"(vb), "i"(OFF) : "memory"); return r;
}
template <int D0> __device__ __forceinline__ void pv_one(f32x16& od, int vb, bf16x8 pa0, bf16x8 pa1, bf16x8 pa2, bf16x8 pa3) {
    const s16x4 l0 = tr_read<v_rd_off(D0, 0, 0)>(vb), h0 = tr_read<v_rd_off(D0, 0, 1)>(vb), l1 = tr_read<v_rd_off(D0, 1, 0)>(vb), h1 = tr_read<v_rd_off(D0, 1, 1)>(vb);
    const s16x4 l2 = tr_read<v_rd_off(D0, 2, 0)>(vb), h2 = tr_read<v_rd_off(D0, 2, 1)>(vb), l3 = tr_read<v_rd_off(D0, 3, 0)>(vb), h3 = tr_read<v_rd_off(D0, 3, 1)>(vb);
    asm volatile("s_waitcnt lgkmcnt(0)" ::: "memory"); SBAR();
#define PK(L, H) (bf16x8){L[0], L[1], L[2], L[3], H[0], H[1], H[2], H[3]}
    od = __builtin_amdgcn_mfma_f32_32x32x16_bf16(pa0, PK(l0, h0), od, 0, 0, 0);
    od = __builtin_amdgcn_mfma_f32_32x32x16_bf16(pa1, PK(l1, h1), od, 0, 0, 0);
    od = __builtin_amdgcn_mfma_f32_32x32x16_bf16(pa2, PK(l2, h2), od, 0, 0, 0);
    od = __builtin_amdgcn_mfma_f32_32x32x16_bf16(pa3, PK(l3, h3), od, 0, 0, 0);
#undef PK
}
__device__ __forceinline__ void pv_d0(f32x16* o, int vb, bf16x8 pa0, bf16x8 pa1, bf16x8 pa2, bf16x8 pa3) {
    pv_one<0>(o[0], vb, pa0, pa1, pa2, pa3); pv_one<1>(o[1], vb, pa0, pa1, pa2, pa3); pv_one<2>(o[2], vb, pa0, pa1, pa2, pa3); pv_one<3>(o[3], vb, pa0, pa1, pa2, pa3);
}
template <class Mid> __device__ __forceinline__ void pv_sm(f32x16* o, int vb, bf16x8 pa0, bf16x8 pa1, bf16x8 pa2, bf16x8 pa3, f32x16& p0, f32x16& p1, float& m_reg, float& mn, float& alpha, Mid mid) {
#define TRD(D0, KS, H) tr_read<v_rd_off(D0, KS, H)>(vb)
#define PKV(L, H) (bf16x8){L[0], L[1], L[2], L[3], H[0], H[1], H[2], H[3]}
#define MF(D0, PA, L, H) SBAR(); o[D0] = __builtin_amdgcn_mfma_f32_32x32x16_bf16(PA, PKV(L, H), o[D0], 0, 0, 0); SBAR()
#define WAITL(n) asm volatile("s_waitcnt lgkmcnt(" #n ")" ::: "memory")
#define MX3(a, b, c) fmaxf(fmaxf(a, b), c)
#define SUB8(P, B) P[B] -= mn; P[B + 1] -= mn; P[B + 2] -= mn; P[B + 3] -= mn; P[B + 4] -= mn; P[B + 5] -= mn; P[B + 6] -= mn; P[B + 7] -= mn; \
    asm volatile("" : "+v"(P[B]), "+v"(P[B + 1]), "+v"(P[B + 2]), "+v"(P[B + 3]), "+v"(P[B + 4]), "+v"(P[B + 5]), "+v"(P[B + 6]), "+v"(P[B + 7]))
#define EX2(P, B) P[B] = __builtin_amdgcn_exp2f(P[B]); P[B + 1] = __builtin_amdgcn_exp2f(P[B + 1]); asm volatile("" : "+v"(P[B]), "+v"(P[B + 1]))
    s16x4 x0, x1, x2, x3, y0, y1, y2, y3, z0, z1, z2, z3, w0, w1, w2, w3;
#define RD4(P, I) P##0 = TRD(((I) & 1) * 2, (I) >> 1, 0); P##1 = TRD(((I) & 1) * 2, (I) >> 1, 1); P##2 = TRD(((I) & 1) * 2 + 1, (I) >> 1, 0); P##3 = TRD(((I) & 1) * 2 + 1, (I) >> 1, 1)
    RD4(x, 0); RD4(y, 1); RD4(z, 2); RD4(w, 3); WAITL(12);
    MF(0, pa0, x0, x1);
    float t0 = MX3(p0[0], p0[1], p0[2]), t1 = MX3(p0[8], p0[9], p0[10]), t2 = MX3(p1[0], p1[1], p1[2]), t3 = MX3(p1[8], p1[9], p1[10]);
    t0 = MX3(t0, p0[3], p0[4]); t1 = MX3(t1, p0[11], p0[12]); t2 = MX3(t2, p1[3], p1[4]); t3 = MX3(t3, p1[11], p1[12]);
    MF(1, pa0, x2, x3);
    t0 = MX3(t0, p0[5], p0[6]); t1 = MX3(t1, p0[13], p0[14]); t2 = MX3(t2, p1[5], p1[6]); t3 = MX3(t3, p1[13], p1[14]);
    t0 = MX3(t0, p0[7], p0[15]); t2 = MX3(t2, p1[7], p1[15]); t0 = MX3(t0, t1, t2); float pmax = fmaxf(t0, t3);
    SBAR(); RD4(x, 4); WAITL(12);
    MF(2, pa0, y0, y1);
    { auto rr = __builtin_amdgcn_permlane32_swap(__float_as_uint(pmax), __float_as_uint(pmax), false, false);
      pmax = fmaxf(__uint_as_float(rr[0]), __uint_as_float(rr[1])); }
    { const bool ok = __all(pmax - m_reg <= THRL); const float mnew = fmaxf(m_reg, pmax); mn = ok ? m_reg : mnew; alpha = __builtin_amdgcn_exp2f(m_reg - mn); m_reg = mn; }
    MF(3, pa0, y2, y3);
    SBAR(); RD4(y, 5); WAITL(12);
    MF(0, pa1, z0, z1); SUB8(p0, 0);
    MF(1, pa1, z2, z3); SUB8(p0, 8);
    SBAR(); RD4(z, 6); WAITL(12);
    MF(2, pa1, w0, w1); SUB8(p1, 0);
    MF(3, pa1, w2, w3); SUB8(p1, 8);
    SBAR(); mid();
    SBAR(); RD4(w, 7); WAITL(12);
    MF(0, pa2, x0, x1); EX2(p0, 0);
    MF(1, pa2, x2, x3); EX2(p0, 2);
    SBAR(); WAITL(8);
    MF(2, pa2, y0, y1); EX2(p0, 4);
    MF(3, pa2, y2, y3); EX2(p0, 6);
    SBAR(); WAITL(4);
    MF(0, pa3, z0, z1); EX2(p0, 8);
    MF(1, pa3, z2, z3); EX2(p0, 10);
    SBAR(); WAITL(0);
    MF(2, pa3, w0, w1); EX2(p0, 12);
    MF(3, pa3, w2, w3); EX2(p0, 14);
    SBAR();
#undef RD4
#undef TRD
#undef PKV
#undef MF
#undef WAITL
#undef MX3
#undef SUB8
#undef EX2
}

__device__ __forceinline__ void attn_unit(const bf16_t* __restrict__ Qb, const bf16_t* __restrict__ Kh, const bf16_t* __restrict__ Vh, bf16_t* __restrict__ Ob,
                                          float lam, float outscale, const float* __restrict__ sub_gain, char* lds, const int tid) {
    constexpr int LDK = NPROJP, seq = SEQ;
    const int wid = tid >> 6, lane = tid & 63, r32 = lane & 31, hi = lane >> 5;
    const int comp = wid & 1, rb = wid >> 1;
    char* V_lds = lds; char* K_lds = lds + 3 * SHM_V;
    float* ws = (float*)(lds + WS_OFF) + wid * 64; float* li_l = ws; float* al_l = ws + 32;
    float m_reg = -1e30f, l_reg = 0; f32x16 o[4] = {}; bf16x8 qr[4];
    const bf16_t* Qw = Qb + (size_t)(rb * 32 + r32) * LDK + comp * 64 + hi * 8;
#pragma unroll
    for (int d0 = 0; d0 < 4; ++d0) qr[d0] = *reinterpret_cast<const bf16x8*>(Qw + d0 * 16);
    const int sr = tid >> 4, sc = (tid & 15) * 8, vst0 = v_st(sr, sc), vst1 = v_st(32 + sr, sc);
    const int vb0 = (int)(uintptr_t)V_lds + v_rd_base(lane);
    bf16x8 vsA0, vsA1, ksA0, ksA1;
#define SLOAD(S, k0) do { vs##S##0 = *reinterpret_cast<const bf16x8*>(&Vh[(size_t)((k0) + sr) * LDK + sc]); vs##S##1 = *reinterpret_cast<const bf16x8*>(&Vh[(size_t)((k0) + 32 + sr) * LDK + sc]); \
    ks##S##0 = *reinterpret_cast<const bf16x8*>(&Kh[(size_t)((k0) + sr) * LDK + sc]); ks##S##1 = *reinterpret_cast<const bf16x8*>(&Kh[(size_t)((k0) + 32 + sr) * LDK + sc]); } while (0)
#define SWRITE(b, S) do { *(bf16x8*)(V_lds + (b) * SHM_V + vst0) = vs##S##0; *(bf16x8*)(V_lds + (b) * SHM_V + vst1) = vs##S##1; const int kc = sc * 2; \
    *(bf16x8*)(K_lds + (b) * SHM_K + KSWZ(sr, kc)) = ks##S##0; *(bf16x8*)(K_lds + (b) * SHM_K + KSWZ(32 + sr, kc)) = ks##S##1; } while (0)
#define SWAIT() asm volatile("s_waitcnt vmcnt(4)" ::: "memory")
#define RESC(a) do { if (__any((a) < 1.f)) { if (hi == 0) al_l[r32] = (a); asm volatile("s_waitcnt lgkmcnt(0)" ::: "memory"); \
    _Pragma("unroll") for (int d = 0; d < 4; ++d) _Pragma("unroll") for (int r = 0; r < 16; ++r) o[d][r] *= al_l[crow(r, hi)]; } } while (0)
    f32x16 pA0, pA1, pB0, pB1; float mnA, mnB, alA, alB; bf16x8 pa0, pa1, pa2, pa3; const int NT = seq / KVBLK;
#define SW0() asm volatile("s_waitcnt vmcnt(0)" ::: "memory")
    SLOAD(A, 0); SW0(); SWRITE(0, A); SLOAD(A, KVBLK); __syncthreads();
    qkt(pA0, pA1, K_lds, qr, r32, hi, comp); partialSM(pA0, pA1, m_reg, mnA, alA);
    SW0(); SWRITE(1, A); SLOAD(A, 2 * KVBLK); __syncthreads();
    int bj = 1;
    for (int j = 1; j + 1 < NT; j += 2) {
        const int bjm1 = (bj == 0) ? 2 : bj - 1, bjp1 = (bj == 2) ? 0 : bj + 1;
        qk_sm(pB0, pB1, K_lds + bj * SHM_K, qr, r32, hi, comp, pA0, pA1, alA, l_reg, pa0, pa1, pa2, pa3);
        pv_sm(o, vb0 + bjm1 * (int)SHM_V, pa0, pa1, pa2, pa3, pB0, pB1, m_reg, mnB, alB, [&] { SW0(); SWRITE(bjp1, A); SLOAD(A, (j + 2) * KVBLK); });
        RESC(alB); __syncthreads();
        qk_sm(pA0, pA1, K_lds + bjp1 * SHM_K, qr, r32, hi, comp, pB0, pB1, alB, l_reg, pa0, pa1, pa2, pa3);
        pv_sm(o, vb0 + bj * (int)SHM_V, pa0, pa1, pa2, pa3, pA0, pA1, m_reg, mnA, alA, [&] { SW0(); SWRITE(bjm1, A); if (j + 3 < NT) SLOAD(A, (j + 3) * KVBLK); });
        RESC(alA); __syncthreads();
        bj = (bj == 0) ? 2 : bj - 1;
    }
    { const int bjm1 = (bj == 0) ? 2 : bj - 1;
      qk_sm(pB0, pB1, K_lds + bj * SHM_K, qr, r32, hi, comp, pA0, pA1, alA, l_reg, pa0, pa1, pa2, pa3);
      pv_sm(o, vb0 + bjm1 * (int)SHM_V, pa0, pa1, pa2, pa3, pB0, pB1, m_reg, mnB, alB, [] {});
      RESC(alB);
      finishSM(pB0, pB1, alB, l_reg, pa0, pa1, pa2, pa3); SBAR();
      pv_d0(o, vb0 + bj * (int)SHM_V, pa0, pa1, pa2, pa3); }
#undef SW0
    if (hi == 0) li_l[r32] = l_reg; asm volatile("s_waitcnt lgkmcnt(0)" ::: "memory");
    float rli[16];
#pragma unroll
    for (int r = 0; r < 16; ++r) rli[r] = __builtin_amdgcn_rcpf(li_l[crow(r, hi)]);
    __syncthreads();
    float* stg = (float*)lds + rb * 32 * 128;
    if (comp == 1) {
#pragma unroll
        for (int r = 0; r < 16; ++r)
#pragma unroll
            for (int d0 = 0; d0 < 4; ++d0) stg[crow(r, hi) * 128 + d0 * 32 + r32] = o[d0][r] * rli[r];
    }
    __syncthreads();
    if (comp == 0) {
#pragma unroll
        for (int r = 0; r < 16; ++r)
#pragma unroll
            for (int d0 = 0; d0 < 4; ++d0) { const int idx = crow(r, hi) * 128 + d0 * 32 + r32; stg[idx] = o[d0][r] * rli[r] - lam * stg[idx]; }
        asm volatile("s_waitcnt lgkmcnt(0)" ::: "memory");
        const int row = lane >> 1, c0 = (lane & 1) * 64;
        const float* sp = stg + row * 128 + c0;
        float ss = 0.f;
#pragma unroll
        for (int i = 0; i < 16; ++i) { const f32x4 v = *(const f32x4*)(sp + 4 * i); ss += (v[0] * v[0] + v[1] * v[1]) + (v[2] * v[2] + v[3] * v[3]); }
        ss += __shfl_xor(ss, 1);
        const float rs = outscale / sqrtf(ss * (1.0f / 128.0f) + 1e-5f);
        bf16_t* op = Ob + (size_t)(rb * 32 + row) * DM + c0;
#pragma unroll
        for (int i = 0; i < 8; ++i) { const f32x4 v0 = *(const f32x4*)(sp + 8 * i), v1 = *(const f32x4*)(sp + 8 * i + 4);
            const f32x4 g0 = *(const f32x4*)(sub_gain + c0 + 8 * i), g1 = *(const f32x4*)(sub_gain + c0 + 8 * i + 4);
            u32x4 w; w.x = cvt_pk_bf16(v0[0] * rs * g0[0], v0[1] * rs * g0[1]); w.y = cvt_pk_bf16(v0[2] * rs * g0[2], v0[3] * rs * g0[3]);
            w.z = cvt_pk_bf16(v1[0] * rs * g1[0], v1[1] * rs * g1[1]); w.w = cvt_pk_bf16(v1[2] * rs * g1[2], v1[3] * rs * g1[3]);
            *(u32x4*)(op + 8 * i) = w; }
    }
    __syncthreads();
#undef SLOAD
#undef SWRITE
#undef SWAIT
#undef RESC
}

#define PIN(x) asm volatile("" : "+v"(x))
#define MFMA_(a, b, c) __builtin_amdgcn_mfma_f32_32x32x16_bf16(a, b, c, 0, 0, 0)
#define WAIT_BAR(N) asm volatile("s_waitcnt vmcnt(" #N ") lgkmcnt(0)\n\ts_barrier" ::: "memory")
typedef __attribute__((address_space(3))) const char* lds_cptr;
typedef short v4i16_t __attribute__((ext_vector_type(4)));
__device__ __forceinline__ unsigned cvtpk_nv(float lo, float hi) { unsigned r; asm("v_cvt_pk_bf16_f32 %0, %1, %2" : "=v"(r) : "v"(lo), "v"(hi)); return r; }
__device__ __forceinline__ void glds16(const void* g, unsigned lds_base) {
    unsigned sv; asm volatile("s_mov_b32 %0, m0\n\ts_mov_b32 m0, %2\n\ts_nop 0\n\tglobal_load_lds_dwordx4 %1, off\n\ts_mov_b32 m0, %0" : "=&s"(sv) : "v"(g), "s"(lds_base) : "memory"); }
__device__ __forceinline__ void kload2(bf16x8* kf, lds_cptr kp, int kb0, int d0) { const lds_cptr p = kp + (kb0 ^ (d0 << 5));
    kf[2 * d0] = *(const __attribute__((address_space(3))) bf16x8*)(p); kf[2 * d0 + 1] = *(const __attribute__((address_space(3))) bf16x8*)(p + 8192); }
__device__ __forceinline__ s16x4 vtr(lds_cptr p) { return __builtin_bit_cast(s16x4, __builtin_amdgcn_ds_read_tr16_b64_v4i16((__attribute__((address_space(3))) v4i16_t*)p)); }
#define MX3(a, b, c) __builtin_fmaxf(__builtin_fmaxf((a), (b)), (c))
__device__ __forceinline__ float rowmax(const f32x16& p0, const f32x16& p1) {
    float a = MX3(p0[0], p0[1], p1[0]), b = MX3(p0[2], p0[3], p1[1]); a = MX3(a, p1[2], p1[3]);
#pragma unroll
    for (int r = 4; r < 16; r += 4) { a = MX3(a, p0[r], p0[r + 1]); b = MX3(b, p0[r + 2], p0[r + 3]); a = MX3(a, p1[r], p1[r + 1]); b = MX3(b, p1[r + 2], p1[r + 3]); }
    float m = __builtin_fmaxf(a, b); auto rr = __builtin_amdgcn_permlane32_swap(__float_as_uint(m), __float_as_uint(m), false, false);
    return __builtin_fmaxf(__uint_as_float(rr[0]), __uint_as_float(rr[1])); }
#undef MX3

__device__ __forceinline__ void attn_unit2(const bf16_t* __restrict__ Qb, const bf16_t* __restrict__ Kh, const bf16_t* __restrict__ Vh, unsigned char* __restrict__ Ob,
                                           float lam, float outscale, const float* __restrict__ sub_gain, char* lds, const int tid) {
    constexpr int LDK = NPROJP, NT = SEQ / KVBLK, SLOTB = 16384, LDS_K = 0, LDS_V = 3 * SLOTB;
    const int lane = tid & 63, r32 = lane & 31, hi = lane >> 5; const int wid = __builtin_amdgcn_readfirstlane(tid >> 6); const int comp = wid & 1, rb = wid >> 1;
    const unsigned lds0 = (unsigned)(uintptr_t)lds; float* wsf = (float*)(lds + WS_OFF) + wid * 64;
    const bf16_t* ksrc = Kh + (size_t)(8 * wid + (lane >> 4)) * LDK + ((lane & 15) ^ (lane >> 4)) * 8;
    const bf16_t* ksrc2 = Kh + (size_t)(8 * wid + 4 + (lane >> 4)) * LDK + ((lane & 15) ^ ((lane >> 4) + 4)) * 8;
    const bf16_t* vsrc = Vh + (size_t)(32 * (wid & 1) + (lane >> 2)) * LDK + (wid >> 1) * 32 + (lane & 3) * 8;
    const unsigned kdst = lds0 + LDS_K + wid * 2048, vdst = lds0 + LDS_V + (wid >> 1) * 4096 + (wid & 1) * 2048;
#define DMA_K(t, slot) do { const unsigned d_ = (unsigned)__builtin_amdgcn_readfirstlane(kdst + (slot)); glds16(ksrc + (size_t)(t) * KVBLK * LDK, d_); glds16(ksrc2 + (size_t)(t) * KVBLK * LDK, d_ + 1024); } while (0)
#define DMA_V(t, slot) do { const bf16_t* s_ = vsrc + (size_t)(t) * KVBLK * LDK; const unsigned d_ = (unsigned)__builtin_amdgcn_readfirstlane(vdst + (slot)); glds16(s_, d_); glds16(s_ + (size_t)16 * LDK, d_ + 1024); } while (0)
    const lds_cptr vp0 = (lds_cptr)lds + LDS_V + ((lane >> 4) & 1) * 32 + (lane & 3) * 8 + (4 * hi + ((lane & 15) >> 2)) * 64;
    const int kb0 = r32 * 256 + ((comp * 128 + hi * 16) ^ ((r32 & 7) << 4));
    const lds_cptr kp0 = (lds_cptr)lds + LDS_K;
    DMA_K(0, 0); DMA_V(0, 0); DMA_K(1, SLOTB);
    bf16x8 qr[4];
    { const bf16_t* Qw = Qb + (size_t)(rb * 32 + r32) * LDK + comp * 64 + hi * 8;
#pragma unroll
      for (int d0 = 0; d0 < 4; ++d0) qr[d0] = *reinterpret_cast<const bf16x8*>(Qw + d0 * 16); }
    float mhat = 0.f, l_reg = 0.f; f32x16 o[4] = {};
    bool resc = false;
    f32x16 pA0, pA1, pB0, pB1; bf16x8 kf[8]; s16x4 vlo[8], vhi[8]; u32x4 pw0, pw1, pw2, pw3;
    int sl_prev = 0, sl_cur = 0, sl_next = SLOTB;
#define ROT() do { sl_prev = sl_cur; sl_cur = sl_next; sl_next = (sl_next == 2 * SLOTB) ? 0 : sl_next + SLOTB; } while (0)
#define EX(v) __builtin_amdgcn_exp2f((v) + nmh)
#define RESC2() do { if (resc) { _Pragma("unroll") for (int d_ = 0; d_ < 4; ++d_) _Pragma("unroll") for (int r = 0; r < 16; ++r) o[d_][r] *= wsf[crow(r, hi)]; } } while (0)
    DMA_K(2, 2 * SLOTB);
    WAIT_BAR(6);
    _Pragma("unroll") for (int d0 = 0; d0 < 4; ++d0) kload2(kf, kp0, kb0, d0);
    pA0 = MFMA_(kf[0], qr[0], f32x16{}); pA1 = MFMA_(kf[1], qr[0], f32x16{}); pA0 = MFMA_(kf[2], qr[1], pA0); pA1 = MFMA_(kf[3], qr[1], pA1);
    pA0 = MFMA_(kf[4], qr[2], pA0); pA1 = MFMA_(kf[5], qr[2], pA1); pA0 = MFMA_(kf[6], qr[3], pA0); pA1 = MFMA_(kf[7], qr[3], pA1);
    { mhat = rowmax(pA0, pA1); const float nmh = -mhat;
#pragma unroll
      for (int r = 0; r < 16; ++r) { pA0[r] = EX(pA0[r]); pA1[r] = EX(pA1[r]); } }
    WAIT_BAR(0);
    DMA_K(3, 0); DMA_V(1, SLOTB); ROT();
    _Pragma("unroll") for (int d0 = 0; d0 < 4; ++d0) kload2(kf, kp0 + sl_cur, kb0, d0);
    WAIT_BAR(4);
#define PKW(P, i) cvtpk_nv(P[i], P[i + 1])
#define PAF(k) __builtin_bit_cast(bf16x8, pw##k)
#define VFR(i) (bf16x8){vlo[i][0], vlo[i][1], vlo[i][2], vlo[i][3], vhi[i][0], vhi[i][1], vhi[i][2], vhi[i][3]}
#define VRD(i, f) do { vlo[i] = vtr(vp_ + (((f) & 3) * 4096 + ((f) >> 2) * 1024)); vhi[i] = vtr(vp_ + (((f) & 3) * 4096 + ((f) >> 2) * 1024 + 512)); } while (0)
#define KRD(G, d0) do { if (G) { kload2(kf, kp0 + sl_next, kb0, d0); SBAR(); } } while (0)
#define GAPA(MF, a0, a1, a2, a3, W0, W1, PW) do { MF; sacc += a0; sacc += a1; sacc += a2; sacc += a3; W0; W1; PIN(PW); PIN(sacc); SBAR(); } while (0)
#define GAPB(MF, X, i) do { MF; X[i] = EX(X[i]); X[i + 1] = EX(X[i + 1]); PIN(X); SBAR(); } while (0)
#define STEP(C0, C1, P0, P1, t, GK, GV, GL) do { SBAR(); \
    const lds_cptr vp_ = vp0 + sl_prev; \
    VRD(0, 0); SBAR(); float sacc = P0[0] + P0[1]; \
                       GAPA(C0 = MFMA_(kf[0], qr[0], f32x16{}), P0[2], P0[3], P0[4], P0[5],     pw0[0] = PKW(P0, 0),  pw0[1] = PKW(P0, 2),  pw0); \
    VRD(1, 1); SBAR(); GAPA(C1 = MFMA_(kf[1], qr[0], f32x16{}), P0[6], P0[7], P0[8], P0[9],     pw0[2] = PKW(P0, 4),  pw0[3] = PKW(P0, 6),  pw0); \
    VRD(2, 2); SBAR(); GAPA(C0 = MFMA_(kf[2], qr[1], C0),       P0[10], P0[11], P0[12], P0[13], pw1[0] = PKW(P0, 8),  pw1[1] = PKW(P0, 10), pw1); \
    VRD(3, 3); SBAR(); GAPA(C1 = MFMA_(kf[3], qr[1], C1),       P0[14], P0[15], P1[0], P1[1],   pw1[2] = PKW(P0, 12), pw1[3] = PKW(P0, 14), pw1); \
    VRD(4, 4); SBAR(); GAPA(C0 = MFMA_(kf[4], qr[2], C0),       P1[2], P1[3], P1[4], P1[5],     pw2[0] = PKW(P1, 0),  pw2[1] = PKW(P1, 2),  pw2); \
    VRD(5, 5); SBAR(); GAPA(C1 = MFMA_(kf[5], qr[2], C1),       P1[6], P1[7], P1[8], P1[9],     pw2[2] = PKW(P1, 4),  pw2[3] = PKW(P1, 6),  pw2); \
    VRD(6, 6); SBAR(); GAPA(C0 = MFMA_(kf[6], qr[3], C0),       P1[10], P1[11], P1[12], P1[13], pw3[0] = PKW(P1, 8),  pw3[1] = PKW(P1, 10), pw3); \
    VRD(7, 7); SBAR(); GAPA(C1 = MFMA_(kf[7], qr[3], C1),       P1[14], P1[15], 0.f, 0.f,       pw3[2] = PKW(P1, 12), pw3[3] = PKW(P1, 14), pw3); \
    l_reg += sacc; \
    if (GK) DMA_K((t) + 3, sl_cur); if (GV) DMA_V((t) + 1, sl_next); \
    { const float rm = rowmax(C0, C1) - mhat; resc = false; \
      if (__builtin_expect(__any(rm > THRL), 0)) { const float dl = __builtin_fmaxf(rm, 0.f); mhat += dl; \
          const float f = __builtin_amdgcn_exp2f(-dl); l_reg *= f; if (hi == 0) wsf[r32] = f; resc = true; } } \
    const float nmh = -mhat; SBAR(); \
    KRD(GL, 0); GAPB(o[0] = MFMA_(PAF(0), VFR(0), o[0]), C0, 0);   KRD(GL, 1); GAPB(o[1] = MFMA_(PAF(0), VFR(1), o[1]), C0, 2); \
    KRD(GL, 2); GAPB(o[2] = MFMA_(PAF(0), VFR(2), o[2]), C0, 4);   KRD(GL, 3); GAPB(o[3] = MFMA_(PAF(0), VFR(3), o[3]), C0, 6); \
    VRD(0, 8);  SBAR(); GAPB(o[0] = MFMA_(PAF(1), VFR(4), o[0]), C0, 8);   VRD(1, 9);  SBAR(); GAPB(o[1] = MFMA_(PAF(1), VFR(5), o[1]), C0, 10); \
    VRD(2, 10); SBAR(); GAPB(o[2] = MFMA_(PAF(1), VFR(6), o[2]), C0, 12);  VRD(3, 11); SBAR(); GAPB(o[3] = MFMA_(PAF(1), VFR(7), o[3]), C0, 14); \
    VRD(4, 12); SBAR(); GAPB(o[0] = MFMA_(PAF(2), VFR(0), o[0]), C1, 0);   VRD(5, 13); SBAR(); GAPB(o[1] = MFMA_(PAF(2), VFR(1), o[1]), C1, 2); \
    VRD(6, 14); SBAR(); GAPB(o[2] = MFMA_(PAF(2), VFR(2), o[2]), C1, 4);   VRD(7, 15); SBAR(); GAPB(o[3] = MFMA_(PAF(2), VFR(3), o[3]), C1, 6); \
    GAPB(o[0] = MFMA_(PAF(3), VFR(4), o[0]), C1, 8);   GAPB(o[1] = MFMA_(PAF(3), VFR(5), o[1]), C1, 10); \
    GAPB(o[2] = MFMA_(PAF(3), VFR(6), o[2]), C1, 12);  GAPB(o[3] = MFMA_(PAF(3), VFR(7), o[3]), C1, 14); \
    } while (0)
    int t = 1;
    for (; t + 5 < NT; t += 2) {
        STEP(pB0, pB1, pA0, pA1, t, true, true, true);     WAIT_BAR(4); RESC2(); ROT();
        STEP(pA0, pA1, pB0, pB1, t + 1, true, true, true); WAIT_BAR(4); RESC2(); ROT();
    }
#define ENDW(tt) do { if ((tt) + 3 < NT) { WAIT_BAR(4); } else if ((tt) + 2 < NT) { WAIT_BAR(2); } else { WAIT_BAR(0); } } while (0)
    for (; t + 1 < NT; t += 2) {
        STEP(pB0, pB1, pA0, pA1, t, (t + 3 < NT), (t + 1 < NT), (t + 1 < NT));         ENDW(t);     RESC2(); ROT();
        STEP(pA0, pA1, pB0, pB1, t + 1, (t + 4 < NT), (t + 2 < NT), (t + 2 < NT));     ENDW(t + 1); RESC2(); ROT();
    }
    STEP(pB0, pB1, pA0, pA1, NT - 1, false, false, false); RESC2();
    { float sacc = pB0[0] + pB0[1];
#pragma unroll
      for (int r = 2; r < 16; ++r) sacc += pB0[r];
#pragma unroll
      for (int r = 0; r < 16; ++r) sacc += pB1[r];
      l_reg += sacc;
      pw0 = (u32x4){PKW(pB0, 0), PKW(pB0, 2), PKW(pB0, 4), PKW(pB0, 6)}; pw1 = (u32x4){PKW(pB0, 8), PKW(pB0, 10), PKW(pB0, 12), PKW(pB0, 14)};
      pw2 = (u32x4){PKW(pB1, 0), PKW(pB1, 2), PKW(pB1, 4), PKW(pB1, 6)}; pw3 = (u32x4){PKW(pB1, 8), PKW(pB1, 10), PKW(pB1, 12), PKW(pB1, 14)};
      const lds_cptr vp_ = vp0 + sl_cur;
      _Pragma("unroll") for (int i = 0; i < 8; ++i) VRD(i, i);
      o[0] = MFMA_(PAF(0), VFR(0), o[0]); o[1] = MFMA_(PAF(0), VFR(1), o[1]); o[2] = MFMA_(PAF(0), VFR(2), o[2]); o[3] = MFMA_(PAF(0), VFR(3), o[3]);
      o[0] = MFMA_(PAF(1), VFR(4), o[0]); o[1] = MFMA_(PAF(1), VFR(5), o[1]); o[2] = MFMA_(PAF(1), VFR(6), o[2]); o[3] = MFMA_(PAF(1), VFR(7), o[3]);
      SBAR();
      _Pragma("unroll") for (int i = 0; i < 8; ++i) VRD(i, 8 + i);
      o[0] = MFMA_(PAF(2), VFR(0), o[0]); o[1] = MFMA_(PAF(2), VFR(1), o[1]); o[2] = MFMA_(PAF(2), VFR(2), o[2]); o[3] = MFMA_(PAF(2), VFR(3), o[3]);
      o[0] = MFMA_(PAF(3), VFR(4), o[0]); o[1] = MFMA_(PAF(3), VFR(5), o[1]); o[2] = MFMA_(PAF(3), VFR(6), o[2]); o[3] = MFMA_(PAF(3), VFR(7), o[3]); }
    { auto rr = __builtin_amdgcn_permlane32_swap(__float_as_uint(l_reg), __float_as_uint(l_reg), false, false); l_reg = __uint_as_float(rr[0]) + __uint_as_float(rr[1]); }
    float* li_l = wsf + 32;
    if (hi == 0) li_l[r32] = l_reg; asm volatile("s_waitcnt lgkmcnt(0)" ::: "memory");
    float rli[16];
#pragma unroll
    for (int r = 0; r < 16; ++r) rli[r] = __builtin_amdgcn_rcpf(li_l[crow(r, hi)]);
    __syncthreads();
    float* stg = (float*)lds + rb * 32 * 128;
    if (comp == 1) {
#pragma unroll
        for (int r = 0; r < 16; ++r)
#pragma unroll
            for (int d0 = 0; d0 < 4; ++d0) stg[crow(r, hi) * 128 + d0 * 32 + r32] = o[d0][r] * rli[r];
    }
    __syncthreads();
    if (comp == 0) {
#pragma unroll
        for (int r = 0; r < 16; ++r)
#pragma unroll
            for (int d0 = 0; d0 < 4; ++d0) { const int idx = crow(r, hi) * 128 + d0 * 32 + r32; stg[idx] = o[d0][r] * rli[r] - lam * stg[idx]; }
        asm volatile("s_waitcnt lgkmcnt(0)" ::: "memory");
        const int row = lane >> 1, c0 = (lane & 1) * 64;
        const float* sp = stg + row * 128 + c0;
        float ss = 0.f;
#pragma unroll
        for (int i = 0; i < 16; ++i) { const f32x4 v = *(const f32x4*)(sp + 4 * i); ss += (v[0] * v[0] + v[1] * v[1]) + (v[2] * v[2] + v[3] * v[3]); }
        ss += __shfl_xor(ss, 1);
        const float rs = outscale / sqrtf(ss * (1.0f / 128.0f) + 1e-5f);
        unsigned char* op = Ob + ((size_t)(rb * 32 + row) * DM + c0) * (WOUT_FP8 ? 1 : 2);
#pragma unroll
        for (int i = 0; i < 8; ++i) { const f32x4 v0 = *(const f32x4*)(sp + 8 * i), v1 = *(const f32x4*)(sp + 8 * i + 4);
            const f32x4 g0 = *(const f32x4*)(sub_gain + c0 + 8 * i), g1 = *(const f32x4*)(sub_gain + c0 + 8 * i + 4);
            if (WOUT_FP8) { const float rq = rs * MIXSC; const float f[8] = {v0[0] * rq * g0[0], v0[1] * rq * g0[1], v0[2] * rq * g0[2], v0[3] * rq * g0[3], v1[0] * rq * g1[0], v1[1] * rq * g1[1], v1[2] * rq * g1[2], v1[3] * rq * g1[3]};
                *(u32x2*)(op + 8 * i) = pack8_fp8(f); }
            else { u32x4 w; w.x = cvt_pk_bf16(v0[0] * rs * g0[0], v0[1] * rs * g0[1]); w.y = cvt_pk_bf16(v0[2] * rs * g0[2], v0[3] * rs * g0[3]);
                w.z = cvt_pk_bf16(v1[0] * rs * g1[0], v1[1] * rs * g1[1]); w.w = cvt_pk_bf16(v1[2] * rs * g1[2], v1[3] * rs * g1[3]);
                *(u32x4*)(op + 16 * i) = w; } }
    }
    __syncthreads();
#undef DMA_K
#undef DMA_V
#undef ROT
#undef EX
#undef RESC2
#undef PKW
#undef PAF
#undef VFR
#undef VRD
#undef KRD
#undef ENDW
#undef GAPA
#undef GAPB
#undef STEP
}
#undef PIN
#undef MFMA_
#undef WAIT_BAR
}

struct Args { const void* in[31]; float* out; unsigned char* ws; int ph_lo, ph_hi; };
typedef const __attribute__((address_space(4))) Args* ArgsP;
__device__ __forceinline__ int launder_v(int x) { asm volatile("" : "+v"(x)); return x; }
__device__ __forceinline__ int phase_tid(int wave) { int l; asm volatile("v_mbcnt_lo_u32_b32 %0, -1, 0\n\tv_mbcnt_hi_u32_b32 %0, -1, %0" : "=v"(l)); return wave * 64 + l; }
__device__ __forceinline__ ArgsP phase_args() { ArgsP p = (ArgsP)__builtin_amdgcn_kernarg_segment_ptr(); asm volatile("" : "+s"(p)); return p; }
enum { I_X = 0, I_C, I_POS, I_WADA, I_BADA, I_NGAIN, I_WIN, I_WOUT, I_MUP, I_MUN, I_DW0, I_DUP, I_A0, I_AUP, I_KK, I_KA, I_RK, I_GUP, I_GNG, I_GNB,
       I_LQ1, I_LK1, I_LQ2, I_LK2, I_SUBG, I_WR, I_RB, I_WG, I_WU, I_WDN, I_FG };

__device__ const double INVF[8] = {1.0, 0.1939227447486858, 0.03760603093086394, 0.007292664737217109, 0.0014142135623730957, 0.00027424817567620724, 5.318295896944988e-05, 1.0313385377212461e-05};

enum { MAP_ID = 0, MAP_QK = 1, MAP_GATE = 2, MAP_UP = 3 };
template <int MAP> __device__ __forceinline__ int map_row(int n) {
    if (MAP == MAP_QK) { if (n < 2048) { const int d = n & 63; if (d < 16) return (n & ~63) | (d & 3) | ((d & 8) >> 1) | ((d & 4) << 1); } return n; }
    if (MAP == MAP_GATE) return ((n >> 2) << 3) | (n & 3);
    if (MAP == MAP_UP) return ((n >> 2) << 3) | 4 | (n & 3);
    return n;
}
template <int MAP, bool F8 = false> __device__ __forceinline__ void transpose_item(const float* __restrict__ W, int K, int N, bf16_t* __restrict__ WT, LAS float* scr, int item, int lane, float scale = 1.0f) {
    const int nblk = N / 32, kb = item / nblk, nb = item % nblk, k0 = 64 * kb, n0 = 32 * nb;
#pragma unroll 8
    for (int i = 0; i < 32; ++i) { const int kk = 2 * i + (lane >> 5); scr[kk * 33 + (lane & 31)] = W[(size_t)(k0 + kk) * N + n0 + (lane & 31)]; }
    LDS_WAIT(); asm volatile("" ::: "memory");
    const int c = lane & 7;
#pragma unroll
    for (int j = 0; j < 4; ++j) { const int n = (lane >> 3) + 8 * j; const LAS float* s = scr + (8 * c) * 33 + n;
        if constexpr (F8) { int w0 = 0, w1 = 0;
            w0 = pk4_fp8(s[0 * 33] * scale, s[1 * 33] * scale, s[2 * 33] * scale, s[3 * 33] * scale);
            w1 = pk4_fp8(s[4 * 33] * scale, s[5 * 33] * scale, s[6 * 33] * scale, s[7 * 33] * scale);
            u32x2 o; o.x = (unsigned)w0; o.y = (unsigned)w1;
            *(u32x2*)((unsigned char*)WT + (size_t)map_row<MAP>(n0 + n) * K + k0 + 8 * c) = o; }
        else { u32x4 o; o.x = cvt_pk_bf16(s[0 * 33], s[1 * 33]); o.y = cvt_pk_bf16(s[2 * 33], s[3 * 33]); o.z = cvt_pk_bf16(s[4 * 33], s[5 * 33]); o.w = cvt_pk_bf16(s[6 * 33], s[7 * 33]);
            *(u32x4*)(WT + (size_t)map_row<MAP>(n0 + n) * K + k0 + 8 * c) = o; } }
    LDS_WAIT(); asm volatile("" ::: "memory");
}
template <int MAP> __device__ __forceinline__ void transpose_item128(const float* __restrict__ W, int K, int N, unsigned char* __restrict__ WT, LAS float* scr, int item, int lane, float scale) {
    const int nblk = N / 32, kb = item / nblk, nb = item % nblk, k0 = 128 * kb, n0 = 32 * nb;
    const int lr = lane >> 3, lc = lane & 7;
    f32x4 t[16];
    const float* src = W + (size_t)(k0 + lr) * N + n0 + 4 * lc;
#pragma unroll
    for (int j = 0; j < 16; ++j) t[j] = *(const f32x4*)(src + (size_t)(8 * j) * N);
#pragma unroll
    for (int j = 0; j < 16; ++j) { const int k = 8 * j + lr; *(LAS f32x4*)(scr + k * 32 + ((lc ^ (k >> 4)) << 2)) = t[j]; }
    LDS_WAIT(); asm volatile("" ::: "memory");
    const int nr = lane >> 3, c = lane & 7;
#pragma unroll
    for (int jj = 0; jj < 4; ++jj) { const int n = 8 * jj + nr; const LAS float* sp = scr + (16 * c) * 32 + ((((n >> 2) ^ c) << 2) | (n & 3));
        float f0[8], f1[8];
#pragma unroll
        for (int e = 0; e < 8; ++e) { f0[e] = sp[e * 32] * scale; f1[e] = sp[(8 + e) * 32] * scale; }
        const u32x2 a = pack8_fp8(f0), b = pack8_fp8(f1); u32x4 o; o.x = a.x; o.y = a.y; o.z = b.x; o.w = b.y;
        *(u32x4*)(WT + (size_t)map_row<MAP>(n0 + n) * K + k0 + 16 * c) = o; }
    LDS_WAIT(); asm volatile("" ::: "memory");
}
template <int MAP> __device__ __forceinline__ void transpose_piece_f8(const float* __restrict__ W, int K, int N, unsigned char* __restrict__ WT, LAS float* scr, int piece, int lane, float scale) {
    const int nblk = N / 32, kb = piece / nblk, nb = piece % nblk, k0 = 32 * kb, n0 = 32 * nb;
    float t[16];
#pragma unroll
    for (int i = 0; i < 16; ++i) t[i] = W[(size_t)(k0 + 2 * i + (lane >> 5)) * N + n0 + (lane & 31)];
#pragma unroll
    for (int i = 0; i < 16; ++i) scr[(2 * i + (lane >> 5)) * 33 + (lane & 31)] = t[i];
    LDS_WAIT(); asm volatile("" ::: "memory");
    const int c = lane & 3;
#pragma unroll
    for (int j = 0; j < 2; ++j) { const int n = (lane >> 2) + 16 * j; const LAS float* s = scr + (8 * c) * 33 + n;
        const float f[8] = {s[0 * 33] * scale, s[1 * 33] * scale, s[2 * 33] * scale, s[3 * 33] * scale, s[4 * 33] * scale, s[5 * 33] * scale, s[6 * 33] * scale, s[7 * 33] * scale};
        *(u32x2*)(WT + (size_t)map_row<MAP>(n0 + n) * K + k0 + 8 * c) = pack8_fp8(f); }
    LDS_WAIT(); asm volatile("" ::: "memory");
}
constexpr int MOE_PIECES = NEXP * 3 * 2048;
__device__ __forceinline__ void convert_moe_piece(ArgsP A, int l, LAS float* scr, int lane, int piece) {
    const int e = piece / 6144; int r = piece % 6144;
    unsigned char* WGU = A->ws + WS_WGU + (size_t)e * 2048 * DM; unsigned char* WD = A->ws + WS_WD + (size_t)e * DM * DFF;
    if (r < 2048) { transpose_piece_f8<MAP_GATE>((const float*)A->in[I_WG] + ((size_t)l * NEXP + e) * DM * DFF, DM, DFF, WGU, scr, r, lane, WSC_GU); return; } r -= 2048;
    if (r < 2048) { transpose_piece_f8<MAP_UP>((const float*)A->in[I_WU] + ((size_t)l * NEXP + e) * DM * DFF, DM, DFF, WGU, scr, r, lane, WSC_GU); return; } r -= 2048;
    transpose_piece_f8<MAP_ID>((const float*)A->in[I_WDN] + ((size_t)l * NEXP + e) * DFF * DM, DFF, DM, WD, scr, r, lane, WSC_D);
}
__device__ __forceinline__ void convert_moe(ArgsP A, int l, LAS unsigned char* lds, int lane, int wave, int gw, int NGW) {
    LAS float* scr = (LAS float*)(lds + wave * 16384);
    unsigned char* WGU = A->ws + WS_WGU; unsigned char* WD = A->ws + WS_WD;
    const float* wg = (const float*)A->in[I_WG] + (size_t)l * NEXP * DM * DFF;
    const float* wu = (const float*)A->in[I_WU] + (size_t)l * NEXP * DM * DFF;
    const float* wd = (const float*)A->in[I_WDN] + (size_t)l * NEXP * DFF * DM;
    constexpr int IG = (DM / 128) * (DFF / 32);
    constexpr int ID = (DFF / 128) * (DM / 32);
    for (int it = gw; it < NEXP * (2 * IG + ID); it += NGW) {
        const int e = it / (2 * IG + ID); int r = it % (2 * IG + ID);
        if (r < IG) { transpose_item128<MAP_GATE>(wg + (size_t)e * DM * DFF, DM, DFF, WGU + (size_t)e * 2048 * DM, scr, r, lane, WSC_GU); continue; } r -= IG;
        if (r < IG) { transpose_item128<MAP_UP>(wu + (size_t)e * DM * DFF, DM, DFF, WGU + (size_t)e * 2048 * DM, scr, r, lane, WSC_GU); continue; } r -= IG;
        transpose_item128<MAP_ID>(wd + (size_t)e * DFF * DM, DFF, DM, WD + (size_t)e * DM * DFF, scr, r, lane, WSC_D);
    }
}

__device__ __forceinline__ void phase_prologue(ArgsP A, LAS unsigned char* lds, int tid, int lane, int wave, int bx, int G) {
    float* MOD = (float*)(A->ws + WS_MOD);
    __syncthreads();
    if (bx < 192) {
        LAS float* sc = (LAS float*)lds; LAS float* red = (LAS float*)(lds + 32768);
        const float* c = (const float*)A->in[I_C];
        for (int i = tid; i < BATCH * DM; i += 512) { const float v = c[i]; sc[i] = v / (1.f + __expf(-v)); }
        __syncthreads();
        const int l = bx / 96, n0 = (bx % 96) * 128, half = lane >> 5, cg = lane & 31;
        const float* wp = (const float*)A->in[I_WADA] + (size_t)l * DM * NMOD + (size_t)(256 * wave + half) * NMOD + n0 + 4 * cg;
        f32x4 a0 = {0.f, 0.f, 0.f, 0.f}, a1 = a0, a2 = a0, a3 = a0;
#pragma unroll 8
        for (int kk = 0; kk < 128; ++kk) { const int k = 256 * wave + 2 * kk + half; const f32x4 wv = *(const f32x4*)(wp + (size_t)(2 * kk) * NMOD);
            a0 += wv * sc[k]; a1 += wv * sc[DM + k]; a2 += wv * sc[2 * DM + k]; a3 += wv * sc[3 * DM + k]; }
#pragma unroll
        for (int j = 0; j < 4; ++j) { a0[j] += __shfl_xor(a0[j], 32); a1[j] += __shfl_xor(a1[j], 32); a2[j] += __shfl_xor(a2[j], 32); a3[j] += __shfl_xor(a3[j], 32); }
        if (half == 0) { *(LAS f32x4*)(red + (wave * 4 + 0) * 128 + 4 * cg) = a0; *(LAS f32x4*)(red + (wave * 4 + 1) * 128 + 4 * cg) = a1;
                         *(LAS f32x4*)(red + (wave * 4 + 2) * 128 + 4 * cg) = a2; *(LAS f32x4*)(red + (wave * 4 + 3) * 128 + 4 * cg) = a3; }
        __syncthreads();
        { const int b = tid >> 7, col = tid & 127; float s = 0.f;
#pragma unroll
          for (int w = 0; w < 8; ++w) s += red[(w * 4 + b) * 128 + col];
          MOD[(size_t)(l * 4 + b) * NMOD + n0 + col] = s + ((const float*)A->in[I_BADA])[l * NMOD + n0 + col]; }
        __syncthreads();
    }
    { float* ROPE = (float*)(A->ws + WS_ROPE); const int* pos = (const int*)A->in[I_POS];
      for (int it = bx * 512 + tid; it < MTOK * 8; it += G * 512) { const int tok = it >> 3, j = it & 7;
          const double x = (double)pos[tok] * INVF[j]; const double n = rint(x * 0.15915494309189535); const float r = (float)(x - n * 6.283185307179586);
          ROPE[tok * 16 + j] = cosf(r); ROPE[tok * 16 + 8 + j] = sinf(r); } }
    const int gw = bx * 8 + wave, NGW = G * 8;
    { LAS float* scr = (LAS float*)(lds + wave * 16384);
      static_assert(PROJ_FP8 && WOUT_FP8, "the 128 x 32 converter writes fp8");
      constexpr int I_IN = (DM / 128) * (NPROJ / 32), I_OUT = (DM / 128) * (DM / 32);
      for (int it = gw; it < DEPTH * (I_IN + I_OUT); it += NGW) { const int l = it / (I_IN + I_OUT); int r = it % (I_IN + I_OUT);
          if (r < I_IN) transpose_item128<MAP_QK>((const float*)A->in[I_WIN] + (size_t)l * DM * NPROJ, DM, NPROJ, A->ws + WS_WIN + (size_t)l * NPROJP * DM, scr, r, lane, WSC_IN);
          else transpose_item128<MAP_ID>((const float*)A->in[I_WOUT] + (size_t)l * DM * DM, DM, DM, A->ws + WS_WOUT + (size_t)l * DM * DM, scr, r - I_IN, lane, WSC_O); } }
    { const int gt = bx * 512 + tid; constexpr int EB = PROJ_FP8 ? 1 : 2; constexpr int PER = (NPROJP - NPROJ) * DM * EB / 16;
      for (int it = gt; it < DEPTH * PER; it += G * 512) { const int l = it / PER, r = it % PER;
          *(u32x4*)(A->ws + WS_WIN + ((size_t)l * NPROJP * DM + (size_t)NPROJ * DM) * EB + (size_t)r * 16) = (u32x4){0u, 0u, 0u, 0u}; } }
    { const int gt = bx * 512 + tid; bf16_t* LW = (bf16_t*)(A->ws + WS_LW);
      for (int it = gt; it < DEPTH * 48 * NDYN; it += G * 512) { const int c = it % NDYN, kc = (it / NDYN) % 48, l = it / (NDYN * 48);
          const int kind = c >> 10, cc = c & 1023; float v[8];
#pragma unroll
          for (int j = 0; j < 8; ++j) { const int k = 8 * kc + j; float x = 0.f;
              if (kind < 2) { const int r = k - 64 * kind; if (r >= 0 && r < 64) x = ((const float*)A->in[I_DUP])[((size_t)(l * 2 + kind) * 64 + r) * 1024 + cc]; }
              else if (kind < 4) { const int r = k - 128 - 64 * (kind - 2); if (r >= 0 && r < 64) x = ((const float*)A->in[I_AUP])[((size_t)(l * 2 + kind - 2) * 64 + r) * 1024 + cc]; }
              else { const int r = k - 256; if (r >= 0 && r < 128) x = ((const float*)A->in[I_GUP])[((size_t)l * 128 + r) * 1024 + cc]; }
              v[j] = x; }
          *(u32x4*)(LW + ((size_t)l * NDYN + c) * KLA + 8 * kc) = pack8(v); } }
#if !SCAN_CONVERT
    convert_moe(A, 0, lds, lane, wave, gw, NGW);
#endif
}

__device__ __forceinline__ void load_moe_table(ArgsP A, int l, LAS unsigned char* lds, int tid) {
    LAS int* tb = (LAS int*)(lds + LDS_MISC + 64); LAS int* cn = (LAS int*)(lds + LDS_MISC + 192);
    if (tid == 0) { unsigned* ctl = (unsigned*)(A->ws + WS_CTL); int s = 0;
        for (int e = 0; e < NEXP; ++e) { int c = (int)__hip_atomic_load(ctl + CW_CNT + (l * 16 + e) * 64, __ATOMIC_RELAXED, __HIP_MEMORY_SCOPE_AGENT); if (c > TOKCAP) c = TOKCAP; cn[e] = c; tb[e] = s; s += (c + 255) >> 8; }
        tb[16] = s; }
    __syncthreads();
}

template <int MODE> __device__ __forceinline__ void phase_norm1(ArgsP A, int l, LAS unsigned char* lds, int tid, int lane, int wave, int bx, int G) {
    const float* MOD = (const float*)(A->ws + WS_MOD);
    bf16_t* X = (bf16_t*)(A->ws + WS_X); bf16_t* H = (bf16_t*)(A->ws + WS_H);
    const unsigned char* Y = A->ws + WS_Y; const u32x4* ASG = (const u32x4*)(A->ws + WS_ASG);
    const LAS int* tb = (const LAS int*)(lds + LDS_MISC + 64);
    if (MODE != 0) load_moe_table(A, l - 1, lds, tid);
    const int gw = bx * 8 + wave, NGW = G * 8;
    for (int b = 0; b < BATCH; ++b) {
        f32x4 mulv[8], addv[8], g2v[8];
#pragma unroll
        for (int j = 0; j < 8; ++j) { const int c = 4 * (lane + 64 * j);
            if (MODE == 2) { mulv[j] = *(const f32x4*)((const float*)A->in[I_FG] + c); addv[j] = (f32x4){0.f, 0.f, 0.f, 0.f}; }
            else { const float* mo = MOD + (size_t)(l * 4 + b) * NMOD; const f32x4 gn = *(const f32x4*)((const float*)A->in[I_NGAIN] + (size_t)(l * 2 + 0) * DM + c);
                   mulv[j] = gn * (*(const f32x4*)(mo + 1 * DM + c) + 1.0f); addv[j] = *(const f32x4*)(mo + 0 * DM + c); }
            if (MODE != 0) g2v[j] = *(const f32x4*)(MOD + (size_t)((l - 1) * 4 + b) * NMOD + 5 * DM + c); }
        for (int row = b * SEQ + gw; row < (b + 1) * SEQ; row += NGW) {
            f32x4 v[8];
            if (MODE == 0) { const f32x4* xr = (const f32x4*)((const float*)A->in[I_X] + (size_t)row * DM) + lane;
#pragma unroll
                for (int j = 0; j < 8; ++j) v[j] = xr[64 * j]; }
            else { const u32x2* xr = (const u32x2*)(X + (size_t)row * DM) + lane;
#pragma unroll
                for (int j = 0; j < 8; ++j) { const u32x2 p = xr[64 * j]; v[j] = (f32x4){bflo(p.x), bfhi(p.x), bflo(p.y), bfhi(p.y)}; } }
            if (MODE != 0) {
                const u32x4 as = ASG[row];
                const int e0 = __builtin_amdgcn_readfirstlane((int)(as.x >> 20)), s0 = __builtin_amdgcn_readfirstlane((int)(as.x & 0xfffffu));
                const int e1 = __builtin_amdgcn_readfirstlane((int)(as.y >> 20)), s1 = __builtin_amdgcn_readfirstlane((int)(as.y & 0xfffffu));
                const float w0 = __uint_as_float(as.z) * (1.0f / YSC), w1 = __uint_as_float(as.w) * (1.0f / YSC);
                const int* y0 = (const int*)(Y + ((size_t)tb[e0] * 256 + s0) * DM) + lane; const int* y1 = (const int*)(Y + ((size_t)tb[e1] * 256 + s1) * DM) + lane;
#pragma unroll
                for (int j = 0; j < 8; ++j) { const int p = y0[64 * j], q = y1[64 * j];
                    f32x4 m; m[0] = w0 * __builtin_amdgcn_cvt_f32_fp8(p, 0) + w1 * __builtin_amdgcn_cvt_f32_fp8(q, 0); m[1] = w0 * __builtin_amdgcn_cvt_f32_fp8(p, 1) + w1 * __builtin_amdgcn_cvt_f32_fp8(q, 1);
                    m[2] = w0 * __builtin_amdgcn_cvt_f32_fp8(p, 2) + w1 * __builtin_amdgcn_cvt_f32_fp8(q, 2); m[3] = w0 * __builtin_amdgcn_cvt_f32_fp8(p, 3) + w1 * __builtin_amdgcn_cvt_f32_fp8(q, 3);
                    v[j] = v[j] + g2v[j] * m; }
                if (MODE == 1) { u32x2* xw = (u32x2*)(X + (size_t)row * DM) + lane;
#pragma unroll
                    for (int j = 0; j < 8; ++j) { u32x2 w; w.x = cvt_pk_bf16(v[j][0], v[j][1]); w.y = cvt_pk_bf16(v[j][2], v[j][3]); xw[64 * j] = w; } }
            }
            float ss = 0.f;
#pragma unroll
            for (int j = 0; j < 8; ++j) ss += (v[j][0] * v[j][0] + v[j][1] * v[j][1]) + (v[j][2] * v[j][2] + v[j][3] * v[j][3]);
            const float rstd = 1.0f / sqrtf(wave_sum(ss) * (1.0f / DM) + 1e-6f);
            if (MODE == 2) { f32x4* ow = (f32x4*)(A->out + (size_t)row * DM) + lane;
#pragma unroll
                for (int j = 0; j < 8; ++j) ow[64 * j] = v[j] * rstd * mulv[j];
            } else {
#if PROJ_FP8
                int* hw = (int*)((unsigned char*)H + (size_t)row * DM) + lane;
#pragma unroll
                for (int j = 0; j < 8; ++j) { const f32x4 h = v[j] * rstd * mulv[j] + addv[j]; hw[64 * j] = pk4_fp8(h[0], h[1], h[2], h[3]); }
#else
                u32x2* hw = (u32x2*)(H + (size_t)row * DM) + lane;
#pragma unroll
                for (int j = 0; j < 8; ++j) { const f32x4 h = v[j] * rstd * mulv[j] + addv[j]; u32x2 w; w.x = cvt_pk_bf16(h[0], h[1]); w.y = cvt_pk_bf16(h[2], h[3]); hw[64 * j] = w; }
#endif
            }
        }
    }
#if !SCAN_CONVERT
    if (MODE == 1) { VM_WAIT(); __syncthreads(); convert_moe(A, l, lds, lane, wave, gw, NGW); }
#endif
}

__device__ __forceinline__ void phase_norm2_router(ArgsP A, int l, LAS unsigned char* lds, int tid, int lane, int wave, int bx, int G, int dry) {
    const float* MOD = (const float*)(A->ws + WS_MOD);
    const bf16_t* X = (const bf16_t*)(A->ws + WS_X); bf16_t* H = (bf16_t*)(A->ws + WS_H);
    LAS float* wr_l = (LAS float*)lds;
    LAS int* l_e = (LAS int*)(lds + LDS_MISC + 512);
    LAS float* l_g = (LAS float*)(lds + LDS_MISC + 1024);
    LAS int* l_cnt = (LAS int*)(lds + LDS_MISC + 1536);
    LAS int* l_base = (LAS int*)(lds + LDS_MISC + 1600);
    LAS int* l_loc = (LAS int*)(lds + LDS_MISC + 1664);
    { const f32x4* src = (const f32x4*)A->in[I_WR]; for (int t = tid; t < DM * NEXP / 4; t += 512) { const int c = t >> 2, q = t & 3, L = (c >> 2) & 63, j = c >> 8, i = c & 3;
        *(LAS f32x4*)(wr_l + 4 * ((((j * 4 + i) * 4 + q) * 64) + L)) = src[t]; } }
    if (tid < 16) l_cnt[tid] = 0;
    __syncthreads();
    for (int rblk = bx; rblk < MTOK / 64; rblk += G) {
        const int b = (rblk * 64) / SEQ;
        const float* mo = MOD + (size_t)(l * 4 + b) * NMOD;
        const float* gnp = (const float*)A->in[I_NGAIN] + (size_t)(l * 2 + 1) * DM;
        for (int rr = 0; rr < 8; rr += 2) {
            const int rl = wave * 8 + rr, row = rblk * 64 + rl;
            u32x2 p0[8], p1[8];
            { const u32x2* x0 = (const u32x2*)(X + (size_t)row * DM) + lane; const u32x2* x1 = x0 + DM / 4;
#pragma unroll
              for (int j = 0; j < 8; ++j) { p0[j] = x0[64 * j]; p1[j] = x1[64 * j]; } }
#define UNP(p) (f32x4){bflo((p).x), bfhi((p).x), bflo((p).y), bfhi((p).y)}
            float ss0 = 0.f, ss1 = 0.f;
#pragma unroll
            for (int j = 0; j < 8; ++j) { const f32x4 a = UNP(p0[j]), b = UNP(p1[j]);
                ss0 += (a[0] * a[0] + a[1] * a[1]) + (a[2] * a[2] + a[3] * a[3]); ss1 += (b[0] * b[0] + b[1] * b[1]) + (b[2] * b[2] + b[3] * b[3]); }
            const float rstd0 = 1.0f / sqrtf(wave_sum(ss0) * (1.0f / DM) + 1e-6f), rstd1 = 1.0f / sqrtf(wave_sum(ss1) * (1.0f / DM) + 1e-6f);
            float lg0[16], lg1[16];
#pragma unroll
            for (int e = 0; e < 16; ++e) { lg0[e] = 0.f; lg1[e] = 0.f; }
            int* hw0 = (int*)((unsigned char*)H + (size_t)row * DM) + lane;
            int* hw1 = hw0 + DM / 4;
#pragma unroll
            for (int j = 0; j < 8; ++j) { const int cj = 4 * (lane + 64 * j);
                const f32x4 mulj = *(const f32x4*)(gnp + cj) * (*(const f32x4*)(mo + 4 * DM + cj) + 1.0f), addj = *(const f32x4*)(mo + 3 * DM + cj);
                const f32x4 h0 = UNP(p0[j]) * rstd0 * mulj + addj, h1 = UNP(p1[j]) * rstd1 * mulj + addj;
                hw0[64 * j] = pk4_fp8(h0[0], h0[1], h0[2], h0[3]); hw1[64 * j] = pk4_fp8(h1[0], h1[1], h1[2], h1[3]);
#pragma unroll
                for (int i = 0; i < 4; ++i) { const LAS f32x4* wp = (const LAS f32x4*)wr_l + (j * 4 + i) * 4 * 64 + lane;
#pragma unroll
                    for (int q = 0; q < 4; ++q) { const f32x4 ww = wp[q * 64];
                        lg0[4 * q + 0] += h0[i] * ww[0]; lg0[4 * q + 1] += h0[i] * ww[1]; lg0[4 * q + 2] += h0[i] * ww[2]; lg0[4 * q + 3] += h0[i] * ww[3];
                        lg1[4 * q + 0] += h1[i] * ww[0]; lg1[4 * q + 1] += h1[i] * ww[1]; lg1[4 * q + 2] += h1[i] * ww[2]; lg1[4 * q + 3] += h1[i] * ww[3]; } }
                __builtin_amdgcn_sched_barrier(0); }
#undef UNP
            float lg[16];
#pragma unroll
            for (int e = 0; e < 16; ++e) { const float a = wave_sum(lg0[e]), b = wave_sum(lg1[e]); lg[e] = (lane == 1) ? b : a; }
            if (lane < 2) {
                const int rl2 = rl + lane;
                float sc[16], sel[16]; const float* rb = (const float*)A->in[I_RB];
#pragma unroll
                for (int e = 0; e < 16; ++e) { sc[e] = sigmoidf_(lg[e]); sel[e] = sc[e] + rb[e]; }
                int bg = 0; float bgs = -1e30f;
#pragma unroll
                for (int g = 0; g < 4; ++g) { float m1 = -1e30f, m2 = -1e30f;
#pragma unroll
                    for (int i = 0; i < 4; ++i) { const float s = sel[4 * g + i]; if (s > m1) { m2 = m1; m1 = s; } else if (s > m2) m2 = s; }
                    const float gs = m1 + m2; if (gs > bgs) { bgs = gs; bg = g; } }
                int i1 = 0; float m1 = -1e30f;
#pragma unroll
                for (int g = 0; g < 4; ++g) if (g == bg) {
#pragma unroll
                    for (int i = 0; i < 4; ++i) if (sel[4 * g + i] > m1) { m1 = sel[4 * g + i]; i1 = i; } }
                int i2 = 0; float m2 = -1e30f;
#pragma unroll
                for (int g = 0; g < 4; ++g) if (g == bg) {
#pragma unroll
                    for (int i = 0; i < 4; ++i) if (i != i1 && sel[4 * g + i] > m2) { m2 = sel[4 * g + i]; i2 = i; } }
                const int e1 = 4 * bg + i1, e2 = 4 * bg + i2; float s1 = 0.f, s2 = 0.f;
#pragma unroll
                for (int e = 0; e < 16; ++e) { if (e == e1) s1 = sc[e]; if (e == e2) s2 = sc[e]; }
                const float inv = 1.0f / (s1 + s2);
                l_e[2 * rl2] = e1; l_e[2 * rl2 + 1] = e2; l_g[2 * rl2] = s1 * inv; l_g[2 * rl2 + 1] = s2 * inv;
            }
        }
        __syncthreads();
        { const int tid2 = launder_v(tid);
        if (tid2 < 128) l_loc[tid2] = atomicAdd((int*)&l_cnt[l_e[tid2]], 1);
        __syncthreads();
        if (tid2 < 16) { unsigned* ctl = (unsigned*)(A->ws + WS_CTL); const int c = l_cnt[tid2];
            l_base[tid2] = c ? (int)__hip_atomic_fetch_add(ctl + CW_CNT + ((l + 2 * dry) * 16 + tid2) * 64, (unsigned)c, __ATOMIC_RELAXED, __HIP_MEMORY_SCOPE_AGENT) : 0; }
        __syncthreads();
        if (tid2 < 128) { const int e = l_e[tid2]; const int slot = l_base[e] + l_loc[tid2]; const int row = rblk * 64 + (tid2 >> 1);
            int* tokl = (int*)(A->ws + WS_TOKL); if (slot < TOKCAP && !dry) tokl[e * TOKCAP + slot] = row;
            unsigned* asg = (unsigned*)(A->ws + WS_ASG) + (size_t)row * 4; if (!dry) asg[tid2 & 1] = ((unsigned)e << 20) | (unsigned)slot; if (!dry) asg[2 + (tid2 & 1)] = __float_as_uint(l_g[tid2]); }
        __syncthreads();
        }
        if (tid < 16) l_cnt[tid] = 0;
        __syncthreads();
    }
}

__device__ __forceinline__ void phase_prep(ArgsP A, int l, int lane, int wave, int bx, int G) {
    const bf16_t* PROJ = (const bf16_t*)(A->ws + WS_PROJ); bf16_t* SHR = (bf16_t*)(A->ws + WS_SHR); bf16_t* LA = (bf16_t*)(A->ws + WS_LA);
    const int gw = bx * 8 + wave, NGW = G * 8;
    for (int it = gw; it < 7 * (MTOK / 64); it += NGW) {
        const int strip = it % 7, run = it / 7;
        if (strip == 6 && lane >= 48) continue;
        const int c = strip * 512 + 8 * lane;
        float mup[8], mun[8], kkv[8];
#pragma unroll
        for (int j = 0; j < 8; ++j) { mup[j] = ((const float*)A->in[I_MUP])[l * RWC + c + j]; mun[j] = ((const float*)A->in[I_MUN])[l * RWC + c + j];
            kkv[j] = (strip == 2 || strip == 3) ? ((const float*)A->in[I_KK])[l * 1024 + (c - 1024) + j] : 0.f; }
        const int t0 = run * 64, tl0 = t0 % SEQ;
        const bf16_t* pp = PROJ + (size_t)t0 * NPROJP + RW0 + c;
        float prev[8], cur[8], nxt[8];
        if (tl0 == 0) {
#pragma unroll
            for (int j = 0; j < 8; ++j) prev[j] = 0.f; } else unpack8(*(const u32x4*)(pp - NPROJP), prev);
        unpack8(*(const u32x4*)pp, cur);
        u32x4 rawn[8];
#pragma unroll
        for (int q = 0; q < 8; ++q) rawn[q] = *(const u32x4*)(pp + (size_t)(q + 1) * NPROJP);
        for (int i0 = 0; i0 < 64; i0 += 8) {
            u32x4 raw[8];
#pragma unroll
            for (int q = 0; q < 8; ++q) raw[q] = rawn[q];
            if (i0 + 8 < 64) {
#pragma unroll
                for (int q = 0; q < 8; ++q) rawn[q] = *(const u32x4*)(pp + (size_t)(i0 + 8 + q + 1) * NPROJP); }
#pragma unroll
            for (int q = 0; q < 8; ++q) {
            const int i = i0 + q; const int row = t0 + i;
            unpack8(raw[q], nxt);
            if (tl0 + i == SEQ - 1) {
#pragma unroll
                for (int j = 0; j < 8; ++j) nxt[j] = 0.f; }
            float ps[8];
#pragma unroll
            for (int j = 0; j < 8; ++j) ps[j] = cur[j] + mup[j] * (prev[j] - cur[j]) + mun[j] * (nxt[j] - cur[j]);
            if (strip < 6) {
                const int reg = strip >> 1, cc = (strip & 1) * 512 + 8 * lane;
                *(u32x4*)(SHR + (size_t)row * 4096 + reg * 1024 + cc) = pack8(ps);
                if (reg == 1) { float x[8]; float ss = 0.f;
#pragma unroll
                    for (int j = 0; j < 8; ++j) { x[j] = ps[j] * kkv[j]; ss += x[j] * x[j]; }
                    ss += __shfl_xor(ss, 1); ss += __shfl_xor(ss, 2); ss += __shfl_xor(ss, 4);
                    const float inv = 1.0f / fmaxf(sqrtf(ss), 1e-12f);
#pragma unroll
                    for (int j = 0; j < 8; ++j) x[j] *= inv;
                    *(u32x4*)(SHR + (size_t)row * 4096 + 3072 + cc) = pack8(x); }
            } else {
                const int ty = lane >> 4; float o[8];
#pragma unroll
                for (int j = 0; j < 8; ++j) o[j] = (ty == 0) ? (1.0f - 2.0f / (1.0f + __expf(2.0f * ps[j]))) : (ty == 1) ? ps[j] : sigmoidf_(ps[j]);
                *(u32x4*)(LA + (size_t)row * KLA + 8 * lane) = pack8(o);
            }
#pragma unroll
            for (int j = 0; j < 8; ++j) { prev[j] = cur[j]; cur[j] = nxt[j]; }
            }
        }
    }
}

__device__ __forceinline__ float rowsum16(float x) {
    x += __builtin_bit_cast(float, __builtin_amdgcn_update_dpp(0, __builtin_bit_cast(int, x), 0x128, 0xf, 0xf, false));
    x += __builtin_bit_cast(float, __builtin_amdgcn_update_dpp(0, __builtin_bit_cast(int, x), 0x124, 0xf, 0xf, false));
    x += __builtin_bit_cast(float, __builtin_amdgcn_update_dpp(0, __builtin_bit_cast(int, x), 0x122, 0xf, 0xf, false));
    x += __builtin_bit_cast(float, __builtin_amdgcn_update_dpp(0, __builtin_bit_cast(int, x), 0x121, 0xf, 0xf, false));
    return x;
}
namespace rs {
constexpr int M = 16, NCH = SEQ / M;
constexpr int SLOT = 21248, O_AR = 0, O_BK = 5632, O_BKT = 10240, O_VT = 15360, O_MRB = 18432, O_LAB = 19968, O_GAM = 20992;
constexpr int P_AR = 176, P_BK = 144, P_BKT = 80, P_VT = 48, P_MRB = 48;
constexpr int O_YB = 3 * SLOT, O_CV = O_YB + 8192;
__device__ __forceinline__ float bfu(unsigned short x) { return __uint_as_float(((unsigned)x) << 16); }
__device__ __forceinline__ unsigned cvtpk(float lo, float hi) { unsigned r; asm("v_cvt_pk_bf16_f32 %0, %1, %2" : "=v"(r) : "v"(lo), "v"(hi)); return r; }
__device__ __forceinline__ unsigned short f2bf(float f) { return (unsigned short)(cvtpk(f, 0.f) & 0xffffu); }
__device__ __forceinline__ bf16x8 pack_bf8(float a, float b, float c, float d, float e, float f, float g, float h) {
    u32x4 w; w.x = cvtpk(a, b); w.y = cvtpk(c, d); w.z = cvtpk(e, f); w.w = cvtpk(g, h); return __builtin_bit_cast(bf16x8, w); }
}
__device__ __forceinline__ void phase_scan(ArgsP A, int l, LAS unsigned char* lds, int tid, int bx, int G) {
    using namespace rs;
    const bf16_t* SHR = (const bf16_t*)(A->ws + WS_SHR); const bf16_t* DYN = (const bf16_t*)(A->ws + WS_DYN); bf16_t* YS = (bf16_t*)(A->ws + WS_YS);
    const int hwid = __builtin_amdgcn_readfirstlane(tid >> 6);
    const int wid = (hwid == 1) ? 7 : (hwid == 5) ? 1 : (hwid == 6) ? 5 : (hwid == 7) ? 6 : hwid;
    const int lane = tid & 63, l31 = lane & 31, hh = lane >> 5;
    const bool xsplit = (G == 256);
    for (int chain = xsplit ? (((bx >> 3) & 1) ? 128 : ((bx >> 4) * 8 + (bx & 7))) : bx; chain < 128; chain += xsplit ? 128 : G) {
        const int d = chain >> 6, b = (chain >> 4) & 3, h = chain & 15; const int hf = (wid == 7) ? 1 : 0;
#define RS_ROW(c, t) ((size_t)b * SEQ + (d ? (SEQ - 1 - ((c) * M + (t))) : ((c) * M + (t))))
        f32x16 ST0 = {}, ST1 = {};
        u32x4 q0a, q0b, q1a, q1b, q2a, q2b, q3a, q3b;
        float kaj = 0.f;
        const int cpos = (lane >> 4) * 32 + ((lane >> 2) & 1) * 16 + ((((lane >> 3) & 1) << 2) | (lane & 3)) * 2;
        const bool e1 = (wid == 2) || (wid == 5), e2 = (wid == 3) || (wid == 6); const int epar = (wid >= 5) ? 1 : 0;
        const int ew = (wid == 2) ? 0 : (wid == 3) ? 1 : (wid == 5) ? 2 : 3;
        LAS unsigned char* stg = lds + O_CV + ew * 8192;
        if (e2) kaj = ((const float*)A->in[I_KA])[l * 1024 + h * 64 + lane];
#define RS_LOAD(c) do { const size_t ra_ = RS_ROW(c, lane >> 3), rb_ = RS_ROW(c, 8 + (lane >> 3)); const int cg_ = 8 * (lane & 7); \
            const bf16_t* sa_ = SHR + ra_ * 4096 + h * 64 + cg_; const bf16_t* sb_ = SHR + rb_ * 4096 + h * 64 + cg_; \
            const bf16_t* da_ = DYN + ra_ * NDYN + d * 1024 + h * 64 + cg_; const bf16_t* db_ = DYN + rb_ * NDYN + d * 1024 + h * 64 + cg_; \
            q0a = *(const u32x4*)da_; q0b = *(const u32x4*)db_; q1a = *(const u32x4*)(sa_ + 3072); q1b = *(const u32x4*)(sb_ + 3072); \
            if (e1) { q2a = *(const u32x4*)sa_; q2b = *(const u32x4*)sb_; q3a = *(const u32x4*)(sa_ + 2048); q3b = *(const u32x4*)(sb_ + 2048); } \
            else { q2a = *(const u32x4*)(da_ + 2048); q2b = *(const u32x4*)(db_ + 2048); q3a = *(const u32x4*)(sa_ + 1024); q3b = *(const u32x4*)(sb_ + 1024); } } while (0)
#define RS_STAGE() do { const int o_ = ((lane >> 3) * 64 + 8 * (lane & 7)) * 2; \
            *(LAS u32x4*)(stg + o_) = q0a; *(LAS u32x4*)(stg + 1024 + o_) = q0b; *(LAS u32x4*)(stg + 2048 + o_) = q1a; *(LAS u32x4*)(stg + 3072 + o_) = q1b; \
            *(LAS u32x4*)(stg + 4096 + o_) = q2a; *(LAS u32x4*)(stg + 5120 + o_) = q2b; \
            *(LAS u32x4*)(stg + 6144 + o_) = q3a; *(LAS u32x4*)(stg + 7168 + o_) = q3b; \
            asm volatile("s_waitcnt lgkmcnt(0)" ::: "memory"); } while (0)
#define RS_GET(arr, t_) bfu(*(const LAS unsigned short*)(stg + (arr) * 2048 + (t_) * 128 + 2 * lane))
        if ((e1 || e2) && epar == 0) RS_LOAD(0);
        for (int n = 0; n < NCH + 3; ++n) {
            if (wid == 0 || wid == 7) {
                const int c = n - 2;
                if (c >= 0 && c < NCH) {
                    LAS unsigned char* sl = lds + (c % 3) * SLOT;
                    f32x16 D = {};
                    const LAS unsigned char* arp = sl + O_AR + l31 * P_AR + hh * 16;
                    {   bf16x8 a0 = *(const LAS bf16x8*)(arp), a1 = *(const LAS bf16x8*)(arp + 32), a2 = *(const LAS bf16x8*)(arp + 64), a3 = *(const LAS bf16x8*)(arp + 96), a4 = *(const LAS bf16x8*)(arp + 128);
                        const bf16x8 bv = *(const LAS bf16x8*)(sl + O_VT + (32 * hf + l31) * P_VT + hh * 16);
                        const bf16x8 b0 = pack_bf8(ST0[0], ST0[1], ST0[2], ST0[3], ST0[4], ST0[5], ST0[6], ST0[7]), b1 = pack_bf8(ST0[8], ST0[9], ST0[10], ST0[11], ST0[12], ST0[13], ST0[14], ST0[15]);
                        const bf16x8 b2 = pack_bf8(ST1[0], ST1[1], ST1[2], ST1[3], ST1[4], ST1[5], ST1[6], ST1[7]), b3 = pack_bf8(ST1[8], ST1[9], ST1[10], ST1[11], ST1[12], ST1[13], ST1[14], ST1[15]);
                        D = __builtin_amdgcn_mfma_f32_32x32x16_bf16(a0, b0, D, 0, 0, 0); D = __builtin_amdgcn_mfma_f32_32x32x16_bf16(a1, b1, D, 0, 0, 0);
                        D = __builtin_amdgcn_mfma_f32_32x32x16_bf16(a2, b2, D, 0, 0, 0); D = __builtin_amdgcn_mfma_f32_32x32x16_bf16(a3, b3, D, 0, 0, 0);
                        D = __builtin_amdgcn_mfma_f32_32x32x16_bf16(a4, bv, D, 0, 0, 0);
                        float da[16];
#pragma unroll
                        for (int r = 0; r < 8; ++r) { auto rr = __builtin_amdgcn_permlane32_swap(__float_as_uint(D[r]), __float_as_uint(D[r]), false, false);
                            const int t0 = (r & 3) + 8 * (r >> 2); da[t0] = __uint_as_float(rr[0]); da[t0 + 4] = __uint_as_float(rr[1]); }
                        const LAS float* lab = (const LAS float*)(sl + O_LAB);
#pragma unroll
                        for (int s_ = 0; s_ < 15; ++s_) {
                            const f32x4 c0 = *(const LAS f32x4*)(lab + s_ * 16), c1 = *(const LAS f32x4*)(lab + s_ * 16 + 4), c2 = *(const LAS f32x4*)(lab + s_ * 16 + 8), c3 = *(const LAS f32x4*)(lab + s_ * 16 + 12);
                            const float cf[16] = {c0[0], c0[1], c0[2], c0[3], c1[0], c1[1], c1[2], c1[3], c2[0], c2[1], c2[2], c2[3], c3[0], c3[1], c3[2], c3[3]};
#pragma unroll
                            for (int t_ = s_ + 1; t_ < 16; ++t_) da[t_] += da[s_] * cf[t_];
                        }
                        const bf16x8 bu = hh ? pack_bf8(da[8], da[9], da[10], da[11], da[12], da[13], da[14], da[15]) : pack_bf8(da[0], da[1], da[2], da[3], da[4], da[5], da[6], da[7]);
                        const bf16x8 am = *(const LAS bf16x8*)(sl + O_MRB + l31 * P_MRB + hh * 16);
                        D = __builtin_amdgcn_mfma_f32_32x32x16_bf16(am, bu, D, 0, 0, 0);
                        LAS float* yb = (LAS float*)(lds + O_YB + (c & 1) * 4096);
#pragma unroll
                        for (int r = 8; r < 16; ++r) yb[((r & 3) + 8 * ((r >> 2) - 2) + 4 * hh) * 64 + 32 * hf + l31] = D[r];
                        const LAS unsigned char* bk0 = sl + O_BKT + l31 * P_BKT + hh * 16; const LAS unsigned char* bk1 = bk0 + 32 * P_BKT;
                        ST0 = __builtin_amdgcn_mfma_f32_32x32x16_bf16(*(const LAS bf16x8*)(bk0), bu, ST0, 0, 0, 0); ST0 = __builtin_amdgcn_mfma_f32_32x32x16_bf16(*(const LAS bf16x8*)(bk0 + 32), bv, ST0, 0, 0, 0);
                        ST1 = __builtin_amdgcn_mfma_f32_32x32x16_bf16(*(const LAS bf16x8*)(bk1), bu, ST1, 0, 0, 0); ST1 = __builtin_amdgcn_mfma_f32_32x32x16_bf16(*(const LAS bf16x8*)(bk1 + 32), bv, ST1, 0, 0, 0);
                        const LAS float* gam = (const LAS float*)(sl + O_GAM) + 4 * hh;
#pragma unroll
                        for (int g4 = 0; g4 < 4; ++g4) { const f32x4 g0 = *(const LAS f32x4*)(gam + 8 * g4), g1 = *(const LAS f32x4*)(gam + 32 + 8 * g4);
#pragma unroll
                            for (int i_ = 0; i_ < 4; ++i_) { ST0[4 * g4 + i_] *= g0[i_]; ST1[4 * g4 + i_] *= g1[i_]; } }
                    }
                }
            } else if (wid == 1) {
                const int c = n - 1;
                if (c >= 0 && c < NCH) {
                    LAS unsigned char* sl = lds + (c % 3) * SLOT;
                    f32x16 Lm = {};
                    const LAS unsigned char* ap = sl + O_BK + l31 * P_BK + hh * 16; const LAS unsigned char* bp = sl + O_AR + l31 * P_AR + hh * 16;
#pragma unroll
                    for (int q = 0; q < 4; ++q) Lm = __builtin_amdgcn_mfma_f32_32x32x16_bf16(*(const LAS bf16x8*)(ap + 32 * q), *(const LAS bf16x8*)(bp + 32 * q), Lm, 0, 0, 0);
                    const int tp = l31, tq = tp & 15; const bool isr = tp >= 16;
                    LAS float* lab = (LAS float*)(sl + O_LAB);
                    float lo[8], hi[8];
#pragma unroll
                    for (int r = 0; r < 8; ++r) { const int s_ = (r & 3) + 8 * (r >> 2) + 4 * hh; const bool keep = isr ? (s_ <= tq) : (s_ < tq);
                        lo[r] = keep ? Lm[r] : 0.f; hi[r] = keep ? Lm[8 + r] : 0.f; }
                    if (!isr) {
#pragma unroll
                        for (int r = 0; r < 8; ++r) lab[((r & 3) + 8 * (r >> 2) + 4 * hh) * 16 + tp] = lo[r]; }
                    { u32x2 w0, w1; w0.x = isr ? cvtpk(lo[0], lo[1]) : 0u; w0.y = isr ? cvtpk(lo[2], lo[3]) : 0u; w1.x = isr ? cvtpk(lo[4], lo[5]) : 0u; w1.y = isr ? cvtpk(lo[6], lo[7]) : 0u;
                      LAS unsigned char* mp = sl + O_MRB + tp * P_MRB + hh * 8; *(LAS u32x2*)(mp) = w0; *(LAS u32x2*)(mp + 16) = w1; }
                    { u32x2 w0, w1; w0.x = cvtpk(hi[0], hi[1]); w0.y = cvtpk(hi[2], hi[3]); w1.x = cvtpk(hi[4], hi[5]); w1.y = cvtpk(hi[6], hi[7]);
                      LAS unsigned char* qp = sl + O_AR + tp * P_AR + 128 + hh * 8; *(LAS u32x2*)(qp) = w0; *(LAS u32x2*)(qp + 16) = w1; }
                }
            } else if (e1) {
                if ((n & 1) != epar) { if (n + 1 < NCH) RS_LOAD(n + 1); }
                else if (n < NCH) {
                    LAS unsigned char* sl = lds + (n % 3) * SLOT;
                    RS_STAGE();
                    float g = 1.0f; float xw[16], xk[16], xr[16];
#pragma unroll
                    for (int t_ = 0; t_ < M; ++t_) { xw[t_] = RS_GET(0, t_); xk[t_] = RS_GET(1, t_); xr[t_] = RS_GET(2, t_); }
#pragma unroll
                    for (int t_ = 0; t_ < M; ++t_) { const float gp = g; g *= xw[t_];
                        *(LAS unsigned short*)(sl + O_AR + t_ * P_AR + cpos) = f2bf(-xk[t_] * gp);
                        *(LAS unsigned short*)(sl + O_AR + (16 + t_) * P_AR + cpos) = f2bf(xr[t_] * g); }
                    *(LAS float*)(sl + O_GAM + 4 * lane) = g;
                    { unsigned short vv[16];
#pragma unroll
                        for (int s_ = 0; s_ < 16; ++s_) vv[s_] = *(const LAS unsigned short*)(stg + 6144 + (s_ * 64 + lane) * 2);
                        u32x4 v0, v1; v0.x = vv[0] | ((unsigned)vv[1] << 16); v0.y = vv[2] | ((unsigned)vv[3] << 16); v0.z = vv[4] | ((unsigned)vv[5] << 16); v0.w = vv[6] | ((unsigned)vv[7] << 16);
                        v1.x = vv[8] | ((unsigned)vv[9] << 16); v1.y = vv[10] | ((unsigned)vv[11] << 16); v1.z = vv[12] | ((unsigned)vv[13] << 16); v1.w = vv[14] | ((unsigned)vv[15] << 16);
                        *(LAS u32x4*)(sl + O_VT + lane * P_VT) = v0; *(LAS u32x4*)(sl + O_VT + lane * P_VT + 16) = v1; }
                }
            } else if (e2) {
                if ((n & 1) != epar) { if (n + 1 < NCH) RS_LOAD(n + 1); }
                else if (n < NCH) {
                    LAS unsigned char* sl = lds + (n % 3) * SLOT;
                    RS_STAGE();
                    float g = 1.0f; float bq[16], kq[16], xw[16], xa[16];
#pragma unroll
                    for (int t_ = 0; t_ < M; ++t_) { xw[t_] = RS_GET(0, t_); xa[t_] = RS_GET(2, t_); bq[t_] = RS_GET(1, t_); kq[t_] = RS_GET(3, t_); }
#pragma unroll
                    for (int t_ = 0; t_ < M; ++t_) { g *= xw[t_]; const float rg = __builtin_amdgcn_rcpf(g); const float al = xa[t_];
                        bq[t_] = bq[t_] * al * rg; kq[t_] = kq[t_] * (1.0f + (al - 1.0f) * kaj) * rg;
                        *(LAS unsigned short*)(sl + O_BK + t_ * P_BK + cpos) = f2bf(bq[t_]);
                        *(LAS unsigned short*)(sl + O_BK + (16 + t_) * P_BK + cpos) = f2bf(kq[t_]); }
                    LAS unsigned char* tp_ = sl + O_BKT + lane * P_BKT;
                    *(LAS bf16x8*)(tp_) = pack_bf8(bq[0], bq[1], bq[2], bq[3], bq[4], bq[5], bq[6], bq[7]); *(LAS bf16x8*)(tp_ + 16) = pack_bf8(bq[8], bq[9], bq[10], bq[11], bq[12], bq[13], bq[14], bq[15]);
                    *(LAS bf16x8*)(tp_ + 32) = pack_bf8(kq[0], kq[1], kq[2], kq[3], kq[4], kq[5], kq[6], kq[7]); *(LAS bf16x8*)(tp_ + 48) = pack_bf8(kq[8], kq[9], kq[10], kq[11], kq[12], kq[13], kq[14], kq[15]);
                }
            } else {
                const int c = n - 3;
                if (wid == 4)
                if (c >= 0 && c < NCH) { const LAS float* yb = (const LAS float*)(lds + O_YB + (c & 1) * 4096); const int t_ = lane >> 2, q_ = lane & 3;
                    const f32x4 y0 = *(const LAS f32x4*)(yb + t_ * 64 + 16 * q_), y1 = *(const LAS f32x4*)(yb + t_ * 64 + 16 * q_ + 4), y2 = *(const LAS f32x4*)(yb + t_ * 64 + 16 * q_ + 8), y3 = *(const LAS f32x4*)(yb + t_ * 64 + 16 * q_ + 12);
                    u32x4 w, w2; w.x = cvt_pk_bf16(y0[0], y0[1]); w.y = cvt_pk_bf16(y0[2], y0[3]); w.z = cvt_pk_bf16(y1[0], y1[1]); w.w = cvt_pk_bf16(y1[2], y1[3]);
                    w2.x = cvt_pk_bf16(y2[0], y2[1]); w2.y = cvt_pk_bf16(y2[2], y2[3]); w2.z = cvt_pk_bf16(y3[0], y3[1]); w2.w = cvt_pk_bf16(y3[2], y3[3]);
                    bf16_t* yp = YS + ((size_t)d * MTOK + RS_ROW(c, t_)) * 1024 + h * 64 + 16 * q_; *(u32x4*)yp = w; *(u32x4*)(yp + 8) = w2; }
#if SCAN_CONVERT
                if (n < NCH) { const int cw = (wid == 7) ? 1 : 0; const int piece = (bx * 2 + cw) + n * (G * 2);
                    if (piece < MOE_PIECES) convert_moe_piece(A, l, (LAS float*)(lds + O_CV + 32768 + cw * 4352), lane, piece); }
#endif
            }
            asm volatile("s_waitcnt lgkmcnt(0)" ::: "memory");
            __builtin_amdgcn_s_barrier();
            asm volatile("" ::: "memory");
        }
#undef RS_LOAD
#undef RS_STAGE
#undef RS_GET
#undef RS_ROW
    }
}

__device__ __forceinline__ void phase_attn(ArgsP A, int l, LAS unsigned char* lds, int tid, int bx, int G) {
    const bf16_t* PROJ = (const bf16_t*)(A->ws + WS_PROJ); bf16_t* MIX = (bf16_t*)(A->ws + WS_MIX);
    float s1 = 0.f, s2 = 0.f;
    for (int i = 0; i < 64; ++i) { s1 += ((const float*)A->in[I_LQ1])[l * 64 + i] * ((const float*)A->in[I_LK1])[l * 64 + i]; s2 += ((const float*)A->in[I_LQ2])[l * 64 + i] * ((const float*)A->in[I_LK2])[l * 64 + i]; }
    const float lam_init = 0.8f - 0.6f * expf(-0.3f * (float)l);
    const float lam = expf(s1) - expf(s2) + lam_init;
    unsigned* ctl = (unsigned*)(A->ws + WS_CTL);
    LAS int* uslot = (LAS int*)(lds + LDS_MISC + 2304);
    const int myx = (int)(xb_xcc_id() & 7u);
    for (int qi = 0; qi < 8; ++qi) {
        const int x = (myx + qi) & 7;
        for (;;) {
            if (tid == 0) *uslot = (int)__hip_atomic_fetch_add(ctl + CW_AQ + (l * 8 + x) * 64, 1u, __ATOMIC_RELAXED, __HIP_MEMORY_SCOPE_AGENT);
            __syncthreads();
            const int k = __builtin_amdgcn_readfirstlane(*uslot);
            __syncthreads();
            if (k >= 128) break;
            const int bh = 4 * x + (k >> 5), qb = k & 31;
            const int b = bh >> 3, h = bh & 7;
            const bf16_t* Qb = PROJ + ((size_t)b * SEQ + qb * 128) * NPROJP + h * 128;
            const bf16_t* Kh = PROJ + ((size_t)b * SEQ) * NPROJP + 1024 + h * 128;
            const bf16_t* Vh = PROJ + ((size_t)b * SEQ) * NPROJP + 2048 + h * 128;
            unsigned char* Ob = (unsigned char*)MIX + (((size_t)b * SEQ + qb * 128) * DM + h * 128) * (WOUT_FP8 ? 1 : 2);
            attn::attn_unit2(Qb, Kh, Vh, Ob, lam, 1.0f - lam_init, (const float*)A->in[I_SUBG] + l * 128, (char*)lds, tid);
        }
    }
}

__device__ __forceinline__ void phase_post(ArgsP A, int l, int lane, int wave, int bx, int G) {
    const bf16_t* SHR = (const bf16_t*)(A->ws + WS_SHR); const bf16_t* DYN = (const bf16_t*)(A->ws + WS_DYN); const bf16_t* YS = (const bf16_t*)(A->ws + WS_YS);
    bf16_t* MIX = (bf16_t*)(A->ws + WS_MIX);
    const int gw = bx * 8 + wave, NGW = G * 8, c = 16 * lane;
    float kav[16], rkv[16], gng[16], gnb[16];
#pragma unroll
    for (int j = 0; j < 16; ++j) { kav[j] = ((const float*)A->in[I_KA])[l * 1024 + c + j]; rkv[j] = ((const float*)A->in[I_RK])[l * 1024 + c + j];
        gng[j] = ((const float*)A->in[I_GNG])[l * 1024 + c + j]; gnb[j] = ((const float*)A->in[I_GNB])[l * 1024 + c + j]; }
    for (int row = gw; row < MTOK; row += NGW) {
        float y[16], t[16], r[16], k[16], v[16], a0[16], a1[16], g[16];
#define LD16(dst, ptr) do { float lo_[8], hi_[8]; unpack8(*(const u32x4*)(ptr), lo_); unpack8(*(const u32x4*)((ptr) + 8), hi_); _Pragma("unroll") for (int j_ = 0; j_ < 8; ++j_) { dst[j_] = lo_[j_]; dst[8 + j_] = hi_[j_]; } } while (0)
        LD16(y, YS + (size_t)row * 1024 + c); LD16(t, YS + ((size_t)MTOK + row) * 1024 + c);
        LD16(r, SHR + (size_t)row * 4096 + c); LD16(k, SHR + (size_t)row * 4096 + 1024 + c); LD16(v, SHR + (size_t)row * 4096 + 2048 + c);
        LD16(a0, DYN + (size_t)row * NDYN + 2048 + c); LD16(a1, DYN + (size_t)row * NDYN + 3072 + c); LD16(g, DYN + (size_t)row * NDYN + 4096 + c);
#undef LD16
        float s = 0.f, bo = 0.f;
#pragma unroll
        for (int j = 0; j < 16; ++j) { y[j] += t[j]; s += y[j]; bo += r[j] * (k[j] * (2.0f + (a0[j] + a1[j] - 2.0f) * kav[j])) * rkv[j]; }
        s += __shfl_xor(s, 1); s += __shfl_xor(s, 2); bo += __shfl_xor(bo, 1); bo += __shfl_xor(bo, 2);
        const float mean = s * (1.0f / 64.0f); float q = 0.f;
#pragma unroll
        for (int j = 0; j < 16; ++j) { y[j] -= mean; q += y[j] * y[j]; }
        q += __shfl_xor(q, 1); q += __shfl_xor(q, 2);
        const float rstd = 1.0f / sqrtf(q * (1.0f / 64.0f) + 64e-5f);
        float o[16];
#pragma unroll
        for (int j = 0; j < 16; ++j) o[j] = (y[j] * rstd * gng[j] + gnb[j] + bo * v[j]) * g[j];
        float o0[8], o1[8];
#pragma unroll
        for (int j = 0; j < 8; ++j) { o0[j] = o[j]; o1[j] = o[8 + j]; }
        if (WOUT_FP8) {
#pragma unroll
            for (int j = 0; j < 8; ++j) { o0[j] *= MIXSC; o1[j] *= MIXSC; }
            unsigned char* mp = (unsigned char*)MIX + (size_t)row * DM + 1024 + c; *(u32x2*)mp = pack8_fp8(o0); *(u32x2*)(mp + 8) = pack8_fp8(o1); }
        else { *(u32x4*)(MIX + (size_t)row * DM + 1024 + c) = pack8(o0); *(u32x4*)(MIX + (size_t)row * DM + 1024 + c + 8) = pack8(o1); }
    }
}

constexpr int NPL = 11, NPHASE = 1 + DEPTH * NPL + 1;
#ifndef ONLY_PHASE
#define ONLY_PHASE -1
#endif
#define PH_ON(k) (ONLY_PHASE < 0 || ONLY_PHASE == (k))
#ifndef REPEAT_PHASE
#define REPEAT_PHASE -1
#endif
#define REP(k, cond) for (int rep_ = 0; rep_ < ((REPEAT_PHASE == (k) && (cond)) ? 2 : 1); ++rep_)
__global__ void __launch_bounds__(512, 2) fwd(Args args) {
    extern __shared__ __attribute__((aligned(16))) unsigned char lds_raw[];
    LAS unsigned char* lds = (LAS unsigned char*)lds_raw;
    const int tid = threadIdx.x, lane = tid & 63, wave = __builtin_amdgcn_readfirstlane(tid >> 6), bx = blockIdx.x, G = gridDim.x;
    if (tid < 4) ((LAS unsigned*)(lds + LDS_MISC))[tid] = 0u;
    __syncthreads();
#if MK_PER_PHASE
#define GRID_BAR() do { } while (0)
#else
    XcdBarrier bar = xcd_barrier_post((unsigned*)(args.ws + WS_CTL) + CW_BAR, (volatile LAS unsigned*)(lds + LDS_MISC));
#define GRID_BAR() xcd_barrier(bar, phase_tid(wave))
#endif
    const int lo = args.ph_lo, hi = args.ph_hi;
#define IN(k) (lo <= (k) && (k) < hi)
#define SEAM(k) do { if (IN(k) && IN((k) + 1)) GRID_BAR(); } while (0)
    if (PH_ON(0) && IN(0)) REP(0, true) { asm volatile("; MARK_PHASE_0"); ArgsP A = phase_args(); const int tl = phase_tid(wave), ll = tl & 63, wl = __builtin_amdgcn_readfirstlane(tl >> 6); phase_prologue(A, lds, tl, ll, wl, bx, G); } SEAM(0);
    for (int l = 0; l < DEPTH; ++l) {
        const int p0 = 1 + l * NPL;
        if (PH_ON(1) && IN(p0 + 0)) REP(1, l == 0) { asm volatile("; MARK_PHASE_1"); ArgsP A = phase_args(); const int tl = phase_tid(wave), ll = tl & 63, wl = __builtin_amdgcn_readfirstlane(tl >> 6); if (l == 0) phase_norm1<0>(A, l, lds, tl, ll, wl, bx, G); else phase_norm1<1>(A, l, lds, tl, ll, wl, bx, G); } SEAM(p0 + 0);
        if (PH_ON(2) && IN(p0 + 1)) REP(2, true) {
            asm volatile("; MARK_PHASE_2"); ArgsP A = phase_args(); const int tl = phase_tid(wave), ll = tl & 63, wl = __builtin_amdgcn_readfirstlane(tl >> 6); unsigned char* ws = A->ws;
            int kk_ = DM; asm volatile("" : "+s"(kk_));
            pg8::Gemm g{(const bf16_t*)(ws + WS_H), (const bf16_t*)(ws + WS_WIN + (size_t)l * NPROJP * DM * (PROJ_FP8 ? 1 : 2)), kk_, 0, nullptr, 0};
            pg8::StaticOrder S; S.init(MTOK, NPROJP, G, bx);
            pg8::EpiProj E{(bf16_t*)(ws + WS_PROJ), (const float*)(ws + WS_ROPE), PROJ_FP8 ? 1.0f / WSC_IN : 1.0f};
            pg8::gemm_phase<pg8::EpiProj, pg8::StaticOrder, false, PROJ_FP8 != 0>(lds, g, S, E, tl);
        } SEAM(p0 + 1);
        if (PH_ON(3) && IN(p0 + 2)) REP(3, true) { asm volatile("; MARK_PHASE_3"); ArgsP A = phase_args(); const int tl = phase_tid(wave), ll = tl & 63, wl = __builtin_amdgcn_readfirstlane(tl >> 6); phase_prep(A, l, ll, wl, bx, G); } SEAM(p0 + 2);
        if (PH_ON(4) && IN(p0 + 3)) REP(4, true) {
            asm volatile("; MARK_PHASE_4"); ArgsP A = phase_args(); const int tl = phase_tid(wave), ll = tl & 63, wl = __builtin_amdgcn_readfirstlane(tl >> 6); unsigned char* ws = A->ws;
            int kla = KLA; asm volatile("" : "+s"(kla));
            int ntw = 2; asm volatile("" : "+s"(ntw));
            pg8::Gemm g{(const bf16_t*)(ws + WS_LA), (const bf16_t*)(ws + WS_LW) + (size_t)l * NDYN * KLA, kla, 0, nullptr, ntw};
            pg8::DynOrder S; S.init(MTOK, NDYN, G, bx);
            pg8::EpiDyn E{(bf16_t*)(ws + WS_DYN), (const float*)A->in[I_DW0] + l * 2048, (const float*)A->in[I_A0] + l * 2048};
            pg8::gemm_phase<pg8::EpiDyn, pg8::DynOrder, false>(lds, g, S, E, tl);
        } SEAM(p0 + 3);
        if (PH_ON(5) && IN(p0 + 4)) REP(5, true) { asm volatile("; MARK_PHASE_5"); ArgsP A = phase_args(); const int tl = phase_tid(wave), ll = tl & 63, wl = __builtin_amdgcn_readfirstlane(tl >> 6); phase_scan(A, l, lds, tl, bx, G); }
#if MK_PER_PHASE
        SEAM(p0 + 4);
#endif
        if (PH_ON(6) && IN(p0 + 5)) REP(6, true) { asm volatile("; MARK_PHASE_6"); ArgsP A = phase_args(); const int tl = phase_tid(wave), ll = tl & 63, wl = __builtin_amdgcn_readfirstlane(tl >> 6); phase_attn(A, l, lds, tl, bx, G); } SEAM(p0 + 5);
        if (PH_ON(7) && IN(p0 + 6)) REP(7, true) { asm volatile("; MARK_PHASE_7"); ArgsP A = phase_args(); const int tl = phase_tid(wave), ll = tl & 63, wl = __builtin_amdgcn_readfirstlane(tl >> 6); phase_post(A, l, ll, wl, bx, G); } SEAM(p0 + 6);
        if (PH_ON(8) && IN(p0 + 7)) REP(8, l == 0) {
            asm volatile("; MARK_PHASE_8"); ArgsP A = phase_args(); const int tl = phase_tid(wave), ll = tl & 63, wl = __builtin_amdgcn_readfirstlane(tl >> 6); unsigned char* ws = A->ws;
            int kk_ = DM; asm volatile("" : "+s"(kk_));
            pg8::Gemm g{(const bf16_t*)(ws + WS_MIX), (const bf16_t*)(ws + WS_WOUT + (size_t)l * DM * DM * (WOUT_FP8 ? 1 : 2)), kk_, 0, nullptr, 0};
            pg8::StaticOrder S; S.init(MTOK, DM, G, bx);
            pg8::EpiRes E{l == 0 ? (const float*)A->in[I_X] : (const float*)nullptr, (bf16_t*)(ws + WS_X), (const float*)(ws + WS_MOD) + (size_t)l * 4 * NMOD + 2 * DM, WOUT_FP8 ? 1.0f / (WSC_O * MIXSC) : 1.0f};
            pg8::gemm_phase<pg8::EpiRes, pg8::StaticOrder, false, WOUT_FP8 != 0>(lds, g, S, E, tl);
        } SEAM(p0 + 7);
        if (PH_ON(9) && IN(p0 + 8)) REP(9, true) { asm volatile("; MARK_PHASE_9"); ArgsP A = phase_args(); const int tl = phase_tid(wave), ll = tl & 63, wl = __builtin_amdgcn_readfirstlane(tl >> 6); phase_norm2_router(A, l, lds, tl, ll, wl, bx, G, rep_); } SEAM(p0 + 8);
        if (PH_ON(10) && IN(p0 + 9)) REP(10, true) {
            asm volatile("; MARK_PHASE_10"); ArgsP A = phase_args(); const int tl = phase_tid(wave), ll = tl & 63, wl = __builtin_amdgcn_readfirstlane(tl >> 6); unsigned char* ws = A->ws;
            load_moe_table(A, l, lds, tl);
            int kk_ = DM; asm volatile("" : "+s"(kk_));
            pg8::Gemm g{(const bf16_t*)(ws + WS_H), (const bf16_t*)(ws + WS_WGU), kk_, (size_t)2048 * DM, (const int*)(ws + WS_TOKL), 0};
            pg8::MoeOrder S{(const LAS int*)(lds + LDS_MISC + 64), (const LAS int*)(lds + LDS_MISC + 192), G, bx, __builtin_amdgcn_readfirstlane(((const LAS int*)(lds + LDS_MISC + 64))[16])};
            pg8::EpiGlu E{ws + WS_ACT, 1.0f / WSC_GU};
            pg8::gemm_phase<pg8::EpiGlu, pg8::MoeOrder, true, true>(lds, g, S, E, tl);
        } SEAM(p0 + 9);
        if (PH_ON(11) && IN(p0 + 10)) REP(11, true) {
            asm volatile("; MARK_PHASE_11"); ArgsP A = phase_args(); const int tl = phase_tid(wave), ll = tl & 63, wl = __builtin_amdgcn_readfirstlane(tl >> 6); unsigned char* ws = A->ws;
            load_moe_table(A, l, lds, tl);
            int kk_ = DFF; asm volatile("" : "+s"(kk_));
            pg8::Gemm g{(const bf16_t*)(ws + WS_ACT), (const bf16_t*)(ws + WS_WD), kk_, (size_t)DM * DFF, nullptr, 0};
            pg8::MoeOrder S{(const LAS int*)(lds + LDS_MISC + 64), (const LAS int*)(lds + LDS_MISC + 192), G, bx, __builtin_amdgcn_readfirstlane(((const LAS int*)(lds + LDS_MISC + 64))[16])};
            pg8::EpiY E{ws + WS_Y, YSC / WSC_D};
            pg8::gemm_phase<pg8::EpiY, pg8::MoeOrder, false, true>(lds, g, S, E, tl);
        } SEAM(p0 + 10);
    }
    if (PH_ON(12) && IN(NPHASE - 1)) { asm volatile("; MARK_PHASE_12"); ArgsP A = phase_args(); const int tl = phase_tid(wave), ll = tl & 63, wl = __builtin_amdgcn_readfirstlane(tl >> 6); phase_norm1<2>(A, DEPTH, lds, tl, ll, wl, bx, G); }
#undef IN
#undef SEAM
}

extern "C" void kernel_launch(void* const* d_in, const int* in_sizes, int n_in, void* d_out, int out_size, void* d_ws, size_t ws_size, hipStream_t stream) {
    static int grid = 0;
    if (grid == 0) {
        if (n_in != 31 || out_size != MTOK * DM || ws_size < WS_END) { fprintf(stderr, "kernel_launch: unexpected shapes (n_in %d out %d ws %zu, need %zu)\n", n_in, out_size, ws_size, (size_t)WS_END); grid = -1; return; }
        int dev = 0, cus = 0;
        if (hipGetDevice(&dev) != hipSuccess || hipDeviceGetAttribute(&cus, hipDeviceAttributeMultiprocessorCount, dev) != hipSuccess) { grid = -1; return; }
        if (hipFuncSetAttribute((const void*)fwd, hipFuncAttributeMaxDynamicSharedMemorySize, LDS_BYTES) != hipSuccess) { fprintf(stderr, "kernel_launch: hipFuncSetAttribute failed\n"); grid = -1; return; }
        int per_cu = 0;
        if (hipOccupancyMaxActiveBlocksPerMultiprocessor(&per_cu, (const void*)fwd, 512, LDS_BYTES) != hipSuccess || per_cu < 1) fprintf(stderr, "kernel_launch: occupancy query says %d\n", per_cu);
        (void)hipGetLastError();
        grid = cus;
    }
    if (grid < 0) return;
    (void)hipMemsetAsync((char*)d_ws + WS_CTL, 0, CTL_BYTES, stream);
    Args a{};
    for (int i = 0; i < 31; ++i) a.in[i] = d_in[i];
    a.out = (float*)d_out; a.ws = (unsigned char*)d_ws;
#if MK_PER_PHASE
    for (int p = 0; p < NPHASE; ++p) { a.ph_lo = p; a.ph_hi = p + 1; hipLaunchKernelGGL(fwd, dim3(grid), dim3(512), LDS_BYTES, stream, a); }
#else
    a.ph_lo = 0; a.ph_hi = NPHASE; hipLaunchKernelGGL(fwd, dim3(grid), dim3(512), LDS_BYTES, stream, a);
#endif
    const hipError_t le = hipPeekAtLastError();
    if (le != hipSuccess) fprintf(stderr, "kernel_launch: launch failed: %s\n", hipGetErrorName(le));
}
```

```cpp
#include <hip/hip_runtime.h>
#include <cstdio>
#include <cstdint>

#ifndef SCAN_CONVERT
#define SCAN_CONVERT 0
#endif
#ifndef PROJ_FP8
#define PROJ_FP8 1
#endif
#ifndef MK_PER_PHASE
#define MK_PER_PHASE 0
#endif

#define LAS __attribute__((address_space(3)))
typedef unsigned short bf16_t;
typedef short bf16x8 __attribute__((ext_vector_type(8)));
typedef short s16x4 __attribute__((ext_vector_type(4)));
typedef float f32x4 __attribute__((ext_vector_type(4)));
typedef float f32x2 __attribute__((ext_vector_type(2)));
typedef float f32x16 __attribute__((ext_vector_type(16)));
typedef unsigned u32x4 __attribute__((ext_vector_type(4)));
typedef unsigned u32x2 __attribute__((ext_vector_type(2)));

constexpr int BATCH = 4, SEQ = 4096, DM = 2048, MTOK = BATCH * SEQ, DEPTH = 2;
constexpr int NPROJ = 6528, NPROJP = 6656, RW0 = 3072, RWC = 3456;
constexpr int NEXP = 16, DFF = 1024, TOKCAP = 16384;
constexpr int NMOD = 6 * DM;
constexpr int NDYN = 5120, KLA = 384;
constexpr float C2 = 0.18033688011112042f;
constexpr int MAXTILES = 144;
#ifndef WOUT_FP8
#define WOUT_FP8 1
#endif
constexpr float WSC_O = 32.0f, MIXSC = 8.0f;
constexpr float WSC_GU = 32.0f, WSC_D = 16.0f, WSC_IN = 32.0f, YSC = 8.0f;

constexpr size_t MiB = 1u << 20;
constexpr size_t WS_CTL = 0, CTL_BYTES = 1 * MiB;
constexpr size_t WS_MOD = 1 * MiB;
constexpr size_t WS_ROPE = 2 * MiB;
constexpr size_t WS_TOKL = 3 * MiB;
constexpr size_t WS_ASG = 4 * MiB;
constexpr size_t WS_LW = 5 * MiB;
constexpr size_t WS_WIN = 13 * MiB;
constexpr size_t WS_WOUT = 65 * MiB;
constexpr size_t WS_WGU = 81 * MiB;
constexpr size_t WS_WD = 209 * MiB;
constexpr size_t WS_X = 273 * MiB;
constexpr size_t WS_H = 401 * MiB;
constexpr size_t WS_MIX = 466 * MiB;
constexpr size_t WS_PROJ = 530 * MiB;
constexpr size_t WS_SHR = 738 * MiB;
constexpr size_t WS_LA = 866 * MiB;
constexpr size_t WS_DYN = 878 * MiB;
constexpr size_t WS_YS = 1038 * MiB;
constexpr size_t WS_END = 1102 * MiB;
constexpr size_t WS_ACT = 530 * MiB;
constexpr size_t WS_Y = 602 * MiB;
constexpr int CW_BAR = 4096;
constexpr int CW_CNT = 16384;
constexpr int CW_AQ = 24576;

constexpr int LDS_MISC = 131072;
constexpr int LDS_BYTES = 147456;

__device__ __forceinline__ unsigned cvt_pk_bf16(float lo, float hi) { unsigned r; asm volatile("v_cvt_pk_bf16_f32 %0, %1, %2" : "=v"(r) : "v"(lo), "v"(hi)); return r; }
__device__ __forceinline__ float bflo(unsigned w) { return __uint_as_float(w << 16); }
__device__ __forceinline__ float bfhi(unsigned w) { return __uint_as_float(w & 0xffff0000u); }
__device__ __forceinline__ void unpack8(const u32x4 w, float (&f)[8]) { f[0] = bflo(w.x); f[1] = bfhi(w.x); f[2] = bflo(w.y); f[3] = bfhi(w.y); f[4] = bflo(w.z); f[5] = bfhi(w.z); f[6] = bflo(w.w); f[7] = bfhi(w.w); }
__device__ __forceinline__ u32x4 pack8(const float (&f)[8]) { u32x4 w; w.x = cvt_pk_bf16(f[0], f[1]); w.y = cvt_pk_bf16(f[2], f[3]); w.z = cvt_pk_bf16(f[4], f[5]); w.w = cvt_pk_bf16(f[6], f[7]); return w; }
__device__ __forceinline__ float sat8(float x) { return __builtin_amdgcn_fmed3f(x, -448.0f, 448.0f); }
__device__ __forceinline__ int pk4_fp8(float a, float b, float c, float d) { int w = 0; w = __builtin_amdgcn_cvt_pk_fp8_f32(sat8(a), sat8(b), w, false); w = __builtin_amdgcn_cvt_pk_fp8_f32(sat8(c), sat8(d), w, true); return w; }
__device__ __forceinline__ u32x2 pack8_fp8(const float (&f)[8]) { int a = 0, b = 0;
    a = pk4_fp8(f[0], f[1], f[2], f[3]); b = pk4_fp8(f[4], f[5], f[6], f[7]); u32x2 w; w.x = (unsigned)a; w.y = (unsigned)b; return w; }
__device__ __forceinline__ float sigmoidf_(float x) { return __builtin_amdgcn_rcpf(1.0f + __builtin_amdgcn_exp2f(-1.4426950408889634f * x)); }
__device__ __forceinline__ float wave_sum(float v) {
#pragma unroll
    for (int o = 1; o < 64; o <<= 1) v += __shfl_xor(v, o);
    return v;
}
#define LDS_WAIT() asm volatile("s_waitcnt lgkmcnt(0)" ::: "memory")
#define VM_WAIT() asm volatile("s_waitcnt vmcnt(0)" ::: "memory")

#define XB_TMO      128
#define XB_XCNT(j)  (256  + 64 * (j))
#define XB_XSUB(j)  (1280 + 64 * (j))
#define XB_XGEN(j)  (2304 + 64 * (j))
#define XB_TOP      3328
#define XB_TOPGEN   3392
#define XCD_BAR_WORDS 3456
#define XB_SPIN_CAP (1u << 18)

__device__ __forceinline__ unsigned xb_ld(unsigned* p)              { return __hip_atomic_load(p, __ATOMIC_RELAXED, __HIP_MEMORY_SCOPE_AGENT); }
__device__ __forceinline__ unsigned xb_add(unsigned* p, unsigned v) { return __hip_atomic_fetch_add(p, v, __ATOMIC_RELAXED, __HIP_MEMORY_SCOPE_AGENT); }
__device__ __forceinline__ unsigned xb_xcc_id() { return (unsigned)__builtin_amdgcn_s_getreg((3 << 11) | 20) & 0xFu; }
#define XB_SPIN(cond, bar) do { unsigned _sp = 0; while (cond) { __builtin_amdgcn_s_sleep(1); \
    if ((++_sp & 255u) == 0u) { if (xb_ld(&(bar)[XB_TMO])) break; if (_sp > XB_SPIN_CAP) { atomicAdd(&(bar)[XB_TMO], 1u); break; } } } } while (0)

struct XcdBarrier { unsigned* bar; unsigned x; volatile LAS unsigned* st; };

__device__ __forceinline__ XcdBarrier xcd_barrier_post(unsigned* bar, volatile LAS unsigned* st) {
    XcdBarrier b; b.bar = bar; b.x = xb_xcc_id(); b.st = st;
    if (threadIdx.x == 0) (void)xb_add(&bar[XB_XCNT(b.x)], 1u);
    return b;
}
__device__ __forceinline__ void xcd_barrier_complete(unsigned* bar, unsigned x, unsigned& nloc, unsigned& nx) {
    const unsigned G = gridDim.x * gridDim.y * gridDim.z;
    unsigned sum, cnt, mine, sp = 0u;
    for (;;) {
        sum = 0u; cnt = 0u; mine = 0u;
#pragma unroll
        for (unsigned j = 0; j < 16; ++j) { const unsigned c = xb_ld(&bar[XB_XCNT(j)]); sum += c; cnt += (c > 0u) ? 1u : 0u; mine = (j == x) ? c : mine; }
        if (sum == G) break;
        __builtin_amdgcn_s_sleep(1);
        if ((++sp & 255u) == 0u) { if (xb_ld(&bar[XB_TMO])) break; if (sp > XB_SPIN_CAP) { atomicAdd(&bar[XB_TMO], 1u); break; } }
    }
    nloc = mine > 0u ? mine : 1u; nx = cnt > 0u ? cnt : 1u;
}
__device__ __forceinline__ void xcd_barrier(const XcdBarrier& b, int tid_) {
    asm volatile("s_waitcnt vmcnt(0)" ::: "memory");
    __syncthreads();
    if (tid_ == 0) {
        unsigned* bar = b.bar;
        __builtin_amdgcn_s_waitcnt(0);
        unsigned nloc = b.st[0], nx = b.st[1];
        if (nloc == 0u) { xcd_barrier_complete(bar, b.x, nloc, nx); b.st[0] = nloc; b.st[1] = nx; }
        const unsigned old = xb_add(&bar[XB_XSUB(b.x)], 1u);
        const unsigned gen = old / nloc;
        if (old + 1u == (gen + 1u) * nloc) {
            __builtin_amdgcn_fence(__ATOMIC_RELEASE, "agent");
            asm volatile("s_waitcnt vmcnt(0)" ::: "memory");
            const unsigned og = xb_add(&bar[XB_TOP], 1u);
            const unsigned tg = og / nx;
            if (og + 1u == (tg + 1u) * nx) xb_add(&bar[XB_TOPGEN], 1u);
            else XB_SPIN(xb_ld(&bar[XB_TOPGEN]) == tg, bar);
            __builtin_amdgcn_fence(__ATOMIC_ACQUIRE, "agent");
            xb_add(&bar[XB_XGEN(b.x)], 1u);
            asm volatile("s_waitcnt vmcnt(0)" ::: "memory");
        } else {
            XB_SPIN(xb_ld(&bar[XB_XGEN(b.x)]) == gen, bar);
            __builtin_amdgcn_fence(__ATOMIC_ACQUIRE, "agent");
            asm volatile("s_waitcnt vmcnt(0)" ::: "memory");
        }
    }
    __syncthreads();
}

namespace pg8 {
constexpr int BM = 256, BK = 64, HALF = 128, HTB = HALF * BK * 2, STAGE_BYTES = 8 * HTB, NXCD = 8, WGM = 8;
__host__ __device__ __forceinline__ int lds_byte(int r, int c) { const int st = (r >> 4) * 2 + (c >> 5), rr = r & 15, cc = c & 31, ob = rr * 64 + cc * 2; return st * 1024 + (ob ^ (((ob >> 9) & 1) << 5)); }
__host__ __device__ __forceinline__ void stage_rc(int b, int& R, int& C) { const int st = b / 1024, sb = b % 1024, swz = sb ^ (((sb >> 9) & 1) << 5); R = (st >> 1) * 16 + swz / 64; C = (st & 1) * 32 + (swz % 64) / 2; }
__host__ __device__ __forceinline__ int perm32(int rho) { const int n = rho >> 4, i = rho & 15; return 8 * (i >> 2) + 4 * n + (i & 3); }

struct Unit { int pm, pn, e, jl, cnt, koff; };
struct Gemm { const bf16_t* A; const bf16_t* Bt; int K; size_t bstride; const int* tokl; int ntov; };

struct StaticOrder {
    int nM, nN, nwg, G, c;
    __device__ void init(int M, int N, int G_, int c_) { nM = M / BM; nN = N / BM; nwg = nM * nN; G = G_; c = c_; }
    __device__ bool next(int i, Unit& u) const {
        const long L = (long)i * G + c; if (L >= nwg) return false;
        int wgid = (int)L; { const int q = nwg / NXCD, r = nwg % NXCD, xcd = wgid % NXCD, off = wgid / NXCD; wgid = (xcd < r ? xcd * (q + 1) : r * (q + 1) + (xcd - r) * q) + off; }
        const int nig = WGM * nN, gid = wgid / nig, fm = gid * WGM, gsz = (nM - fm) < WGM ? (nM - fm) : WGM;
        u.pm = fm + ((wgid % nig) % gsz); u.pn = (wgid % nig) / gsz; u.e = 0; u.jl = 0; u.cnt = 0; u.koff = 0; return true;
    }
};
struct DynOrder : StaticOrder {
    __device__ bool next(int i, Unit& u) const { if (!StaticOrder::next(i, u)) return false; u.koff = (u.pn < 8 ? 0 : (u.pn < 16 ? 128 : 256)) * 2; return true; }
};
struct MoeOrder {
    const LAS int* tb; const LAS int* cn; int G, c, ntot;
    __device__ bool next(int i, Unit& u) const {
        const long L = (long)i * G + c; if (L >= (long)ntot * 8) return false;
        const int mt = (int)(L >> 3); int e = 0;
#pragma unroll
        for (int k = 1; k < 16; ++k) e += (mt >= tb[k]) ? 1 : 0;
        e = __builtin_amdgcn_readfirstlane(e);
        u.koff = 0; u.pm = mt; u.pn = (int)(L & 7); u.e = e; u.jl = __builtin_amdgcn_readfirstlane(mt - tb[e]); u.cnt = __builtin_amdgcn_readfirstlane(cn[e]); return true;
    }
};

typedef int i32x8 __attribute__((ext_vector_type(8)));
typedef int i32x4_ __attribute__((ext_vector_type(4)));
template <class Epi, class Sched, bool GATHER, bool FP8 = false>
__device__ __forceinline__ void gemm_phase(LAS unsigned char* lds, const Gemm g, const Sched& S, const Epi& E, const int tid) {
    const int wid = __builtin_amdgcn_readfirstlane(tid >> 6), lane = tid & 63, wr = wid >> 2, wc = wid & 3, fr = lane & 15, fq = lane >> 4;
    const int K = FP8 ? (g.K >> 1) : g.K, nt = g.ntov ? g.ntov : K / BK;
    unsigned voffA[2], voffB[2]; int Rr[2], Cc[2];
#pragma unroll
    for (int i = 0; i < 2; ++i) { int R, C; stage_rc(tid * 16 + i * 8192, R, C); const int Rb = Epi::PERM ? ((R & ~31) + perm32(R & 31)) : R;
        voffA[i] = (unsigned)(R * K + C) * 2u; voffB[i] = (unsigned)(Rb * K + C) * 2u; Rr[i] = R; Cc[i] = C; }
    const size_t kstep = (size_t)(BK * 2);
    const size_t hstep = (size_t)HALF * K * 2;
    const size_t tstep = 2 * hstep;
    const unsigned ldsw = (unsigned)wid * 1024u;
    const int aoff = lds_byte(wr * 64 + fr, fq * 8), boff = lds_byte(wc * 32 + fr, fq * 8);
#define PG8_SA(b, h) (((b) * 2 + (h)) * HTB)
#define PG8_SB(b, h) ((4 + (b) * 2 + (h)) * HTB)
#define PG8_STAGE(bufoff, gbase, voff) do { _Pragma("unroll") for (int _i = 0; _i < 2; ++_i) \
        __builtin_amdgcn_global_load_lds((const unsigned*)((const char*)(gbase) + (voff)[_i]), (LAS unsigned*)(lds + (bufoff) + ldsw + _i * 8192), 16, 0, 0); } while (0)
#define PG8_LDA(dst, b, h) do { _Pragma("unroll") for (int m = 0; m < 4; ++m) _Pragma("unroll") for (int k = 0; k < 2; ++k) dst[m][k] = *(const LAS bf16x8*)(lds + PG8_SA(b, h) + aoff + m * 2048 + k * 1024); } while (0)
#define PG8_LDB(dst, b, h) do { _Pragma("unroll") for (int n = 0; n < 2; ++n) _Pragma("unroll") for (int k = 0; k < 2; ++k) dst[n][k] = *(const LAS bf16x8*)(lds + PG8_SB(b, h) + boff + n * 2048 + k * 1024); } while (0)
#define PG8_CAT(x) __builtin_shufflevector(__builtin_bit_cast(i32x4_, (x)[0]), __builtin_bit_cast(i32x4_, (x)[1]), 0, 1, 2, 3, 4, 5, 6, 7)
#define PG8_MMA(ai, bj, At, Bt) do { __builtin_amdgcn_s_setprio(1); \
        if constexpr (FP8) { _Pragma("unroll") for (int m = 0; m < 4; ++m) _Pragma("unroll") for (int n = 0; n < 2; ++n) \
            { const i32x8 b8_ = PG8_CAT(Bt[n]), a8_ = PG8_CAT(At[m]); \
              asm volatile("v_mfma_scale_f32_16x16x128_f8f6f4 %0, %1, %2, %0, %3, %3 op_sel_hi:[0,0,0]" : "+v"(acc[ai][bj][m][n]) : "v"(b8_), "v"(a8_), "v"(0x7F7F7F7F)); } } \
        else { _Pragma("unroll") for (int m = 0; m < 4; ++m) _Pragma("unroll") for (int n = 0; n < 2; ++n) _Pragma("unroll") for (int k = 0; k < 2; ++k) \
            acc[ai][bj][m][n] = __builtin_amdgcn_mfma_f32_16x16x32_bf16(Bt[n][k], At[m][k], acc[ai][bj][m][n], 0, 0, 0); } \
        __builtin_amdgcn_s_setprio(0); } while (0)
#define PG8_WAIT_V(n) asm volatile("s_waitcnt vmcnt(" #n ")" ::: "memory")
#define PG8_WAIT_L(n) asm volatile("s_waitcnt lgkmcnt(" #n ")" ::: "memory")
#define PG8_BAR __builtin_amdgcn_s_barrier()
#define PG8_SCHED __builtin_amdgcn_sched_barrier(0)
#define PG8_GOFF(dst, u) do { _Pragma("unroll") for (int _h = 0; _h < 2; ++_h) _Pragma("unroll") for (int _i = 0; _i < 2; ++_i) { \
        const int _slot = (u).jl * 256 + _h * 128 + Rr[_i]; const int _tok = (_slot < (u).cnt) ? g.tokl[(u).e * TOKCAP + _slot] : 0; dst[_h][_i] = (unsigned)(_tok * K + Cc[_i]) * 2u; } } while (0)
    Unit cur, nxt; int ui = 0;
    if (!S.next(0, cur)) return;
    f32x4 acc[2][2][4][2];
#pragma unroll
    for (int a = 0; a < 2; ++a)
#pragma unroll
        for (int b = 0; b < 2; ++b)
#pragma unroll
            for (int m = 0; m < 4; ++m)
#pragma unroll
                for (int n = 0; n < 2; ++n) acc[a][b][m][n] = (f32x4){0.f, 0.f, 0.f, 0.f};
    bf16x8 At[4][2], B0[2][2], B1[2][2];
    const char* Ab = (const char*)g.A;
    const char* cA = Ab + (size_t)cur.pm * tstep + cur.koff; const char* cB = (const char*)g.Bt + (size_t)cur.e * g.bstride + (size_t)cur.pn * tstep + cur.koff;
    unsigned offc[2][2], offn[2][2];
    if constexpr (GATHER) { PG8_GOFF(offc, cur); }
#define PG8_STA_C(bufoff, h, kb) do { if constexpr (GATHER) { PG8_STAGE(bufoff, Ab + (kb), offc[h]); } else { PG8_STAGE(bufoff, cA + (h) * hstep + (kb), voffA); } } while (0)
    PG8_STAGE(PG8_SB(0, 0), cB, voffB); PG8_STAGE(PG8_SB(0, 1), cB + hstep, voffB); PG8_STA_C(PG8_SA(0, 0), 0, 0); PG8_STA_C(PG8_SA(0, 1), 1, 0);
    if (wr == 1) PG8_BAR;
    PG8_WAIT_V(2); PG8_BAR;
    PG8_STAGE(PG8_SB(1, 0), cB + kstep, voffB); PG8_STA_C(PG8_SA(1, 0), 0, kstep); PG8_STAGE(PG8_SB(1, 1), cB + hstep + kstep, voffB);
    PG8_WAIT_V(6); PG8_BAR;
    for (;;) {
        const bool has_next = S.next(ui + 1, nxt);
        const char* nA = has_next ? Ab + (size_t)nxt.pm * tstep + nxt.koff : cA; const char* nB = has_next ? (const char*)g.Bt + (size_t)nxt.e * g.bstride + (size_t)nxt.pn * tstep + nxt.koff : cB;
        if constexpr (GATHER) {
            if (has_next) { PG8_GOFF(offn, nxt); }
            else {
#pragma unroll
                for (int h = 0; h < 2; ++h)
#pragma unroll
                    for (int i = 0; i < 2; ++i) offn[h][i] = offc[h][i]; }
        }
        for (int t = 0; t < nt; t += 2) {
            const bool last = (t == nt - 2);
            const size_t kb1 = (size_t)(t + 1) * kstep;
            const char* b2 = last ? nB : cB + (size_t)(t + 2) * kstep; const char* b3 = b2 + kstep;
            const char* a2 = last ? nA : cA + (size_t)(t + 2) * kstep; const char* a3 = a2 + kstep;
            unsigned o2[2][2]; size_t kb2 = last ? 0 : (size_t)(t + 2) * kstep;
            if constexpr (GATHER) {
#pragma unroll
                for (int h = 0; h < 2; ++h)
#pragma unroll
                    for (int i = 0; i < 2; ++i) o2[h][i] = last ? offn[h][i] : offc[h][i];
            }
#define PG8_STA_2(bufoff, h, extra) do { if constexpr (GATHER) { PG8_STAGE(bufoff, Ab + kb2 + (extra), o2[h]); } else { PG8_STAGE(bufoff, a2 + (h) * hstep + (extra), voffA); } } while (0)
            PG8_LDB(B0, 0, 0); PG8_LDB(B1, 0, 1); PG8_SCHED; PG8_LDA(At, 0, 0); PG8_STA_C(PG8_SA(1, 1), 1, kb1);
            PG8_WAIT_V(8); PG8_WAIT_L(0); PG8_BAR; PG8_MMA(0, 0, At, B0); PG8_MMA(0, 1, At, B1); PG8_BAR; PG8_SCHED;
            PG8_LDA(At, 0, 1); PG8_STAGE(PG8_SB(0, 0), b2, voffB); PG8_STAGE(PG8_SB(0, 1), b2 + hstep, voffB); PG8_STA_2(PG8_SA(0, 0), 0, 0);
            PG8_WAIT_V(8); PG8_WAIT_L(0); PG8_BAR; PG8_MMA(1, 0, At, B0); PG8_MMA(1, 1, At, B1); PG8_BAR; PG8_SCHED;
            PG8_LDB(B0, 1, 0); PG8_LDB(B1, 1, 1); PG8_SCHED; PG8_LDA(At, 1, 0); PG8_STA_2(PG8_SA(0, 1), 1, 0);
            PG8_WAIT_V(8); PG8_WAIT_L(0); PG8_BAR; PG8_MMA(0, 0, At, B0); PG8_MMA(0, 1, At, B1); PG8_BAR; PG8_SCHED;
            PG8_LDA(At, 1, 1); PG8_STAGE(PG8_SB(1, 0), b3, voffB); PG8_STAGE(PG8_SB(1, 1), b3 + hstep, voffB); PG8_STA_2(PG8_SA(1, 0), 0, kstep);
            PG8_WAIT_V(8); PG8_WAIT_L(0); PG8_BAR; PG8_MMA(1, 0, At, B0); PG8_MMA(1, 1, At, B1); PG8_BAR; PG8_SCHED;
#undef PG8_STA_2
            (void)a3;
        }
        if (wr == 0) PG8_BAR;
        { int l2 = lane; asm volatile("" : "+v"(l2)); E(acc, cur, wr, wc, l2 & 15, l2 >> 4); }
        if (!has_next) break;
#pragma unroll
        for (int a = 0; a < 2; ++a)
#pragma unroll
            for (int b = 0; b < 2; ++b)
#pragma unroll
                for (int m = 0; m < 4; ++m)
#pragma unroll
                    for (int n = 0; n < 2; ++n) acc[a][b][m][n] = (f32x4){0.f, 0.f, 0.f, 0.f};
        cur = nxt; cA = nA; cB = nB; ++ui;
        if constexpr (GATHER) {
#pragma unroll
            for (int h = 0; h < 2; ++h)
#pragma unroll
                for (int i = 0; i < 2; ++i) offc[h][i] = offn[h][i];
        }
        if (wr == 1) PG8_BAR;
    }
    PG8_WAIT_V(0);
    PG8_BAR;
#undef PG8_STA_C
#undef PG8_GOFF
#undef PG8_SA
#undef PG8_SB
#undef PG8_STAGE
#undef PG8_LDA
#undef PG8_LDB
#undef PG8_MMA
#undef PG8_CAT
#undef PG8_WAIT_V
#undef PG8_WAIT_L
#undef PG8_BAR
#undef PG8_SCHED
}

struct EpiProj {
    static constexpr bool PERM = true;
    bf16_t* O; const float* rope; float inv;
    __device__ __forceinline__ void operator()(const f32x4 (&acc)[2][2][4][2], const Unit& u, int wr, int wc, int fr, int fq) const {
        const int row0 = u.pm * BM + wr * 64 + fr, col0 = u.pn * BM + wc * 32 + 8 * fq;
        const bool dorope = (u.pn < 8) && ((wc & 1) == 0) && (fq < 2);
        const float sc = ((u.pn < 4) ? C2 : 1.0f) * inv;
#pragma unroll
        for (int ai = 0; ai < 2; ++ai)
#pragma unroll
            for (int m = 0; m < 4; ++m) {
                const int row = row0 + ai * HALF + m * 16;
                bf16_t* rowp = O + (size_t)row * NPROJP + col0;
                f32x4 cs = (f32x4){1.f, 1.f, 1.f, 1.f}, sn = (f32x4){0.f, 0.f, 0.f, 0.f};
                if (dorope) { cs = *(const f32x4*)(rope + (size_t)row * 16 + 4 * fq); sn = *(const f32x4*)(rope + (size_t)row * 16 + 8 + 4 * fq); }
#pragma unroll
                for (int bj = 0; bj < 2; ++bj) {
                    f32x4 v0 = acc[ai][bj][m][0], v1 = acc[ai][bj][m][1];
                    const f32x4 r0 = (v0 * cs - v1 * sn) * sc, r1 = (v1 * cs + v0 * sn) * sc;
                    u32x4 w; w.x = cvt_pk_bf16(r0[0], r0[1]); w.y = cvt_pk_bf16(r0[2], r0[3]); w.z = cvt_pk_bf16(r1[0], r1[1]); w.w = cvt_pk_bf16(r1[2], r1[3]);
                    *(u32x4*)(rowp + bj * HALF) = w; }
            }
    }
};
struct EpiDyn {
    static constexpr bool PERM = true;
    bf16_t* O; const float* w0; const float* a0;
    __device__ __forceinline__ void operator()(const f32x4 (&acc)[2][2][4][2], const Unit& u, int wr, int wc, int fr, int fq) const {
        const int row0 = u.pm * BM + wr * 64 + fr, col0 = u.pn * BM + wc * 32 + 8 * fq;
        const int kind = u.pn >> 3;
        const float* bsrc = (kind == 0) ? (w0 + col0) : (a0 + (col0 - 2048));
#pragma unroll
        for (int bj = 0; bj < 2; ++bj) {
            f32x4 b0 = (f32x4){0.f, 0.f, 0.f, 0.f}, b1 = b0;
            if (kind < 2) { b0 = *(const f32x4*)(bsrc + bj * HALF); b1 = *(const f32x4*)(bsrc + bj * HALF + 4); }
#pragma unroll
            for (int ai = 0; ai < 2; ++ai)
#pragma unroll
                for (int m = 0; m < 4; ++m) {
                    f32x4 v0 = acc[ai][bj][m][0] + b0, v1 = acc[ai][bj][m][1] + b1;
                    if (kind < 2) {
#pragma unroll
                        for (int j = 0; j < 4; ++j) { float s0 = sigmoidf_(v0[j]), s1 = sigmoidf_(v1[j]);
                            if (kind == 0) { s0 = __builtin_amdgcn_exp2f(-0.875039f * s0); s1 = __builtin_amdgcn_exp2f(-0.875039f * s1); }
                            v0[j] = s0; v1[j] = s1; } }
                    u32x4 w; w.x = cvt_pk_bf16(v0[0], v0[1]); w.y = cvt_pk_bf16(v0[2], v0[3]); w.z = cvt_pk_bf16(v1[0], v1[1]); w.w = cvt_pk_bf16(v1[2], v1[3]);
                    *(u32x4*)(O + (size_t)(row0 + ai * HALF + m * 16) * NDYN + col0 + bj * HALF) = w;
                    __builtin_amdgcn_sched_barrier(0); }
        }
    }
};
struct EpiRes {
    static constexpr bool PERM = true;
    const float* xin32; bf16_t* X; const float* g1; float inv;
    __device__ __forceinline__ void operator()(const f32x4 (&acc)[2][2][4][2], const Unit& u, int wr, int wc, int fr, int fq) const {
        const int row0 = u.pm * BM + wr * 64 + fr, col0 = u.pn * BM + wc * 32 + 8 * fq;
        const int b = (u.pm * BM) / SEQ;
        f32x4 gv[2][2];
#pragma unroll
        for (int bj = 0; bj < 2; ++bj)
#pragma unroll
            for (int n = 0; n < 2; ++n) gv[bj][n] = *(const f32x4*)(g1 + (size_t)b * NMOD + col0 + bj * HALF + 4 * n) * inv;
#pragma unroll
        for (int ai = 0; ai < 2; ++ai)
#pragma unroll
            for (int m = 0; m < 4; ++m) { const size_t off = (size_t)(row0 + ai * HALF + m * 16) * DM + col0;
#pragma unroll
                for (int bj = 0; bj < 2; ++bj) { f32x4 x0, x1;
                    if (xin32) { x0 = *(const f32x4*)(xin32 + off + bj * HALF); x1 = *(const f32x4*)(xin32 + off + bj * HALF + 4); }
                    else { const u32x4 p = *(const u32x4*)(X + off + bj * HALF); x0 = (f32x4){bflo(p.x), bfhi(p.x), bflo(p.y), bfhi(p.y)}; x1 = (f32x4){bflo(p.z), bfhi(p.z), bflo(p.w), bfhi(p.w)}; }
                    const f32x4 r0 = x0 + gv[bj][0] * acc[ai][bj][m][0], r1 = x1 + gv[bj][1] * acc[ai][bj][m][1];
                    u32x4 w; w.x = cvt_pk_bf16(r0[0], r0[1]); w.y = cvt_pk_bf16(r0[2], r0[3]); w.z = cvt_pk_bf16(r1[0], r1[1]); w.w = cvt_pk_bf16(r1[2], r1[3]);
                    *(u32x4*)(X + off + bj * HALF) = w; } }
    }
};
struct EpiGlu {
    static constexpr bool PERM = true;
    unsigned char* O; float inv;
    __device__ __forceinline__ void operator()(const f32x4 (&acc)[2][2][4][2], const Unit& u, int wr, int wc, int fr, int fq) const {
        const int row0 = u.pm * BM + wr * 64 + fr, j0 = u.pn * 128 + wc * 16 + 4 * fq;
#pragma unroll
        for (int ai = 0; ai < 2; ++ai)
#pragma unroll
            for (int m = 0; m < 4; ++m) { unsigned char* rowp = O + (size_t)(row0 + ai * HALF + m * 16) * DFF + j0;
#pragma unroll
                for (int bj = 0; bj < 2; ++bj) { const f32x4 gt = acc[ai][bj][m][0] * inv, up = acc[ai][bj][m][1] * inv; f32x4 r;
#pragma unroll
                    for (int j = 0; j < 4; ++j) r[j] = gt[j] * sigmoidf_(gt[j]) * up[j];
                    *(int*)(rowp + bj * 64) = pk4_fp8(r[0], r[1], r[2], r[3]); } }
    }
};
struct EpiY {
    static constexpr bool PERM = true;
    unsigned char* O; float inv;
    __device__ __forceinline__ void operator()(const f32x4 (&acc)[2][2][4][2], const Unit& u, int wr, int wc, int fr, int fq) const {
        const int row0 = u.pm * BM + wr * 64 + fr, col0 = u.pn * BM + wc * 32 + 8 * fq;
#pragma unroll
        for (int ai = 0; ai < 2; ++ai)
#pragma unroll
            for (int m = 0; m < 4; ++m) { unsigned char* rowp = O + (size_t)(row0 + ai * HALF + m * 16) * DM + col0;
#pragma unroll
                for (int bj = 0; bj < 2; ++bj) { const f32x4 v0 = acc[ai][bj][m][0] * inv, v1 = acc[ai][bj][m][1] * inv;
                    u32x2 w; w.x = (unsigned)pk4_fp8(v0[0], v0[1], v0[2], v0[3]); w.y = (unsigned)pk4_fp8(v1[0], v1[1], v1[2], v1[3]);
                    *(u32x2*)(rowp + bj * HALF) = w; } }
    }
};
}

namespace attn {
constexpr int KVBLK = 64;
constexpr size_t SHM_V = KVBLK * 128 * 2, SHM_K = KVBLK * 128 * 2;
constexpr int WS_OFF = 3 * SHM_V + 3 * SHM_K;
constexpr float THRL = 8.0f;
#define KSWZ(row, colB) ((row) * 256 + ((colB) ^ (((row) & 7) << 4)))
#define SBAR() __builtin_amdgcn_sched_barrier(0)
__device__ __forceinline__ int crow(int r, int hi) { return (r & 3) + 8 * (r >> 2) + 4 * hi; }

__device__ __forceinline__ void partialSM(f32x16& p0, f32x16& p1, float& m_reg, float& mn, float& alpha) {
    float pmax = p0[0];
#pragma unroll
    for (int r = 1; r < 16; ++r) pmax = fmaxf(pmax, p0[r]);
#pragma unroll
    for (int r = 0; r < 16; ++r) pmax = fmaxf(pmax, p1[r]);
    { auto rr = __builtin_amdgcn_permlane32_swap(__float_as_uint(pmax), __float_as_uint(pmax), false, false);
      pmax = fmaxf(__uint_as_float(rr[0]), __uint_as_float(rr[1])); }
    if (__builtin_expect(__all(pmax - m_reg <= THRL), 1)) { mn = m_reg; alpha = 1.f; }
    else { mn = fmaxf(m_reg, pmax); alpha = __builtin_amdgcn_exp2f(m_reg - mn); m_reg = mn; }
#pragma unroll
    for (int r = 0; r < 16; ++r) p0[r] = p0[r] - mn;
#pragma unroll
    for (int r = 0; r < 16; ++r) p1[r] = p1[r] - mn;
#pragma unroll
    for (int r = 0; r < 16; ++r) p0[r] = __builtin_amdgcn_exp2f(p0[r]);
}
__device__ __forceinline__ void finishSM(f32x16& p0, f32x16& p1, float alpha, float& l_reg, bf16x8& pa0, bf16x8& pa1, bf16x8& pa2, bf16x8& pa3) {
#pragma unroll
    for (int r = 0; r < 16; ++r) p1[r] = __builtin_amdgcn_exp2f(p1[r]);
    float ps = 0;
#pragma unroll
    for (int r = 0; r < 16; ++r) ps += p0[r];
#pragma unroll
    for (int r = 0; r < 16; ++r) ps += p1[r];
    { auto rr = __builtin_amdgcn_permlane32_swap(__float_as_uint(ps), __float_as_uint(ps), false, false);
      ps = __uint_as_float(rr[0]) + __uint_as_float(rr[1]); }
    l_reg = l_reg * alpha + ps;
#define PK4(P, BASE, OUT) do { u32x4 w = {cvt_pk_bf16(P[BASE + 0], P[BASE + 1]), cvt_pk_bf16(P[BASE + 2], P[BASE + 3]), cvt_pk_bf16(P[BASE + 4], P[BASE + 5]), cvt_pk_bf16(P[BASE + 6], P[BASE + 7])}; \
    OUT = *reinterpret_cast<bf16x8*>(&w); } while (0)
    PK4(p0, 0, pa0); PK4(p0, 8, pa1); PK4(p1, 0, pa2); PK4(p1, 8, pa3);
#undef PK4
}
__device__ __forceinline__ void qkt(f32x16& p0, f32x16& p1, const char* Ks, const bf16x8* qr, int r32, int hi, int comp) {
    p0 = f32x16{}; p1 = f32x16{};
#pragma unroll
    for (int d0 = 0; d0 < 4; ++d0) { const int cb = ((comp * 4 + d0) * 16 + hi * 8) * 2;
        bf16x8 b0 = *reinterpret_cast<const bf16x8*>(Ks + KSWZ(r32, cb));
        bf16x8 b1 = *reinterpret_cast<const bf16x8*>(Ks + KSWZ(32 + r32, cb));
        p0 = __builtin_amdgcn_mfma_f32_32x32x16_bf16(b0, qr[d0], p0, 0, 0, 0);
        p1 = __builtin_amdgcn_mfma_f32_32x32x16_bf16(b1, qr[d0], p1, 0, 0, 0); }
}
__device__ __forceinline__ void qk_sm(f32x16& n0, f32x16& n1, const char* Ks, const bf16x8* qr, int r32, int hi, int comp,
                                      f32x16& p0, f32x16& p1, float alpha, float& l_reg, bf16x8& pa0, bf16x8& pa1, bf16x8& pa2, bf16x8& pa3) {
#define LDKF(D0, R) *reinterpret_cast<const bf16x8*>(Ks + KSWZ((R), ((comp * 4 + (D0)) * 16 + hi * 8) * 2))
#define EX2(P, B) P[B] = __builtin_amdgcn_exp2f(P[B]); P[B + 1] = __builtin_amdgcn_exp2f(P[B + 1]); asm volatile("" : "+v"(P[B]), "+v"(P[B + 1]))
#define QMF(N, KF, D0) SBAR(); N = __builtin_amdgcn_mfma_f32_32x32x16_bf16(KF, qr[D0], N, 0, 0, 0); SBAR()
    SBAR();
    const bf16x8 k00 = LDKF(0, r32), k01 = LDKF(0, 32 + r32), k10 = LDKF(1, r32), k11 = LDKF(1, 32 + r32);
    SBAR();
    EX2(p1, 0); EX2(p1, 2); EX2(p1, 4); EX2(p1, 6);
    SBAR(); n0 = __builtin_amdgcn_mfma_f32_32x32x16_bf16(k00, qr[0], f32x16{}, 0, 0, 0); SBAR();
    EX2(p1, 8);
    SBAR(); n1 = __builtin_amdgcn_mfma_f32_32x32x16_bf16(k01, qr[0], f32x16{}, 0, 0, 0); SBAR();
    EX2(p1, 10);
    const bf16x8 k20 = LDKF(2, r32), k21 = LDKF(2, 32 + r32);
    QMF(n0, k10, 1); EX2(p1, 12);
    QMF(n1, k11, 1); EX2(p1, 14);
    const bf16x8 k30 = LDKF(3, r32), k31 = LDKF(3, 32 + r32);
    QMF(n0, k20, 2);
    float s0 = p0[0] + p0[1], s1 = p0[2] + p0[3]; s0 += p0[4]; s1 += p0[5]; s0 += p0[6]; s1 += p0[7]; s0 += p0[8]; s1 += p0[9];
    QMF(n1, k21, 2);
    s0 += p0[10]; s1 += p0[11]; s0 += p0[12]; s1 += p0[13]; s0 += p0[14]; s1 += p0[15]; s0 += p1[0]; s1 += p1[1];
    QMF(n0, k30, 3);
    s0 += p1[2]; s1 += p1[3]; s0 += p1[4]; s1 += p1[5]; s0 += p1[6]; s1 += p1[7]; s0 += p1[8]; s1 += p1[9];
    QMF(n1, k31, 3);
    s0 += p1[10]; s1 += p1[11]; s0 += p1[12]; s1 += p1[13]; s0 += p1[14]; s1 += p1[15]; float ps = s0 + s1;
    { auto rr = __builtin_amdgcn_permlane32_swap(__float_as_uint(ps), __float_as_uint(ps), false, false);
      ps = __uint_as_float(rr[0]) + __uint_as_float(rr[1]); }
    l_reg = l_reg * alpha + ps;
#define PK4(P, BASE, OUT) do { u32x4 w = {cvt_pk_bf16(P[BASE + 0], P[BASE + 1]), cvt_pk_bf16(P[BASE + 2], P[BASE + 3]), cvt_pk_bf16(P[BASE + 4], P[BASE + 5]), cvt_pk_bf16(P[BASE + 6], P[BASE + 7])}; \
    OUT = *reinterpret_cast<bf16x8*>(&w); } while (0)
    PK4(p0, 0, pa0); PK4(p0, 8, pa1); PK4(p1, 0, pa2); PK4(p1, 8, pa3);
    SBAR();
#undef PK4
#undef LDKF
#undef EX2
#undef QMF
}
__device__ __forceinline__ int v_st(int k, int c) { const int kk = k; return ((kk >> 3) * 4 + (c >> 5)) * 512 + ((kk & 7) * 32 + (c & 31)) * 2; }
__device__ __forceinline__ int v_rd_base(int lane) { return ((lane & 3) << 3) | (((lane >> 2) & 3) << 6) | (((lane >> 4) & 1) << 5) | (((lane >> 5) & 1) << 8); }
constexpr int v_rd_off(int d0, int ks, int half) { return d0 * 512 + ks * 4096 + half * 2048; }
template <int OFF> __device__ __forceinline__ s16x4 tr_read(int vb) {
    s16x4 r; asm volatile("ds_read_b64_tr_b16 %0, %1 offset:%2" : "=&v"(r) : "v"(vb), "i"(OFF) : "memory"); return r;
}
template <int D0> __device__ __forceinline__ void pv_one(f32x16& od, int vb, bf16x8 pa0, bf16x8 pa1, bf16x8 pa2, bf16x8 pa3) {
    const s16x4 l0 = tr_read<v_rd_off(D0, 0, 0)>(vb), h0 = tr_read<v_rd_off(D0, 0, 1)>(vb), l1 = tr_read<v_rd_off(D0, 1, 0)>(vb), h1 = tr_read<v_rd_off(D0, 1, 1)>(vb);
    const s16x4 l2 = tr_read<v_rd_off(D0, 2, 0)>(vb), h2 = tr_read<v_rd_off(D0, 2, 1)>(vb), l3 = tr_read<v_rd_off(D0, 3, 0)>(vb), h3 = tr_read<v_rd_off(D0, 3, 1)>(vb);
    asm volatile("s_waitcnt lgkmcnt(0)" ::: "memory"); SBAR();
#define PK(L, H) (bf16x8){L[0], L[1], L[2], L[3], H[0], H[1], H[2], H[3]}
    od = __builtin_amdgcn_mfma_f32_32x32x16_bf16(pa0, PK(l0, h0), od, 0, 0, 0);
    od = __builtin_amdgcn_mfma_f32_32x32x16_bf16(pa1, PK(l1, h1), od, 0, 0, 0);
    od = __builtin_amdgcn_mfma_f32_32x32x16_bf16(pa2, PK(l2, h2), od, 0, 0, 0);
    od = __builtin_amdgcn_mfma_f32_32x32x16_bf16(pa3, PK(l3, h3), od, 0, 0, 0);
#undef PK
}
__device__ __forceinline__ void pv_d0(f32x16* o, int vb, bf16x8 pa0, bf16x8 pa1, bf16x8 pa2, bf16x8 pa3) {
    pv_one<0>(o[0], vb, pa0, pa1, pa2, pa3); pv_one<1>(o[1], vb, pa0, pa1, pa2, pa3); pv_one<2>(o[2], vb, pa0, pa1, pa2, pa3); pv_one<3>(o[3], vb, pa0, pa1, pa2, pa3);
}
template <class Mid> __device__ __forceinline__ void pv_sm(f32x16* o, int vb, bf16x8 pa0, bf16x8 pa1, bf16x8 pa2, bf16x8 pa3, f32x16& p0, f32x16& p1, float& m_reg, float& mn, float& alpha, Mid mid) {
#define TRD(D0, KS, H) tr_read<v_rd_off(D0, KS, H)>(vb)
#define PKV(L, H) (bf16x8){L[0], L[1], L[2], L[3], H[0], H[1], H[2], H[3]}
#define MF(D0, PA, L, H) SBAR(); o[D0] = __builtin_amdgcn_mfma_f32_32x32x16_bf16(PA, PKV(L, H), o[D0], 0, 0, 0); SBAR()
#define WAITL(n) asm volatile("s_waitcnt lgkmcnt(" #n ")" ::: "memory")
#define MX3(a, b, c) fmaxf(fmaxf(a, b), c)
#define SUB8(P, B) P[B] -= mn; P[B + 1] -= mn; P[B + 2] -= mn; P[B + 3] -= mn; P[B + 4] -= mn; P[B + 5] -= mn; P[B + 6] -= mn; P[B + 7] -= mn; \
    asm volatile("" : "+v"(P[B]), "+v"(P[B + 1]), "+v"(P[B + 2]), "+v"(P[B + 3]), "+v"(P[B + 4]), "+v"(P[B + 5]), "+v"(P[B + 6]), "+v"(P[B + 7]))
#define EX2(P, B) P[B] = __builtin_amdgcn_exp2f(P[B]); P[B + 1] = __builtin_amdgcn_exp2f(P[B + 1]); asm volatile("" : "+v"(P[B]), "+v"(P[B + 1]))
    s16x4 x0, x1, x2, x3, y0, y1, y2, y3, z0, z1, z2, z3, w0, w1, w2, w3;
#define RD4(P, I) P##0 = TRD(((I) & 1) * 2, (I) >> 1, 0); P##1 = TRD(((I) & 1) * 2, (I) >> 1, 1); P##2 = TRD(((I) & 1) * 2 + 1, (I) >> 1, 0); P##3 = TRD(((I) & 1) * 2 + 1, (I) >> 1, 1)
    RD4(x, 0); RD4(y, 1); RD4(z, 2); RD4(w, 3); WAITL(12);
    MF(0, pa0, x0, x1);
    float t0 = MX3(p0[0], p0[1], p0[2]), t1 = MX3(p0[8], p0[9], p0[10]), t2 = MX3(p1[0], p1[1], p1[2]), t3 = MX3(p1[8], p1[9], p1[10]);
    t0 = MX3(t0, p0[3], p0[4]); t1 = MX3(t1, p0[11], p0[12]); t2 = MX3(t2, p1[3], p1[4]); t3 = MX3(t3, p1[11], p1[12]);
    MF(1, pa0, x2, x3);
    t0 = MX3(t0, p0[5], p0[6]); t1 = MX3(t1, p0[13], p0[14]); t2 = MX3(t2, p1[5], p1[6]); t3 = MX3(t3, p1[13], p1[14]);
    t0 = MX3(t0, p0[7], p0[15]); t2 = MX3(t2, p1[7], p1[15]); t0 = MX3(t0, t1, t2); float pmax = fmaxf(t0, t3);
    SBAR(); RD4(x, 4); WAITL(12);
    MF(2, pa0, y0, y1);
    { auto rr = __builtin_amdgcn_permlane32_swap(__float_as_uint(pmax), __float_as_uint(pmax), false, false);
      pmax = fmaxf(__uint_as_float(rr[0]), __uint_as_float(rr[1])); }
    { const bool ok = __all(pmax - m_reg <= THRL); const float mnew = fmaxf(m_reg, pmax); mn = ok ? m_reg : mnew; alpha = __builtin_amdgcn_exp2f(m_reg - mn); m_reg = mn; }
    MF(3, pa0, y2, y3);
    SBAR(); RD4(y, 5); WAITL(12);
    MF(0, pa1, z0, z1); SUB8(p0, 0);
    MF(1, pa1, z2, z3); SUB8(p0, 8);
    SBAR(); RD4(z, 6); WAITL(12);
    MF(2, pa1, w0, w1); SUB8(p1, 0);
    MF(3, pa1, w2, w3); SUB8(p1, 8);
    SBAR(); mid();
    SBAR(); RD4(w, 7); WAITL(12);
    MF(0, pa2, x0, x1); EX2(p0, 0);
    MF(1, pa2, x2, x3); EX2(p0, 2);
    SBAR(); WAITL(8);
    MF(2, pa2, y0, y1); EX2(p0, 4);
    MF(3, pa2, y2, y3); EX2(p0, 6);
    SBAR(); WAITL(4);
    MF(0, pa3, z0, z1); EX2(p0, 8);
    MF(1, pa3, z2, z3); EX2(p0, 10);
    SBAR(); WAITL(0);
    MF(2, pa3, w0, w1); EX2(p0, 12);
    MF(3, pa3, w2, w3); EX2(p0, 14);
    SBAR();
#undef RD4
#undef TRD
#undef PKV
#undef MF
#undef WAITL
#undef MX3
#undef SUB8
#undef EX2
}

__device__ __forceinline__ void attn_unit(const bf16_t* __restrict__ Qb, const bf16_t* __restrict__ Kh, const bf16_t* __restrict__ Vh, bf16_t* __restrict__ Ob,
                                          float lam, float outscale, const float* __restrict__ sub_gain, char* lds, const int tid) {
    constexpr int LDK = NPROJP, seq = SEQ;
    const int wid = tid >> 6, lane = tid & 63, r32 = lane & 31, hi = lane >> 5;
    const int comp = wid & 1, rb = wid >> 1;
    char* V_lds = lds; char* K_lds = lds + 3 * SHM_V;
    float* ws = (float*)(lds + WS_OFF) + wid * 64; float* li_l = ws; float* al_l = ws + 32;
    float m_reg = -1e30f, l_reg = 0; f32x16 o[4] = {}; bf16x8 qr[4];
    const bf16_t* Qw = Qb + (size_t)(rb * 32 + r32) * LDK + comp * 64 + hi * 8;
#pragma unroll
    for (int d0 = 0; d0 < 4; ++d0) qr[d0] = *reinterpret_cast<const bf16x8*>(Qw + d0 * 16);
    const int sr = tid >> 4, sc = (tid & 15) * 8, vst0 = v_st(sr, sc), vst1 = v_st(32 + sr, sc);
    const int vb0 = (int)(uintptr_t)V_lds + v_rd_base(lane);
    bf16x8 vsA0, vsA1, ksA0, ksA1;
#define SLOAD(S, k0) do { vs##S##0 = *reinterpret_cast<const bf16x8*>(&Vh[(size_t)((k0) + sr) * LDK + sc]); vs##S##1 = *reinterpret_cast<const bf16x8*>(&Vh[(size_t)((k0) + 32 + sr) * LDK + sc]); \
    ks##S##0 = *reinterpret_cast<const bf16x8*>(&Kh[(size_t)((k0) + sr) * LDK + sc]); ks##S##1 = *reinterpret_cast<const bf16x8*>(&Kh[(size_t)((k0) + 32 + sr) * LDK + sc]); } while (0)
#define SWRITE(b, S) do { *(bf16x8*)(V_lds + (b) * SHM_V + vst0) = vs##S##0; *(bf16x8*)(V_lds + (b) * SHM_V + vst1) = vs##S##1; const int kc = sc * 2; \
    *(bf16x8*)(K_lds + (b) * SHM_K + KSWZ(sr, kc)) = ks##S##0; *(bf16x8*)(K_lds + (b) * SHM_K + KSWZ(32 + sr, kc)) = ks##S##1; } while (0)
#define SWAIT() asm volatile("s_waitcnt vmcnt(4)" ::: "memory")
#define RESC(a) do { if (__any((a) < 1.f)) { if (hi == 0) al_l[r32] = (a); asm volatile("s_waitcnt lgkmcnt(0)" ::: "memory"); \
    _Pragma("unroll") for (int d = 0; d < 4; ++d) _Pragma("unroll") for (int r = 0; r < 16; ++r) o[d][r] *= al_l[crow(r, hi)]; } } while (0)
    f32x16 pA0, pA1, pB0, pB1; float mnA, mnB, alA, alB; bf16x8 pa0, pa1, pa2, pa3; const int NT = seq / KVBLK;
#define SW0() asm volatile("s_waitcnt vmcnt(0)" ::: "memory")
    SLOAD(A, 0); SW0(); SWRITE(0, A); SLOAD(A, KVBLK); __syncthreads();
    qkt(pA0, pA1, K_lds, qr, r32, hi, comp); partialSM(pA0, pA1, m_reg, mnA, alA);
    SW0(); SWRITE(1, A); SLOAD(A, 2 * KVBLK); __syncthreads();
    int bj = 1;
    for (int j = 1; j + 1 < NT; j += 2) {
        const int bjm1 = (bj == 0) ? 2 : bj - 1, bjp1 = (bj == 2) ? 0 : bj + 1;
        qk_sm(pB0, pB1, K_lds + bj * SHM_K, qr, r32, hi, comp, pA0, pA1, alA, l_reg, pa0, pa1, pa2, pa3);
        pv_sm(o, vb0 + bjm1 * (int)SHM_V, pa0, pa1, pa2, pa3, pB0, pB1, m_reg, mnB, alB, [&] { SW0(); SWRITE(bjp1, A); SLOAD(A, (j + 2) * KVBLK); });
        RESC(alB); __syncthreads();
        qk_sm(pA0, pA1, K_lds + bjp1 * SHM_K, qr, r32, hi, comp, pB0, pB1, alB, l_reg, pa0, pa1, pa2, pa3);
        pv_sm(o, vb0 + bj * (int)SHM_V, pa0, pa1, pa2, pa3, pA0, pA1, m_reg, mnA, alA, [&] { SW0(); SWRITE(bjm1, A); if (j + 3 < NT) SLOAD(A, (j + 3) * KVBLK); });
        RESC(alA); __syncthreads();
        bj = (bj == 0) ? 2 : bj - 1;
    }
    { const int bjm1 = (bj == 0) ? 2 : bj - 1;
      qk_sm(pB0, pB1, K_lds + bj * SHM_K, qr, r32, hi, comp, pA0, pA1, alA, l_reg, pa0, pa1, pa2, pa3);
      pv_sm(o, vb0 + bjm1 * (int)SHM_V, pa0, pa1, pa2, pa3, pB0, pB1, m_reg, mnB, alB, [] {});
      RESC(alB);
      finishSM(pB0, pB1, alB, l_reg, pa0, pa1, pa2, pa3); SBAR();
      pv_d0(o, vb0 + bj * (int)SHM_V, pa0, pa1, pa2, pa3); }
#undef SW0
    if (hi == 0) li_l[r32] = l_reg; asm volatile("s_waitcnt lgkmcnt(0)" ::: "memory");
    float rli[16];
#pragma unroll
    for (int r = 0; r < 16; ++r) rli[r] = __builtin_amdgcn_rcpf(li_l[crow(r, hi)]);
    __syncthreads();
    float* stg = (float*)lds + rb * 32 * 128;
    if (comp == 1) {
#pragma unroll
        for (int r = 0; r < 16; ++r)
#pragma unroll
            for (int d0 = 0; d0 < 4; ++d0) stg[crow(r, hi) * 128 + d0 * 32 + r32] = o[d0][r] * rli[r];
    }
    __syncthreads();
    if (comp == 0) {
#pragma unroll
        for (int r = 0; r < 16; ++r)
#pragma unroll
            for (int d0 = 0; d0 < 4; ++d0) { const int idx = crow(r, hi) * 128 + d0 * 32 + r32; stg[idx] = o[d0][r] * rli[r] - lam * stg[idx]; }
        asm volatile("s_waitcnt lgkmcnt(0)" ::: "memory");
        const int row = lane >> 1, c0 = (lane & 1) * 64;
        const float* sp = stg + row * 128 + c0;
        float ss = 0.f;
#pragma unroll
        for (int i = 0; i < 16; ++i) { const f32x4 v = *(const f32x4*)(sp + 4 * i); ss += (v[0] * v[0] + v[1] * v[1]) + (v[2] * v[2] + v[3] * v[3]); }
        ss += __shfl_xor(ss, 1);
        const float rs = outscale / sqrtf(ss * (1.0f / 128.0f) + 1e-5f);
        bf16_t* op = Ob + (size_t)(rb * 32 + row) * DM + c0;
#pragma unroll
        for (int i = 0; i < 8; ++i) { const f32x4 v0 = *(const f32x4*)(sp + 8 * i), v1 = *(const f32x4*)(sp + 8 * i + 4);
            const f32x4 g0 = *(const f32x4*)(sub_gain + c0 + 8 * i), g1 = *(const f32x4*)(sub_gain + c0 + 8 * i + 4);
            u32x4 w; w.x = cvt_pk_bf16(v0[0] * rs * g0[0], v0[1] * rs * g0[1]); w.y = cvt_pk_bf16(v0[2] * rs * g0[2], v0[3] * rs * g0[3]);
            w.z = cvt_pk_bf16(v1[0] * rs * g1[0], v1[1] * rs * g1[1]); w.w = cvt_pk_bf16(v1[2] * rs * g1[2], v1[3] * rs * g1[3]);
            *(u32x4*)(op + 8 * i) = w; }
    }
    __syncthreads();
#undef SLOAD
#undef SWRITE
#undef SWAIT
#undef RESC
}

#define PIN(x) asm volatile("" : "+v"(x))
#define MFMA_(a, b, c) __builtin_amdgcn_mfma_f32_32x32x16_bf16(a, b, c, 0, 0, 0)
#define WAIT_BAR(N) asm volatile("s_waitcnt vmcnt(" #N ") lgkmcnt(0)\n\ts_barrier" ::: "memory")
typedef __attribute__((address_space(3))) const char* lds_cptr;
typedef short v4i16_t __attribute__((ext_vector_type(4)));
__device__ __forceinline__ unsigned cvtpk_nv(float lo, float hi) { unsigned r; asm("v_cvt_pk_bf16_f32 %0, %1, %2" : "=v"(r) : "v"(lo), "v"(hi)); return r; }
__device__ __forceinline__ void glds16(const void* g, unsigned lds_base) {
    unsigned sv; asm volatile("s_mov_b32 %0, m0\n\ts_mov_b32 m0, %2\n\ts_nop 0\n\tglobal_load_lds_dwordx4 %1, off\n\ts_mov_b32 m0, %0" : "=&s"(sv) : "v"(g), "s"(lds_base) : "memory"); }
__device__ __forceinline__ void kload2(bf16x8* kf, lds_cptr kp, int kb0, int d0) { const lds_cptr p = kp + (kb0 ^ (d0 << 5));
    kf[2 * d0] = *(const __attribute__((address_space(3))) bf16x8*)(p); kf[2 * d0 + 1] = *(const __attribute__((address_space(3))) bf16x8*)(p + 8192); }
__device__ __forceinline__ s16x4 vtr(lds_cptr p) { return __builtin_bit_cast(s16x4, __builtin_amdgcn_ds_read_tr16_b64_v4i16((__attribute__((address_space(3))) v4i16_t*)p)); }
#define MX3(a, b, c) __builtin_fmaxf(__builtin_fmaxf((a), (b)), (c))
__device__ __forceinline__ float rowmax(const f32x16& p0, const f32x16& p1) {
    float a = MX3(p0[0], p0[1], p1[0]), b = MX3(p0[2], p0[3], p1[1]); a = MX3(a, p1[2], p1[3]);
#pragma unroll
    for (int r = 4; r < 16; r += 4) { a = MX3(a, p0[r], p0[r + 1]); b = MX3(b, p0[r + 2], p0[r + 3]); a = MX3(a, p1[r], p1[r + 1]); b = MX3(b, p1[r + 2], p1[r + 3]); }
    float m = __builtin_fmaxf(a, b); auto rr = __builtin_amdgcn_permlane32_swap(__float_as_uint(m), __float_as_uint(m), false, false);
    return __builtin_fmaxf(__uint_as_float(rr[0]), __uint_as_float(rr[1])); }
#undef MX3

__device__ __forceinline__ void attn_unit2(const bf16_t* __restrict__ Qb, const bf16_t* __restrict__ Kh, const bf16_t* __restrict__ Vh, unsigned char* __restrict__ Ob,
                                           float lam, float outscale, const float* __restrict__ sub_gain, char* lds, const int tid) {
    constexpr int LDK = NPROJP, NT = SEQ / KVBLK, SLOTB = 16384, LDS_K = 0, LDS_V = 3 * SLOTB;
    const int lane = tid & 63, r32 = lane & 31, hi = lane >> 5; const int wid = __builtin_amdgcn_readfirstlane(tid >> 6); const int comp = wid & 1, rb = wid >> 1;
    const unsigned lds0 = (unsigned)(uintptr_t)lds; float* wsf = (float*)(lds + WS_OFF) + wid * 64;
    const bf16_t* ksrc = Kh + (size_t)(8 * wid + (lane >> 4)) * LDK + ((lane & 15) ^ (lane >> 4)) * 8;
    const bf16_t* ksrc2 = Kh + (size_t)(8 * wid + 4 + (lane >> 4)) * LDK + ((lane & 15) ^ ((lane >> 4) + 4)) * 8;
    const bf16_t* vsrc = Vh + (size_t)(32 * (wid & 1) + (lane >> 2)) * LDK + (wid >> 1) * 32 + (lane & 3) * 8;
    const unsigned kdst = lds0 + LDS_K + wid * 2048, vdst = lds0 + LDS_V + (wid >> 1) * 4096 + (wid & 1) * 2048;
#define DMA_K(t, slot) do { const unsigned d_ = (unsigned)__builtin_amdgcn_readfirstlane(kdst + (slot)); glds16(ksrc + (size_t)(t) * KVBLK * LDK, d_); glds16(ksrc2 + (size_t)(t) * KVBLK * LDK, d_ + 1024); } while (0)
#define DMA_V(t, slot) do { const bf16_t* s_ = vsrc + (size_t)(t) * KVBLK * LDK; const unsigned d_ = (unsigned)__builtin_amdgcn_readfirstlane(vdst + (slot)); glds16(s_, d_); glds16(s_ + (size_t)16 * LDK, d_ + 1024); } while (0)
    const lds_cptr vp0 = (lds_cptr)lds + LDS_V + ((lane >> 4) & 1) * 32 + (lane & 3) * 8 + (4 * hi + ((lane & 15) >> 2)) * 64;
    const int kb0 = r32 * 256 + ((comp * 128 + hi * 16) ^ ((r32 & 7) << 4));
    const lds_cptr kp0 = (lds_cptr)lds + LDS_K;
    DMA_K(0, 0); DMA_V(0, 0); DMA_K(1, SLOTB);
    bf16x8 qr[4];
    { const bf16_t* Qw = Qb + (size_t)(rb * 32 + r32) * LDK + comp * 64 + hi * 8;
#pragma unroll
      for (int d0 = 0; d0 < 4; ++d0) qr[d0] = *reinterpret_cast<const bf16x8*>(Qw + d0 * 16); }
    float mhat = 0.f, l_reg = 0.f; f32x16 o[4] = {};
    bool resc = false;
    f32x16 pA0, pA1, pB0, pB1; bf16x8 kf[8]; s16x4 vlo[8], vhi[8]; u32x4 pw0, pw1, pw2, pw3;
    int sl_prev = 0, sl_cur = 0, sl_next = SLOTB;
#define ROT() do { sl_prev = sl_cur; sl_cur = sl_next; sl_next = (sl_next == 2 * SLOTB) ? 0 : sl_next + SLOTB; } while (0)
#define EX(v) __builtin_amdgcn_exp2f((v) + nmh)
#define RESC2() do { if (resc) { _Pragma("unroll") for (int d_ = 0; d_ < 4; ++d_) _Pragma("unroll") for (int r = 0; r < 16; ++r) o[d_][r] *= wsf[crow(r, hi)]; } } while (0)
    DMA_K(2, 2 * SLOTB);
    WAIT_BAR(6);
    _Pragma("unroll") for (int d0 = 0; d0 < 4; ++d0) kload2(kf, kp0, kb0, d0);
    pA0 = MFMA_(kf[0], qr[0], f32x16{}); pA1 = MFMA_(kf[1], qr[0], f32x16{}); pA0 = MFMA_(kf[2], qr[1], pA0); pA1 = MFMA_(kf[3], qr[1], pA1);
    pA0 = MFMA_(kf[4], qr[2], pA0); pA1 = MFMA_(kf[5], qr[2], pA1); pA0 = MFMA_(kf[6], qr[3], pA0); pA1 = MFMA_(kf[7], qr[3], pA1);
    { mhat = rowmax(pA0, pA1); const float nmh = -mhat;
#pragma unroll
      for (int r = 0; r < 16; ++r) { pA0[r] = EX(pA0[r]); pA1[r] = EX(pA1[r]); } }
    WAIT_BAR(0);
    DMA_K(3, 0); DMA_V(1, SLOTB); ROT();
    _Pragma("unroll") for (int d0 = 0; d0 < 4; ++d0) kload2(kf, kp0 + sl_cur, kb0, d0);
    WAIT_BAR(4);
#define PKW(P, i) cvtpk_nv(P[i], P[i + 1])
#define PAF(k) __builtin_bit_cast(bf16x8, pw##k)
#define VFR(i) (bf16x8){vlo[i][0], vlo[i][1], vlo[i][2], vlo[i][3], vhi[i][0], vhi[i][1], vhi[i][2], vhi[i][3]}
#define VRD(i, f) do { vlo[i] = vtr(vp_ + (((f) & 3) * 4096 + ((f) >> 2) * 1024)); vhi[i] = vtr(vp_ + (((f) & 3) * 4096 + ((f) >> 2) * 1024 + 512)); } while (0)
#define KRD(G, d0) do { if (G) { kload2(kf, kp0 + sl_next, kb0, d0); SBAR(); } } while (0)
#define GAPA(MF, a0, a1, a2, a3, W0, W1, PW) do { MF; sacc += a0; sacc += a1; sacc += a2; sacc += a3; W0; W1; PIN(PW); PIN(sacc); SBAR(); } while (0)
#define GAPB(MF, X, i) do { MF; X[i] = EX(X[i]); X[i + 1] = EX(X[i + 1]); PIN(X); SBAR(); } while (0)
#define STEP(C0, C1, P0, P1, t, GK, GV, GL) do { SBAR(); \
    const lds_cptr vp_ = vp0 + sl_prev; \
    VRD(0, 0); SBAR(); float sacc = P0[0] + P0[1]; \
                       GAPA(C0 = MFMA_(kf[0], qr[0], f32x16{}), P0[2], P0[3], P0[4], P0[5],     pw0[0] = PKW(P0, 0),  pw0[1] = PKW(P0, 2),  pw0); \
    VRD(1, 1); SBAR(); GAPA(C1 = MFMA_(kf[1], qr[0], f32x16{}), P0[6], P0[7], P0[8], P0[9],     pw0[2] = PKW(P0, 4),  pw0[3] = PKW(P0, 6),  pw0); \
    VRD(2, 2); SBAR(); GAPA(C0 = MFMA_(kf[2], qr[1], C0),       P0[10], P0[11], P0[12], P0[13], pw1[0] = PKW(P0, 8),  pw1[1] = PKW(P0, 10), pw1); \
    VRD(3, 3); SBAR(); GAPA(C1 = MFMA_(kf[3], qr[1], C1),       P0[14], P0[15], P1[0], P1[1],   pw1[2] = PKW(P0, 12), pw1[3] = PKW(P0, 14), pw1); \
    VRD(4, 4); SBAR(); GAPA(C0 = MFMA_(kf[4], qr[2], C0),       P1[2], P1[3], P1[4], P1[5],     pw2[0] = PKW(P1, 0),  pw2[1] = PKW(P1, 2),  pw2); \
    VRD(5, 5); SBAR(); GAPA(C1 = MFMA_(kf[5], qr[2], C1),       P1[6], P1[7], P1[8], P1[9],     pw2[2] = PKW(P1, 4),  pw2[3] = PKW(P1, 6),  pw2); \
    VRD(6, 6); SBAR(); GAPA(C0 = MFMA_(kf[6], qr[3], C0),       P1[10], P1[11], P1[12], P1[13], pw3[0] = PKW(P1, 8),  pw3[1] = PKW(P1, 10), pw3); \
    VRD(7, 7); SBAR(); GAPA(C1 = MFMA_(kf[7], qr[3], C1),       P1[14], P1[15], 0.f, 0.f,       pw3[2] = PKW(P1, 12), pw3[3] = PKW(P1, 14), pw3); \
    l_reg += sacc; \
    if (GK) DMA_K((t) + 3, sl_cur); if (GV) DMA_V((t) + 1, sl_next); \
    { const float rm = rowmax(C0, C1) - mhat; resc = false; \
      if (__builtin_expect(__any(rm > THRL), 0)) { const float dl = __builtin_fmaxf(rm, 0.f); mhat += dl; \
          const float f = __builtin_amdgcn_exp2f(-dl); l_reg *= f; if (hi == 0) wsf[r32] = f; resc = true; } } \
    const float nmh = -mhat; SBAR(); \
    KRD(GL, 0); GAPB(o[0] = MFMA_(PAF(0), VFR(0), o[0]), C0, 0);   KRD(GL, 1); GAPB(o[1] = MFMA_(PAF(0), VFR(1), o[1]), C0, 2); \
    KRD(GL, 2); GAPB(o[2] = MFMA_(PAF(0), VFR(2), o[2]), C0, 4);   KRD(GL, 3); GAPB(o[3] = MFMA_(PAF(0), VFR(3), o[3]), C0, 6); \
    VRD(0, 8);  SBAR(); GAPB(o[0] = MFMA_(PAF(1), VFR(4), o[0]), C0, 8);   VRD(1, 9);  SBAR(); GAPB(o[1] = MFMA_(PAF(1), VFR(5), o[1]), C0, 10); \
    VRD(2, 10); SBAR(); GAPB(o[2] = MFMA_(PAF(1), VFR(6), o[2]), C0, 12);  VRD(3, 11); SBAR(); GAPB(o[3] = MFMA_(PAF(1), VFR(7), o[3]), C0, 14); \
    VRD(4, 12); SBAR(); GAPB(o[0] = MFMA_(PAF(2), VFR(0), o[0]), C1, 0);   VRD(5, 13); SBAR(); GAPB(o[1] = MFMA_(PAF(2), VFR(1), o[1]), C1, 2); \
    VRD(6, 14); SBAR(); GAPB(o[2] = MFMA_(PAF(2), VFR(2), o[2]), C1, 4);   VRD(7, 15); SBAR(); GAPB(o[3] = MFMA_(PAF(2), VFR(3), o[3]), C1, 6); \
    GAPB(o[0] = MFMA_(PAF(3), VFR(4), o[0]), C1, 8);   GAPB(o[1] = MFMA_(PAF(3), VFR(5), o[1]), C1, 10); \
    GAPB(o[2] = MFMA_(PAF(3), VFR(6), o[2]), C1, 12);  GAPB(o[3] = MFMA_(PAF(3), VFR(7), o[3]), C1, 14); \
    } while (0)
    int t = 1;
    for (; t + 5 < NT; t += 2) {
        STEP(pB0, pB1, pA0, pA1, t, true, true, true);     WAIT_BAR(4); RESC2(); ROT();
        STEP(pA0, pA1, pB0, pB1, t + 1, true, true, true); WAIT_BAR(4); RESC2(); ROT();
    }
#define ENDW(tt) do { if ((tt) + 3 < NT) { WAIT_BAR(4); } else if ((tt) + 2 < NT) { WAIT_BAR(2); } else { WAIT_BAR(0); } } while (0)
    for (; t + 1 < NT; t += 2) {
        STEP(pB0, pB1, pA0, pA1, t, (t + 3 < NT), (t + 1 < NT), (t + 1 < NT));         ENDW(t);     RESC2(); ROT();
        STEP(pA0, pA1, pB0, pB1, t + 1, (t + 4 < NT), (t + 2 < NT), (t + 2 < NT));     ENDW(t + 1); RESC2(); ROT();
    }
    STEP(pB0, pB1, pA0, pA1, NT - 1, false, false, false); RESC2();
    { float sacc = pB0[0] + pB0[1];
#pragma unroll
      for (int r = 2; r < 16; ++r) sacc += pB0[r];
#pragma unroll
      for (int r = 0; r < 16; ++r) sacc += pB1[r];
      l_reg += sacc;
      pw0 = (u32x4){PKW(pB0, 0), PKW(pB0, 2), PKW(pB0, 4), PKW(pB0, 6)}; pw1 = (u32x4){PKW(pB0, 8), PKW(pB0, 10), PKW(pB0, 12), PKW(pB0, 14)};
      pw2 = (u32x4){PKW(pB1, 0), PKW(pB1, 2), PKW(pB1, 4), PKW(pB1, 6)}; pw3 = (u32x4){PKW(pB1, 8), PKW(pB1, 10), PKW(pB1, 12), PKW(pB1, 14)};
      const lds_cptr vp_ = vp0 + sl_cur;
      _Pragma("unroll") for (int i = 0; i < 8; ++i) VRD(i, i);
      o[0] = MFMA_(PAF(0), VFR(0), o[0]); o[1] = MFMA_(PAF(0), VFR(1), o[1]); o[2] = MFMA_(PAF(0), VFR(2), o[2]); o[3] = MFMA_(PAF(0), VFR(3), o[3]);
      o[0] = MFMA_(PAF(1), VFR(4), o[0]); o[1] = MFMA_(PAF(1), VFR(5), o[1]); o[2] = MFMA_(PAF(1), VFR(6), o[2]); o[3] = MFMA_(PAF(1), VFR(7), o[3]);
      SBAR();
      _Pragma("unroll") for (int i = 0; i < 8; ++i) VRD(i, 8 + i);
      o[0] = MFMA_(PAF(2), VFR(0), o[0]); o[1] = MFMA_(PAF(2), VFR(1), o[1]); o[2] = MFMA_(PAF(2), VFR(2), o[2]); o[3] = MFMA_(PAF(2), VFR(3), o[3]);
      o[0] = MFMA_(PAF(3), VFR(4), o[0]); o[1] = MFMA_(PAF(3), VFR(5), o[1]); o[2] = MFMA_(PAF(3), VFR(6), o[2]); o[3] = MFMA_(PAF(3), VFR(7), o[3]); }
    { auto rr = __builtin_amdgcn_permlane32_swap(__float_as_uint(l_reg), __float_as_uint(l_reg), false, false); l_reg = __uint_as_float(rr[0]) + __uint_as_float(rr[1]); }
    float* li_l = wsf + 32;
    if (hi == 0) li_l[r32] = l_reg; asm volatile("s_waitcnt lgkmcnt(0)" ::: "memory");
    float rli[16];
#pragma unroll
    for (int r = 0; r < 16; ++r) rli[r] = __builtin_amdgcn_rcpf(li_l[crow(r, hi)]);
    __syncthreads();
    float* stg = (float*)lds + rb * 32 * 128;
    if (comp == 1) {
#pragma unroll
        for (int r = 0; r < 16; ++r)
#pragma unroll
            for (int d0 = 0; d0 < 4; ++d0) stg[crow(r, hi) * 128 + d0 * 32 + r32] = o[d0][r] * rli[r];
    }
    __syncthreads();
    if (comp == 0) {
#pragma unroll
        for (int r = 0; r < 16; ++r)
#pragma unroll
            for (int d0 = 0; d0 < 4; ++d0) { const int idx = crow(r, hi) * 128 + d0 * 32 + r32; stg[idx] = o[d0][r] * rli[r] - lam * stg[idx]; }
        asm volatile("s_waitcnt lgkmcnt(0)" ::: "memory");
        const int row = lane >> 1, c0 = (lane & 1) * 64;
        const float* sp = stg + row * 128 + c0;
        float ss = 0.f;
#pragma unroll
        for (int i = 0; i < 16; ++i) { const f32x4 v = *(const f32x4*)(sp + 4 * i); ss += (v[0] * v[0] + v[1] * v[1]) + (v[2] * v[2] + v[3] * v[3]); }
        ss += __shfl_xor(ss, 1);
        const float rs = outscale / sqrtf(ss * (1.0f / 128.0f) + 1e-5f);
        unsigned char* op = Ob + ((size_t)(rb * 32 + row) * DM + c0) * (WOUT_FP8 ? 1 : 2);
#pragma unroll
        for (int i = 0; i < 8; ++i) { const f32x4 v0 = *(const f32x4*)(sp + 8 * i), v1 = *(const f32x4*)(sp + 8 * i + 4);
            const f32x4 g0 = *(const f32x4*)(sub_gain + c0 + 8 * i), g1 = *(const f32x4*)(sub_gain + c0 + 8 * i + 4);
            if (WOUT_FP8) { const float rq = rs * MIXSC; const float f[8] = {v0[0] * rq * g0[0], v0[1] * rq * g0[1], v0[2] * rq * g0[2], v0[3] * rq * g0[3], v1[0] * rq * g1[0], v1[1] * rq * g1[1], v1[2] * rq * g1[2], v1[3] * rq * g1[3]};
                *(u32x2*)(op + 8 * i) = pack8_fp8(f); }
            else { u32x4 w; w.x = cvt_pk_bf16(v0[0] * rs * g0[0], v0[1] * rs * g0[1]); w.y = cvt_pk_bf16(v0[2] * rs * g0[2], v0[3] * rs * g0[3]);
                w.z = cvt_pk_bf16(v1[0] * rs * g1[0], v1[1] * rs * g1[1]); w.w = cvt_pk_bf16(v1[2] * rs * g1[2], v1[3] * rs * g1[3]);
                *(u32x4*)(op + 16 * i) = w; } }
    }
    __syncthreads();
#undef DMA_K
#undef DMA_V
#undef ROT
#undef EX
#undef RESC2
#undef PKW
#undef PAF
#undef VFR
#undef VRD
#undef KRD
#undef ENDW
#undef GAPA
#undef GAPB
#undef STEP
}
#undef PIN
#undef MFMA_
#undef WAIT_BAR
}

struct Args { const void* in[31]; float* out; unsigned char* ws; int ph_lo, ph_hi; };
typedef const __attribute__((address_space(4))) Args* ArgsP;
__device__ __forceinline__ int launder_v(int x) { asm volatile("" : "+v"(x)); return x; }
__device__ __forceinline__ int phase_tid(int wave) { int l; asm volatile("v_mbcnt_lo_u32_b32 %0, -1, 0\n\tv_mbcnt_hi_u32_b32 %0, -1, %0" : "=v"(l)); return wave * 64 + l; }
__device__ __forceinline__ ArgsP phase_args() { ArgsP p = (ArgsP)__builtin_amdgcn_kernarg_segment_ptr(); asm volatile("" : "+s"(p)); return p; }
enum { I_X = 0, I_C, I_POS, I_WADA, I_BADA, I_NGAIN, I_WIN, I_WOUT, I_MUP, I_MUN, I_DW0, I_DUP, I_A0, I_AUP, I_KK, I_KA, I_RK, I_GUP, I_GNG, I_GNB,
       I_LQ1, I_LK1, I_LQ2, I_LK2, I_SUBG, I_WR, I_RB, I_WG, I_WU, I_WDN, I_FG };

__device__ const double INVF[8] = {1.0, 0.1939227447486858, 0.03760603093086394, 0.007292664737217109, 0.0014142135623730957, 0.00027424817567620724, 5.318295896944988e-05, 1.0313385377212461e-05};

enum { MAP_ID = 0, MAP_QK = 1, MAP_GATE = 2, MAP_UP = 3 };
template <int MAP> __device__ __forceinline__ int map_row(int n) {
    if (MAP == MAP_QK) { if (n < 2048) { const int d = n & 63; if (d < 16) return (n & ~63) | (d & 3) | ((d & 8) >> 1) | ((d & 4) << 1); } return n; }
    if (MAP == MAP_GATE) return ((n >> 2) << 3) | (n & 3);
    if (MAP == MAP_UP) return ((n >> 2) << 3) | 4 | (n & 3);
    return n;
}
template <int MAP, bool F8 = false> __device__ __forceinline__ void transpose_item(const float* __restrict__ W, int K, int N, bf16_t* __restrict__ WT, LAS float* scr, int item, int lane, float scale = 1.0f) {
    const int nblk = N / 32, kb = item / nblk, nb = item % nblk, k0 = 64 * kb, n0 = 32 * nb;
#pragma unroll 8
    for (int i = 0; i < 32; ++i) { const int kk = 2 * i + (lane >> 5); scr[kk * 33 + (lane & 31)] = W[(size_t)(k0 + kk) * N + n0 + (lane & 31)]; }
    LDS_WAIT(); asm volatile("" ::: "memory");
    const int c = lane & 7;
#pragma unroll
    for (int j = 0; j < 4; ++j) { const int n = (lane >> 3) + 8 * j; const LAS float* s = scr + (8 * c) * 33 + n;
        if constexpr (F8) { int w0 = 0, w1 = 0;
            w0 = pk4_fp8(s[0 * 33] * scale, s[1 * 33] * scale, s[2 * 33] * scale, s[3 * 33] * scale);
            w1 = pk4_fp8(s[4 * 33] * scale, s[5 * 33] * scale, s[6 * 33] * scale, s[7 * 33] * scale);
            u32x2 o; o.x = (unsigned)w0; o.y = (unsigned)w1;
            *(u32x2*)((unsigned char*)WT + (size_t)map_row<MAP>(n0 + n) * K + k0 + 8 * c) = o; }
        else { u32x4 o; o.x = cvt_pk_bf16(s[0 * 33], s[1 * 33]); o.y = cvt_pk_bf16(s[2 * 33], s[3 * 33]); o.z = cvt_pk_bf16(s[4 * 33], s[5 * 33]); o.w = cvt_pk_bf16(s[6 * 33], s[7 * 33]);
            *(u32x4*)(WT + (size_t)map_row<MAP>(n0 + n) * K + k0 + 8 * c) = o; } }
    LDS_WAIT(); asm volatile("" ::: "memory");
}
template <int MAP> __device__ __forceinline__ void transpose_item128(const float* __restrict__ W, int K, int N, unsigned char* __restrict__ WT, LAS float* scr, int item, int lane, float scale) {
    const int nblk = N / 32, kb = item / nblk, nb = item % nblk, k0 = 128 * kb, n0 = 32 * nb;
    const int lr = lane >> 3, lc = lane & 7;
    f32x4 t[16];
    const float* src = W + (size_t)(k0 + lr) * N + n0 + 4 * lc;
#pragma unroll
    for (int j = 0; j < 16; ++j) t[j] = *(const f32x4*)(src + (size_t)(8 * j) * N);
#pragma unroll
    for (int j = 0; j < 16; ++j) { const int k = 8 * j + lr; *(LAS f32x4*)(scr + k * 32 + ((lc ^ (k >> 4)) << 2)) = t[j]; }
    LDS_WAIT(); asm volatile("" ::: "memory");
    const int nr = lane >> 3, c = lane & 7;
#pragma unroll
    for (int jj = 0; jj < 4; ++jj) { const int n = 8 * jj + nr; const LAS float* sp = scr + (16 * c) * 32 + ((((n >> 2) ^ c) << 2) | (n & 3));
        float f0[8], f1[8];
#pragma unroll
        for (int e = 0; e < 8; ++e) { f0[e] = sp[e * 32] * scale; f1[e] = sp[(8 + e) * 32] * scale; }
        const u32x2 a = pack8_fp8(f0), b = pack8_fp8(f1); u32x4 o; o.x = a.x; o.y = a.y; o.z = b.x; o.w = b.y;
        *(u32x4*)(WT + (size_t)map_row<MAP>(n0 + n) * K + k0 + 16 * c) = o; }
    LDS_WAIT(); asm volatile("" ::: "memory");
}
template <int MAP> __device__ __forceinline__ void transpose_piece_f8(const float* __restrict__ W, int K, int N, unsigned char* __restrict__ WT, LAS float* scr, int piece, int lane, float scale) {
    const int nblk = N / 32, kb = piece / nblk, nb = piece % nblk, k0 = 32 * kb, n0 = 32 * nb;
    float t[16];
#pragma unroll
    for (int i = 0; i < 16; ++i) t[i] = W[(size_t)(k0 + 2 * i + (lane >> 5)) * N + n0 + (lane & 31)];
#pragma unroll
    for (int i = 0; i < 16; ++i) scr[(2 * i + (lane >> 5)) * 33 + (lane & 31)] = t[i];
    LDS_WAIT(); asm volatile("" ::: "memory");
    const int c = lane & 3;
#pragma unroll
    for (int j = 0; j < 2; ++j) { const int n = (lane >> 2) + 16 * j; const LAS float* s = scr + (8 * c) * 33 + n;
        const float f[8] = {s[0 * 33] * scale, s[1 * 33] * scale, s[2 * 33] * scale, s[3 * 33] * scale, s[4 * 33] * scale, s[5 * 33] * scale, s[6 * 33] * scale, s[7 * 33] * scale};
        *(u32x2*)(WT + (size_t)map_row<MAP>(n0 + n) * K + k0 + 8 * c) = pack8_fp8(f); }
    LDS_WAIT(); asm volatile("" ::: "memory");
}
constexpr int MOE_PIECES = NEXP * 3 * 2048;
__device__ __forceinline__ void convert_moe_piece(ArgsP A, int l, LAS float* scr, int lane, int piece) {
    const int e = piece / 6144; int r = piece % 6144;
    unsigned char* WGU = A->ws + WS_WGU + (size_t)e * 2048 * DM; unsigned char* WD = A->ws + WS_WD + (size_t)e * DM * DFF;
    if (r < 2048) { transpose_piece_f8<MAP_GATE>((const float*)A->in[I_WG] + ((size_t)l * NEXP + e) * DM * DFF, DM, DFF, WGU, scr, r, lane, WSC_GU); return; } r -= 2048;
    if (r < 2048) { transpose_piece_f8<MAP_UP>((const float*)A->in[I_WU] + ((size_t)l * NEXP + e) * DM * DFF, DM, DFF, WGU, scr, r, lane, WSC_GU); return; } r -= 2048;
    transpose_piece_f8<MAP_ID>((const float*)A->in[I_WDN] + ((size_t)l * NEXP + e) * DFF * DM, DFF, DM, WD, scr, r, lane, WSC_D);
}
__device__ __forceinline__ void convert_moe(ArgsP A, int l, LAS unsigned char* lds, int lane, int wave, int gw, int NGW) {
    LAS float* scr = (LAS float*)(lds + wave * 16384);
    unsigned char* WGU = A->ws + WS_WGU; unsigned char* WD = A->ws + WS_WD;
    const float* wg = (const float*)A->in[I_WG] + (size_t)l * NEXP * DM * DFF;
    const float* wu = (const float*)A->in[I_WU] + (size_t)l * NEXP * DM * DFF;
    const float* wd = (const float*)A->in[I_WDN] + (size_t)l * NEXP * DFF * DM;
    constexpr int IG = (DM / 128) * (DFF / 32);
    constexpr int ID = (DFF / 128) * (DM / 32);
    for (int it = gw; it < NEXP * (2 * IG + ID); it += NGW) {
        const int e = it / (2 * IG + ID); int r = it % (2 * IG + ID);
        if (r < IG) { transpose_item128<MAP_GATE>(wg + (size_t)e * DM * DFF, DM, DFF, WGU + (size_t)e * 2048 * DM, scr, r, lane, WSC_GU); continue; } r -= IG;
        if (r < IG) { transpose_item128<MAP_UP>(wu + (size_t)e * DM * DFF, DM, DFF, WGU + (size_t)e * 2048 * DM, scr, r, lane, WSC_GU); continue; } r -= IG;
        transpose_item128<MAP_ID>(wd + (size_t)e * DFF * DM, DFF, DM, WD + (size_t)e * DM * DFF, scr, r, lane, WSC_D);
    }
}

__device__ __forceinline__ void phase_prologue(ArgsP A, LAS unsigned char* lds, int tid, int lane, int wave, int bx, int G) {
    float* MOD = (float*)(A->ws + WS_MOD);
    __syncthreads();
    if (bx < 192) {
        LAS float* sc = (LAS float*)lds; LAS float* red = (LAS float*)(lds + 32768);
        const float* c = (const float*)A->in[I_C];
        for (int i = tid; i < BATCH * DM; i += 512) { const float v = c[i]; sc[i] = v / (1.f + __expf(-v)); }
        __syncthreads();
        const int l = bx / 96, n0 = (bx % 96) * 128, half = lane >> 5, cg = lane & 31;
        const float* wp = (const float*)A->in[I_WADA] + (size_t)l * DM * NMOD + (size_t)(256 * wave + half) * NMOD + n0 + 4 * cg;
        f32x4 a0 = {0.f, 0.f, 0.f, 0.f}, a1 = a0, a2 = a0, a3 = a0;
#pragma unroll 8
        for (int kk = 0; kk < 128; ++kk) { const int k = 256 * wave + 2 * kk + half; const f32x4 wv = *(const f32x4*)(wp + (size_t)(2 * kk) * NMOD);
            a0 += wv * sc[k]; a1 += wv * sc[DM + k]; a2 += wv * sc[2 * DM + k]; a3 += wv * sc[3 * DM + k]; }
#pragma unroll
        for (int j = 0; j < 4; ++j) { a0[j] += __shfl_xor(a0[j], 32); a1[j] += __shfl_xor(a1[j], 32); a2[j] += __shfl_xor(a2[j], 32); a3[j] += __shfl_xor(a3[j], 32); }
        if (half == 0) { *(LAS f32x4*)(red + (wave * 4 + 0) * 128 + 4 * cg) = a0; *(LAS f32x4*)(red + (wave * 4 + 1) * 128 + 4 * cg) = a1;
                         *(LAS f32x4*)(red + (wave * 4 + 2) * 128 + 4 * cg) = a2; *(LAS f32x4*)(red + (wave * 4 + 3) * 128 + 4 * cg) = a3; }
        __syncthreads();
        { const int b = tid >> 7, col = tid & 127; float s = 0.f;
#pragma unroll
          for (int w = 0; w < 8; ++w) s += red[(w * 4 + b) * 128 + col];
          MOD[(size_t)(l * 4 + b) * NMOD + n0 + col] = s + ((const float*)A->in[I_BADA])[l * NMOD + n0 + col]; }
        __syncthreads();
    }
    { float* ROPE = (float*)(A->ws + WS_ROPE); const int* pos = (const int*)A->in[I_POS];
      for (int it = bx * 512 + tid; it < MTOK * 8; it += G * 512) { const int tok = it >> 3, j = it & 7;
          const double x = (double)pos[tok] * INVF[j]; const double n = rint(x * 0.15915494309189535); const float r = (float)(x - n * 6.283185307179586);
          ROPE[tok * 16 + j] = cosf(r); ROPE[tok * 16 + 8 + j] = sinf(r); } }
    const int gw = bx * 8 + wave, NGW = G * 8;
    { LAS float* scr = (LAS float*)(lds + wave * 16384);
      static_assert(PROJ_FP8 && WOUT_FP8, "the 128 x 32 converter writes fp8");
      constexpr int I_IN = (DM / 128) * (NPROJ / 32), I_OUT = (DM / 128) * (DM / 32);
      for (int it = gw; it < DEPTH * (I_IN + I_OUT); it += NGW) { const int l = it / (I_IN + I_OUT); int r = it % (I_IN + I_OUT);
          if (r < I_IN) transpose_item128<MAP_QK>((const float*)A->in[I_WIN] + (size_t)l * DM * NPROJ, DM, NPROJ, A->ws + WS_WIN + (size_t)l * NPROJP * DM, scr, r, lane, WSC_IN);
          else transpose_item128<MAP_ID>((const float*)A->in[I_WOUT] + (size_t)l * DM * DM, DM, DM, A->ws + WS_WOUT + (size_t)l * DM * DM, scr, r - I_IN, lane, WSC_O); } }
    { const int gt = bx * 512 + tid; constexpr int EB = PROJ_FP8 ? 1 : 2; constexpr int PER = (NPROJP - NPROJ) * DM * EB / 16;
      for (int it = gt; it < DEPTH * PER; it += G * 512) { const int l = it / PER, r = it % PER;
          *(u32x4*)(A->ws + WS_WIN + ((size_t)l * NPROJP * DM + (size_t)NPROJ * DM) * EB + (size_t)r * 16) = (u32x4){0u, 0u, 0u, 0u}; } }
    { const int gt = bx * 512 + tid; bf16_t* LW = (bf16_t*)(A->ws + WS_LW);
      for (int it = gt; it < DEPTH * 48 * NDYN; it += G * 512) { const int c = it % NDYN, kc = (it / NDYN) % 48, l = it / (NDYN * 48);
          const int kind = c >> 10, cc = c & 1023; float v[8];
#pragma unroll
          for (int j = 0; j < 8; ++j) { const int k = 8 * kc + j; float x = 0.f;
              if (kind < 2) { const int r = k - 64 * kind; if (r >= 0 && r < 64) x = ((const float*)A->in[I_DUP])[((size_t)(l * 2 + kind) * 64 + r) * 1024 + cc]; }
              else if (kind < 4) { const int r = k - 128 - 64 * (kind - 2); if (r >= 0 && r < 64) x = ((const float*)A->in[I_AUP])[((size_t)(l * 2 + kind - 2) * 64 + r) * 1024 + cc]; }
              else { const int r = k - 256; if (r >= 0 && r < 128) x = ((const float*)A->in[I_GUP])[((size_t)l * 128 + r) * 1024 + cc]; }
              v[j] = x; }
          *(u32x4*)(LW + ((size_t)l * NDYN + c) * KLA + 8 * kc) = pack8(v); } }
#if !SCAN_CONVERT
    convert_moe(A, 0, lds, lane, wave, gw, NGW);
#endif
}

__device__ __forceinline__ void load_moe_table(ArgsP A, int l, LAS unsigned char* lds, int tid) {
    LAS int* tb = (LAS int*)(lds + LDS_MISC + 64); LAS int* cn = (LAS int*)(lds + LDS_MISC + 192);
    if (tid == 0) { unsigned* ctl = (unsigned*)(A->ws + WS_CTL); int s = 0;
        for (int e = 0; e < NEXP; ++e) { int c = (int)__hip_atomic_load(ctl + CW_CNT + (l * 16 + e) * 64, __ATOMIC_RELAXED, __HIP_MEMORY_SCOPE_AGENT); if (c > TOKCAP) c = TOKCAP; cn[e] = c; tb[e] = s; s += (c + 255) >> 8; }
        tb[16] = s; }
    __syncthreads();
}

template <int MODE> __device__ __forceinline__ void phase_norm1(ArgsP A, int l, LAS unsigned char* lds, int tid, int lane, int wave, int bx, int G) {
    const float* MOD = (const float*)(A->ws + WS_MOD);
    bf16_t* X = (bf16_t*)(A->ws + WS_X); bf16_t* H = (bf16_t*)(A->ws + WS_H);
    const unsigned char* Y = A->ws + WS_Y; const u32x4* ASG = (const u32x4*)(A->ws + WS_ASG);
    const LAS int* tb = (const LAS int*)(lds + LDS_MISC + 64);
    if (MODE != 0) load_moe_table(A, l - 1, lds, tid);
    const int gw = bx * 8 + wave, NGW = G * 8;
    for (int b = 0; b < BATCH; ++b) {
        f32x4 mulv[8], addv[8], g2v[8];
#pragma unroll
        for (int j = 0; j < 8; ++j) { const int c = 4 * (lane + 64 * j);
            if (MODE == 2) { mulv[j] = *(const f32x4*)((const float*)A->in[I_FG] + c); addv[j] = (f32x4){0.f, 0.f, 0.f, 0.f}; }
            else { const float* mo = MOD + (size_t)(l * 4 + b) * NMOD; const f32x4 gn = *(const f32x4*)((const float*)A->in[I_NGAIN] + (size_t)(l * 2 + 0) * DM + c);
                   mulv[j] = gn * (*(const f32x4*)(mo + 1 * DM + c) + 1.0f); addv[j] = *(const f32x4*)(mo + 0 * DM + c); }
            if (MODE != 0) g2v[j] = *(const f32x4*)(MOD + (size_t)((l - 1) * 4 + b) * NMOD + 5 * DM + c); }
        for (int row = b * SEQ + gw; row < (b + 1) * SEQ; row += NGW) {
            f32x4 v[8];
            if (MODE == 0) { const f32x4* xr = (const f32x4*)((const float*)A->in[I_X] + (size_t)row * DM) + lane;
#pragma unroll
                for (int j = 0; j < 8; ++j) v[j] = xr[64 * j]; }
            else { const u32x2* xr = (const u32x2*)(X + (size_t)row * DM) + lane;
#pragma unroll
                for (int j = 0; j < 8; ++j) { const u32x2 p = xr[64 * j]; v[j] = (f32x4){bflo(p.x), bfhi(p.x), bflo(p.y), bfhi(p.y)}; } }
            if (MODE != 0) {
                const u32x4 as = ASG[row];
                const int e0 = __builtin_amdgcn_readfirstlane((int)(as.x >> 20)), s0 = __builtin_amdgcn_readfirstlane((int)(as.x & 0xfffffu));
                const int e1 = __builtin_amdgcn_readfirstlane((int)(as.y >> 20)), s1 = __builtin_amdgcn_readfirstlane((int)(as.y & 0xfffffu));
                const float w0 = __uint_as_float(as.z) * (1.0f / YSC), w1 = __uint_as_float(as.w) * (1.0f / YSC);
                const int* y0 = (const int*)(Y + ((size_t)tb[e0] * 256 + s0) * DM) + lane; const int* y1 = (const int*)(Y + ((size_t)tb[e1] * 256 + s1) * DM) + lane;
#pragma unroll
                for (int j = 0; j < 8; ++j) { const int p = y0[64 * j], q = y1[64 * j];
                    f32x4 m; m[0] = w0 * __builtin_amdgcn_cvt_f32_fp8(p, 0) + w1 * __builtin_amdgcn_cvt_f32_fp8(q, 0); m[1] = w0 * __builtin_amdgcn_cvt_f32_fp8(p, 1) + w1 * __builtin_amdgcn_cvt_f32_fp8(q, 1);
                    m[2] = w0 * __builtin_amdgcn_cvt_f32_fp8(p, 2) + w1 * __builtin_amdgcn_cvt_f32_fp8(q, 2); m[3] = w0 * __builtin_amdgcn_cvt_f32_fp8(p, 3) + w1 * __builtin_amdgcn_cvt_f32_fp8(q, 3);
                    v[j] = v[j] + g2v[j] * m; }
                if (MODE == 1) { u32x2* xw = (u32x2*)(X + (size_t)row * DM) + lane;
#pragma unroll
                    for (int j = 0; j < 8; ++j) { u32x2 w; w.x = cvt_pk_bf16(v[j][0], v[j][1]); w.y = cvt_pk_bf16(v[j][2], v[j][3]); xw[64 * j] = w; } }
            }
            float ss = 0.f;
#pragma unroll
            for (int j = 0; j < 8; ++j) ss += (v[j][0] * v[j][0] + v[j][1] * v[j][1]) + (v[j][2] * v[j][2] + v[j][3] * v[j][3]);
            const float rstd = 1.0f / sqrtf(wave_sum(ss) * (1.0f / DM) + 1e-6f);
            if (MODE == 2) { f32x4* ow = (f32x4*)(A->out + (size_t)row * DM) + lane;
#pragma unroll
                for (int j = 0; j < 8; ++j) ow[64 * j] = v[j] * rstd * mulv[j];
            } else {
#if PROJ_FP8
                int* hw = (int*)((unsigned char*)H + (size_t)row * DM) + lane;
#pragma unroll
                for (int j = 0; j < 8; ++j) { const f32x4 h = v[j] * rstd * mulv[j] + addv[j]; hw[64 * j] = pk4_fp8(h[0], h[1], h[2], h[3]); }
#else
                u32x2* hw = (u32x2*)(H + (size_t)row * DM) + lane;
#pragma unroll
                for (int j = 0; j < 8; ++j) { const f32x4 h = v[j] * rstd * mulv[j] + addv[j]; u32x2 w; w.x = cvt_pk_bf16(h[0], h[1]); w.y = cvt_pk_bf16(h[2], h[3]); hw[64 * j] = w; }
#endif
            }
        }
    }
#if !SCAN_CONVERT
    if (MODE == 1) { VM_WAIT(); __syncthreads(); convert_moe(A, l, lds, lane, wave, gw, NGW); }
#endif
}

__device__ __forceinline__ void phase_norm2_router(ArgsP A, int l, LAS unsigned char* lds, int tid, int lane, int wave, int bx, int G, int dry) {
    const float* MOD = (const float*)(A->ws + WS_MOD);
    const bf16_t* X = (const bf16_t*)(A->ws + WS_X); bf16_t* H = (bf16_t*)(A->ws + WS_H);
    LAS float* wr_l = (LAS float*)lds;
    LAS int* l_e = (LAS int*)(lds + LDS_MISC + 512);
    LAS float* l_g = (LAS float*)(lds + LDS_MISC + 1024);
    LAS int* l_cnt = (LAS int*)(lds + LDS_MISC + 1536);
    LAS int* l_base = (LAS int*)(lds + LDS_MISC + 1600);
    LAS int* l_loc = (LAS int*)(lds + LDS_MISC + 1664);
    { const f32x4* src = (const f32x4*)A->in[I_WR]; for (int t = tid; t < DM * NEXP / 4; t += 512) { const int c = t >> 2, q = t & 3, L = (c >> 2) & 63, j = c >> 8, i = c & 3;
        *(LAS f32x4*)(wr_l + 4 * ((((j * 4 + i) * 4 + q) * 64) + L)) = src[t]; } }
    if (tid < 16) l_cnt[tid] = 0;
    __syncthreads();
    for (int rblk = bx; rblk < MTOK / 64; rblk += G) {
        const int b = (rblk * 64) / SEQ;
        const float* mo = MOD + (size_t)(l * 4 + b) * NMOD;
        const float* gnp = (const float*)A->in[I_NGAIN] + (size_t)(l * 2 + 1) * DM;
        for (int rr = 0; rr < 8; rr += 2) {
            const int rl = wave * 8 + rr, row = rblk * 64 + rl;
            u32x2 p0[8], p1[8];
            { const u32x2* x0 = (const u32x2*)(X + (size_t)row * DM) + lane; const u32x2* x1 = x0 + DM / 4;
#pragma unroll
              for (int j = 0; j < 8; ++j) { p0[j] = x0[64 * j]; p1[j] = x1[64 * j]; } }
#define UNP(p) (f32x4){bflo((p).x), bfhi((p).x), bflo((p).y), bfhi((p).y)}
            float ss0 = 0.f, ss1 = 0.f;
#pragma unroll
            for (int j = 0; j < 8; ++j) { const f32x4 a = UNP(p0[j]), b = UNP(p1[j]);
                ss0 += (a[0] * a[0] + a[1] * a[1]) + (a[2] * a[2] + a[3] * a[3]); ss1 += (b[0] * b[0] + b[1] * b[1]) + (b[2] * b[2] + b[3] * b[3]); }
            const float rstd0 = 1.0f / sqrtf(wave_sum(ss0) * (1.0f / DM) + 1e-6f), rstd1 = 1.0f / sqrtf(wave_sum(ss1) * (1.0f / DM) + 1e-6f);
            float lg0[16], lg1[16];
#pragma unroll
            for (int e = 0; e < 16; ++e) { lg0[e] = 0.f; lg1[e] = 0.f; }
            int* hw0 = (int*)((unsigned char*)H + (size_t)row * DM) + lane;
            int* hw1 = hw0 + DM / 4;
#pragma unroll
            for (int j = 0; j < 8; ++j) { const int cj = 4 * (lane + 64 * j);
                const f32x4 mulj = *(const f32x4*)(gnp + cj) * (*(const f32x4*)(mo + 4 * DM + cj) + 1.0f), addj = *(const f32x4*)(mo + 3 * DM + cj);
                const f32x4 h0 = UNP(p0[j]) * rstd0 * mulj + addj, h1 = UNP(p1[j]) * rstd1 * mulj + addj;
                hw0[64 * j] = pk4_fp8(h0[0], h0[1], h0[2], h0[3]); hw1[64 * j] = pk4_fp8(h1[0], h1[1], h1[2], h1[3]);
#pragma unroll
                for (int i = 0; i < 4; ++i) { const LAS f32x4* wp = (const LAS f32x4*)wr_l + (j * 4 + i) * 4 * 64 + lane;
#pragma unroll
                    for (int q = 0; q < 4; ++q) { const f32x4 ww = wp[q * 64];
                        lg0[4 * q + 0] += h0[i] * ww[0]; lg0[4 * q + 1] += h0[i] * ww[1]; lg0[4 * q + 2] += h0[i] * ww[2]; lg0[4 * q + 3] += h0[i] * ww[3];
                        lg1[4 * q + 0] += h1[i] * ww[0]; lg1[4 * q + 1] += h1[i] * ww[1]; lg1[4 * q + 2] += h1[i] * ww[2]; lg1[4 * q + 3] += h1[i] * ww[3]; } }
                __builtin_amdgcn_sched_barrier(0); }
#undef UNP
            float lg[16];
#pragma unroll
            for (int e = 0; e < 16; ++e) { const float a = wave_sum(lg0[e]), b = wave_sum(lg1[e]); lg[e] = (lane == 1) ? b : a; }
            if (lane < 2) {
                const int rl2 = rl + lane;
                float sc[16], sel[16]; const float* rb = (const float*)A->in[I_RB];
#pragma unroll
                for (int e = 0; e < 16; ++e) { sc[e] = sigmoidf_(lg[e]); sel[e] = sc[e] + rb[e]; }
                int bg = 0; float bgs = -1e30f;
#pragma unroll
                for (int g = 0; g < 4; ++g) { float m1 = -1e30f, m2 = -1e30f;
#pragma unroll
                    for (int i = 0; i < 4; ++i) { const float s = sel[4 * g + i]; if (s > m1) { m2 = m1; m1 = s; } else if (s > m2) m2 = s; }
                    const float gs = m1 + m2; if (gs > bgs) { bgs = gs; bg = g; } }
                int i1 = 0; float m1 = -1e30f;
#pragma unroll
                for (int g = 0; g < 4; ++g) if (g == bg) {
#pragma unroll
                    for (int i = 0; i < 4; ++i) if (sel[4 * g + i] > m1) { m1 = sel[4 * g + i]; i1 = i; } }
                int i2 = 0; float m2 = -1e30f;
#pragma unroll
                for (int g = 0; g < 4; ++g) if (g == bg) {
#pragma unroll
                    for (int i = 0; i < 4; ++i) if (i != i1 && sel[4 * g + i] > m2) { m2 = sel[4 * g + i]; i2 = i; } }
                const int e1 = 4 * bg + i1, e2 = 4 * bg + i2; float s1 = 0.f, s2 = 0.f;
#pragma unroll
                for (int e = 0; e < 16; ++e) { if (e == e1) s1 = sc[e]; if (e == e2) s2 = sc[e]; }
                const float inv = 1.0f / (s1 + s2);
                l_e[2 * rl2] = e1; l_e[2 * rl2 + 1] = e2; l_g[2 * rl2] = s1 * inv; l_g[2 * rl2 + 1] = s2 * inv;
            }
        }
        __syncthreads();
        { const int tid2 = launder_v(tid);
        if (tid2 < 128) l_loc[tid2] = atomicAdd((int*)&l_cnt[l_e[tid2]], 1);
        __syncthreads();
        if (tid2 < 16) { unsigned* ctl = (unsigned*)(A->ws + WS_CTL); const int c = l_cnt[tid2];
            l_base[tid2] = c ? (int)__hip_atomic_fetch_add(ctl + CW_CNT + ((l + 2 * dry) * 16 + tid2) * 64, (unsigned)c, __ATOMIC_RELAXED, __HIP_MEMORY_SCOPE_AGENT) : 0; }
        __syncthreads();
        if (tid2 < 128) { const int e = l_e[tid2]; const int slot = l_base[e] + l_loc[tid2]; const int row = rblk * 64 + (tid2 >> 1);
            int* tokl = (int*)(A->ws + WS_TOKL); if (slot < TOKCAP && !dry) tokl[e * TOKCAP + slot] = row;
            unsigned* asg = (unsigned*)(A->ws + WS_ASG) + (size_t)row * 4; if (!dry) asg[tid2 & 1] = ((unsigned)e << 20) | (unsigned)slot; if (!dry) asg[2 + (tid2 & 1)] = __float_as_uint(l_g[tid2]); }
        __syncthreads();
        }
        if (tid < 16) l_cnt[tid] = 0;
        __syncthreads();
    }
}

__device__ __forceinline__ void phase_prep(ArgsP A, int l, int lane, int wave, int bx, int G) {
    const bf16_t* PROJ = (const bf16_t*)(A->ws + WS_PROJ); bf16_t* SHR = (bf16_t*)(A->ws + WS_SHR); bf16_t* LA = (bf16_t*)(A->ws + WS_LA);
    const int gw = bx * 8 + wave, NGW = G * 8;
    for (int it = gw; it < 7 * (MTOK / 64); it += NGW) {
        const int strip = it % 7, run = it / 7;
        if (strip == 6 && lane >= 48) continue;
        const int c = strip * 512 + 8 * lane;
        float mup[8], mun[8], kkv[8];
#pragma unroll
        for (int j = 0; j < 8; ++j) { mup[j] = ((const float*)A->in[I_MUP])[l * RWC + c + j]; mun[j] = ((const float*)A->in[I_MUN])[l * RWC + c + j];
            kkv[j] = (strip == 2 || strip == 3) ? ((const float*)A->in[I_KK])[l * 1024 + (c - 1024) + j] : 0.f; }
        const int t0 = run * 64, tl0 = t0 % SEQ;
        const bf16_t* pp = PROJ + (size_t)t0 * NPROJP + RW0 + c;
        float prev[8], cur[8], nxt[8];
        if (tl0 == 0) {
#pragma unroll
            for (int j = 0; j < 8; ++j) prev[j] = 0.f; } else unpack8(*(const u32x4*)(pp - NPROJP), prev);
        unpack8(*(const u32x4*)pp, cur);
        u32x4 rawn[8];
#pragma unroll
        for (int q = 0; q < 8; ++q) rawn[q] = *(const u32x4*)(pp + (size_t)(q + 1) * NPROJP);
        for (int i0 = 0; i0 < 64; i0 += 8) {
            u32x4 raw[8];
#pragma unroll
            for (int q = 0; q < 8; ++q) raw[q] = rawn[q];
            if (i0 + 8 < 64) {
#pragma unroll
                for (int q = 0; q < 8; ++q) rawn[q] = *(const u32x4*)(pp + (size_t)(i0 + 8 + q + 1) * NPROJP); }
#pragma unroll
            for (int q = 0; q < 8; ++q) {
            const int i = i0 + q; const int row = t0 + i;
            unpack8(raw[q], nxt);
            if (tl0 + i == SEQ - 1) {
#pragma unroll
                for (int j = 0; j < 8; ++j) nxt[j] = 0.f; }
            float ps[8];
#pragma unroll
            for (int j = 0; j < 8; ++j) ps[j] = cur[j] + mup[j] * (prev[j] - cur[j]) + mun[j] * (nxt[j] - cur[j]);
            if (strip < 6) {
                const int reg = strip >> 1, cc = (strip & 1) * 512 + 8 * lane;
                *(u32x4*)(SHR + (size_t)row * 4096 + reg * 1024 + cc) = pack8(ps);
                if (reg == 1) { float x[8]; float ss = 0.f;
#pragma unroll
                    for (int j = 0; j < 8; ++j) { x[j] = ps[j] * kkv[j]; ss += x[j] * x[j]; }
                    ss += __shfl_xor(ss, 1); ss += __shfl_xor(ss, 2); ss += __shfl_xor(ss, 4);
                    const float inv = 1.0f / fmaxf(sqrtf(ss), 1e-12f);
#pragma unroll
                    for (int j = 0; j < 8; ++j) x[j] *= inv;
                    *(u32x4*)(SHR + (size_t)row * 4096 + 3072 + cc) = pack8(x); }
            } else {
                const int ty = lane >> 4; float o[8];
#pragma unroll
                for (int j = 0; j < 8; ++j) o[j] = (ty == 0) ? (1.0f - 2.0f / (1.0f + __expf(2.0f * ps[j]))) : (ty == 1) ? ps[j] : sigmoidf_(ps[j]);
                *(u32x4*)(LA + (size_t)row * KLA + 8 * lane) = pack8(o);
            }
#pragma unroll
            for (int j = 0; j < 8; ++j) { prev[j] = cur[j]; cur[j] = nxt[j]; }
            }
        }
    }
}

__device__ __forceinline__ float rowsum16(float x) {
    x += __builtin_bit_cast(float, __builtin_amdgcn_update_dpp(0, __builtin_bit_cast(int, x), 0x128, 0xf, 0xf, false));
    x += __builtin_bit_cast(float, __builtin_amdgcn_update_dpp(0, __builtin_bit_cast(int, x), 0x124, 0xf, 0xf, false));
    x += __builtin_bit_cast(float, __builtin_amdgcn_update_dpp(0, __builtin_bit_cast(int, x), 0x122, 0xf, 0xf, false));
    x += __builtin_bit_cast(float, __builtin_amdgcn_update_dpp(0, __builtin_bit_cast(int, x), 0x121, 0xf, 0xf, false));
    return x;
}
namespace rs {
typedef short rs_v4i16 __attribute__((ext_vector_type(4)));
template <int T> __device__ __forceinline__ void fmac_bc(float& acc, float c, float x) { asm("v_fmac_f32_dpp %0, %1, %2 row_newbcast:%3 row_mask:0xf bank_mask:0xf" : "+v"(acc) : "v"(c), "v"(x), "n"(T)); }
constexpr int M = 16, NCH = SEQ / M;
constexpr int SLOT = 21248, O_AR = 0, O_BK = 5632, O_BKT = 10240, O_VT = 15360, O_MRB = 18432, O_LAB = 19968, O_GAM = 20992;
constexpr int P_AR = 176, P_BK = 144, P_BKT = 80, P_VT = 48, P_MRB = 48;
constexpr int O_YB = 3 * SLOT, O_CV = O_YB + 8192;
__device__ __forceinline__ float bfu(unsigned short x) { return __uint_as_float(((unsigned)x) << 16); }
__device__ __forceinline__ unsigned cvtpk(float lo, float hi) { unsigned r; asm("v_cvt_pk_bf16_f32 %0, %1, %2" : "=v"(r) : "v"(lo), "v"(hi)); return r; }
__device__ __forceinline__ unsigned short f2bf(float f) { return (unsigned short)(cvtpk(f, 0.f) & 0xffffu); }
__device__ __forceinline__ bf16x8 pack_bf8(float a, float b, float c, float d, float e, float f, float g, float h) {
    u32x4 w; w.x = cvtpk(a, b); w.y = cvtpk(c, d); w.z = cvtpk(e, f); w.w = cvtpk(g, h); return __builtin_bit_cast(bf16x8, w); }
}
__device__ __forceinline__ void phase_scan(ArgsP A, int l, LAS unsigned char* lds, int tid, int bx, int G) {
    using namespace rs;
    const bf16_t* SHR = (const bf16_t*)(A->ws + WS_SHR); const bf16_t* DYN = (const bf16_t*)(A->ws + WS_DYN); bf16_t* YS = (bf16_t*)(A->ws + WS_YS);
    const int hwid = __builtin_amdgcn_readfirstlane(tid >> 6);
    const int wid = (hwid == 1) ? 7 : (hwid == 5) ? 1 : (hwid == 6) ? 5 : (hwid == 7) ? 6 : hwid;
    const int lane = tid & 63, l31 = lane & 31, hh = lane >> 5;
    const bool xsplit = (G == 256);
    for (int chain = xsplit ? (((bx >> 3) & 1) ? 128 : ((bx >> 4) * 8 + (bx & 7))) : bx; chain < 128; chain += xsplit ? 128 : G) {
        const int d = chain >> 6, b = (chain >> 4) & 3, h = chain & 15; const int hf = (wid == 7) ? 1 : 0;
#define RS_ROW(c, t) ((size_t)b * SEQ + (d ? (SEQ - 1 - ((c) * M + (t))) : ((c) * M + (t))))
        f32x16 ST0 = {}, ST1 = {};
        u32x4 q0a, q0b, q1a, q1b, q2a, q2b, q3a, q3b;
        float kaj = 0.f;
        const int cpos = (lane >> 4) * 32 + ((lane >> 2) & 1) * 16 + ((((lane >> 3) & 1) << 2) | (lane & 3)) * 2;
        const bool e1 = (wid == 2) || (wid == 5), e2 = (wid == 3) || (wid == 6); const int epar = (wid >= 5) ? 1 : 0;
        const int ew = (wid == 2) ? 0 : (wid == 3) ? 1 : (wid == 5) ? 2 : 3;
        LAS unsigned char* stg = lds + O_CV + ew * 8192;
        if (e2) kaj = ((const float*)A->in[I_KA])[l * 1024 + h * 64 + lane];
#define RS_LOAD(c) do { const size_t ra_ = RS_ROW(c, lane >> 3), rb_ = RS_ROW(c, 8 + (lane >> 3)); const int cg_ = 8 * (lane & 7); \
            const bf16_t* sa_ = SHR + ra_ * 4096 + h * 64 + cg_; const bf16_t* sb_ = SHR + rb_ * 4096 + h * 64 + cg_; \
            const bf16_t* da_ = DYN + ra_ * NDYN + d * 1024 + h * 64 + cg_; const bf16_t* db_ = DYN + rb_ * NDYN + d * 1024 + h * 64 + cg_; \
            q0a = *(const u32x4*)da_; q0b = *(const u32x4*)db_; q1a = *(const u32x4*)(sa_ + 3072); q1b = *(const u32x4*)(sb_ + 3072); \
            if (e1) { q2a = *(const u32x4*)sa_; q2b = *(const u32x4*)sb_; q3a = *(const u32x4*)(sa_ + 2048); q3b = *(const u32x4*)(sb_ + 2048); } \
            else { q2a = *(const u32x4*)(da_ + 2048); q2b = *(const u32x4*)(db_ + 2048); q3a = *(const u32x4*)(sa_ + 1024); q3b = *(const u32x4*)(sb_ + 1024); } } while (0)
#define RS_STAGE() do { const int o_ = ((lane >> 3) * 64 + 8 * (lane & 7)) * 2; \
            *(LAS u32x4*)(stg + o_) = q0a; *(LAS u32x4*)(stg + 1024 + o_) = q0b; *(LAS u32x4*)(stg + 2048 + o_) = q1a; *(LAS u32x4*)(stg + 3072 + o_) = q1b; \
            *(LAS u32x4*)(stg + 4096 + o_) = q2a; *(LAS u32x4*)(stg + 5120 + o_) = q2b; \
            *(LAS u32x4*)(stg + 6144 + o_) = q3a; *(LAS u32x4*)(stg + 7168 + o_) = q3b; \
            asm volatile("s_waitcnt lgkmcnt(0)" ::: "memory"); } while (0)
#define RS_GET(arr, t_) bfu(*(const LAS unsigned short*)(stg + (arr) * 2048 + (t_) * 128 + 2 * lane))
        const int trb = ((lane & 15) >> 2) * 128 + (lane >> 4) * 32 + (lane & 3) * 8;
#define RS_GET4(arr, t0) __builtin_bit_cast(s16x4, __builtin_amdgcn_ds_read_tr16_b64_v4i16((LAS rs_v4i16*)(stg + (arr) * 2048 + (t0) * 128 + trb)))
#define RS_UNP4(dst, t0, q) do { dst[(t0)] = bfu((unsigned short)q[0]); dst[(t0) + 1] = bfu((unsigned short)q[1]); dst[(t0) + 2] = bfu((unsigned short)q[2]); dst[(t0) + 3] = bfu((unsigned short)q[3]); } while (0)
        if ((e1 || e2) && epar == 0) { RS_LOAD(0); asm volatile("s_waitcnt vmcnt(0)" ::: "memory"); RS_STAGE(); }
        for (int n = 0; n < NCH + 3; ++n) {
            if (wid == 0 || wid == 7) {
                const int c = n - 2;
                if (c >= 0 && c < NCH) {
                    LAS unsigned char* sl = lds + (c % 3) * SLOT;
                    f32x16 D = {};
                    const LAS unsigned char* arp = sl + O_AR + l31 * P_AR + hh * 16;
                    {   bf16x8 a0 = *(const LAS bf16x8*)(arp), a1 = *(const LAS bf16x8*)(arp + 32), a2 = *(const LAS bf16x8*)(arp + 64), a3 = *(const LAS bf16x8*)(arp + 96), a4 = *(const LAS bf16x8*)(arp + 128);
                        const bf16x8 bv = *(const LAS bf16x8*)(sl + O_VT + (32 * hf + l31) * P_VT + hh * 16);
                        const bf16x8 b0 = pack_bf8(ST0[0], ST0[1], ST0[2], ST0[3], ST0[4], ST0[5], ST0[6], ST0[7]), b1 = pack_bf8(ST0[8], ST0[9], ST0[10], ST0[11], ST0[12], ST0[13], ST0[14], ST0[15]);
                        const bf16x8 b2 = pack_bf8(ST1[0], ST1[1], ST1[2], ST1[3], ST1[4], ST1[5], ST1[6], ST1[7]), b3 = pack_bf8(ST1[8], ST1[9], ST1[10], ST1[11], ST1[12], ST1[13], ST1[14], ST1[15]);
                        D = __builtin_amdgcn_mfma_f32_32x32x16_bf16(a0, b0, D, 0, 0, 0); D = __builtin_amdgcn_mfma_f32_32x32x16_bf16(a1, b1, D, 0, 0, 0);
                        D = __builtin_amdgcn_mfma_f32_32x32x16_bf16(a2, b2, D, 0, 0, 0); D = __builtin_amdgcn_mfma_f32_32x32x16_bf16(a3, b3, D, 0, 0, 0);
                        D = __builtin_amdgcn_mfma_f32_32x32x16_bf16(a4, bv, D, 0, 0, 0);
                        float da[16];
#pragma unroll
                        for (int r = 0; r < 8; ++r) { auto rr = __builtin_amdgcn_permlane32_swap(__float_as_uint(D[r]), __float_as_uint(D[r]), false, false);
                            const int t0 = (r & 3) + 8 * (r >> 2); da[t0] = __uint_as_float(rr[0]); da[t0 + 4] = __uint_as_float(rr[1]); }
                        const LAS float* lab = (const LAS float*)(sl + O_LAB) + (lane & 15);
                        float lr_[15];
#pragma unroll
                        for (int s_ = 0; s_ < 15; ++s_) lr_[s_] = lab[s_ * 16];
                        rs::fmac_bc<1>(da[1], lr_[0], da[0]); rs::fmac_bc<2>(da[2], lr_[0], da[0]); rs::fmac_bc<3>(da[3], lr_[0], da[0]); rs::fmac_bc<4>(da[4], lr_[0], da[0]); rs::fmac_bc<5>(da[5], lr_[0], da[0]); rs::fmac_bc<6>(da[6], lr_[0], da[0]); rs::fmac_bc<7>(da[7], lr_[0], da[0]); rs::fmac_bc<8>(da[8], lr_[0], da[0]); rs::fmac_bc<9>(da[9], lr_[0], da[0]); rs::fmac_bc<10>(da[10], lr_[0], da[0]); rs::fmac_bc<11>(da[11], lr_[0], da[0]); rs::fmac_bc<12>(da[12], lr_[0], da[0]); rs::fmac_bc<13>(da[13], lr_[0], da[0]); rs::fmac_bc<14>(da[14], lr_[0], da[0]); rs::fmac_bc<15>(da[15], lr_[0], da[0]);
                        rs::fmac_bc<2>(da[2], lr_[1], da[1]); rs::fmac_bc<3>(da[3], lr_[1], da[1]); rs::fmac_bc<4>(da[4], lr_[1], da[1]); rs::fmac_bc<5>(da[5], lr_[1], da[1]); rs::fmac_bc<6>(da[6], lr_[1], da[1]); rs::fmac_bc<7>(da[7], lr_[1], da[1]); rs::fmac_bc<8>(da[8], lr_[1], da[1]); rs::fmac_bc<9>(da[9], lr_[1], da[1]); rs::fmac_bc<10>(da[10], lr_[1], da[1]); rs::fmac_bc<11>(da[11], lr_[1], da[1]); rs::fmac_bc<12>(da[12], lr_[1], da[1]); rs::fmac_bc<13>(da[13], lr_[1], da[1]); rs::fmac_bc<14>(da[14], lr_[1], da[1]); rs::fmac_bc<15>(da[15], lr_[1], da[1]);
                        rs::fmac_bc<3>(da[3], lr_[2], da[2]); rs::fmac_bc<4>(da[4], lr_[2], da[2]); rs::fmac_bc<5>(da[5], lr_[2], da[2]); rs::fmac_bc<6>(da[6], lr_[2], da[2]); rs::fmac_bc<7>(da[7], lr_[2], da[2]); rs::fmac_bc<8>(da[8], lr_[2], da[2]); rs::fmac_bc<9>(da[9], lr_[2], da[2]); rs::fmac_bc<10>(da[10], lr_[2], da[2]); rs::fmac_bc<11>(da[11], lr_[2], da[2]); rs::fmac_bc<12>(da[12], lr_[2], da[2]); rs::fmac_bc<13>(da[13], lr_[2], da[2]); rs::fmac_bc<14>(da[14], lr_[2], da[2]); rs::fmac_bc<15>(da[15], lr_[2], da[2]);
                        rs::fmac_bc<4>(da[4], lr_[3], da[3]); rs::fmac_bc<5>(da[5], lr_[3], da[3]); rs::fmac_bc<6>(da[6], lr_[3], da[3]); rs::fmac_bc<7>(da[7], lr_[3], da[3]); rs::fmac_bc<8>(da[8], lr_[3], da[3]); rs::fmac_bc<9>(da[9], lr_[3], da[3]); rs::fmac_bc<10>(da[10], lr_[3], da[3]); rs::fmac_bc<11>(da[11], lr_[3], da[3]); rs::fmac_bc<12>(da[12], lr_[3], da[3]); rs::fmac_bc<13>(da[13], lr_[3], da[3]); rs::fmac_bc<14>(da[14], lr_[3], da[3]); rs::fmac_bc<15>(da[15], lr_[3], da[3]);
                        rs::fmac_bc<5>(da[5], lr_[4], da[4]); rs::fmac_bc<6>(da[6], lr_[4], da[4]); rs::fmac_bc<7>(da[7], lr_[4], da[4]); rs::fmac_bc<8>(da[8], lr_[4], da[4]); rs::fmac_bc<9>(da[9], lr_[4], da[4]); rs::fmac_bc<10>(da[10], lr_[4], da[4]); rs::fmac_bc<11>(da[11], lr_[4], da[4]); rs::fmac_bc<12>(da[12], lr_[4], da[4]); rs::fmac_bc<13>(da[13], lr_[4], da[4]); rs::fmac_bc<14>(da[14], lr_[4], da[4]); rs::fmac_bc<15>(da[15], lr_[4], da[4]);
                        rs::fmac_bc<6>(da[6], lr_[5], da[5]); rs::fmac_bc<7>(da[7], lr_[5], da[5]); rs::fmac_bc<8>(da[8], lr_[5], da[5]); rs::fmac_bc<9>(da[9], lr_[5], da[5]); rs::fmac_bc<10>(da[10], lr_[5], da[5]); rs::fmac_bc<11>(da[11], lr_[5], da[5]); rs::fmac_bc<12>(da[12], lr_[5], da[5]); rs::fmac_bc<13>(da[13], lr_[5], da[5]); rs::fmac_bc<14>(da[14], lr_[5], da[5]); rs::fmac_bc<15>(da[15], lr_[5], da[5]);
                        rs::fmac_bc<7>(da[7], lr_[6], da[6]); rs::fmac_bc<8>(da[8], lr_[6], da[6]); rs::fmac_bc<9>(da[9], lr_[6], da[6]); rs::fmac_bc<10>(da[10], lr_[6], da[6]); rs::fmac_bc<11>(da[11], lr_[6], da[6]); rs::fmac_bc<12>(da[12], lr_[6], da[6]); rs::fmac_bc<13>(da[13], lr_[6], da[6]); rs::fmac_bc<14>(da[14], lr_[6], da[6]); rs::fmac_bc<15>(da[15], lr_[6], da[6]);
                        rs::fmac_bc<8>(da[8], lr_[7], da[7]); rs::fmac_bc<9>(da[9], lr_[7], da[7]); rs::fmac_bc<10>(da[10], lr_[7], da[7]); rs::fmac_bc<11>(da[11], lr_[7], da[7]); rs::fmac_bc<12>(da[12], lr_[7], da[7]); rs::fmac_bc<13>(da[13], lr_[7], da[7]); rs::fmac_bc<14>(da[14], lr_[7], da[7]); rs::fmac_bc<15>(da[15], lr_[7], da[7]);
                        rs::fmac_bc<9>(da[9], lr_[8], da[8]); rs::fmac_bc<10>(da[10], lr_[8], da[8]); rs::fmac_bc<11>(da[11], lr_[8], da[8]); rs::fmac_bc<12>(da[12], lr_[8], da[8]); rs::fmac_bc<13>(da[13], lr_[8], da[8]); rs::fmac_bc<14>(da[14], lr_[8], da[8]); rs::fmac_bc<15>(da[15], lr_[8], da[8]);
                        rs::fmac_bc<10>(da[10], lr_[9], da[9]); rs::fmac_bc<11>(da[11], lr_[9], da[9]); rs::fmac_bc<12>(da[12], lr_[9], da[9]); rs::fmac_bc<13>(da[13], lr_[9], da[9]); rs::fmac_bc<14>(da[14], lr_[9], da[9]); rs::fmac_bc<15>(da[15], lr_[9], da[9]);
                        rs::fmac_bc<11>(da[11], lr_[10], da[10]); rs::fmac_bc<12>(da[12], lr_[10], da[10]); rs::fmac_bc<13>(da[13], lr_[10], da[10]); rs::fmac_bc<14>(da[14], lr_[10], da[10]); rs::fmac_bc<15>(da[15], lr_[10], da[10]);
                        rs::fmac_bc<12>(da[12], lr_[11], da[11]); rs::fmac_bc<13>(da[13], lr_[11], da[11]); rs::fmac_bc<14>(da[14], lr_[11], da[11]); rs::fmac_bc<15>(da[15], lr_[11], da[11]);
                        rs::fmac_bc<13>(da[13], lr_[12], da[12]); rs::fmac_bc<14>(da[14], lr_[12], da[12]); rs::fmac_bc<15>(da[15], lr_[12], da[12]);
                        rs::fmac_bc<14>(da[14], lr_[13], da[13]); rs::fmac_bc<15>(da[15], lr_[13], da[13]);
                        rs::fmac_bc<15>(da[15], lr_[14], da[14]);
                        const bf16x8 bu = hh ? pack_bf8(da[8], da[9], da[10], da[11], da[12], da[13], da[14], da[15]) : pack_bf8(da[0], da[1], da[2], da[3], da[4], da[5], da[6], da[7]);
                        const bf16x8 am = *(const LAS bf16x8*)(sl + O_MRB + l31 * P_MRB + hh * 16);
                        D = __builtin_amdgcn_mfma_f32_32x32x16_bf16(am, bu, D, 0, 0, 0);
                        LAS float* yb = (LAS float*)(lds + O_YB + (c & 1) * 4096);
#pragma unroll
                        for (int r = 8; r < 16; ++r) yb[((r & 3) + 8 * ((r >> 2) - 2) + 4 * hh) * 64 + 32 * hf + l31] = D[r];
                        const LAS unsigned char* bk0 = sl + O_BKT + l31 * P_BKT + hh * 16; const LAS unsigned char* bk1 = bk0 + 32 * P_BKT;
                        ST0 = __builtin_amdgcn_mfma_f32_32x32x16_bf16(*(const LAS bf16x8*)(bk0), bu, ST0, 0, 0, 0); ST0 = __builtin_amdgcn_mfma_f32_32x32x16_bf16(*(const LAS bf16x8*)(bk0 + 32), bv, ST0, 0, 0, 0);
                        ST1 = __builtin_amdgcn_mfma_f32_32x32x16_bf16(*(const LAS bf16x8*)(bk1), bu, ST1, 0, 0, 0); ST1 = __builtin_amdgcn_mfma_f32_32x32x16_bf16(*(const LAS bf16x8*)(bk1 + 32), bv, ST1, 0, 0, 0);
                        const LAS float* gam = (const LAS float*)(sl + O_GAM) + 4 * hh;
#pragma unroll
                        for (int g4 = 0; g4 < 4; ++g4) { const f32x4 g0 = *(const LAS f32x4*)(gam + 8 * g4), g1 = *(const LAS f32x4*)(gam + 32 + 8 * g4);
#pragma unroll
                            for (int i_ = 0; i_ < 4; ++i_) { ST0[4 * g4 + i_] *= g0[i_]; ST1[4 * g4 + i_] *= g1[i_]; } }
                    }
                }
            } else if (wid == 1) {
                const int c = n - 1;
                if (c >= 0 && c < NCH) {
                    LAS unsigned char* sl = lds + (c % 3) * SLOT;
                    f32x16 Lm = {};
                    const LAS unsigned char* ap = sl + O_BK + l31 * P_BK + hh * 16; const LAS unsigned char* bp = sl + O_AR + l31 * P_AR + hh * 16;
#pragma unroll
                    for (int q = 0; q < 4; ++q) Lm = __builtin_amdgcn_mfma_f32_32x32x16_bf16(*(const LAS bf16x8*)(ap + 32 * q), *(const LAS bf16x8*)(bp + 32 * q), Lm, 0, 0, 0);
                    const int tp = l31, tq = tp & 15; const bool isr = tp >= 16;
                    LAS float* lab = (LAS float*)(sl + O_LAB);
                    float lo[8], hi[8];
#pragma unroll
                    for (int r = 0; r < 8; ++r) { const int s_ = (r & 3) + 8 * (r >> 2) + 4 * hh; const bool keep = isr ? (s_ <= tq) : (s_ < tq);
                        lo[r] = keep ? Lm[r] : 0.f; hi[r] = keep ? Lm[8 + r] : 0.f; }
                    if (!isr) {
#pragma unroll
                        for (int r = 0; r < 8; ++r) lab[((r & 3) + 8 * (r >> 2) + 4 * hh) * 16 + tp] = lo[r]; }
                    { u32x2 w0, w1; w0.x = isr ? cvtpk(lo[0], lo[1]) : 0u; w0.y = isr ? cvtpk(lo[2], lo[3]) : 0u; w1.x = isr ? cvtpk(lo[4], lo[5]) : 0u; w1.y = isr ? cvtpk(lo[6], lo[7]) : 0u;
                      LAS unsigned char* mp = sl + O_MRB + tp * P_MRB + hh * 8; *(LAS u32x2*)(mp) = w0; *(LAS u32x2*)(mp + 16) = w1; }
                    { u32x2 w0, w1; w0.x = cvtpk(hi[0], hi[1]); w0.y = cvtpk(hi[2], hi[3]); w1.x = cvtpk(hi[4], hi[5]); w1.y = cvtpk(hi[6], hi[7]);
                      LAS unsigned char* qp = sl + O_AR + tp * P_AR + 128 + hh * 8; *(LAS u32x2*)(qp) = w0; *(LAS u32x2*)(qp + 16) = w1; }
                }
            } else if (e1) {
                if ((n & 1) != epar) { if (n + 1 < NCH) { RS_LOAD(n + 1); asm volatile("s_waitcnt vmcnt(0)" ::: "memory"); RS_STAGE(); } }
                else if (n < NCH) {
                    LAS unsigned char* sl = lds + (n % 3) * SLOT;
                    float g = 1.0f; float xw[16], xk[16], xr[16];
#pragma unroll
                    for (int t_ = 0; t_ < M; t_ += 4) { const s16x4 qa = RS_GET4(0, t_), qb = RS_GET4(1, t_), qc = RS_GET4(2, t_); RS_UNP4(xw, t_, qa); RS_UNP4(xk, t_, qb); RS_UNP4(xr, t_, qc); }
#pragma unroll
                    for (int t_ = 0; t_ < M; ++t_) { const float gp = g; g *= xw[t_];
                        *(LAS unsigned short*)(sl + O_AR + t_ * P_AR + cpos) = f2bf(-xk[t_] * gp);
                        *(LAS unsigned short*)(sl + O_AR + (16 + t_) * P_AR + cpos) = f2bf(xr[t_] * g); }
                    *(LAS float*)(sl + O_GAM + 4 * lane) = g;
                    { const s16x4 q0 = RS_GET4(3, 0), q1 = RS_GET4(3, 4), q2 = RS_GET4(3, 8), q3 = RS_GET4(3, 12);
                        const u32x2 d0 = __builtin_bit_cast(u32x2, q0), d1 = __builtin_bit_cast(u32x2, q1), d2 = __builtin_bit_cast(u32x2, q2), d3 = __builtin_bit_cast(u32x2, q3);
                        u32x4 v0, v1; v0.x = d0.x; v0.y = d0.y; v0.z = d1.x; v0.w = d1.y; v1.x = d2.x; v1.y = d2.y; v1.z = d3.x; v1.w = d3.y;
                        *(LAS u32x4*)(sl + O_VT + lane * P_VT) = v0; *(LAS u32x4*)(sl + O_VT + lane * P_VT + 16) = v1; }
                }
            } else if (e2) {
                if ((n & 1) != epar) { if (n + 1 < NCH) { RS_LOAD(n + 1); asm volatile("s_waitcnt vmcnt(0)" ::: "memory"); RS_STAGE(); } }
                else if (n < NCH) {
                    LAS unsigned char* sl = lds + (n % 3) * SLOT;
                    float g = 1.0f; float bq[16], kq[16], xw[16], xa[16];
#pragma unroll
                    for (int t_ = 0; t_ < M; t_ += 4) { const s16x4 qa = RS_GET4(0, t_), qb = RS_GET4(2, t_), qc = RS_GET4(1, t_), qd = RS_GET4(3, t_); RS_UNP4(xw, t_, qa); RS_UNP4(xa, t_, qb); RS_UNP4(bq, t_, qc); RS_UNP4(kq, t_, qd); }
#pragma unroll
                    for (int t_ = 0; t_ < M; ++t_) { g *= xw[t_]; const float rg = __builtin_amdgcn_rcpf(g); const float al = xa[t_];
                        bq[t_] = bq[t_] * al * rg; kq[t_] = kq[t_] * (1.0f + (al - 1.0f) * kaj) * rg;
                        *(LAS unsigned short*)(sl + O_BK + t_ * P_BK + cpos) = f2bf(bq[t_]);
                        *(LAS unsigned short*)(sl + O_BK + (16 + t_) * P_BK + cpos) = f2bf(kq[t_]); }
                    LAS unsigned char* tp_ = sl + O_BKT + lane * P_BKT;
                    *(LAS bf16x8*)(tp_) = pack_bf8(bq[0], bq[1], bq[2], bq[3], bq[4], bq[5], bq[6], bq[7]); *(LAS bf16x8*)(tp_ + 16) = pack_bf8(bq[8], bq[9], bq[10], bq[11], bq[12], bq[13], bq[14], bq[15]);
                    *(LAS bf16x8*)(tp_ + 32) = pack_bf8(kq[0], kq[1], kq[2], kq[3], kq[4], kq[5], kq[6], kq[7]); *(LAS bf16x8*)(tp_ + 48) = pack_bf8(kq[8], kq[9], kq[10], kq[11], kq[12], kq[13], kq[14], kq[15]);
                }
            } else {
                const int c = n - 3;
                if (wid == 4)
                if (c >= 0 && c < NCH) { const LAS float* yb = (const LAS float*)(lds + O_YB + (c & 1) * 4096); const int t_ = lane >> 2, q_ = lane & 3;
                    const f32x4 y0 = *(const LAS f32x4*)(yb + t_ * 64 + 16 * q_), y1 = *(const LAS f32x4*)(yb + t_ * 64 + 16 * q_ + 4), y2 = *(const LAS f32x4*)(yb + t_ * 64 + 16 * q_ + 8), y3 = *(const LAS f32x4*)(yb + t_ * 64 + 16 * q_ + 12);
                    u32x4 w, w2; w.x = cvt_pk_bf16(y0[0], y0[1]); w.y = cvt_pk_bf16(y0[2], y0[3]); w.z = cvt_pk_bf16(y1[0], y1[1]); w.w = cvt_pk_bf16(y1[2], y1[3]);
                    w2.x = cvt_pk_bf16(y2[0], y2[1]); w2.y = cvt_pk_bf16(y2[2], y2[3]); w2.z = cvt_pk_bf16(y3[0], y3[1]); w2.w = cvt_pk_bf16(y3[2], y3[3]);
                    bf16_t* yp = YS + ((size_t)d * MTOK + RS_ROW(c, t_)) * 1024 + h * 64 + 16 * q_; *(u32x4*)yp = w; *(u32x4*)(yp + 8) = w2; }
#if SCAN_CONVERT
                if (n < NCH) { const int cw = (wid == 7) ? 1 : 0; const int piece = (bx * 2 + cw) + n * (G * 2);
                    if (piece < MOE_PIECES) convert_moe_piece(A, l, (LAS float*)(lds + O_CV + 32768 + cw * 4352), lane, piece); }
#endif
            }
            asm volatile("s_waitcnt lgkmcnt(0)" ::: "memory");
            __builtin_amdgcn_s_barrier();
            asm volatile("" ::: "memory");
        }
#undef RS_LOAD
#undef RS_STAGE
#undef RS_GET
#undef RS_GET4
#undef RS_UNP4
#undef RS_ROW
    }
}

__device__ __forceinline__ void phase_attn(ArgsP A, int l, LAS unsigned char* lds, int tid, int bx, int G) {
    const bf16_t* PROJ = (const bf16_t*)(A->ws + WS_PROJ); bf16_t* MIX = (bf16_t*)(A->ws + WS_MIX);
    float s1 = 0.f, s2 = 0.f;
    for (int i = 0; i < 64; ++i) { s1 += ((const float*)A->in[I_LQ1])[l * 64 + i] * ((const float*)A->in[I_LK1])[l * 64 + i]; s2 += ((const float*)A->in[I_LQ2])[l * 64 + i] * ((const float*)A->in[I_LK2])[l * 64 + i]; }
    const float lam_init = 0.8f - 0.6f * expf(-0.3f * (float)l);
    const float lam = expf(s1) - expf(s2) + lam_init;
    unsigned* ctl = (unsigned*)(A->ws + WS_CTL);
    LAS int* uslot = (LAS int*)(lds + LDS_MISC + 2304);
    const int myx = (int)(xb_xcc_id() & 7u);
    for (int qi = 0; qi < 8; ++qi) {
        const int x = (myx + qi) & 7;
        for (;;) {
            if (tid == 0) *uslot = (int)__hip_atomic_fetch_add(ctl + CW_AQ + (l * 8 + x) * 64, 1u, __ATOMIC_RELAXED, __HIP_MEMORY_SCOPE_AGENT);
            __syncthreads();
            const int k = __builtin_amdgcn_readfirstlane(*uslot);
            __syncthreads();
            if (k >= 128) break;
            const int bh = 4 * x + (k >> 5), qb = k & 31;
            const int b = bh >> 3, h = bh & 7;
            const bf16_t* Qb = PROJ + ((size_t)b * SEQ + qb * 128) * NPROJP + h * 128;
            const bf16_t* Kh = PROJ + ((size_t)b * SEQ) * NPROJP + 1024 + h * 128;
            const bf16_t* Vh = PROJ + ((size_t)b * SEQ) * NPROJP + 2048 + h * 128;
            unsigned char* Ob = (unsigned char*)MIX + (((size_t)b * SEQ + qb * 128) * DM + h * 128) * (WOUT_FP8 ? 1 : 2);
            attn::attn_unit2(Qb, Kh, Vh, Ob, lam, 1.0f - lam_init, (const float*)A->in[I_SUBG] + l * 128, (char*)lds, tid);
        }
    }
}

__device__ __forceinline__ void phase_post(ArgsP A, int l, int lane, int wave, int bx, int G) {
    const bf16_t* SHR = (const bf16_t*)(A->ws + WS_SHR); const bf16_t* DYN = (const bf16_t*)(A->ws + WS_DYN); const bf16_t* YS = (const bf16_t*)(A->ws + WS_YS);
    bf16_t* MIX = (bf16_t*)(A->ws + WS_MIX);
    const int gw = bx * 8 + wave, NGW = G * 8, c = 16 * lane;
    float kav[16], rkv[16], gng[16], gnb[16];
#pragma unroll
    for (int j = 0; j < 16; ++j) { kav[j] = ((const float*)A->in[I_KA])[l * 1024 + c + j]; rkv[j] = ((const float*)A->in[I_RK])[l * 1024 + c + j];
        gng[j] = ((const float*)A->in[I_GNG])[l * 1024 + c + j]; gnb[j] = ((const float*)A->in[I_GNB])[l * 1024 + c + j]; }
    for (int row = gw; row < MTOK; row += NGW) {
        float y[16], t[16], r[16], k[16], v[16], a0[16], a1[16], g[16];
#define LD16(dst, ptr) do { float lo_[8], hi_[8]; unpack8(*(const u32x4*)(ptr), lo_); unpack8(*(const u32x4*)((ptr) + 8), hi_); _Pragma("unroll") for (int j_ = 0; j_ < 8; ++j_) { dst[j_] = lo_[j_]; dst[8 + j_] = hi_[j_]; } } while (0)
        LD16(y, YS + (size_t)row * 1024 + c); LD16(t, YS + ((size_t)MTOK + row) * 1024 + c);
        LD16(r, SHR + (size_t)row * 4096 + c); LD16(k, SHR + (size_t)row * 4096 + 1024 + c); LD16(v, SHR + (size_t)row * 4096 + 2048 + c);
        LD16(a0, DYN + (size_t)row * NDYN + 2048 + c); LD16(a1, DYN + (size_t)row * NDYN + 3072 + c); LD16(g, DYN + (size_t)row * NDYN + 4096 + c);
#undef LD16
        float s = 0.f, bo = 0.f;
#pragma unroll
        for (int j = 0; j < 16; ++j) { y[j] += t[j]; s += y[j]; bo += r[j] * (k[j] * (2.0f + (a0[j] + a1[j] - 2.0f) * kav[j])) * rkv[j]; }
        s += __shfl_xor(s, 1); s += __shfl_xor(s, 2); bo += __shfl_xor(bo, 1); bo += __shfl_xor(bo, 2);
        const float mean = s * (1.0f / 64.0f); float q = 0.f;
#pragma unroll
        for (int j = 0; j < 16; ++j) { y[j] -= mean; q += y[j] * y[j]; }
        q += __shfl_xor(q, 1); q += __shfl_xor(q, 2);
        const float rstd = 1.0f / sqrtf(q * (1.0f / 64.0f) + 64e-5f);
        float o[16];
#pragma unroll
        for (int j = 0; j < 16; ++j) o[j] = (y[j] * rstd * gng[j] + gnb[j] + bo * v[j]) * g[j];
        float o0[8], o1[8];
#pragma unroll
        for (int j = 0; j < 8; ++j) { o0[j] = o[j]; o1[j] = o[8 + j]; }
        if (WOUT_FP8) {
#pragma unroll
            for (int j = 0; j < 8; ++j) { o0[j] *= MIXSC; o1[j] *= MIXSC; }
            unsigned char* mp = (unsigned char*)MIX + (size_t)row * DM + 1024 + c; *(u32x2*)mp = pack8_fp8(o0); *(u32x2*)(mp + 8) = pack8_fp8(o1); }
        else { *(u32x4*)(MIX + (size_t)row * DM + 1024 + c) = pack8(o0); *(u32x4*)(MIX + (size_t)row * DM + 1024 + c + 8) = pack8(o1); }
    }
}

constexpr int NPL = 11, NPHASE = 1 + DEPTH * NPL + 1;
#ifndef ONLY_PHASE
#define ONLY_PHASE -1
#endif
#define PH_ON(k) (ONLY_PHASE < 0 || ONLY_PHASE == (k))
#ifndef REPEAT_PHASE
#define REPEAT_PHASE -1
#endif
#define REP(k, cond) for (int rep_ = 0; rep_ < ((REPEAT_PHASE == (k) && (cond)) ? 2 : 1); ++rep_)
__global__ void __launch_bounds__(512, 2) fwd(Args args) {
    extern __shared__ __attribute__((aligned(16))) unsigned char lds_raw[];
    LAS unsigned char* lds = (LAS unsigned char*)lds_raw;
    const int tid = threadIdx.x, lane = tid & 63, wave = __builtin_amdgcn_readfirstlane(tid >> 6), bx = blockIdx.x, G = gridDim.x;
    if (tid < 4) ((LAS unsigned*)(lds + LDS_MISC))[tid] = 0u;
    __syncthreads();
#if MK_PER_PHASE
#define GRID_BAR() do { } while (0)
#else
    XcdBarrier bar = xcd_barrier_post((unsigned*)(args.ws + WS_CTL) + CW_BAR, (volatile LAS unsigned*)(lds + LDS_MISC));
#define GRID_BAR() xcd_barrier(bar, phase_tid(wave))
#endif
    const int lo = args.ph_lo, hi = args.ph_hi;
#define IN(k) (lo <= (k) && (k) < hi)
#define SEAM(k) do { if (IN(k) && IN((k) + 1)) GRID_BAR(); } while (0)
    if (PH_ON(0) && IN(0)) REP(0, true) { asm volatile("; MARK_PHASE_0"); ArgsP A = phase_args(); const int tl = phase_tid(wave), ll = tl & 63, wl = __builtin_amdgcn_readfirstlane(tl >> 6); phase_prologue(A, lds, tl, ll, wl, bx, G); } SEAM(0);
    for (int l = 0; l < DEPTH; ++l) {
        const int p0 = 1 + l * NPL;
        if (PH_ON(1) && IN(p0 + 0)) REP(1, l == 0) { asm volatile("; MARK_PHASE_1"); ArgsP A = phase_args(); const int tl = phase_tid(wave), ll = tl & 63, wl = __builtin_amdgcn_readfirstlane(tl >> 6); if (l == 0) phase_norm1<0>(A, l, lds, tl, ll, wl, bx, G); else phase_norm1<1>(A, l, lds, tl, ll, wl, bx, G); } SEAM(p0 + 0);
        if (PH_ON(2) && IN(p0 + 1)) REP(2, true) {
            asm volatile("; MARK_PHASE_2"); ArgsP A = phase_args(); const int tl = phase_tid(wave), ll = tl & 63, wl = __builtin_amdgcn_readfirstlane(tl >> 6); unsigned char* ws = A->ws;
            int kk_ = DM; asm volatile("" : "+s"(kk_));
            pg8::Gemm g{(const bf16_t*)(ws + WS_H), (const bf16_t*)(ws + WS_WIN + (size_t)l * NPROJP * DM * (PROJ_FP8 ? 1 : 2)), kk_, 0, nullptr, 0};
            pg8::StaticOrder S; S.init(MTOK, NPROJP, G, bx);
            pg8::EpiProj E{(bf16_t*)(ws + WS_PROJ), (const float*)(ws + WS_ROPE), PROJ_FP8 ? 1.0f / WSC_IN : 1.0f};
            pg8::gemm_phase<pg8::EpiProj, pg8::StaticOrder, false, PROJ_FP8 != 0>(lds, g, S, E, tl);
        } SEAM(p0 + 1);
        if (PH_ON(3) && IN(p0 + 2)) REP(3, true) { asm volatile("; MARK_PHASE_3"); ArgsP A = phase_args(); const int tl = phase_tid(wave), ll = tl & 63, wl = __builtin_amdgcn_readfirstlane(tl >> 6); phase_prep(A, l, ll, wl, bx, G); } SEAM(p0 + 2);
        if (PH_ON(4) && IN(p0 + 3)) REP(4, true) {
            asm volatile("; MARK_PHASE_4"); ArgsP A = phase_args(); const int tl = phase_tid(wave), ll = tl & 63, wl = __builtin_amdgcn_readfirstlane(tl >> 6); unsigned char* ws = A->ws;
            int kla = KLA; asm volatile("" : "+s"(kla));
            int ntw = 2; asm volatile("" : "+s"(ntw));
            pg8::Gemm g{(const bf16_t*)(ws + WS_LA), (const bf16_t*)(ws + WS_LW) + (size_t)l * NDYN * KLA, kla, 0, nullptr, ntw};
            pg8::DynOrder S; S.init(MTOK, NDYN, G, bx);
            pg8::EpiDyn E{(bf16_t*)(ws + WS_DYN), (const float*)A->in[I_DW0] + l * 2048, (const float*)A->in[I_A0] + l * 2048};
            pg8::gemm_phase<pg8::EpiDyn, pg8::DynOrder, false>(lds, g, S, E, tl);
        } SEAM(p0 + 3);
        if (PH_ON(5) && IN(p0 + 4)) REP(5, true) { asm volatile("; MARK_PHASE_5"); ArgsP A = phase_args(); const int tl = phase_tid(wave), ll = tl & 63, wl = __builtin_amdgcn_readfirstlane(tl >> 6); phase_scan(A, l, lds, tl, bx, G); }
#if MK_PER_PHASE
        SEAM(p0 + 4);
#endif
        if (PH_ON(6) && IN(p0 + 5)) REP(6, true) { asm volatile("; MARK_PHASE_6"); ArgsP A = phase_args(); const int tl = phase_tid(wave), ll = tl & 63, wl = __builtin_amdgcn_readfirstlane(tl >> 6); phase_attn(A, l, lds, tl, bx, G); } SEAM(p0 + 5);
        if (PH_ON(7) && IN(p0 + 6)) REP(7, true) { asm volatile("; MARK_PHASE_7"); ArgsP A = phase_args(); const int tl = phase_tid(wave), ll = tl & 63, wl = __builtin_amdgcn_readfirstlane(tl >> 6); phase_post(A, l, ll, wl, bx, G); } SEAM(p0 + 6);
        if (PH_ON(8) && IN(p0 + 7)) REP(8, l == 0) {
            asm volatile("; MARK_PHASE_8"); ArgsP A = phase_args(); const int tl = phase_tid(wave), ll = tl & 63, wl = __builtin_amdgcn_readfirstlane(tl >> 6); unsigned char* ws = A->ws;
            int kk_ = DM; asm volatile("" : "+s"(kk_));
            pg8::Gemm g{(const bf16_t*)(ws + WS_MIX), (const bf16_t*)(ws + WS_WOUT + (size_t)l * DM * DM * (WOUT_FP8 ? 1 : 2)), kk_, 0, nullptr, 0};
            pg8::StaticOrder S; S.init(MTOK, DM, G, bx);
            pg8::EpiRes E{l == 0 ? (const float*)A->in[I_X] : (const float*)nullptr, (bf16_t*)(ws + WS_X), (const float*)(ws + WS_MOD) + (size_t)l * 4 * NMOD + 2 * DM, WOUT_FP8 ? 1.0f / (WSC_O * MIXSC) : 1.0f};
            pg8::gemm_phase<pg8::EpiRes, pg8::StaticOrder, false, WOUT_FP8 != 0>(lds, g, S, E, tl);
        } SEAM(p0 + 7);
        if (PH_ON(9) && IN(p0 + 8)) REP(9, true) { asm volatile("; MARK_PHASE_9"); ArgsP A = phase_args(); const int tl = phase_tid(wave), ll = tl & 63, wl = __builtin_amdgcn_readfirstlane(tl >> 6); phase_norm2_router(A, l, lds, tl, ll, wl, bx, G, rep_); } SEAM(p0 + 8);
        if (PH_ON(10) && IN(p0 + 9)) REP(10, true) {
            asm volatile("; MARK_PHASE_10"); ArgsP A = phase_args(); const int tl = phase_tid(wave), ll = tl & 63, wl = __builtin_amdgcn_readfirstlane(tl >> 6); unsigned char* ws = A->ws;
            load_moe_table(A, l, lds, tl);
            int kk_ = DM; asm volatile("" : "+s"(kk_));
            pg8::Gemm g{(const bf16_t*)(ws + WS_H), (const bf16_t*)(ws + WS_WGU), kk_, (size_t)2048 * DM, (const int*)(ws + WS_TOKL), 0};
            pg8::MoeOrder S{(const LAS int*)(lds + LDS_MISC + 64), (const LAS int*)(lds + LDS_MISC + 192), G, bx, __builtin_amdgcn_readfirstlane(((const LAS int*)(lds + LDS_MISC + 64))[16])};
            pg8::EpiGlu E{ws + WS_ACT, 1.0f / WSC_GU};
            pg8::gemm_phase<pg8::EpiGlu, pg8::MoeOrder, true, true>(lds, g, S, E, tl);
        } SEAM(p0 + 9);
        if (PH_ON(11) && IN(p0 + 10)) REP(11, true) {
            asm volatile("; MARK_PHASE_11"); ArgsP A = phase_args(); const int tl = phase_tid(wave), ll = tl & 63, wl = __builtin_amdgcn_readfirstlane(tl >> 6); unsigned char* ws = A->ws;
            load_moe_table(A, l, lds, tl);
            int kk_ = DFF; asm volatile("" : "+s"(kk_));
            pg8::Gemm g{(const bf16_t*)(ws + WS_ACT), (const bf16_t*)(ws + WS_WD), kk_, (size_t)DM * DFF, nullptr, 0};
            pg8::MoeOrder S{(const LAS int*)(lds + LDS_MISC + 64), (const LAS int*)(lds + LDS_MISC + 192), G, bx, __builtin_amdgcn_readfirstlane(((const LAS int*)(lds + LDS_MISC + 64))[16])};
            pg8::EpiY E{ws + WS_Y, YSC / WSC_D};
            pg8::gemm_phase<pg8::EpiY, pg8::MoeOrder, false, true>(lds, g, S, E, tl);
        } SEAM(p0 + 10);
    }
    if (PH_ON(12) && IN(NPHASE - 1)) { asm volatile("; MARK_PHASE_12"); ArgsP A = phase_args(); const int tl = phase_tid(wave), ll = tl & 63, wl = __builtin_amdgcn_readfirstlane(tl >> 6); phase_norm1<2>(A, DEPTH, lds, tl, ll, wl, bx, G); }
#undef IN
#undef SEAM
}

extern "C" void kernel_launch(void* const* d_in, const int* in_sizes, int n_in, void* d_out, int out_size, void* d_ws, size_t ws_size, hipStream_t stream) {
    static int grid = 0;
    if (grid == 0) {
        if (n_in != 31 || out_size != MTOK * DM || ws_size < WS_END) { fprintf(stderr, "kernel_launch: unexpected shapes (n_in %d out %d ws %zu, need %zu)\n", n_in, out_size, ws_size, (size_t)WS_END); grid = -1; return; }
        int dev = 0, cus = 0;
        if (hipGetDevice(&dev) != hipSuccess || hipDeviceGetAttribute(&cus, hipDeviceAttributeMultiprocessorCount, dev) != hipSuccess) { grid = -1; return; }
        if (hipFuncSetAttribute((const void*)fwd, hipFuncAttributeMaxDynamicSharedMemorySize, LDS_BYTES) != hipSuccess) { fprintf(stderr, "kernel_launch: hipFuncSetAttribute failed\n"); grid = -1; return; }
        int per_cu = 0;
        if (hipOccupancyMaxActiveBlocksPerMultiprocessor(&per_cu, (const void*)fwd, 512, LDS_BYTES) != hipSuccess || per_cu < 1) fprintf(stderr, "kernel_launch: occupancy query says %d\n", per_cu);
        (void)hipGetLastError();
        grid = cus;
    }
    if (grid < 0) return;
    (void)hipMemsetAsync((char*)d_ws + WS_CTL, 0, CTL_BYTES, stream);
    Args a{};
    for (int i = 0; i < 31; ++i) a.in[i] = d_in[i];
    a.out = (float*)d_out; a.ws = (unsigned char*)d_ws;
#if MK_PER_PHASE
    for (int p = 0; p < NPHASE; ++p) { a.ph_lo = p; a.ph_hi = p + 1; hipLaunchKernelGGL(fwd, dim3(grid), dim3(512), LDS_BYTES, stream, a); }
#else
    a.ph_lo = 0; a.ph_hi = NPHASE; hipLaunchKernelGGL(fwd, dim3(grid), dim3(512), LDS_BYTES, stream, a);
#endif
    const hipError_t le = hipPeekAtLastError();
    if (le != hipSuccess) fprintf(stderr, "kernel_launch: launch failed: %s\n", hipGetErrorName(le));
}
```

```cpp
#include <hip/hip_runtime.h>
#include <cstdio>
#include <cstdint>

#ifndef SCAN_CONVERT
#define SCAN_CONVERT 0
#endif
#ifndef PROJ_FP8
#define PROJ_FP8 1
#endif
#ifndef MK_PER_PHASE
#define MK_PER_PHASE 0
#endif

#define LAS __attribute__((address_space(3)))
typedef unsigned short bf16_t;
typedef short bf16x8 __attribute__((ext_vector_type(8)));
typedef short s16x4 __attribute__((ext_vector_type(4)));
typedef float f32x4 __attribute__((ext_vector_type(4)));
typedef float f32x2 __attribute__((ext_vector_type(2)));
typedef float f32x16 __attribute__((ext_vector_type(16)));
typedef unsigned u32x4 __attribute__((ext_vector_type(4)));
typedef unsigned u32x2 __attribute__((ext_vector_type(2)));

constexpr int BATCH = 4, SEQ = 4096, DM = 2048, MTOK = BATCH * SEQ, DEPTH = 2;
constexpr int NPROJ = 6528, NPROJP = 6656, RW0 = 3072, RWC = 3456;
constexpr int NEXP = 16, DFF = 1024, TOKCAP = 16384;
constexpr int NMOD = 6 * DM;
constexpr int NDYN = 5120, KLA = 384;
constexpr float C2 = 0.18033688011112042f;
constexpr int MAXTILES = 144;
#ifndef WOUT_FP8
#define WOUT_FP8 1
#endif
constexpr float WSC_O = 32.0f, MIXSC = 8.0f;
constexpr float WSC_GU = 32.0f, WSC_D = 16.0f, WSC_IN = 32.0f, YSC = 8.0f;

constexpr size_t MiB = 1u << 20;
constexpr size_t WS_CTL = 0, CTL_BYTES = 1 * MiB;
constexpr size_t WS_MOD = 1 * MiB;
constexpr size_t WS_ROPE = 2 * MiB;
constexpr size_t WS_TOKL = 3 * MiB;
constexpr size_t WS_ASG = 4 * MiB;
constexpr size_t WS_LW = 5 * MiB;
constexpr size_t WS_WIN = 13 * MiB;
constexpr size_t WS_WOUT = 65 * MiB;
constexpr size_t WS_WGU = 81 * MiB;
constexpr size_t WS_WD = 209 * MiB;
constexpr size_t WS_X = 273 * MiB;
constexpr size_t WS_H = 401 * MiB;
constexpr size_t WS_MIX = 466 * MiB;
constexpr size_t WS_PROJ = 530 * MiB;
constexpr size_t WS_SHR = 738 * MiB;
constexpr size_t WS_LA = 866 * MiB;
constexpr size_t WS_DYN = 878 * MiB;
constexpr size_t WS_YS = 1038 * MiB;
constexpr size_t WS_END = 1102 * MiB;
constexpr size_t WS_ACT = 530 * MiB;
constexpr size_t WS_Y = 602 * MiB;
constexpr int CW_BAR = 4096;
constexpr int CW_CNT = 16384;
constexpr int CW_AQ = 24576;

constexpr int LDS_MISC = 131072;
constexpr int LDS_BYTES = 147456;

__device__ __forceinline__ unsigned cvt_pk_bf16(float lo, float hi) { unsigned r; asm volatile("v_cvt_pk_bf16_f32 %0, %1, %2" : "=v"(r) : "v"(lo), "v"(hi)); return r; }
__device__ __forceinline__ float bflo(unsigned w) { return __uint_as_float(w << 16); }
__device__ __forceinline__ float bfhi(unsigned w) { return __uint_as_float(w & 0xffff0000u); }
__device__ __forceinline__ void unpack8(const u32x4 w, float (&f)[8]) { f[0] = bflo(w.x); f[1] = bfhi(w.x); f[2] = bflo(w.y); f[3] = bfhi(w.y); f[4] = bflo(w.z); f[5] = bfhi(w.z); f[6] = bflo(w.w); f[7] = bfhi(w.w); }
__device__ __forceinline__ u32x4 pack8(const float (&f)[8]) { u32x4 w; w.x = cvt_pk_bf16(f[0], f[1]); w.y = cvt_pk_bf16(f[2], f[3]); w.z = cvt_pk_bf16(f[4], f[5]); w.w = cvt_pk_bf16(f[6], f[7]); return w; }
__device__ __forceinline__ float sat8(float x) { return __builtin_amdgcn_fmed3f(x, -448.0f, 448.0f); }
__device__ __forceinline__ int pk4_fp8(float a, float b, float c, float d) { int w = 0; w = __builtin_amdgcn_cvt_pk_fp8_f32(sat8(a), sat8(b), w, false); w = __builtin_amdgcn_cvt_pk_fp8_f32(sat8(c), sat8(d), w, true); return w; }
__device__ __forceinline__ u32x2 pack8_fp8(const float (&f)[8]) { int a = 0, b = 0;
    a = pk4_fp8(f[0], f[1], f[2], f[3]); b = pk4_fp8(f[4], f[5], f[6], f[7]); u32x2 w; w.x = (unsigned)a; w.y = (unsigned)b; return w; }
__device__ __forceinline__ float sigmoidf_(float x) { return __builtin_amdgcn_rcpf(1.0f + __builtin_amdgcn_exp2f(-1.4426950408889634f * x)); }
__device__ __forceinline__ float wave_sum(float v) {
#pragma unroll
    for (int o = 1; o < 16; o <<= 1) v += __shfl_xor(v, o);
    { auto r = __builtin_amdgcn_permlane16_swap(__float_as_uint(v), __float_as_uint(v), false, false); v = __uint_as_float(r[0]) + __uint_as_float(r[1]); }
    { auto r = __builtin_amdgcn_permlane32_swap(__float_as_uint(v), __float_as_uint(v), false, false); v = __uint_as_float(r[0]) + __uint_as_float(r[1]); }
    return v;
}
#define LDS_WAIT() asm volatile("s_waitcnt lgkmcnt(0)" ::: "memory")
#define VM_WAIT() asm volatile("s_waitcnt vmcnt(0)" ::: "memory")

#define XB_TMO      128
#define XB_XCNT(j)  (256  + 64 * (j))
#define XB_XSUB(j)  (1280 + 64 * (j))
#define XB_XGEN(j)  (2304 + 64 * (j))
#define XB_TOP      3328
#define XB_TOPGEN   3392
#define XCD_BAR_WORDS 3456
#define XB_SPIN_CAP (1u << 18)

__device__ __forceinline__ unsigned xb_ld(unsigned* p)              { return __hip_atomic_load(p, __ATOMIC_RELAXED, __HIP_MEMORY_SCOPE_AGENT); }
__device__ __forceinline__ unsigned xb_add(unsigned* p, unsigned v) { return __hip_atomic_fetch_add(p, v, __ATOMIC_RELAXED, __HIP_MEMORY_SCOPE_AGENT); }
__device__ __forceinline__ unsigned xb_xcc_id() { return (unsigned)__builtin_amdgcn_s_getreg((3 << 11) | 20) & 0xFu; }
#define XB_SPIN(cond, bar) do { unsigned _sp = 0; while (cond) { __builtin_amdgcn_s_sleep(1); \
    if ((++_sp & 255u) == 0u) { if (xb_ld(&(bar)[XB_TMO])) break; if (_sp > XB_SPIN_CAP) { atomicAdd(&(bar)[XB_TMO], 1u); break; } } } } while (0)

struct XcdBarrier { unsigned* bar; unsigned x; volatile LAS unsigned* st; };

__device__ __forceinline__ XcdBarrier xcd_barrier_post(unsigned* bar, volatile LAS unsigned* st) {
    XcdBarrier b; b.bar = bar; b.x = xb_xcc_id(); b.st = st;
    if (threadIdx.x == 0) (void)xb_add(&bar[XB_XCNT(b.x)], 1u);
    return b;
}
__device__ __forceinline__ void xcd_barrier_complete(unsigned* bar, unsigned x, unsigned& nloc, unsigned& nx) {
    const unsigned G = gridDim.x * gridDim.y * gridDim.z;
    unsigned sum, cnt, mine, sp = 0u;
    for (;;) {
        sum = 0u; cnt = 0u; mine = 0u;
#pragma unroll
        for (unsigned j = 0; j < 16; ++j) { const unsigned c = xb_ld(&bar[XB_XCNT(j)]); sum += c; cnt += (c > 0u) ? 1u : 0u; mine = (j == x) ? c : mine; }
        if (sum == G) break;
        __builtin_amdgcn_s_sleep(1);
        if ((++sp & 255u) == 0u) { if (xb_ld(&bar[XB_TMO])) break; if (sp > XB_SPIN_CAP) { atomicAdd(&bar[XB_TMO], 1u); break; } }
    }
    nloc = mine > 0u ? mine : 1u; nx = cnt > 0u ? cnt : 1u;
}
__device__ __forceinline__ void xcd_barrier(const XcdBarrier& b, int tid_) {
    asm volatile("s_waitcnt vmcnt(0)" ::: "memory");
    __syncthreads();
    if (tid_ == 0) {
        unsigned* bar = b.bar;
        __builtin_amdgcn_s_waitcnt(0);
        unsigned nloc = b.st[0], nx = b.st[1];
        if (nloc == 0u) { xcd_barrier_complete(bar, b.x, nloc, nx); b.st[0] = nloc; b.st[1] = nx; }
        const unsigned old = xb_add(&bar[XB_XSUB(b.x)], 1u);
        const unsigned gen = old / nloc;
        if (old + 1u == (gen + 1u) * nloc) {
            __builtin_amdgcn_fence(__ATOMIC_RELEASE, "agent");
            asm volatile("s_waitcnt vmcnt(0)" ::: "memory");
            const unsigned og = xb_add(&bar[XB_TOP], 1u);
            const unsigned tg = og / nx;
            if (og + 1u == (tg + 1u) * nx) xb_add(&bar[XB_TOPGEN], 1u);
            else XB_SPIN(xb_ld(&bar[XB_TOPGEN]) == tg, bar);
            __builtin_amdgcn_fence(__ATOMIC_ACQUIRE, "agent");
            xb_add(&bar[XB_XGEN(b.x)], 1u);
            asm volatile("s_waitcnt vmcnt(0)" ::: "memory");
        } else {
            XB_SPIN(xb_ld(&bar[XB_XGEN(b.x)]) == gen, bar);
            __builtin_amdgcn_fence(__ATOMIC_ACQUIRE, "agent");
            asm volatile("s_waitcnt vmcnt(0)" ::: "memory");
        }
    }
    __syncthreads();
}

namespace pg8 {
constexpr int BM = 256, BK = 64, HALF = 128, HTB = HALF * BK * 2, STAGE_BYTES = 8 * HTB, NXCD = 8, WGM = 8;
__host__ __device__ __forceinline__ int lds_byte(int r, int c) { const int st = (r >> 4) * 2 + (c >> 5), rr = r & 15, cc = c & 31, ob = rr * 64 + cc * 2; return st * 1024 + (ob ^ (((ob >> 9) & 1) << 5)); }
__host__ __device__ __forceinline__ void stage_rc(int b, int& R, int& C) { const int st = b / 1024, sb = b % 1024, swz = sb ^ (((sb >> 9) & 1) << 5); R = (st >> 1) * 16 + swz / 64; C = (st & 1) * 32 + (swz % 64) / 2; }
__host__ __device__ __forceinline__ int perm32(int rho) { const int n = rho >> 4, i = rho & 15; return 8 * (i >> 2) + 4 * n + (i & 3); }

struct Unit { int pm, pn, e, jl, cnt, koff; };
struct Gemm { const bf16_t* A; const bf16_t* Bt; int K; size_t bstride; const int* tokl; int ntov; };

struct StaticOrder {
    int nM, nN, nwg, G, c;
    __device__ void init(int M, int N, int G_, int c_) { nM = M / BM; nN = N / BM; nwg = nM * nN; G = G_; c = c_; }
    __device__ bool next(int i, Unit& u) const {
        const long L = (long)i * G + c; if (L >= nwg) return false;
        int wgid = (int)L; { const int q = nwg / NXCD, r = nwg % NXCD, xcd = wgid % NXCD, off = wgid / NXCD; wgid = (xcd < r ? xcd * (q + 1) : r * (q + 1) + (xcd - r) * q) + off; }
        const int nig = WGM * nN, gid = wgid / nig, fm = gid * WGM, gsz = (nM - fm) < WGM ? (nM - fm) : WGM;
        u.pm = fm + ((wgid % nig) % gsz); u.pn = (wgid % nig) / gsz; u.e = 0; u.jl = 0; u.cnt = 0; u.koff = 0; return true;
    }
};
struct DynOrder : StaticOrder {
    __device__ bool next(int i, Unit& u) const { if (!StaticOrder::next(i, u)) return false; u.koff = (u.pn < 8 ? 0 : (u.pn < 16 ? 128 : 256)) * 2; return true; }
};
struct MoeOrder {
    const LAS int* tb; const LAS int* cn; int G, c, ntot;
    __device__ bool next(int i, Unit& u) const {
        const long L = (long)i * G + c; if (L >= (long)ntot * 8) return false;
        const int mt = (int)(L >> 3); int e = 0;
#pragma unroll
        for (int k = 1; k < 16; ++k) e += (mt >= tb[k]) ? 1 : 0;
        e = __builtin_amdgcn_readfirstlane(e);
        u.koff = 0; u.pm = mt; u.pn = (int)(L & 7); u.e = e; u.jl = __builtin_amdgcn_readfirstlane(mt - tb[e]); u.cnt = __builtin_amdgcn_readfirstlane(cn[e]); return true;
    }
};

typedef int i32x8 __attribute__((ext_vector_type(8)));
typedef int i32x4_ __attribute__((ext_vector_type(4)));
template <class Epi, class Sched, bool GATHER, bool FP8 = false>
__device__ __forceinline__ void gemm_phase(LAS unsigned char* lds, const Gemm g, const Sched& S, const Epi& E, const int tid) {
    const int wid = __builtin_amdgcn_readfirstlane(tid >> 6), lane = tid & 63, wr = wid >> 2, wc = wid & 3, fr = lane & 15, fq = lane >> 4;
    const int K = FP8 ? (g.K >> 1) : g.K, nt = g.ntov ? g.ntov : K / BK;
    unsigned voffA[2], voffB[2]; int Rr[2], Cc[2];
#pragma unroll
    for (int i = 0; i < 2; ++i) { int R, C; stage_rc(tid * 16 + i * 8192, R, C); const int Rb = Epi::PERM ? ((R & ~31) + perm32(R & 31)) : R;
        voffA[i] = (unsigned)(R * K + C) * 2u; voffB[i] = (unsigned)(Rb * K + C) * 2u; Rr[i] = R; Cc[i] = C; }
    const size_t kstep = (size_t)(BK * 2);
    const size_t hstep = (size_t)HALF * K * 2;
    const size_t tstep = 2 * hstep;
    const unsigned ldsw = (unsigned)wid * 1024u;
    const int aoff = lds_byte(wr * 64 + fr, fq * 8), boff = lds_byte(wc * 32 + fr, fq * 8);
#define PG8_SA(b, h) (((b) * 2 + (h)) * HTB)
#define PG8_SB(b, h) ((4 + (b) * 2 + (h)) * HTB)
#define PG8_STAGE(bufoff, gbase, voff) do { _Pragma("unroll") for (int _i = 0; _i < 2; ++_i) \
        __builtin_amdgcn_global_load_lds((const unsigned*)((const char*)(gbase) + (voff)[_i]), (LAS unsigned*)(lds + (bufoff) + ldsw + _i * 8192), 16, 0, 0); } while (0)
#define PG8_LDA(dst, b, h) do { _Pragma("unroll") for (int m = 0; m < 4; ++m) _Pragma("unroll") for (int k = 0; k < 2; ++k) dst[m][k] = *(const LAS bf16x8*)(lds + PG8_SA(b, h) + aoff + m * 2048 + k * 1024); } while (0)
#define PG8_LDB(dst, b, h) do { _Pragma("unroll") for (int n = 0; n < 2; ++n) _Pragma("unroll") for (int k = 0; k < 2; ++k) dst[n][k] = *(const LAS bf16x8*)(lds + PG8_SB(b, h) + boff + n * 2048 + k * 1024); } while (0)
#define PG8_CAT(x) __builtin_shufflevector(__builtin_bit_cast(i32x4_, (x)[0]), __builtin_bit_cast(i32x4_, (x)[1]), 0, 1, 2, 3, 4, 5, 6, 7)
#define PG8_MMA(ai, bj, At, Bt) do { __builtin_amdgcn_s_setprio(1); \
        if constexpr (FP8) { _Pragma("unroll") for (int m = 0; m < 4; ++m) _Pragma("unroll") for (int n = 0; n < 2; ++n) \
            { const i32x8 b8_ = PG8_CAT(Bt[n]), a8_ = PG8_CAT(At[m]); \
              asm volatile("v_mfma_scale_f32_16x16x128_f8f6f4 %0, %1, %2, %0, %3, %3 op_sel_hi:[0,0,0]" : "+v"(acc[ai][bj][m][n]) : "v"(b8_), "v"(a8_), "v"(0x7F7F7F7F)); } } \
        else { _Pragma("unroll") for (int m = 0; m < 4; ++m) _Pragma("unroll") for (int n = 0; n < 2; ++n) _Pragma("unroll") for (int k = 0; k < 2; ++k) \
            acc[ai][bj][m][n] = __builtin_amdgcn_mfma_f32_16x16x32_bf16(Bt[n][k], At[m][k], acc[ai][bj][m][n], 0, 0, 0); } \
        __builtin_amdgcn_s_setprio(0); } while (0)
#define PG8_WAIT_V(n) asm volatile("s_waitcnt vmcnt(" #n ")" ::: "memory")
#define PG8_WAIT_L(n) asm volatile("s_waitcnt lgkmcnt(" #n ")" ::: "memory")
#define PG8_BAR __builtin_amdgcn_s_barrier()
#define PG8_SCHED __builtin_amdgcn_sched_barrier(0)
#define PG8_GOFF(dst, u) do { _Pragma("unroll") for (int _h = 0; _h < 2; ++_h) _Pragma("unroll") for (int _i = 0; _i < 2; ++_i) { \
        const int _slot = (u).jl * 256 + _h * 128 + Rr[_i]; const int _tok = (_slot < (u).cnt) ? g.tokl[(u).e * TOKCAP + _slot] : 0; dst[_h][_i] = (unsigned)(_tok * K + Cc[_i]) * 2u; } } while (0)
    Unit cur, nxt; int ui = 0;
    if (!S.next(0, cur)) return;
    f32x4 acc[2][2][4][2];
#pragma unroll
    for (int a = 0; a < 2; ++a)
#pragma unroll
        for (int b = 0; b < 2; ++b)
#pragma unroll
            for (int m = 0; m < 4; ++m)
#pragma unroll
                for (int n = 0; n < 2; ++n) acc[a][b][m][n] = (f32x4){0.f, 0.f, 0.f, 0.f};
    bf16x8 At[4][2], B0[2][2], B1[2][2];
    const char* Ab = (const char*)g.A;
    const char* cA = Ab + (size_t)cur.pm * tstep + cur.koff; const char* cB = (const char*)g.Bt + (size_t)cur.e * g.bstride + (size_t)cur.pn * tstep + cur.koff;
    unsigned offc[2][2], offn[2][2];
    if constexpr (GATHER) { PG8_GOFF(offc, cur); }
#define PG8_STA_C(bufoff, h, kb) do { if constexpr (GATHER) { PG8_STAGE(bufoff, Ab + (kb), offc[h]); } else { PG8_STAGE(bufoff, cA + (h) * hstep + (kb), voffA); } } while (0)
    PG8_STAGE(PG8_SB(0, 0), cB, voffB); PG8_STAGE(PG8_SB(0, 1), cB + hstep, voffB); PG8_STA_C(PG8_SA(0, 0), 0, 0); PG8_STA_C(PG8_SA(0, 1), 1, 0);
    if (wr == 1) PG8_BAR;
    PG8_WAIT_V(2); PG8_BAR;
    PG8_STAGE(PG8_SB(1, 0), cB + kstep, voffB); PG8_STA_C(PG8_SA(1, 0), 0, kstep); PG8_STAGE(PG8_SB(1, 1), cB + hstep + kstep, voffB);
    PG8_WAIT_V(6); PG8_BAR;
    for (;;) {
        const bool has_next = S.next(ui + 1, nxt);
        const char* nA = has_next ? Ab + (size_t)nxt.pm * tstep + nxt.koff : cA; const char* nB = has_next ? (const char*)g.Bt + (size_t)nxt.e * g.bstride + (size_t)nxt.pn * tstep + nxt.koff : cB;
        if constexpr (GATHER) {
            if (has_next) { PG8_GOFF(offn, nxt); }
            else {
#pragma unroll
                for (int h = 0; h < 2; ++h)
#pragma unroll
                    for (int i = 0; i < 2; ++i) offn[h][i] = offc[h][i]; }
        }
        for (int t = 0; t < nt; t += 2) {
            const bool last = (t == nt - 2);
            const size_t kb1 = (size_t)(t + 1) * kstep;
            const char* b2 = last ? nB : cB + (size_t)(t + 2) * kstep; const char* b3 = b2 + kstep;
            const char* a2 = last ? nA : cA + (size_t)(t + 2) * kstep; const char* a3 = a2 + kstep;
            unsigned o2[2][2]; size_t kb2 = last ? 0 : (size_t)(t + 2) * kstep;
            if constexpr (GATHER) {
#pragma unroll
                for (int h = 0; h < 2; ++h)
#pragma unroll
                    for (int i = 0; i < 2; ++i) o2[h][i] = last ? offn[h][i] : offc[h][i];
            }
#define PG8_STA_2(bufoff, h, extra) do { if constexpr (GATHER) { PG8_STAGE(bufoff, Ab + kb2 + (extra), o2[h]); } else { PG8_STAGE(bufoff, a2 + (h) * hstep + (extra), voffA); } } while (0)
            PG8_LDB(B0, 0, 0); PG8_LDB(B1, 0, 1); PG8_SCHED; PG8_LDA(At, 0, 0); PG8_STA_C(PG8_SA(1, 1), 1, kb1);
            PG8_WAIT_V(8); PG8_WAIT_L(0); PG8_BAR; PG8_MMA(0, 0, At, B0); PG8_MMA(0, 1, At, B1); PG8_BAR; PG8_SCHED;
            PG8_LDA(At, 0, 1); PG8_STAGE(PG8_SB(0, 0), b2, voffB); PG8_STAGE(PG8_SB(0, 1), b2 + hstep, voffB); PG8_STA_2(PG8_SA(0, 0), 0, 0);
            PG8_WAIT_V(8); PG8_WAIT_L(0); PG8_BAR; PG8_MMA(1, 0, At, B0); PG8_MMA(1, 1, At, B1); PG8_BAR; PG8_SCHED;
            PG8_LDB(B0, 1, 0); PG8_LDB(B1, 1, 1); PG8_SCHED; PG8_LDA(At, 1, 0); PG8_STA_2(PG8_SA(0, 1), 1, 0);
            PG8_WAIT_V(8); PG8_WAIT_L(0); PG8_BAR; PG8_MMA(0, 0, At, B0); PG8_MMA(0, 1, At, B1); PG8_BAR; PG8_SCHED;
            PG8_LDA(At, 1, 1); PG8_STAGE(PG8_SB(1, 0), b3, voffB); PG8_STAGE(PG8_SB(1, 1), b3 + hstep, voffB); PG8_STA_2(PG8_SA(1, 0), 0, kstep);
            PG8_WAIT_V(8); PG8_WAIT_L(0); PG8_BAR; PG8_MMA(1, 0, At, B0); PG8_MMA(1, 1, At, B1); PG8_BAR; PG8_SCHED;
#undef PG8_STA_2
            (void)a3;
        }
        if (wr == 0) PG8_BAR;
        { int l2 = lane; asm volatile("" : "+v"(l2)); E(acc, cur, wr, wc, l2 & 15, l2 >> 4); }
        if (!has_next) break;
#pragma unroll
        for (int a = 0; a < 2; ++a)
#pragma unroll
            for (int b = 0; b < 2; ++b)
#pragma unroll
                for (int m = 0; m < 4; ++m)
#pragma unroll
                    for (int n = 0; n < 2; ++n) acc[a][b][m][n] = (f32x4){0.f, 0.f, 0.f, 0.f};
        cur = nxt; cA = nA; cB = nB; ++ui;
        if constexpr (GATHER) {
#pragma unroll
            for (int h = 0; h < 2; ++h)
#pragma unroll
                for (int i = 0; i < 2; ++i) offc[h][i] = offn[h][i];
        }
        if (wr == 1) PG8_BAR;
    }
    PG8_WAIT_V(0);
    PG8_BAR;
#undef PG8_STA_C
#undef PG8_GOFF
#undef PG8_SA
#undef PG8_SB
#undef PG8_STAGE
#undef PG8_LDA
#undef PG8_LDB
#undef PG8_MMA
#undef PG8_CAT
#undef PG8_WAIT_V
#undef PG8_WAIT_L
#undef PG8_BAR
#undef PG8_SCHED
}

struct EpiProj {
    static constexpr bool PERM = true;
    bf16_t* O; const float* rope; float inv;
    __device__ __forceinline__ void operator()(const f32x4 (&acc)[2][2][4][2], const Unit& u, int wr, int wc, int fr, int fq) const {
        const int row0 = u.pm * BM + wr * 64 + fr, col0 = u.pn * BM + wc * 32 + 8 * fq;
        const bool dorope = (u.pn < 8) && ((wc & 1) == 0) && (fq < 2);
        const float sc = ((u.pn < 4) ? C2 : 1.0f) * inv;
#pragma unroll
        for (int ai = 0; ai < 2; ++ai)
#pragma unroll
            for (int m = 0; m < 4; ++m) {
                const int row = row0 + ai * HALF + m * 16;
                bf16_t* rowp = O + (size_t)row * NPROJP + col0;
                f32x4 cs = (f32x4){1.f, 1.f, 1.f, 1.f}, sn = (f32x4){0.f, 0.f, 0.f, 0.f};
                if (dorope) { cs = *(const f32x4*)(rope + (size_t)row * 16 + 4 * fq); sn = *(const f32x4*)(rope + (size_t)row * 16 + 8 + 4 * fq); }
#pragma unroll
                for (int bj = 0; bj < 2; ++bj) {
                    f32x4 v0 = acc[ai][bj][m][0], v1 = acc[ai][bj][m][1];
                    const f32x4 r0 = (v0 * cs - v1 * sn) * sc, r1 = (v1 * cs + v0 * sn) * sc;
                    u32x4 w; w.x = cvt_pk_bf16(r0[0], r0[1]); w.y = cvt_pk_bf16(r0[2], r0[3]); w.z = cvt_pk_bf16(r1[0], r1[1]); w.w = cvt_pk_bf16(r1[2], r1[3]);
                    *(u32x4*)(rowp + bj * HALF) = w; }
            }
    }
};
struct EpiDyn {
    static constexpr bool PERM = true;
    bf16_t* O; const float* w0; const float* a0;
    __device__ __forceinline__ void operator()(const f32x4 (&acc)[2][2][4][2], const Unit& u, int wr, int wc, int fr, int fq) const {
        const int row0 = u.pm * BM + wr * 64 + fr, col0 = u.pn * BM + wc * 32 + 8 * fq;
        const int kind = u.pn >> 3;
        const float* bsrc = (kind == 0) ? (w0 + col0) : (a0 + (col0 - 2048));
#pragma unroll
        for (int bj = 0; bj < 2; ++bj) {
            f32x4 b0 = (f32x4){0.f, 0.f, 0.f, 0.f}, b1 = b0;
            if (kind < 2) { b0 = *(const f32x4*)(bsrc + bj * HALF); b1 = *(const f32x4*)(bsrc + bj * HALF + 4); }
#pragma unroll
            for (int ai = 0; ai < 2; ++ai)
#pragma unroll
                for (int m = 0; m < 4; ++m) {
                    f32x4 v0 = acc[ai][bj][m][0] + b0, v1 = acc[ai][bj][m][1] + b1;
                    if (kind < 2) {
#pragma unroll
                        for (int j = 0; j < 4; ++j) { float s0 = sigmoidf_(v0[j]), s1 = sigmoidf_(v1[j]);
                            if (kind == 0) { s0 = __builtin_amdgcn_exp2f(-0.875039f * s0); s1 = __builtin_amdgcn_exp2f(-0.875039f * s1); }
                            v0[j] = s0; v1[j] = s1; } }
                    u32x4 w; w.x = cvt_pk_bf16(v0[0], v0[1]); w.y = cvt_pk_bf16(v0[2], v0[3]); w.z = cvt_pk_bf16(v1[0], v1[1]); w.w = cvt_pk_bf16(v1[2], v1[3]);
                    *(u32x4*)(O + (size_t)(row0 + ai * HALF + m * 16) * NDYN + col0 + bj * HALF) = w;
                    __builtin_amdgcn_sched_barrier(0); }
        }
    }
};
struct EpiRes {
    static constexpr bool PERM = true;
    const float* xin32; bf16_t* X; const float* g1; float inv;
    __device__ __forceinline__ void operator()(const f32x4 (&acc)[2][2][4][2], const Unit& u, int wr, int wc, int fr, int fq) const {
        const int row0 = u.pm * BM + wr * 64 + fr, col0 = u.pn * BM + wc * 32 + 8 * fq;
        const int b = (u.pm * BM) / SEQ;
        f32x4 gv[2][2];
#pragma unroll
        for (int bj = 0; bj < 2; ++bj)
#pragma unroll
            for (int n = 0; n < 2; ++n) gv[bj][n] = *(const f32x4*)(g1 + (size_t)b * NMOD + col0 + bj * HALF + 4 * n) * inv;
#define EPIRES_TAIL(x0_, x1_) do { const f32x4 r0 = (x0_) + gv[bj][0] * acc[ai][bj][m][0], r1 = (x1_) + gv[bj][1] * acc[ai][bj][m][1]; \
            u32x4 w; w.x = cvt_pk_bf16(r0[0], r0[1]); w.y = cvt_pk_bf16(r0[2], r0[3]); w.z = cvt_pk_bf16(r1[0], r1[1]); w.w = cvt_pk_bf16(r1[2], r1[3]); \
            *(u32x4*)(X + off + bj * HALF) = w; } while (0)
        if (xin32) {
#pragma unroll
            for (int ai = 0; ai < 2; ++ai)
#pragma unroll
              for (int mh = 0; mh < 4; mh += 2) { f32x4 xa[2][2], xb[2][2];
#pragma unroll
                for (int mm = 0; mm < 2; ++mm) { const size_t off = (size_t)(row0 + ai * HALF + (mh + mm) * 16) * DM + col0;
#pragma unroll
                    for (int bj = 0; bj < 2; ++bj) { xa[mm][bj] = *(const f32x4*)(xin32 + off + bj * HALF); xb[mm][bj] = *(const f32x4*)(xin32 + off + bj * HALF + 4); } }
#pragma unroll
                for (int mm = 0; mm < 2; ++mm) { const int m = mh + mm; const size_t off = (size_t)(row0 + ai * HALF + m * 16) * DM + col0;
#pragma unroll
                    for (int bj = 0; bj < 2; ++bj) EPIRES_TAIL(xa[mm][bj], xb[mm][bj]); } }
        } else {
#pragma unroll
            for (int ai = 0; ai < 2; ++ai) { u32x4 xp[4][2];
#pragma unroll
                for (int m = 0; m < 4; ++m) { const size_t off = (size_t)(row0 + ai * HALF + m * 16) * DM + col0;
#pragma unroll
                    for (int bj = 0; bj < 2; ++bj) xp[m][bj] = *(const u32x4*)(X + off + bj * HALF); }
#pragma unroll
                for (int m = 0; m < 4; ++m) { const size_t off = (size_t)(row0 + ai * HALF + m * 16) * DM + col0;
#pragma unroll
                    for (int bj = 0; bj < 2; ++bj) { const u32x4 p = xp[m][bj];
                        const f32x4 x0 = (f32x4){bflo(p.x), bfhi(p.x), bflo(p.y), bfhi(p.y)}, x1 = (f32x4){bflo(p.z), bfhi(p.z), bflo(p.w), bfhi(p.w)};
                        EPIRES_TAIL(x0, x1); } } }
        }
#undef EPIRES_TAIL
    }
};
struct EpiGlu {
    static constexpr bool PERM = true;
    unsigned char* O; float inv;
    __device__ __forceinline__ void operator()(const f32x4 (&acc)[2][2][4][2], const Unit& u, int wr, int wc, int fr, int fq) const {
        const int row0 = u.pm * BM + wr * 64 + fr, j0 = u.pn * 128 + wc * 16 + 4 * fq;
#pragma unroll
        for (int ai = 0; ai < 2; ++ai)
#pragma unroll
            for (int m = 0; m < 4; ++m) { unsigned char* rowp = O + (size_t)(row0 + ai * HALF + m * 16) * DFF + j0;
#pragma unroll
                for (int bj = 0; bj < 2; ++bj) { const f32x4 gt = acc[ai][bj][m][0] * inv, up = acc[ai][bj][m][1] * inv; f32x4 r;
#pragma unroll
                    for (int j = 0; j < 4; ++j) r[j] = gt[j] * sigmoidf_(gt[j]) * up[j];
                    *(int*)(rowp + bj * 64) = pk4_fp8(r[0], r[1], r[2], r[3]); } }
    }
};
struct EpiY {
    static constexpr bool PERM = true;
    unsigned char* O; float inv;
    __device__ __forceinline__ void operator()(const f32x4 (&acc)[2][2][4][2], const Unit& u, int wr, int wc, int fr, int fq) const {
        const int row0 = u.pm * BM + wr * 64 + fr, col0 = u.pn * BM + wc * 32 + 8 * fq;
#pragma unroll
        for (int ai = 0; ai < 2; ++ai)
#pragma unroll
            for (int m = 0; m < 4; ++m) { unsigned char* rowp = O + (size_t)(row0 + ai * HALF + m * 16) * DM + col0;
#pragma unroll
                for (int bj = 0; bj < 2; ++bj) { const f32x4 v0 = acc[ai][bj][m][0] * inv, v1 = acc[ai][bj][m][1] * inv;
                    u32x2 w; w.x = (unsigned)pk4_fp8(v0[0], v0[1], v0[2], v0[3]); w.y = (unsigned)pk4_fp8(v1[0], v1[1], v1[2], v1[3]);
                    *(u32x2*)(rowp + bj * HALF) = w; } }
    }
};
}

namespace attn {
constexpr int KVBLK = 64;
constexpr size_t SHM_V = KVBLK * 128 * 2, SHM_K = KVBLK * 128 * 2;
constexpr int WS_OFF = 3 * SHM_V + 3 * SHM_K;
constexpr float THRL = 8.0f;
#define KSWZ(row, colB) ((row) * 256 + ((colB) ^ (((row) & 7) << 4)))
#define SBAR() __builtin_amdgcn_sched_barrier(0)
__device__ __forceinline__ int crow(int r, int hi) { return (r & 3) + 8 * (r >> 2) + 4 * hi; }

__device__ __forceinline__ void partialSM(f32x16& p0, f32x16& p1, float& m_reg, float& mn, float& alpha) {
    float pmax = p0[0];
#pragma unroll
    for (int r = 1; r < 16; ++r) pmax = fmaxf(pmax, p0[r]);
#pragma unroll
    for (int r = 0; r < 16; ++r) pmax = fmaxf(pmax, p1[r]);
    { auto rr = __builtin_amdgcn_permlane32_swap(__float_as_uint(pmax), __float_as_uint(pmax), false, false);
      pmax = fmaxf(__uint_as_float(rr[0]), __uint_as_float(rr[1])); }
    if (__builtin_expect(__all(pmax - m_reg <= THRL), 1)) { mn = m_reg; alpha = 1.f; }
    else { mn = fmaxf(m_reg, pmax); alpha = __builtin_amdgcn_exp2f(m_reg - mn); m_reg = mn; }
#pragma unroll
    for (int r = 0; r < 16; ++r) p0[r] = p0[r] - mn;
#pragma unroll
    for (int r = 0; r < 16; ++r) p1[r] = p1[r] - mn;
#pragma unroll
    for (int r = 0; r < 16; ++r) p0[r] = __builtin_amdgcn_exp2f(p0[r]);
}
__device__ __forceinline__ void finishSM(f32x16& p0, f32x16& p1, float alpha, float& l_reg, bf16x8& pa0, bf16x8& pa1, bf16x8& pa2, bf16x8& pa3) {
#pragma unroll
    for (int r = 0; r < 16; ++r) p1[r] = __builtin_amdgcn_exp2f(p1[r]);
    float ps = 0;
#pragma unroll
    for (int r = 0; r < 16; ++r) ps += p0[r];
#pragma unroll
    for (int r = 0; r < 16; ++r) ps += p1[r];
    { auto rr = __builtin_amdgcn_permlane32_swap(__float_as_uint(ps), __float_as_uint(ps), false, false);
      ps = __uint_as_float(rr[0]) + __uint_as_float(rr[1]); }
    l_reg = l_reg * alpha + ps;
#define PK4(P, BASE, OUT) do { u32x4 w = {cvt_pk_bf16(P[BASE + 0], P[BASE + 1]), cvt_pk_bf16(P[BASE + 2], P[BASE + 3]), cvt_pk_bf16(P[BASE + 4], P[BASE + 5]), cvt_pk_bf16(P[BASE + 6], P[BASE + 7])}; \
    OUT = *reinterpret_cast<bf16x8*>(&w); } while (0)
    PK4(p0, 0, pa0); PK4(p0, 8, pa1); PK4(p1, 0, pa2); PK4(p1, 8, pa3);
#undef PK4
}
__device__ __forceinline__ void qkt(f32x16& p0, f32x16& p1, const char* Ks, const bf16x8* qr, int r32, int hi, int comp) {
    p0 = f32x16{}; p1 = f32x16{};
#pragma unroll
    for (int d0 = 0; d0 < 4; ++d0) { const int cb = ((comp * 4 + d0) * 16 + hi * 8) * 2;
        bf16x8 b0 = *reinterpret_cast<const bf16x8*>(Ks + KSWZ(r32, cb));
        bf16x8 b1 = *reinterpret_cast<const bf16x8*>(Ks + KSWZ(32 + r32, cb));
        p0 = __builtin_amdgcn_mfma_f32_32x32x16_bf16(b0, qr[d0], p0, 0, 0, 0);
        p1 = __builtin_amdgcn_mfma_f32_32x32x16_bf16(b1, qr[d0], p1, 0, 0, 0); }
}
__device__ __forceinline__ void qk_sm(f32x16& n0, f32x16& n1, const char* Ks, const bf16x8* qr, int r32, int hi, int comp,
                                      f32x16& p0, f32x16& p1, float alpha, float& l_reg, bf16x8& pa0, bf16x8& pa1, bf16x8& pa2, bf16x8& pa3) {
#define LDKF(D0, R) *reinterpret_cast<const bf16x8*>(Ks + KSWZ((R), ((comp * 4 + (D0)) * 16 + hi * 8) * 2))
#define EX2(P, B) P[B] = __builtin_amdgcn_exp2f(P[B]); P[B + 1] = __builtin_amdgcn_exp2f(P[B + 1]); asm volatile("" : "+v"(P[B]), "+v"(P[B + 1]))
#define QMF(N, KF, D0) SBAR(); N = __builtin_amdgcn_mfma_f32_32x32x16_bf16(KF, qr[D0], N, 0, 0, 0); SBAR()
    SBAR();
    const bf16x8 k00 = LDKF(0, r32), k01 = LDKF(0, 32 + r32), k10 = LDKF(1, r32), k11 = LDKF(1, 32 + r32);
    SBAR();
    EX2(p1, 0); EX2(p1, 2); EX2(p1, 4); EX2(p1, 6);
    SBAR(); n0 = __builtin_amdgcn_mfma_f32_32x32x16_bf16(k00, qr[0], f32x16{}, 0, 0, 0); SBAR();
    EX2(p1, 8);
    SBAR(); n1 = __builtin_amdgcn_mfma_f32_32x32x16_bf16(k01, qr[0], f32x16{}, 0, 0, 0); SBAR();
    EX2(p1, 10);
    const bf16x8 k20 = LDKF(2, r32), k21 = LDKF(2, 32 + r32);
    QMF(n0, k10, 1); EX2(p1, 12);
    QMF(n1, k11, 1); EX2(p1, 14);
    const bf16x8 k30 = LDKF(3, r32), k31 = LDKF(3, 32 + r32);
    QMF(n0, k20, 2);
    float s0 = p0[0] + p0[1], s1 = p0[2] + p0[3]; s0 += p0[4]; s1 += p0[5]; s0 += p0[6]; s1 += p0[7]; s0 += p0[8]; s1 += p0[9];
    QMF(n1, k21, 2);
    s0 += p0[10]; s1 += p0[11]; s0 += p0[12]; s1 += p0[13]; s0 += p0[14]; s1 += p0[15]; s0 += p1[0]; s1 += p1[1];
    QMF(n0, k30, 3);
    s0 += p1[2]; s1 += p1[3]; s0 += p1[4]; s1 += p1[5]; s0 += p1[6]; s1 += p1[7]; s0 += p1[8]; s1 += p1[9];
    QMF(n1, k31, 3);
    s0 += p1[10]; s1 += p1[11]; s0 += p1[12]; s1 += p1[13]; s0 += p1[14]; s1 += p1[15]; float ps = s0 + s1;
    { auto rr = __builtin_amdgcn_permlane32_swap(__float_as_uint(ps), __float_as_uint(ps), false, false);
      ps = __uint_as_float(rr[0]) + __uint_as_float(rr[1]); }
    l_reg = l_reg * alpha + ps;
#define PK4(P, BASE, OUT) do { u32x4 w = {cvt_pk_bf16(P[BASE + 0], P[BASE + 1]), cvt_pk_bf16(P[BASE + 2], P[BASE + 3]), cvt_pk_bf16(P[BASE + 4], P[BASE + 5]), cvt_pk_bf16(P[BASE + 6], P[BASE + 7])}; \
    OUT = *reinterpret_cast<bf16x8*>(&w); } while (0)
    PK4(p0, 0, pa0); PK4(p0, 8, pa1); PK4(p1, 0, pa2); PK4(p1, 8, pa3);
    SBAR();
#undef PK4
#undef LDKF
#undef EX2
#undef QMF
}
__device__ __forceinline__ int v_st(int k, int c) { const int kk = k; return ((kk >> 3) * 4 + (c >> 5)) * 512 + ((kk & 7) * 32 + (c & 31)) * 2; }
__device__ __forceinline__ int v_rd_base(int lane) { return ((lane & 3) << 3) | (((lane >> 2) & 3) << 6) | (((lane >> 4) & 1) << 5) | (((lane >> 5) & 1) << 8); }
constexpr int v_rd_off(int d0, int ks, int half) { return d0 * 512 + ks * 4096 + half * 2048; }
template <int OFF> __device__ __forceinline__ s16x4 tr_read(int vb) {
    s16x4 r; asm volatile("ds_read_b64_tr_b16 %0, %1 offset:%2" : "=&v"(r) : "v"(vb), "i"(OFF) : "memory"); return r;
}
template <int D0> __device__ __forceinline__ void pv_one(f32x16& od, int vb, bf16x8 pa0, bf16x8 pa1, bf16x8 pa2, bf16x8 pa3) {
    const s16x4 l0 = tr_read<v_rd_off(D0, 0, 0)>(vb), h0 = tr_read<v_rd_off(D0, 0, 1)>(vb), l1 = tr_read<v_rd_off(D0, 1, 0)>(vb), h1 = tr_read<v_rd_off(D0, 1, 1)>(vb);
    const s16x4 l2 = tr_read<v_rd_off(D0, 2, 0)>(vb), h2 = tr_read<v_rd_off(D0, 2, 1)>(vb), l3 = tr_read<v_rd_off(D0, 3, 0)>(vb), h3 = tr_read<v_rd_off(D0, 3, 1)>(vb);
    asm volatile("s_waitcnt lgkmcnt(0)" ::: "memory"); SBAR();
#define PK(L, H) (bf16x8){L[0], L[1], L[2], L[3], H[0], H[1], H[2], H[3]}
    od = __builtin_amdgcn_mfma_f32_32x32x16_bf16(pa0, PK(l0, h0), od, 0, 0, 0);
    od = __builtin_amdgcn_mfma_f32_32x32x16_bf16(pa1, PK(l1, h1), od, 0, 0, 0);
    od = __builtin_amdgcn_mfma_f32_32x32x16_bf16(pa2, PK(l2, h2), od, 0, 0, 0);
    od = __builtin_amdgcn_mfma_f32_32x32x16_bf16(pa3, PK(l3, h3), od, 0, 0, 0);
#undef PK
}
__device__ __forceinline__ void pv_d0(f32x16* o, int vb, bf16x8 pa0, bf16x8 pa1, bf16x8 pa2, bf16x8 pa3) {
    pv_one<0>(o[0], vb, pa0, pa1, pa2, pa3); pv_one<1>(o[1], vb, pa0, pa1, pa2, pa3); pv_one<2>(o[2], vb, pa0, pa1, pa2, pa3); pv_one<3>(o[3], vb, pa0, pa1, pa2, pa3);
}
template <class Mid> __device__ __forceinline__ void pv_sm(f32x16* o, int vb, bf16x8 pa0, bf16x8 pa1, bf16x8 pa2, bf16x8 pa3, f32x16& p0, f32x16& p1, float& m_reg, float& mn, float& alpha, Mid mid) {
#define TRD(D0, KS, H) tr_read<v_rd_off(D0, KS, H)>(vb)
#define PKV(L, H) (bf16x8){L[0], L[1], L[2], L[3], H[0], H[1], H[2], H[3]}
#define MF(D0, PA, L, H) SBAR(); o[D0] = __builtin_amdgcn_mfma_f32_32x32x16_bf16(PA, PKV(L, H), o[D0], 0, 0, 0); SBAR()
#define WAITL(n) asm volatile("s_waitcnt lgkmcnt(" #n ")" ::: "memory")
#define MX3(a, b, c) fmaxf(fmaxf(a, b), c)
#define SUB8(P, B) P[B] -= mn; P[B + 1] -= mn; P[B + 2] -= mn; P[B + 3] -= mn; P[B + 4] -= mn; P[B + 5] -= mn; P[B + 6] -= mn; P[B + 7] -= mn; \
    asm volatile("" : "+v"(P[B]), "+v"(P[B + 1]), "+v"(P[B + 2]), "+v"(P[B + 3]), "+v"(P[B + 4]), "+v"(P[B + 5]), "+v"(P[B + 6]), "+v"(P[B + 7]))
#define EX2(P, B) P[B] = __builtin_amdgcn_exp2f(P[B]); P[B + 1] = __builtin_amdgcn_exp2f(P[B + 1]); asm volatile("" : "+v"(P[B]), "+v"(P[B + 1]))
    s16x4 x0, x1, x2, x3, y0, y1, y2, y3, z0, z1, z2, z3, w0, w1, w2, w3;
#define RD4(P, I) P##0 = TRD(((I) & 1) * 2, (I) >> 1, 0); P##1 = TRD(((I) & 1) * 2, (I) >> 1, 1); P##2 = TRD(((I) & 1) * 2 + 1, (I) >> 1, 0); P##3 = TRD(((I) & 1) * 2 + 1, (I) >> 1, 1)
    RD4(x, 0); RD4(y, 1); RD4(z, 2); RD4(w, 3); WAITL(12);
    MF(0, pa0, x0, x1);
    float t0 = MX3(p0[0], p0[1], p0[2]), t1 = MX3(p0[8], p0[9], p0[10]), t2 = MX3(p1[0], p1[1], p1[2]), t3 = MX3(p1[8], p1[9], p1[10]);
    t0 = MX3(t0, p0[3], p0[4]); t1 = MX3(t1, p0[11], p0[12]); t2 = MX3(t2, p1[3], p1[4]); t3 = MX3(t3, p1[11], p1[12]);
    MF(1, pa0, x2, x3);
    t0 = MX3(t0, p0[5], p0[6]); t1 = MX3(t1, p0[13], p0[14]); t2 = MX3(t2, p1[5], p1[6]); t3 = MX3(t3, p1[13], p1[14]);
    t0 = MX3(t0, p0[7], p0[15]); t2 = MX3(t2, p1[7], p1[15]); t0 = MX3(t0, t1, t2); float pmax = fmaxf(t0, t3);
    SBAR(); RD4(x, 4); WAITL(12);
    MF(2, pa0, y0, y1);
    { auto rr = __builtin_amdgcn_permlane32_swap(__float_as_uint(pmax), __float_as_uint(pmax), false, false);
      pmax = fmaxf(__uint_as_float(rr[0]), __uint_as_float(rr[1])); }
    { const bool ok = __all(pmax - m_reg <= THRL); const float mnew = fmaxf(m_reg, pmax); mn = ok ? m_reg : mnew; alpha = __builtin_amdgcn_exp2f(m_reg - mn); m_reg = mn; }
    MF(3, pa0, y2, y3);
    SBAR(); RD4(y, 5); WAITL(12);
    MF(0, pa1, z0, z1); SUB8(p0, 0);
    MF(1, pa1, z2, z3); SUB8(p0, 8);
    SBAR(); RD4(z, 6); WAITL(12);
    MF(2, pa1, w0, w1); SUB8(p1, 0);
    MF(3, pa1, w2, w3); SUB8(p1, 8);
    SBAR(); mid();
    SBAR(); RD4(w, 7); WAITL(12);
    MF(0, pa2, x0, x1); EX2(p0, 0);
    MF(1, pa2, x2, x3); EX2(p0, 2);
    SBAR(); WAITL(8);
    MF(2, pa2, y0, y1); EX2(p0, 4);
    MF(3, pa2, y2, y3); EX2(p0, 6);
    SBAR(); WAITL(4);
    MF(0, pa3, z0, z1); EX2(p0, 8);
    MF(1, pa3, z2, z3); EX2(p0, 10);
    SBAR(); WAITL(0);
    MF(2, pa3, w0, w1); EX2(p0, 12);
    MF(3, pa3, w2, w3); EX2(p0, 14);
    SBAR();
#undef RD4
#undef TRD
#undef PKV
#undef MF
#undef WAITL
#undef MX3
#undef SUB8
#undef EX2
}

__device__ __forceinline__ void attn_unit(const bf16_t* __restrict__ Qb, const bf16_t* __restrict__ Kh, const bf16_t* __restrict__ Vh, bf16_t* __restrict__ Ob,
                                          float lam, float outscale, const float* __restrict__ sub_gain, char* lds, const int tid) {
    constexpr int LDK = NPROJP, seq = SEQ;
    const int wid = tid >> 6, lane = tid & 63, r32 = lane & 31, hi = lane >> 5;
    const int comp = wid & 1, rb = wid >> 1;
    char* V_lds = lds; char* K_lds = lds + 3 * SHM_V;
    float* ws = (float*)(lds + WS_OFF) + wid * 64; float* li_l = ws; float* al_l = ws + 32;
    float m_reg = -1e30f, l_reg = 0; f32x16 o[4] = {}; bf16x8 qr[4];
    const bf16_t* Qw = Qb + (size_t)(rb * 32 + r32) * LDK + comp * 64 + hi * 8;
#pragma unroll
    for (int d0 = 0; d0 < 4; ++d0) qr[d0] = *reinterpret_cast<const bf16x8*>(Qw + d0 * 16);
    const int sr = tid >> 4, sc = (tid & 15) * 8, vst0 = v_st(sr, sc), vst1 = v_st(32 + sr, sc);
    const int vb0 = (int)(uintptr_t)V_lds + v_rd_base(lane);
    bf16x8 vsA0, vsA1, ksA0, ksA1;
#define SLOAD(S, k0) do { vs##S##0 = *reinterpret_cast<const bf16x8*>(&Vh[(size_t)((k0) + sr) * LDK + sc]); vs##S##1 = *reinterpret_cast<const bf16x8*>(&Vh[(size_t)((k0) + 32 + sr) * LDK + sc]); \
    ks##S##0 = *reinterpret_cast<const bf16x8*>(&Kh[(size_t)((k0) + sr) * LDK + sc]); ks##S##1 = *reinterpret_cast<const bf16x8*>(&Kh[(size_t)((k0) + 32 + sr) * LDK + sc]); } while (0)
#define SWRITE(b, S) do { *(bf16x8*)(V_lds + (b) * SHM_V + vst0) = vs##S##0; *(bf16x8*)(V_lds + (b) * SHM_V + vst1) = vs##S##1; const int kc = sc * 2; \
    *(bf16x8*)(K_lds + (b) * SHM_K + KSWZ(sr, kc)) = ks##S##0; *(bf16x8*)(K_lds + (b) * SHM_K + KSWZ(32 + sr, kc)) = ks##S##1; } while (0)
#define SWAIT() asm volatile("s_waitcnt vmcnt(4)" ::: "memory")
#define RESC(a) do { if (__any((a) < 1.f)) { if (hi == 0) al_l[r32] = (a); asm volatile("s_waitcnt lgkmcnt(0)" ::: "memory"); \
    _Pragma("unroll") for (int d = 0; d < 4; ++d) _Pragma("unroll") for (int r = 0; r < 16; ++r) o[d][r] *= al_l[crow(r, hi)]; } } while (0)
    f32x16 pA0, pA1, pB0, pB1; float mnA, mnB, alA, alB; bf16x8 pa0, pa1, pa2, pa3; const int NT = seq / KVBLK;
#define SW0() asm volatile("s_waitcnt vmcnt(0)" ::: "memory")
    SLOAD(A, 0); SW0(); SWRITE(0, A); SLOAD(A, KVBLK); __syncthreads();
    qkt(pA0, pA1, K_lds, qr, r32, hi, comp); partialSM(pA0, pA1, m_reg, mnA, alA);
    SW0(); SWRITE(1, A); SLOAD(A, 2 * KVBLK); __syncthreads();
    int bj = 1;
    for (int j = 1; j + 1 < NT; j += 2) {
        const int bjm1 = (bj == 0) ? 2 : bj - 1, bjp1 = (bj == 2) ? 0 : bj + 1;
        qk_sm(pB0, pB1, K_lds + bj * SHM_K, qr, r32, hi, comp, pA0, pA1, alA, l_reg, pa0, pa1, pa2, pa3);
        pv_sm(o, vb0 + bjm1 * (int)SHM_V, pa0, pa1, pa2, pa3, pB0, pB1, m_reg, mnB, alB, [&] { SW0(); SWRITE(bjp1, A); SLOAD(A, (j + 2) * KVBLK); });
        RESC(alB); __syncthreads();
        qk_sm(pA0, pA1, K_lds + bjp1 * SHM_K, qr, r32, hi, comp, pB0, pB1, alB, l_reg, pa0, pa1, pa2, pa3);
        pv_sm(o, vb0 + bj * (int)SHM_V, pa0, pa1, pa2, pa3, pA0, pA1, m_reg, mnA, alA, [&] { SW0(); SWRITE(bjm1, A); if (j + 3 < NT) SLOAD(A, (j + 3) * KVBLK); });
        RESC(alA); __syncthreads();
        bj = (bj == 0) ? 2 : bj - 1;
    }
    { const int bjm1 = (bj == 0) ? 2 : bj - 1;
      qk_sm(pB0, pB1, K_lds + bj * SHM_K, qr, r32, hi, comp, pA0, pA1, alA, l_reg, pa0, pa1, pa2, pa3);
      pv_sm(o, vb0 + bjm1 * (int)SHM_V, pa0, pa1, pa2, pa3, pB0, pB1, m_reg, mnB, alB, [] {});
      RESC(alB);
      finishSM(pB0, pB1, alB, l_reg, pa0, pa1, pa2, pa3); SBAR();
      pv_d0(o, vb0 + bj * (int)SHM_V, pa0, pa1, pa2, pa3); }
#undef SW0
    if (hi == 0) li_l[r32] = l_reg; asm volatile("s_waitcnt lgkmcnt(0)" ::: "memory");
    float rli[16];
#pragma unroll
    for (int r = 0; r < 16; ++r) rli[r] = __builtin_amdgcn_rcpf(li_l[crow(r, hi)]);
    __syncthreads();
    float* stg = (float*)lds + rb * 32 * 128;
    if (comp == 1) {
#pragma unroll
        for (int r = 0; r < 16; ++r)
#pragma unroll
            for (int d0 = 0; d0 < 4; ++d0) stg[crow(r, hi) * 128 + d0 * 32 + r32] = o[d0][r] * rli[r];
    }
    __syncthreads();
    if (comp == 0) {
#pragma unroll
        for (int r = 0; r < 16; ++r)
#pragma unroll
            for (int d0 = 0; d0 < 4; ++d0) { const int idx = crow(r, hi) * 128 + d0 * 32 + r32; stg[idx] = o[d0][r] * rli[r] - lam * stg[idx]; }
        asm volatile("s_waitcnt lgkmcnt(0)" ::: "memory");
        const int row = lane >> 1, c0 = (lane & 1) * 64;
        const float* sp = stg + row * 128 + c0;
        float ss = 0.f;
#pragma unroll
        for (int i = 0; i < 16; ++i) { const f32x4 v = *(const f32x4*)(sp + 4 * i); ss += (v[0] * v[0] + v[1] * v[1]) + (v[2] * v[2] + v[3] * v[3]); }
        ss += __shfl_xor(ss, 1);
        const float rs = outscale / sqrtf(ss * (1.0f / 128.0f) + 1e-5f);
        bf16_t* op = Ob + (size_t)(rb * 32 + row) * DM + c0;
#pragma unroll
        for (int i = 0; i < 8; ++i) { const f32x4 v0 = *(const f32x4*)(sp + 8 * i), v1 = *(const f32x4*)(sp + 8 * i + 4);
            const f32x4 g0 = *(const f32x4*)(sub_gain + c0 + 8 * i), g1 = *(const f32x4*)(sub_gain + c0 + 8 * i + 4);
            u32x4 w; w.x = cvt_pk_bf16(v0[0] * rs * g0[0], v0[1] * rs * g0[1]); w.y = cvt_pk_bf16(v0[2] * rs * g0[2], v0[3] * rs * g0[3]);
            w.z = cvt_pk_bf16(v1[0] * rs * g1[0], v1[1] * rs * g1[1]); w.w = cvt_pk_bf16(v1[2] * rs * g1[2], v1[3] * rs * g1[3]);
            *(u32x4*)(op + 8 * i) = w; }
    }
    __syncthreads();
#undef SLOAD
#undef SWRITE
#undef SWAIT
#undef RESC
}

#define PIN(x) asm volatile("" : "+v"(x))
#define MFMA_(a, b, c) __builtin_amdgcn_mfma_f32_32x32x16_bf16(a, b, c, 0, 0, 0)
#define WAIT_BAR(N) asm volatile("s_waitcnt vmcnt(" #N ") lgkmcnt(0)\n\ts_barrier" ::: "memory")
typedef __attribute__((address_space(3))) const char* lds_cptr;
typedef short v4i16_t __attribute__((ext_vector_type(4)));
__device__ __forceinline__ unsigned cvtpk_nv(float lo, float hi) { unsigned r; asm("v_cvt_pk_bf16_f32 %0, %1, %2" : "=v"(r) : "v"(lo), "v"(hi)); return r; }
__device__ __forceinline__ void glds16(const void* g, unsigned lds_base) {
    unsigned sv; asm volatile("s_mov_b32 %0, m0\n\ts_mov_b32 m0, %2\n\ts_nop 0\n\tglobal_load_lds_dwordx4 %1, off\n\ts_mov_b32 m0, %0" : "=&s"(sv) : "v"(g), "s"(lds_base) : "memory"); }
__device__ __forceinline__ void kload2(bf16x8* kf, lds_cptr kp, int kb0, int d0) { const lds_cptr p = kp + (kb0 ^ (d0 << 5));
    kf[2 * d0] = *(const __attribute__((address_space(3))) bf16x8*)(p); kf[2 * d0 + 1] = *(const __attribute__((address_space(3))) bf16x8*)(p + 8192); }
__device__ __forceinline__ s16x4 vtr(lds_cptr p) { return __builtin_bit_cast(s16x4, __builtin_amdgcn_ds_read_tr16_b64_v4i16((__attribute__((address_space(3))) v4i16_t*)p)); }
#define MX3(a, b, c) __builtin_fmaxf(__builtin_fmaxf((a), (b)), (c))
__device__ __forceinline__ float rowmax(const f32x16& p0, const f32x16& p1) {
    float a = MX3(p0[0], p0[1], p1[0]), b = MX3(p0[2], p0[3], p1[1]); a = MX3(a, p1[2], p1[3]);
#pragma unroll
    for (int r = 4; r < 16; r += 4) { a = MX3(a, p0[r], p0[r + 1]); b = MX3(b, p0[r + 2], p0[r + 3]); a = MX3(a, p1[r], p1[r + 1]); b = MX3(b, p1[r + 2], p1[r + 3]); }
    float m = __builtin_fmaxf(a, b); auto rr = __builtin_amdgcn_permlane32_swap(__float_as_uint(m), __float_as_uint(m), false, false);
    return __builtin_fmaxf(__uint_as_float(rr[0]), __uint_as_float(rr[1])); }
#undef MX3

__device__ __forceinline__ void attn_unit2(const bf16_t* __restrict__ Qb, const bf16_t* __restrict__ Kh, const bf16_t* __restrict__ Vh, unsigned char* __restrict__ Ob,
                                           float lam, float outscale, const float* __restrict__ sub_gain, char* lds, const int tid) {
    constexpr int LDK = NPROJP, NT = SEQ / KVBLK, SLOTB = 16384, LDS_K = 0, LDS_V = 3 * SLOTB;
    const int lane = tid & 63, r32 = lane & 31, hi = lane >> 5; const int wid = __builtin_amdgcn_readfirstlane(tid >> 6); const int comp = wid & 1, rb = wid >> 1;
    const unsigned lds0 = (unsigned)(uintptr_t)lds; float* wsf = (float*)(lds + WS_OFF) + wid * 64;
    const bf16_t* ksrc = Kh + (size_t)(8 * wid + (lane >> 4)) * LDK + ((lane & 15) ^ (lane >> 4)) * 8;
    const bf16_t* ksrc2 = Kh + (size_t)(8 * wid + 4 + (lane >> 4)) * LDK + ((lane & 15) ^ ((lane >> 4) + 4)) * 8;
    const bf16_t* vsrc = Vh + (size_t)(32 * (wid & 1) + (lane >> 2)) * LDK + (wid >> 1) * 32 + (lane & 3) * 8;
    const unsigned kdst = lds0 + LDS_K + wid * 2048, vdst = lds0 + LDS_V + (wid >> 1) * 4096 + (wid & 1) * 2048;
#define DMA_K(t, slot) do { const unsigned d_ = (unsigned)__builtin_amdgcn_readfirstlane(kdst + (slot)); glds16(ksrc + (size_t)(t) * KVBLK * LDK, d_); glds16(ksrc2 + (size_t)(t) * KVBLK * LDK, d_ + 1024); } while (0)
#define DMA_V(t, slot) do { const bf16_t* s_ = vsrc + (size_t)(t) * KVBLK * LDK; const unsigned d_ = (unsigned)__builtin_amdgcn_readfirstlane(vdst + (slot)); glds16(s_, d_); glds16(s_ + (size_t)16 * LDK, d_ + 1024); } while (0)
    const lds_cptr vp0 = (lds_cptr)lds + LDS_V + ((lane >> 4) & 1) * 32 + (lane & 3) * 8 + (4 * hi + ((lane & 15) >> 2)) * 64;
    const int kb0 = r32 * 256 + ((comp * 128 + hi * 16) ^ ((r32 & 7) << 4));
    const lds_cptr kp0 = (lds_cptr)lds + LDS_K;
    DMA_K(0, 0); DMA_V(0, 0); DMA_K(1, SLOTB);
    bf16x8 qr[4];
    { const bf16_t* Qw = Qb + (size_t)(rb * 32 + r32) * LDK + comp * 64 + hi * 8;
#pragma unroll
      for (int d0 = 0; d0 < 4; ++d0) qr[d0] = *reinterpret_cast<const bf16x8*>(Qw + d0 * 16); }
    float mhat = 0.f, l_reg = 0.f; f32x16 o[4] = {};
    bool resc = false;
    f32x16 pA0, pA1, pB0, pB1; bf16x8 kf[8]; s16x4 vlo[8], vhi[8]; u32x4 pw0, pw1, pw2, pw3;
    int sl_prev = 0, sl_cur = 0, sl_next = SLOTB;
#define ROT() do { sl_prev = sl_cur; sl_cur = sl_next; sl_next = (sl_next == 2 * SLOTB) ? 0 : sl_next + SLOTB; } while (0)
#define EX(v) __builtin_amdgcn_exp2f((v) + nmh)
#define RESC2() do { if (resc) { _Pragma("unroll") for (int d_ = 0; d_ < 4; ++d_) _Pragma("unroll") for (int r = 0; r < 16; ++r) o[d_][r] *= wsf[crow(r, hi)]; } } while (0)
    DMA_K(2, 2 * SLOTB);
    WAIT_BAR(6);
    _Pragma("unroll") for (int d0 = 0; d0 < 4; ++d0) kload2(kf, kp0, kb0, d0);
    pA0 = MFMA_(kf[0], qr[0], f32x16{}); pA1 = MFMA_(kf[1], qr[0], f32x16{}); pA0 = MFMA_(kf[2], qr[1], pA0); pA1 = MFMA_(kf[3], qr[1], pA1);
    pA0 = MFMA_(kf[4], qr[2], pA0); pA1 = MFMA_(kf[5], qr[2], pA1); pA0 = MFMA_(kf[6], qr[3], pA0); pA1 = MFMA_(kf[7], qr[3], pA1);
    { mhat = rowmax(pA0, pA1); const float nmh = -mhat;
#pragma unroll
      for (int r = 0; r < 16; ++r) { pA0[r] = EX(pA0[r]); pA1[r] = EX(pA1[r]); } }
    WAIT_BAR(0);
    DMA_K(3, 0); DMA_V(1, SLOTB); ROT();
    _Pragma("unroll") for (int d0 = 0; d0 < 4; ++d0) kload2(kf, kp0 + sl_cur, kb0, d0);
    WAIT_BAR(4);
#define PKW(P, i) cvtpk_nv(P[i], P[i + 1])
#define PAF(k) __builtin_bit_cast(bf16x8, pw##k)
#define VFR(i) (bf16x8){vlo[i][0], vlo[i][1], vlo[i][2], vlo[i][3], vhi[i][0], vhi[i][1], vhi[i][2], vhi[i][3]}
#define VRD(i, f) do { vlo[i] = vtr(vp_ + (((f) & 3) * 4096 + ((f) >> 2) * 1024)); vhi[i] = vtr(vp_ + (((f) & 3) * 4096 + ((f) >> 2) * 1024 + 512)); } while (0)
#define KRD(G, d0) do { if (G) { kload2(kf, kp0 + sl_next, kb0, d0); SBAR(); } } while (0)
#define GAPA(MF, a0, a1, a2, a3, W0, W1, PW) do { MF; sacc += a0; sacc += a1; sacc += a2; sacc += a3; W0; W1; PIN(PW); PIN(sacc); SBAR(); } while (0)
#define GAPB(MF, X, i) do { MF; X[i] = EX(X[i]); X[i + 1] = EX(X[i + 1]); PIN(X); SBAR(); } while (0)
#define STEP(C0, C1, P0, P1, t, GK, GV, GL) do { SBAR(); \
    const lds_cptr vp_ = vp0 + sl_prev; \
    VRD(0, 0); SBAR(); float sacc = P0[0] + P0[1]; \
                       GAPA(C0 = MFMA_(kf[0], qr[0], f32x16{}), P0[2], P0[3], P0[4], P0[5],     pw0[0] = PKW(P0, 0),  pw0[1] = PKW(P0, 2),  pw0); \
    VRD(1, 1); SBAR(); GAPA(C1 = MFMA_(kf[1], qr[0], f32x16{}), P0[6], P0[7], P0[8], P0[9],     pw0[2] = PKW(P0, 4),  pw0[3] = PKW(P0, 6),  pw0); \
    VRD(2, 2); SBAR(); GAPA(C0 = MFMA_(kf[2], qr[1], C0),       P0[10], P0[11], P0[12], P0[13], pw1[0] = PKW(P0, 8),  pw1[1] = PKW(P0, 10), pw1); \
    VRD(3, 3); SBAR(); GAPA(C1 = MFMA_(kf[3], qr[1], C1),       P0[14], P0[15], P1[0], P1[1],   pw1[2] = PKW(P0, 12), pw1[3] = PKW(P0, 14), pw1); \
    VRD(4, 4); SBAR(); GAPA(C0 = MFMA_(kf[4], qr[2], C0),       P1[2], P1[3], P1[4], P1[5],     pw2[0] = PKW(P1, 0),  pw2[1] = PKW(P1, 2),  pw2); \
    VRD(5, 5); SBAR(); GAPA(C1 = MFMA_(kf[5], qr[2], C1),       P1[6], P1[7], P1[8], P1[9],     pw2[2] = PKW(P1, 4),  pw2[3] = PKW(P1, 6),  pw2); \
    VRD(6, 6); SBAR(); GAPA(C0 = MFMA_(kf[6], qr[3], C0),       P1[10], P1[11], P1[12], P1[13], pw3[0] = PKW(P1, 8),  pw3[1] = PKW(P1, 10), pw3); \
    VRD(7, 7); SBAR(); GAPA(C1 = MFMA_(kf[7], qr[3], C1),       P1[14], P1[15], 0.f, 0.f,       pw3[2] = PKW(P1, 12), pw3[3] = PKW(P1, 14), pw3); \
    l_reg += sacc; \
    if (GK) DMA_K((t) + 3, sl_cur); if (GV) DMA_V((t) + 1, sl_next); \
    { const float rm = rowmax(C0, C1) - mhat; resc = false; \
      if (__builtin_expect(__any(rm > THRL), 0)) { const float dl = __builtin_fmaxf(rm, 0.f); mhat += dl; \
          const float f = __builtin_amdgcn_exp2f(-dl); l_reg *= f; if (hi == 0) wsf[r32] = f; resc = true; } } \
    const float nmh = -mhat; SBAR(); \
    KRD(GL, 0); GAPB(o[0] = MFMA_(PAF(0), VFR(0), o[0]), C0, 0);   KRD(GL, 1); GAPB(o[1] = MFMA_(PAF(0), VFR(1), o[1]), C0, 2); \
    KRD(GL, 2); GAPB(o[2] = MFMA_(PAF(0), VFR(2), o[2]), C0, 4);   KRD(GL, 3); GAPB(o[3] = MFMA_(PAF(0), VFR(3), o[3]), C0, 6); \
    VRD(0, 8);  SBAR(); GAPB(o[0] = MFMA_(PAF(1), VFR(4), o[0]), C0, 8);   VRD(1, 9);  SBAR(); GAPB(o[1] = MFMA_(PAF(1), VFR(5), o[1]), C0, 10); \
    VRD(2, 10); SBAR(); GAPB(o[2] = MFMA_(PAF(1), VFR(6), o[2]), C0, 12);  VRD(3, 11); SBAR(); GAPB(o[3] = MFMA_(PAF(1), VFR(7), o[3]), C0, 14); \
    VRD(4, 12); SBAR(); GAPB(o[0] = MFMA_(PAF(2), VFR(0), o[0]), C1, 0);   VRD(5, 13); SBAR(); GAPB(o[1] = MFMA_(PAF(2), VFR(1), o[1]), C1, 2); \
    VRD(6, 14); SBAR(); GAPB(o[2] = MFMA_(PAF(2), VFR(2), o[2]), C1, 4);   VRD(7, 15); SBAR(); GAPB(o[3] = MFMA_(PAF(2), VFR(3), o[3]), C1, 6); \
    GAPB(o[0] = MFMA_(PAF(3), VFR(4), o[0]), C1, 8);   GAPB(o[1] = MFMA_(PAF(3), VFR(5), o[1]), C1, 10); \
    GAPB(o[2] = MFMA_(PAF(3), VFR(6), o[2]), C1, 12);  GAPB(o[3] = MFMA_(PAF(3), VFR(7), o[3]), C1, 14); \
    } while (0)
    int t = 1;
    for (; t + 5 < NT; t += 2) {
        STEP(pB0, pB1, pA0, pA1, t, true, true, true);     WAIT_BAR(4); RESC2(); ROT();
        STEP(pA0, pA1, pB0, pB1, t + 1, true, true, true); WAIT_BAR(4); RESC2(); ROT();
    }
#define ENDW(tt) do { if ((tt) + 3 < NT) { WAIT_BAR(4); } else if ((tt) + 2 < NT) { WAIT_BAR(2); } else { WAIT_BAR(0); } } while (0)
    for (; t + 1 < NT; t += 2) {
        STEP(pB0, pB1, pA0, pA1, t, (t + 3 < NT), (t + 1 < NT), (t + 1 < NT));         ENDW(t);     RESC2(); ROT();
        STEP(pA0, pA1, pB0, pB1, t + 1, (t + 4 < NT), (t + 2 < NT), (t + 2 < NT));     ENDW(t + 1); RESC2(); ROT();
    }
    STEP(pB0, pB1, pA0, pA1, NT - 1, false, false, false); RESC2();
    { float sacc = pB0[0] + pB0[1];
#pragma unroll
      for (int r = 2; r < 16; ++r) sacc += pB0[r];
#pragma unroll
      for (int r = 0; r < 16; ++r) sacc += pB1[r];
      l_reg += sacc;
      pw0 = (u32x4){PKW(pB0, 0), PKW(pB0, 2), PKW(pB0, 4), PKW(pB0, 6)}; pw1 = (u32x4){PKW(pB0, 8), PKW(pB0, 10), PKW(pB0, 12), PKW(pB0, 14)};
      pw2 = (u32x4){PKW(pB1, 0), PKW(pB1, 2), PKW(pB1, 4), PKW(pB1, 6)}; pw3 = (u32x4){PKW(pB1, 8), PKW(pB1, 10), PKW(pB1, 12), PKW(pB1, 14)};
      const lds_cptr vp_ = vp0 + sl_cur;
      _Pragma("unroll") for (int i = 0; i < 8; ++i) VRD(i, i);
      o[0] = MFMA_(PAF(0), VFR(0), o[0]); o[1] = MFMA_(PAF(0), VFR(1), o[1]); o[2] = MFMA_(PAF(0), VFR(2), o[2]); o[3] = MFMA_(PAF(0), VFR(3), o[3]);
      o[0] = MFMA_(PAF(1), VFR(4), o[0]); o[1] = MFMA_(PAF(1), VFR(5), o[1]); o[2] = MFMA_(PAF(1), VFR(6), o[2]); o[3] = MFMA_(PAF(1), VFR(7), o[3]);
      SBAR();
      _Pragma("unroll") for (int i = 0; i < 8; ++i) VRD(i, 8 + i);
      o[0] = MFMA_(PAF(2), VFR(0), o[0]); o[1] = MFMA_(PAF(2), VFR(1), o[1]); o[2] = MFMA_(PAF(2), VFR(2), o[2]); o[3] = MFMA_(PAF(2), VFR(3), o[3]);
      o[0] = MFMA_(PAF(3), VFR(4), o[0]); o[1] = MFMA_(PAF(3), VFR(5), o[1]); o[2] = MFMA_(PAF(3), VFR(6), o[2]); o[3] = MFMA_(PAF(3), VFR(7), o[3]); }
    { auto rr = __builtin_amdgcn_permlane32_swap(__float_as_uint(l_reg), __float_as_uint(l_reg), false, false); l_reg = __uint_as_float(rr[0]) + __uint_as_float(rr[1]); }
    float* li_l = wsf + 32;
    if (hi == 0) li_l[r32] = l_reg; asm volatile("s_waitcnt lgkmcnt(0)" ::: "memory");
    float rli[16];
#pragma unroll
    for (int r = 0; r < 16; ++r) rli[r] = __builtin_amdgcn_rcpf(li_l[crow(r, hi)]);
    __syncthreads();
    float* stg = (float*)lds + rb * 32 * 128;
    if (comp == 1) {
#pragma unroll
        for (int r = 0; r < 16; ++r)
#pragma unroll
            for (int d0 = 0; d0 < 4; ++d0) stg[crow(r, hi) * 128 + d0 * 32 + r32] = o[d0][r] * rli[r];
    }
    __syncthreads();
    if (comp == 0) {
#pragma unroll
        for (int r = 0; r < 16; ++r)
#pragma unroll
            for (int d0 = 0; d0 < 4; ++d0) { const int idx = crow(r, hi) * 128 + d0 * 32 + r32; stg[idx] = o[d0][r] * rli[r] - lam * stg[idx]; }
        asm volatile("s_waitcnt lgkmcnt(0)" ::: "memory");
        static_assert(WOUT_FP8, "the mix buffer is fp8");
        const int rsub = lane >> 4, c16 = lane & 15, sw = c16 >> 3;
        const f32x4 ga = *(const f32x4*)(sub_gain + c16 * 8 + 4 * sw), gb = *(const f32x4*)(sub_gain + c16 * 8 + 4 * (sw ^ 1));
        const float* sp0 = stg + rsub * 128 + c16 * 8;
        unsigned char* op0 = Ob + (size_t)(rb * 32 + rsub) * DM + c16 * 8;
#pragma unroll
        for (int i = 0; i < 8; ++i) { const float* sp = sp0 + i * 4 * 128;
            const f32x4 va = *(const f32x4*)(sp + 4 * sw), vb = *(const f32x4*)(sp + 4 * (sw ^ 1));
            float ss = (va[0] * va[0] + va[1] * va[1]) + (va[2] * va[2] + va[3] * va[3]) + (vb[0] * vb[0] + vb[1] * vb[1]) + (vb[2] * vb[2] + vb[3] * vb[3]);
            ss += __shfl_xor(ss, 1); ss += __shfl_xor(ss, 2); ss += __shfl_xor(ss, 4); ss += __shfl_xor(ss, 8);
            const float rq = outscale * MIXSC / sqrtf(ss * (1.0f / 128.0f) + 1e-5f);
            const int wa = pk4_fp8(va[0] * rq * ga[0], va[1] * rq * ga[1], va[2] * rq * ga[2], va[3] * rq * ga[3]);
            const int wb = pk4_fp8(vb[0] * rq * gb[0], vb[1] * rq * gb[1], vb[2] * rq * gb[2], vb[3] * rq * gb[3]);
            u32x2 w; w.x = (unsigned)(sw ? wb : wa); w.y = (unsigned)(sw ? wa : wb);
            *(u32x2*)(op0 + (size_t)(i * 4) * DM) = w; }
    }
    __syncthreads();
#undef DMA_K
#undef DMA_V
#undef ROT
#undef EX
#undef RESC2
#undef PKW
#undef PAF
#undef VFR
#undef VRD
#undef KRD
#undef ENDW
#undef GAPA
#undef GAPB
#undef STEP
}
#undef PIN
#undef MFMA_
#undef WAIT_BAR
}

struct Args { const void* in[31]; float* out; unsigned char* ws; int ph_lo, ph_hi; };
typedef const __attribute__((address_space(4))) Args* ArgsP;
__device__ __forceinline__ int launder_v(int x) { asm volatile("" : "+v"(x)); return x; }
__device__ __forceinline__ int phase_tid(int wave) { int l; asm volatile("v_mbcnt_lo_u32_b32 %0, -1, 0\n\tv_mbcnt_hi_u32_b32 %0, -1, %0" : "=v"(l)); return wave * 64 + l; }
__device__ __forceinline__ ArgsP phase_args() { ArgsP p = (ArgsP)__builtin_amdgcn_kernarg_segment_ptr(); asm volatile("" : "+s"(p)); return p; }
enum { I_X = 0, I_C, I_POS, I_WADA, I_BADA, I_NGAIN, I_WIN, I_WOUT, I_MUP, I_MUN, I_DW0, I_DUP, I_A0, I_AUP, I_KK, I_KA, I_RK, I_GUP, I_GNG, I_GNB,
       I_LQ1, I_LK1, I_LQ2, I_LK2, I_SUBG, I_WR, I_RB, I_WG, I_WU, I_WDN, I_FG };

__device__ const double INVF[8] = {1.0, 0.1939227447486858, 0.03760603093086394, 0.007292664737217109, 0.0014142135623730957, 0.00027424817567620724, 5.318295896944988e-05, 1.0313385377212461e-05};

enum { MAP_ID = 0, MAP_QK = 1, MAP_GATE = 2, MAP_UP = 3 };
template <int MAP> __device__ __forceinline__ int map_row(int n) {
    if (MAP == MAP_QK) { if (n < 2048) { const int d = n & 63; if (d < 16) return (n & ~63) | (d & 3) | ((d & 8) >> 1) | ((d & 4) << 1); } return n; }
    if (MAP == MAP_GATE) return ((n >> 2) << 3) | (n & 3);
    if (MAP == MAP_UP) return ((n >> 2) << 3) | 4 | (n & 3);
    return n;
}
template <int MAP, bool F8 = false> __device__ __forceinline__ void transpose_item(const float* __restrict__ W, int K, int N, bf16_t* __restrict__ WT, LAS float* scr, int item, int lane, float scale = 1.0f) {
    const int nblk = N / 32, kb = item / nblk, nb = item % nblk, k0 = 64 * kb, n0 = 32 * nb;
#pragma unroll 8
    for (int i = 0; i < 32; ++i) { const int kk = 2 * i + (lane >> 5); scr[kk * 33 + (lane & 31)] = W[(size_t)(k0 + kk) * N + n0 + (lane & 31)]; }
    LDS_WAIT(); asm volatile("" ::: "memory");
    const int c = lane & 7;
#pragma unroll
    for (int j = 0; j < 4; ++j) { const int n = (lane >> 3) + 8 * j; const LAS float* s = scr + (8 * c) * 33 + n;
        if constexpr (F8) { int w0 = 0, w1 = 0;
            w0 = pk4_fp8(s[0 * 33] * scale, s[1 * 33] * scale, s[2 * 33] * scale, s[3 * 33] * scale);
            w1 = pk4_fp8(s[4 * 33] * scale, s[5 * 33] * scale, s[6 * 33] * scale, s[7 * 33] * scale);
            u32x2 o; o.x = (unsigned)w0; o.y = (unsigned)w1;
            *(u32x2*)((unsigned char*)WT + (size_t)map_row<MAP>(n0 + n) * K + k0 + 8 * c) = o; }
        else { u32x4 o; o.x = cvt_pk_bf16(s[0 * 33], s[1 * 33]); o.y = cvt_pk_bf16(s[2 * 33], s[3 * 33]); o.z = cvt_pk_bf16(s[4 * 33], s[5 * 33]); o.w = cvt_pk_bf16(s[6 * 33], s[7 * 33]);
            *(u32x4*)(WT + (size_t)map_row<MAP>(n0 + n) * K + k0 + 8 * c) = o; } }
    LDS_WAIT(); asm volatile("" ::: "memory");
}
template <int MAP> __device__ __forceinline__ void transpose_item128(const float* __restrict__ W, int K, int N, unsigned char* __restrict__ WT, LAS float* scr, int item, int lane, float scale) {
    const int nblk = N / 32, kb = item / nblk, nb = item % nblk, k0 = 128 * kb, n0 = 32 * nb;
    const int lr = lane >> 3, lc = lane & 7;
    f32x4 t[16];
    const float* src = W + (size_t)(k0 + lr) * N + n0 + 4 * lc;
#pragma unroll
    for (int j = 0; j < 16; ++j) t[j] = *(const f32x4*)(src + (size_t)(8 * j) * N);
#pragma unroll
    for (int j = 0; j < 16; ++j) { const int k = 8 * j + lr; *(LAS f32x4*)(scr + k * 32 + ((lc ^ (k >> 4)) << 2)) = t[j]; }
    LDS_WAIT(); asm volatile("" ::: "memory");
    const int nr = lane >> 3, c = lane & 7;
#pragma unroll
    for (int jj = 0; jj < 4; ++jj) { const int n = 8 * jj + nr; const LAS float* sp = scr + (16 * c) * 32 + ((((n >> 2) ^ c) << 2) | (n & 3));
        float f0[8], f1[8];
#pragma unroll
        for (int e = 0; e < 8; ++e) { f0[e] = sp[e * 32] * scale; f1[e] = sp[(8 + e) * 32] * scale; }
        const u32x2 a = pack8_fp8(f0), b = pack8_fp8(f1); u32x4 o; o.x = a.x; o.y = a.y; o.z = b.x; o.w = b.y;
        *(u32x4*)(WT + (size_t)map_row<MAP>(n0 + n) * K + k0 + 16 * c) = o; }
    LDS_WAIT(); asm volatile("" ::: "memory");
}
template <int MAP> __device__ __forceinline__ void transpose_piece_f8(const float* __restrict__ W, int K, int N, unsigned char* __restrict__ WT, LAS float* scr, int piece, int lane, float scale) {
    const int nblk = N / 32, kb = piece / nblk, nb = piece % nblk, k0 = 32 * kb, n0 = 32 * nb;
    float t[16];
#pragma unroll
    for (int i = 0; i < 16; ++i) t[i] = W[(size_t)(k0 + 2 * i + (lane >> 5)) * N + n0 + (lane & 31)];
#pragma unroll
    for (int i = 0; i < 16; ++i) scr[(2 * i + (lane >> 5)) * 33 + (lane & 31)] = t[i];
    LDS_WAIT(); asm volatile("" ::: "memory");
    const int c = lane & 3;
#pragma unroll
    for (int j = 0; j < 2; ++j) { const int n = (lane >> 2) + 16 * j; const LAS float* s = scr + (8 * c) * 33 + n;
        const float f[8] = {s[0 * 33] * scale, s[1 * 33] * scale, s[2 * 33] * scale, s[3 * 33] * scale, s[4 * 33] * scale, s[5 * 33] * scale, s[6 * 33] * scale, s[7 * 33] * scale};
        *(u32x2*)(WT + (size_t)map_row<MAP>(n0 + n) * K + k0 + 8 * c) = pack8_fp8(f); }
    LDS_WAIT(); asm volatile("" ::: "memory");
}
constexpr int MOE_PIECES = NEXP * 3 * 2048;
__device__ __forceinline__ void convert_moe_piece(ArgsP A, int l, LAS float* scr, int lane, int piece) {
    const int e = piece / 6144; int r = piece % 6144;
    unsigned char* WGU = A->ws + WS_WGU + (size_t)e * 2048 * DM; unsigned char* WD = A->ws + WS_WD + (size_t)e * DM * DFF;
    if (r < 2048) { transpose_piece_f8<MAP_GATE>((const float*)A->in[I_WG] + ((size_t)l * NEXP + e) * DM * DFF, DM, DFF, WGU, scr, r, lane, WSC_GU); return; } r -= 2048;
    if (r < 2048) { transpose_piece_f8<MAP_UP>((const float*)A->in[I_WU] + ((size_t)l * NEXP + e) * DM * DFF, DM, DFF, WGU, scr, r, lane, WSC_GU); return; } r -= 2048;
    transpose_piece_f8<MAP_ID>((const float*)A->in[I_WDN] + ((size_t)l * NEXP + e) * DFF * DM, DFF, DM, WD, scr, r, lane, WSC_D);
}
__device__ __forceinline__ void convert_moe(ArgsP A, int l, LAS unsigned char* lds, int lane, int wave, int gw, int NGW) {
    LAS float* scr = (LAS float*)(lds + wave * 16384);
    unsigned char* WGU = A->ws + WS_WGU; unsigned char* WD = A->ws + WS_WD;
    const float* wg = (const float*)A->in[I_WG] + (size_t)l * NEXP * DM * DFF;
    const float* wu = (const float*)A->in[I_WU] + (size_t)l * NEXP * DM * DFF;
    const float* wd = (const float*)A->in[I_WDN] + (size_t)l * NEXP * DFF * DM;
    constexpr int IG = (DM / 128) * (DFF / 32);
    constexpr int ID = (DFF / 128) * (DM / 32);
    for (int it = gw; it < NEXP * (2 * IG + ID); it += NGW) {
        const int e = it / (2 * IG + ID); int r = it % (2 * IG + ID);
        if (r < IG) { transpose_item128<MAP_GATE>(wg + (size_t)e * DM * DFF, DM, DFF, WGU + (size_t)e * 2048 * DM, scr, r, lane, WSC_GU); continue; } r -= IG;
        if (r < IG) { transpose_item128<MAP_UP>(wu + (size_t)e * DM * DFF, DM, DFF, WGU + (size_t)e * 2048 * DM, scr, r, lane, WSC_GU); continue; } r -= IG;
        transpose_item128<MAP_ID>(wd + (size_t)e * DFF * DM, DFF, DM, WD + (size_t)e * DM * DFF, scr, r, lane, WSC_D);
    }
}

__device__ __forceinline__ void phase_prologue(ArgsP A, LAS unsigned char* lds, int tid, int lane, int wave, int bx, int G) {
    float* MOD = (float*)(A->ws + WS_MOD);
    __syncthreads();
    if (bx < 192) {
        LAS float* sc = (LAS float*)lds; LAS float* red = (LAS float*)(lds + 32768);
        const float* c = (const float*)A->in[I_C];
        for (int i = tid; i < BATCH * DM; i += 512) { const float v = c[i]; sc[i] = v / (1.f + __expf(-v)); }
        __syncthreads();
        const int l = bx / 96, n0 = (bx % 96) * 128, half = lane >> 5, cg = lane & 31;
        const float* wp = (const float*)A->in[I_WADA] + (size_t)l * DM * NMOD + (size_t)(256 * wave + half) * NMOD + n0 + 4 * cg;
        f32x4 a0 = {0.f, 0.f, 0.f, 0.f}, a1 = a0, a2 = a0, a3 = a0;
#pragma unroll 8
        for (int kk = 0; kk < 128; ++kk) { const int k = 256 * wave + 2 * kk + half; const f32x4 wv = *(const f32x4*)(wp + (size_t)(2 * kk) * NMOD);
            a0 += wv * sc[k]; a1 += wv * sc[DM + k]; a2 += wv * sc[2 * DM + k]; a3 += wv * sc[3 * DM + k]; }
#pragma unroll
        for (int j = 0; j < 4; ++j) { a0[j] += __shfl_xor(a0[j], 32); a1[j] += __shfl_xor(a1[j], 32); a2[j] += __shfl_xor(a2[j], 32); a3[j] += __shfl_xor(a3[j], 32); }
        if (half == 0) { *(LAS f32x4*)(red + (wave * 4 + 0) * 128 + 4 * cg) = a0; *(LAS f32x4*)(red + (wave * 4 + 1) * 128 + 4 * cg) = a1;
                         *(LAS f32x4*)(red + (wave * 4 + 2) * 128 + 4 * cg) = a2; *(LAS f32x4*)(red + (wave * 4 + 3) * 128 + 4 * cg) = a3; }
        __syncthreads();
        { const int b = tid >> 7, col = tid & 127; float s = 0.f;
#pragma unroll
          for (int w = 0; w < 8; ++w) s += red[(w * 4 + b) * 128 + col];
          MOD[(size_t)(l * 4 + b) * NMOD + n0 + col] = s + ((const float*)A->in[I_BADA])[l * NMOD + n0 + col]; }
        __syncthreads();
    }
    { float* ROPE = (float*)(A->ws + WS_ROPE); const int* pos = (const int*)A->in[I_POS];
      for (int it = bx * 512 + tid; it < MTOK * 8; it += G * 512) { const int tok = it >> 3, j = it & 7;
          const double x = (double)pos[tok] * INVF[j]; const double n = rint(x * 0.15915494309189535); const float r = (float)(x - n * 6.283185307179586);
          ROPE[tok * 16 + j] = cosf(r); ROPE[tok * 16 + 8 + j] = sinf(r); } }
    const int gw = bx * 8 + wave, NGW = G * 8;
    { LAS float* scr = (LAS float*)(lds + wave * 16384);
      static_assert(PROJ_FP8 && WOUT_FP8, "the 128 x 32 converter writes fp8");
      constexpr int I_IN = (DM / 128) * (NPROJ / 32), I_OUT = (DM / 128) * (DM / 32);
      for (int it = gw; it < DEPTH * (I_IN + I_OUT); it += NGW) { const int l = it / (I_IN + I_OUT); int r = it % (I_IN + I_OUT);
          if (r < I_IN) transpose_item128<MAP_QK>((const float*)A->in[I_WIN] + (size_t)l * DM * NPROJ, DM, NPROJ, A->ws + WS_WIN + (size_t)l * NPROJP * DM, scr, r, lane, WSC_IN);
          else transpose_item128<MAP_ID>((const float*)A->in[I_WOUT] + (size_t)l * DM * DM, DM, DM, A->ws + WS_WOUT + (size_t)l * DM * DM, scr, r - I_IN, lane, WSC_O); } }
    { const int gt = bx * 512 + tid; constexpr int EB = PROJ_FP8 ? 1 : 2; constexpr int PER = (NPROJP - NPROJ) * DM * EB / 16;
      for (int it = gt; it < DEPTH * PER; it += G * 512) { const int l = it / PER, r = it % PER;
          *(u32x4*)(A->ws + WS_WIN + ((size_t)l * NPROJP * DM + (size_t)NPROJ * DM) * EB + (size_t)r * 16) = (u32x4){0u, 0u, 0u, 0u}; } }
    { const int gt = bx * 512 + tid; bf16_t* LW = (bf16_t*)(A->ws + WS_LW);
      for (int it = gt; it < DEPTH * 48 * NDYN; it += G * 512) { const int c = it % NDYN, kc = (it / NDYN) % 48, l = it / (NDYN * 48);
          const int kind = c >> 10, cc = c & 1023; float v[8];
#pragma unroll
          for (int j = 0; j < 8; ++j) { const int k = 8 * kc + j; float x = 0.f;
              if (kind < 2) { const int r = k - 64 * kind; if (r >= 0 && r < 64) x = ((const float*)A->in[I_DUP])[((size_t)(l * 2 + kind) * 64 + r) * 1024 + cc]; }
              else if (kind < 4) { const int r = k - 128 - 64 * (kind - 2); if (r >= 0 && r < 64) x = ((const float*)A->in[I_AUP])[((size_t)(l * 2 + kind - 2) * 64 + r) * 1024 + cc]; }
              else { const int r = k - 256; if (r >= 0 && r < 128) x = ((const float*)A->in[I_GUP])[((size_t)l * 128 + r) * 1024 + cc]; }
              v[j] = x; }
          *(u32x4*)(LW + ((size_t)l * NDYN + c) * KLA + 8 * kc) = pack8(v); } }
#if !SCAN_CONVERT
    convert_moe(A, 0, lds, lane, wave, gw, NGW);
#endif
}

__device__ __forceinline__ void load_moe_table(ArgsP A, int l, LAS unsigned char* lds, int tid) {
    LAS int* tb = (LAS int*)(lds + LDS_MISC + 64); LAS int* cn = (LAS int*)(lds + LDS_MISC + 192);
    if (tid == 0) { unsigned* ctl = (unsigned*)(A->ws + WS_CTL); int s = 0;
        for (int e = 0; e < NEXP; ++e) { int c = (int)__hip_atomic_load(ctl + CW_CNT + (l * 16 + e) * 64, __ATOMIC_RELAXED, __HIP_MEMORY_SCOPE_AGENT); if (c > TOKCAP) c = TOKCAP; cn[e] = c; tb[e] = s; s += (c + 255) >> 8; }
        tb[16] = s; }
    __syncthreads();
}

template <int MODE> __device__ __forceinline__ void phase_norm1(ArgsP A, int l, LAS unsigned char* lds, int tid, int lane, int wave, int bx, int G) {
    const float* MOD = (const float*)(A->ws + WS_MOD);
    bf16_t* X = (bf16_t*)(A->ws + WS_X); bf16_t* H = (bf16_t*)(A->ws + WS_H);
    const unsigned char* Y = A->ws + WS_Y; const u32x4* ASG = (const u32x4*)(A->ws + WS_ASG);
    const LAS int* tb = (const LAS int*)(lds + LDS_MISC + 64);
    if (MODE != 0) load_moe_table(A, l - 1, lds, tid);
    const int gw = bx * 8 + wave, NGW = G * 8;
    for (int b = 0; b < BATCH; ++b) {
        f32x4 mulv[8], addv[8], g2v[8];
#pragma unroll
        for (int j = 0; j < 8; ++j) { const int c = 4 * (lane + 64 * j);
            if (MODE == 2) { mulv[j] = *(const f32x4*)((const float*)A->in[I_FG] + c); addv[j] = (f32x4){0.f, 0.f, 0.f, 0.f}; }
            else { const float* mo = MOD + (size_t)(l * 4 + b) * NMOD; const f32x4 gn = *(const f32x4*)((const float*)A->in[I_NGAIN] + (size_t)(l * 2 + 0) * DM + c);
                   mulv[j] = gn * (*(const f32x4*)(mo + 1 * DM + c) + 1.0f); addv[j] = *(const f32x4*)(mo + 0 * DM + c); }
            if (MODE != 0) g2v[j] = *(const f32x4*)(MOD + (size_t)((l - 1) * 4 + b) * NMOD + 5 * DM + c); }
        for (int row = b * SEQ + gw; row < (b + 1) * SEQ; row += NGW) {
            f32x4 v[8];
            if (MODE == 0) { const f32x4* xr = (const f32x4*)((const float*)A->in[I_X] + (size_t)row * DM) + lane;
#pragma unroll
                for (int j = 0; j < 8; ++j) v[j] = xr[64 * j]; }
            else { const u32x2* xr = (const u32x2*)(X + (size_t)row * DM) + lane;
#pragma unroll
                for (int j = 0; j < 8; ++j) { const u32x2 p = xr[64 * j]; v[j] = (f32x4){bflo(p.x), bfhi(p.x), bflo(p.y), bfhi(p.y)}; } }
            if (MODE != 0) {
                const u32x4 as = ASG[row];
                const int e0 = __builtin_amdgcn_readfirstlane((int)(as.x >> 20)), s0 = __builtin_amdgcn_readfirstlane((int)(as.x & 0xfffffu));
                const int e1 = __builtin_amdgcn_readfirstlane((int)(as.y >> 20)), s1 = __builtin_amdgcn_readfirstlane((int)(as.y & 0xfffffu));
                const float w0 = __uint_as_float(as.z) * (1.0f / YSC), w1 = __uint_as_float(as.w) * (1.0f / YSC);
                const int* y0 = (const int*)(Y + ((size_t)tb[e0] * 256 + s0) * DM) + lane; const int* y1 = (const int*)(Y + ((size_t)tb[e1] * 256 + s1) * DM) + lane;
#pragma unroll
                for (int j = 0; j < 8; ++j) { const int p = y0[64 * j], q = y1[64 * j];
                    f32x4 m; m[0] = w0 * __builtin_amdgcn_cvt_f32_fp8(p, 0) + w1 * __builtin_amdgcn_cvt_f32_fp8(q, 0); m[1] = w0 * __builtin_amdgcn_cvt_f32_fp8(p, 1) + w1 * __builtin_amdgcn_cvt_f32_fp8(q, 1);
                    m[2] = w0 * __builtin_amdgcn_cvt_f32_fp8(p, 2) + w1 * __builtin_amdgcn_cvt_f32_fp8(q, 2); m[3] = w0 * __builtin_amdgcn_cvt_f32_fp8(p, 3) + w1 * __builtin_amdgcn_cvt_f32_fp8(q, 3);
                    v[j] = v[j] + g2v[j] * m; }
                if (MODE == 1) { u32x2* xw = (u32x2*)(X + (size_t)row * DM) + lane;
#pragma unroll
                    for (int j = 0; j < 8; ++j) { u32x2 w; w.x = cvt_pk_bf16(v[j][0], v[j][1]); w.y = cvt_pk_bf16(v[j][2], v[j][3]); xw[64 * j] = w; } }
            }
            float ss = 0.f;
#pragma unroll
            for (int j = 0; j < 8; ++j) ss += (v[j][0] * v[j][0] + v[j][1] * v[j][1]) + (v[j][2] * v[j][2] + v[j][3] * v[j][3]);
            const float rstd = 1.0f / sqrtf(wave_sum(ss) * (1.0f / DM) + 1e-6f);
            if (MODE == 2) { f32x4* ow = (f32x4*)(A->out + (size_t)row * DM) + lane;
#pragma unroll
                for (int j = 0; j < 8; ++j) ow[64 * j] = v[j] * rstd * mulv[j];
            } else {
#if PROJ_FP8
                int* hw = (int*)((unsigned char*)H + (size_t)row * DM) + lane;
#pragma unroll
                for (int j = 0; j < 8; ++j) { const f32x4 h = v[j] * rstd * mulv[j] + addv[j]; hw[64 * j] = pk4_fp8(h[0], h[1], h[2], h[3]); }
#else
                u32x2* hw = (u32x2*)(H + (size_t)row * DM) + lane;
#pragma unroll
                for (int j = 0; j < 8; ++j) { const f32x4 h = v[j] * rstd * mulv[j] + addv[j]; u32x2 w; w.x = cvt_pk_bf16(h[0], h[1]); w.y = cvt_pk_bf16(h[2], h[3]); hw[64 * j] = w; }
#endif
            }
        }
    }
#if !SCAN_CONVERT
    if (MODE == 1) { VM_WAIT(); __syncthreads(); convert_moe(A, l, lds, lane, wave, gw, NGW); }
#endif
}

__device__ __forceinline__ void phase_norm2_router(ArgsP A, int l, LAS unsigned char* lds, int tid, int lane, int wave, int bx, int G, int dry) {
    const float* MOD = (const float*)(A->ws + WS_MOD);
    const bf16_t* X = (const bf16_t*)(A->ws + WS_X); bf16_t* H = (bf16_t*)(A->ws + WS_H);
    LAS float* wr_l = (LAS float*)lds;
    LAS int* l_e = (LAS int*)(lds + LDS_MISC + 512);
    LAS float* l_g = (LAS float*)(lds + LDS_MISC + 1024);
    LAS int* l_cnt = (LAS int*)(lds + LDS_MISC + 1536);
    LAS int* l_base = (LAS int*)(lds + LDS_MISC + 1600);
    LAS int* l_loc = (LAS int*)(lds + LDS_MISC + 1664);
    { const f32x4* src = (const f32x4*)A->in[I_WR]; for (int t = tid; t < DM * NEXP / 4; t += 512) { const int c = t >> 2, q = t & 3, L = (c >> 2) & 63, j = c >> 8, i = c & 3;
        *(LAS f32x4*)(wr_l + 4 * ((((j * 4 + i) * 4 + q) * 64) + L)) = src[t]; } }
    if (tid < 16) l_cnt[tid] = 0;
    __syncthreads();
    for (int rblk = bx; rblk < MTOK / 64; rblk += G) {
        const int b = (rblk * 64) / SEQ;
        const float* mo = MOD + (size_t)(l * 4 + b) * NMOD;
        const float* gnp = (const float*)A->in[I_NGAIN] + (size_t)(l * 2 + 1) * DM;
        for (int rr = 0; rr < 8; rr += 2) {
            const int rl = wave * 8 + rr, row = rblk * 64 + rl;
            u32x2 p0[8], p1[8];
            { const u32x2* x0 = (const u32x2*)(X + (size_t)row * DM) + lane; const u32x2* x1 = x0 + DM / 4;
#pragma unroll
              for (int j = 0; j < 8; ++j) { p0[j] = x0[64 * j]; p1[j] = x1[64 * j]; } }
#define UNP(p) (f32x4){bflo((p).x), bfhi((p).x), bflo((p).y), bfhi((p).y)}
            float ss0 = 0.f, ss1 = 0.f;
#pragma unroll
            for (int j = 0; j < 8; ++j) { const f32x4 a = UNP(p0[j]), b = UNP(p1[j]);
                ss0 += (a[0] * a[0] + a[1] * a[1]) + (a[2] * a[2] + a[3] * a[3]); ss1 += (b[0] * b[0] + b[1] * b[1]) + (b[2] * b[2] + b[3] * b[3]); }
            const float rstd0 = 1.0f / sqrtf(wave_sum(ss0) * (1.0f / DM) + 1e-6f), rstd1 = 1.0f / sqrtf(wave_sum(ss1) * (1.0f / DM) + 1e-6f);
            float lg0[16], lg1[16];
#pragma unroll
            for (int e = 0; e < 16; ++e) { lg0[e] = 0.f; lg1[e] = 0.f; }
            int* hw0 = (int*)((unsigned char*)H + (size_t)row * DM) + lane;
            int* hw1 = hw0 + DM / 4;
            f32x4 gn_n = *(const f32x4*)(gnp + 4 * lane), m4_n = *(const f32x4*)(mo + 4 * DM + 4 * lane), ad_n = *(const f32x4*)(mo + 3 * DM + 4 * lane);
#pragma unroll
            for (int j = 0; j < 8; ++j) {
                const f32x4 mulj = gn_n * (m4_n + 1.0f), addj = ad_n;
                if (j + 1 < 8) { const int cn = 4 * (lane + 64 * (j + 1)); gn_n = *(const f32x4*)(gnp + cn); m4_n = *(const f32x4*)(mo + 4 * DM + cn); ad_n = *(const f32x4*)(mo + 3 * DM + cn); }
                const f32x4 h0 = UNP(p0[j]) * rstd0 * mulj + addj, h1 = UNP(p1[j]) * rstd1 * mulj + addj;
                hw0[64 * j] = pk4_fp8(h0[0], h0[1], h0[2], h0[3]); hw1[64 * j] = pk4_fp8(h1[0], h1[1], h1[2], h1[3]);
#pragma unroll
                for (int i = 0; i < 4; ++i) { const LAS f32x4* wp = (const LAS f32x4*)wr_l + (j * 4 + i) * 4 * 64 + lane;
#pragma unroll
                    for (int q = 0; q < 4; ++q) { const f32x4 ww = wp[q * 64];
                        lg0[4 * q + 0] += h0[i] * ww[0]; lg0[4 * q + 1] += h0[i] * ww[1]; lg0[4 * q + 2] += h0[i] * ww[2]; lg0[4 * q + 3] += h0[i] * ww[3];
                        lg1[4 * q + 0] += h1[i] * ww[0]; lg1[4 * q + 1] += h1[i] * ww[1]; lg1[4 * q + 2] += h1[i] * ww[2]; lg1[4 * q + 3] += h1[i] * ww[3]; } }
                __builtin_amdgcn_sched_barrier(0); }
#undef UNP
            float lg[16];
#pragma unroll
            for (int e = 0; e < 16; ++e) { const float a = wave_sum(lg0[e]), b = wave_sum(lg1[e]); lg[e] = (lane == 1) ? b : a; }
            if (lane < 2) {
                const int rl2 = rl + lane;
                float sc[16], sel[16]; const float* rb = (const float*)A->in[I_RB];
#pragma unroll
                for (int e = 0; e < 16; ++e) { sc[e] = sigmoidf_(lg[e]); sel[e] = sc[e] + rb[e]; }
                int bg = 0; float bgs = -1e30f;
#pragma unroll
                for (int g = 0; g < 4; ++g) { float m1 = -1e30f, m2 = -1e30f;
#pragma unroll
                    for (int i = 0; i < 4; ++i) { const float s = sel[4 * g + i]; if (s > m1) { m2 = m1; m1 = s; } else if (s > m2) m2 = s; }
                    const float gs = m1 + m2; if (gs > bgs) { bgs = gs; bg = g; } }
                int i1 = 0; float m1 = -1e30f;
#pragma unroll
                for (int g = 0; g < 4; ++g) if (g == bg) {
#pragma unroll
                    for (int i = 0; i < 4; ++i) if (sel[4 * g + i] > m1) { m1 = sel[4 * g + i]; i1 = i; } }
                int i2 = 0; float m2 = -1e30f;
#pragma unroll
                for (int g = 0; g < 4; ++g) if (g == bg) {
#pragma unroll
                    for (int i = 0; i < 4; ++i) if (i != i1 && sel[4 * g + i] > m2) { m2 = sel[4 * g + i]; i2 = i; } }
                const int e1 = 4 * bg + i1, e2 = 4 * bg + i2; float s1 = 0.f, s2 = 0.f;
#pragma unroll
                for (int e = 0; e < 16; ++e) { if (e == e1) s1 = sc[e]; if (e == e2) s2 = sc[e]; }
                const float inv = 1.0f / (s1 + s2);
                l_e[2 * rl2] = e1; l_e[2 * rl2 + 1] = e2; l_g[2 * rl2] = s1 * inv; l_g[2 * rl2 + 1] = s2 * inv;
            }
        }
        __syncthreads();
        { const int tid2 = launder_v(tid);
        if (tid2 < 128) l_loc[tid2] = atomicAdd((int*)&l_cnt[l_e[tid2]], 1);
        __syncthreads();
        if (tid2 < 16) { unsigned* ctl = (unsigned*)(A->ws + WS_CTL); const int c = l_cnt[tid2];
            l_base[tid2] = c ? (int)__hip_atomic_fetch_add(ctl + CW_CNT + ((l + 2 * dry) * 16 + tid2) * 64, (unsigned)c, __ATOMIC_RELAXED, __HIP_MEMORY_SCOPE_AGENT) : 0; }
        __syncthreads();
        if (tid2 < 128) { const int e = l_e[tid2]; const int slot = l_base[e] + l_loc[tid2]; const int row = rblk * 64 + (tid2 >> 1);
            int* tokl = (int*)(A->ws + WS_TOKL); if (slot < TOKCAP && !dry) tokl[e * TOKCAP + slot] = row;
            unsigned* asg = (unsigned*)(A->ws + WS_ASG) + (size_t)row * 4; if (!dry) asg[tid2 & 1] = ((unsigned)e << 20) | (unsigned)slot; if (!dry) asg[2 + (tid2 & 1)] = __float_as_uint(l_g[tid2]); }
        __syncthreads();
        }
        if (tid < 16) l_cnt[tid] = 0;
        __syncthreads();
    }
}

__device__ __forceinline__ void phase_prep(ArgsP A, int l, int lane, int wave, int bx, int G) {
    const bf16_t* PROJ = (const bf16_t*)(A->ws + WS_PROJ); bf16_t* SHR = (bf16_t*)(A->ws + WS_SHR); bf16_t* LA = (bf16_t*)(A->ws + WS_LA);
    const int gw = bx * 8 + wave, NGW = G * 8;
    for (int it = gw; it < 7 * (MTOK / 64); it += NGW) {
        const int strip = it % 7, run = it / 7;
        if (strip == 6 && lane >= 48) continue;
        const int c = strip * 512 + 8 * lane;
        float mup[8], mun[8], kkv[8];
#pragma unroll
        for (int j = 0; j < 8; ++j) { mup[j] = ((const float*)A->in[I_MUP])[l * RWC + c + j]; mun[j] = ((const float*)A->in[I_MUN])[l * RWC + c + j];
            kkv[j] = (strip == 2 || strip == 3) ? ((const float*)A->in[I_KK])[l * 1024 + (c - 1024) + j] : 0.f; }
        const int t0 = run * 64, tl0 = t0 % SEQ;
        const bf16_t* pp = PROJ + (size_t)t0 * NPROJP + RW0 + c;
        float prev[8], cur[8], nxt[8];
        if (tl0 == 0) {
#pragma unroll
            for (int j = 0; j < 8; ++j) prev[j] = 0.f; } else unpack8(*(const u32x4*)(pp - NPROJP), prev);
        unpack8(*(const u32x4*)pp, cur);
        u32x4 rawn[8];
#pragma unroll
        for (int q = 0; q < 8; ++q) rawn[q] = *(const u32x4*)(pp + (size_t)(q + 1) * NPROJP);
        for (int i0 = 0; i0 < 64; i0 += 8) {
            u32x4 raw[8];
#pragma unroll
            for (int q = 0; q < 8; ++q) raw[q] = rawn[q];
            if (i0 + 8 < 64) {
#pragma unroll
                for (int q = 0; q < 8; ++q) rawn[q] = *(const u32x4*)(pp + (size_t)(i0 + 8 + q + 1) * NPROJP); }
#pragma unroll
            for (int q = 0; q < 8; ++q) {
            const int i = i0 + q; const int row = t0 + i;
            unpack8(raw[q], nxt);
            if (tl0 + i == SEQ - 1) {
#pragma unroll
                for (int j = 0; j < 8; ++j) nxt[j] = 0.f; }
            float ps[8];
#pragma unroll
            for (int j = 0; j < 8; ++j) ps[j] = cur[j] + mup[j] * (prev[j] - cur[j]) + mun[j] * (nxt[j] - cur[j]);
            if (strip < 6) {
                const int reg = strip >> 1, cc = (strip & 1) * 512 + 8 * lane;
                *(u32x4*)(SHR + (size_t)row * 4096 + reg * 1024 + cc) = pack8(ps);
                if (reg == 1) { float x[8]; float ss = 0.f;
#pragma unroll
                    for (int j = 0; j < 8; ++j) { x[j] = ps[j] * kkv[j]; ss += x[j] * x[j]; }
                    ss += __shfl_xor(ss, 1); ss += __shfl_xor(ss, 2); ss += __shfl_xor(ss, 4);
                    const float inv = 1.0f / fmaxf(sqrtf(ss), 1e-12f);
#pragma unroll
                    for (int j = 0; j < 8; ++j) x[j] *= inv;
                    *(u32x4*)(SHR + (size_t)row * 4096 + 3072 + cc) = pack8(x); }
            } else {
                const int ty = lane >> 4; float o[8];
#pragma unroll
                for (int j = 0; j < 8; ++j) o[j] = (ty == 0) ? (1.0f - 2.0f / (1.0f + __expf(2.0f * ps[j]))) : (ty == 1) ? ps[j] : sigmoidf_(ps[j]);
                *(u32x4*)(LA + (size_t)row * KLA + 8 * lane) = pack8(o);
            }
#pragma unroll
            for (int j = 0; j < 8; ++j) { prev[j] = cur[j]; cur[j] = nxt[j]; }
            }
        }
    }
}

__device__ __forceinline__ float rowsum16(float x) {
    x += __builtin_bit_cast(float, __builtin_amdgcn_update_dpp(0, __builtin_bit_cast(int, x), 0x128, 0xf, 0xf, false));
    x += __builtin_bit_cast(float, __builtin_amdgcn_update_dpp(0, __builtin_bit_cast(int, x), 0x124, 0xf, 0xf, false));
    x += __builtin_bit_cast(float, __builtin_amdgcn_update_dpp(0, __builtin_bit_cast(int, x), 0x122, 0xf, 0xf, false));
    x += __builtin_bit_cast(float, __builtin_amdgcn_update_dpp(0, __builtin_bit_cast(int, x), 0x121, 0xf, 0xf, false));
    return x;
}
namespace rs {
typedef short rs_v4i16 __attribute__((ext_vector_type(4)));
template <int T> __device__ __forceinline__ void fmac_bc(float& acc, float c, float x) { asm("v_fmac_f32_dpp %0, %1, %2 row_newbcast:%3 row_mask:0xf bank_mask:0xf" : "+v"(acc) : "v"(c), "v"(x), "n"(T)); }
constexpr int M = 16, NCH = SEQ / M;
constexpr int SLOT = 21248, O_AR = 0, O_BK = 5632, O_BKT = 10240, O_VT = 15360, O_MRB = 18432, O_LAB = 19968, O_GAM = 20992;
constexpr int P_AR = 176, P_BK = 144, P_BKT = 80, P_VT = 48, P_MRB = 48;
constexpr int O_YB = 3 * SLOT, O_CV = O_YB + 8192;
__device__ __forceinline__ float bfu(unsigned short x) { return __uint_as_float(((unsigned)x) << 16); }
__device__ __forceinline__ unsigned cvtpk(float lo, float hi) { unsigned r; asm("v_cvt_pk_bf16_f32 %0, %1, %2" : "=v"(r) : "v"(lo), "v"(hi)); return r; }
__device__ __forceinline__ unsigned short f2bf(float f) { return (unsigned short)(cvtpk(f, 0.f) & 0xffffu); }
__device__ __forceinline__ bf16x8 pack_bf8(float a, float b, float c, float d, float e, float f, float g, float h) {
    u32x4 w; w.x = cvtpk(a, b); w.y = cvtpk(c, d); w.z = cvtpk(e, f); w.w = cvtpk(g, h); return __builtin_bit_cast(bf16x8, w); }
}
__device__ __forceinline__ void phase_scan(ArgsP A, int l, LAS unsigned char* lds, int tid, int bx, int G) {
    using namespace rs;
    const bf16_t* SHR = (const bf16_t*)(A->ws + WS_SHR); const bf16_t* DYN = (const bf16_t*)(A->ws + WS_DYN); bf16_t* YS = (bf16_t*)(A->ws + WS_YS);
    const int hwid = __builtin_amdgcn_readfirstlane(tid >> 6);
    const int wid = (hwid == 1) ? 7 : (hwid == 5) ? 1 : (hwid == 6) ? 5 : (hwid == 7) ? 6 : hwid;
    const int lane = tid & 63, l31 = lane & 31, hh = lane >> 5;
    const bool xsplit = (G == 256);
    for (int chain = xsplit ? (((bx >> 3) & 1) ? 128 : ((bx >> 4) * 8 + (bx & 7))) : bx; chain < 128; chain += xsplit ? 128 : G) {
        const int d = chain >> 6, b = (chain >> 4) & 3, h = chain & 15; const int hf = (wid == 7) ? 1 : 0;
#define RS_ROW(c, t) ((size_t)b * SEQ + (d ? (SEQ - 1 - ((c) * M + (t))) : ((c) * M + (t))))
        f32x16 ST0 = {}, ST1 = {};
        u32x4 q0a, q0b, q1a, q1b, q2a, q2b, q3a, q3b;
        float kaj = 0.f;
        const int cpos = (lane >> 4) * 32 + ((lane >> 2) & 1) * 16 + ((((lane >> 3) & 1) << 2) | (lane & 3)) * 2;
        const bool e1 = (wid == 2) || (wid == 5), e2 = (wid == 3) || (wid == 6); const int epar = (wid >= 5) ? 1 : 0;
        const int ew = (wid == 2) ? 0 : (wid == 3) ? 1 : (wid == 5) ? 2 : 3;
        LAS unsigned char* stg = lds + O_CV + ew * 8192;
        if (e2) kaj = ((const float*)A->in[I_KA])[l * 1024 + h * 64 + lane];
#define RS_LOAD(c) do { const size_t ra_ = RS_ROW(c, lane >> 3), rb_ = RS_ROW(c, 8 + (lane >> 3)); const int cg_ = 8 * (lane & 7); \
            const bf16_t* sa_ = SHR + ra_ * 4096 + h * 64 + cg_; const bf16_t* sb_ = SHR + rb_ * 4096 + h * 64 + cg_; \
            const bf16_t* da_ = DYN + ra_ * NDYN + d * 1024 + h * 64 + cg_; const bf16_t* db_ = DYN + rb_ * NDYN + d * 1024 + h * 64 + cg_; \
            q0a = *(const u32x4*)da_; q0b = *(const u32x4*)db_; q1a = *(const u32x4*)(sa_ + 3072); q1b = *(const u32x4*)(sb_ + 3072); \
            if (e1) { q2a = *(const u32x4*)sa_; q2b = *(const u32x4*)sb_; q3a = *(const u32x4*)(sa_ + 2048); q3b = *(const u32x4*)(sb_ + 2048); } \
            else { q2a = *(const u32x4*)(da_ + 2048); q2b = *(const u32x4*)(db_ + 2048); q3a = *(const u32x4*)(sa_ + 1024); q3b = *(const u32x4*)(sb_ + 1024); } } while (0)
#define RS_STAGE() do { const int o_ = ((lane >> 3) * 64 + 8 * (lane & 7)) * 2; \
            *(LAS u32x4*)(stg + o_) = q0a; *(LAS u32x4*)(stg + 1024 + o_) = q0b; *(LAS u32x4*)(stg + 2048 + o_) = q1a; *(LAS u32x4*)(stg + 3072 + o_) = q1b; \
            *(LAS u32x4*)(stg + 4096 + o_) = q2a; *(LAS u32x4*)(stg + 5120 + o_) = q2b; \
            *(LAS u32x4*)(stg + 6144 + o_) = q3a; *(LAS u32x4*)(stg + 7168 + o_) = q3b; \
            asm volatile("s_waitcnt lgkmcnt(0)" ::: "memory"); } while (0)
#define RS_GET(arr, t_) bfu(*(const LAS unsigned short*)(stg + (arr) * 2048 + (t_) * 128 + 2 * lane))
        const int trb = ((lane & 15) >> 2) * 128 + (lane >> 4) * 32 + (lane & 3) * 8;
#define RS_GET4(arr, t0) __builtin_bit_cast(s16x4, __builtin_amdgcn_ds_read_tr16_b64_v4i16((LAS rs_v4i16*)(stg + (arr) * 2048 + (t0) * 128 + trb)))
#define RS_UNP4(dst, t0, q) do { dst[(t0)] = bfu((unsigned short)q[0]); dst[(t0) + 1] = bfu((unsigned short)q[1]); dst[(t0) + 2] = bfu((unsigned short)q[2]); dst[(t0) + 3] = bfu((unsigned short)q[3]); } while (0)
        if ((e1 || e2) && epar == 0) { RS_LOAD(0); asm volatile("s_waitcnt vmcnt(0)" ::: "memory"); RS_STAGE(); }
        for (int n = 0; n < NCH + 3; ++n) {
            if (wid == 0 || wid == 7) {
                const int c = n - 2;
                if (c >= 0 && c < NCH) {
                    LAS unsigned char* sl = lds + (c % 3) * SLOT;
                    f32x16 D = {};
                    const LAS unsigned char* arp = sl + O_AR + l31 * P_AR + hh * 16;
                    {   bf16x8 a0 = *(const LAS bf16x8*)(arp), a1 = *(const LAS bf16x8*)(arp + 32), a2 = *(const LAS bf16x8*)(arp + 64), a3 = *(const LAS bf16x8*)(arp + 96), a4 = *(const LAS bf16x8*)(arp + 128);
                        const bf16x8 bv = *(const LAS bf16x8*)(sl + O_VT + (32 * hf + l31) * P_VT + hh * 16);
                        const bf16x8 am = *(const LAS bf16x8*)(sl + O_MRB + l31 * P_MRB + hh * 16);
                        const LAS unsigned char* bk0 = sl + O_BKT + l31 * P_BKT + hh * 16; const LAS unsigned char* bk1 = bk0 + 32 * P_BKT;
                        const bf16x8 bk0a = *(const LAS bf16x8*)(bk0), bk0b = *(const LAS bf16x8*)(bk0 + 32), bk1a = *(const LAS bf16x8*)(bk1), bk1b = *(const LAS bf16x8*)(bk1 + 32);
                        const LAS float* gam = (const LAS float*)(sl + O_GAM) + 4 * hh;
                        f32x4 gq0[4], gq1[4];
#pragma unroll
                        for (int g4 = 0; g4 < 4; ++g4) { gq0[g4] = *(const LAS f32x4*)(gam + 8 * g4); gq1[g4] = *(const LAS f32x4*)(gam + 32 + 8 * g4); }
                        const LAS float* lab = (const LAS float*)(sl + O_LAB) + (lane & 15);
                        float lr_[15];
#pragma unroll
                        for (int s_ = 0; s_ < 15; ++s_) lr_[s_] = lab[s_ * 16];
                        const bf16x8 b0 = pack_bf8(ST0[0], ST0[1], ST0[2], ST0[3], ST0[4], ST0[5], ST0[6], ST0[7]), b1 = pack_bf8(ST0[8], ST0[9], ST0[10], ST0[11], ST0[12], ST0[13], ST0[14], ST0[15]);
                        const bf16x8 b2 = pack_bf8(ST1[0], ST1[1], ST1[2], ST1[3], ST1[4], ST1[5], ST1[6], ST1[7]), b3 = pack_bf8(ST1[8], ST1[9], ST1[10], ST1[11], ST1[12], ST1[13], ST1[14], ST1[15]);
                        D = __builtin_amdgcn_mfma_f32_32x32x16_bf16(a0, b0, D, 0, 0, 0); D = __builtin_amdgcn_mfma_f32_32x32x16_bf16(a1, b1, D, 0, 0, 0);
                        D = __builtin_amdgcn_mfma_f32_32x32x16_bf16(a2, b2, D, 0, 0, 0); D = __builtin_amdgcn_mfma_f32_32x32x16_bf16(a3, b3, D, 0, 0, 0);
                        D = __builtin_amdgcn_mfma_f32_32x32x16_bf16(a4, bv, D, 0, 0, 0);
                        float da[16];
#pragma unroll
                        for (int r = 0; r < 8; ++r) { auto rr = __builtin_amdgcn_permlane32_swap(__float_as_uint(D[r]), __float_as_uint(D[r]), false, false);
                            const int t0 = (r & 3) + 8 * (r >> 2); da[t0] = __uint_as_float(rr[0]); da[t0 + 4] = __uint_as_float(rr[1]); }
                        rs::fmac_bc<1>(da[1], lr_[0], da[0]); rs::fmac_bc<2>(da[2], lr_[0], da[0]); rs::fmac_bc<3>(da[3], lr_[0], da[0]); rs::fmac_bc<4>(da[4], lr_[0], da[0]); rs::fmac_bc<5>(da[5], lr_[0], da[0]); rs::fmac_bc<6>(da[6], lr_[0], da[0]); rs::fmac_bc<7>(da[7], lr_[0], da[0]); rs::fmac_bc<8>(da[8], lr_[0], da[0]); rs::fmac_bc<9>(da[9], lr_[0], da[0]); rs::fmac_bc<10>(da[10], lr_[0], da[0]); rs::fmac_bc<11>(da[11], lr_[0], da[0]); rs::fmac_bc<12>(da[12], lr_[0], da[0]); rs::fmac_bc<13>(da[13], lr_[0], da[0]); rs::fmac_bc<14>(da[14], lr_[0], da[0]); rs::fmac_bc<15>(da[15], lr_[0], da[0]);
                        rs::fmac_bc<2>(da[2], lr_[1], da[1]); rs::fmac_bc<3>(da[3], lr_[1], da[1]); rs::fmac_bc<4>(da[4], lr_[1], da[1]); rs::fmac_bc<5>(da[5], lr_[1], da[1]); rs::fmac_bc<6>(da[6], lr_[1], da[1]); rs::fmac_bc<7>(da[7], lr_[1], da[1]); rs::fmac_bc<8>(da[8], lr_[1], da[1]); rs::fmac_bc<9>(da[9], lr_[1], da[1]); rs::fmac_bc<10>(da[10], lr_[1], da[1]); rs::fmac_bc<11>(da[11], lr_[1], da[1]); rs::fmac_bc<12>(da[12], lr_[1], da[1]); rs::fmac_bc<13>(da[13], lr_[1], da[1]); rs::fmac_bc<14>(da[14], lr_[1], da[1]); rs::fmac_bc<15>(da[15], lr_[1], da[1]);
                        rs::fmac_bc<3>(da[3], lr_[2], da[2]); rs::fmac_bc<4>(da[4], lr_[2], da[2]); rs::fmac_bc<5>(da[5], lr_[2], da[2]); rs::fmac_bc<6>(da[6], lr_[2], da[2]); rs::fmac_bc<7>(da[7], lr_[2], da[2]); rs::fmac_bc<8>(da[8], lr_[2], da[2]); rs::fmac_bc<9>(da[9], lr_[2], da[2]); rs::fmac_bc<10>(da[10], lr_[2], da[2]); rs::fmac_bc<11>(da[11], lr_[2], da[2]); rs::fmac_bc<12>(da[12], lr_[2], da[2]); rs::fmac_bc<13>(da[13], lr_[2], da[2]); rs::fmac_bc<14>(da[14], lr_[2], da[2]); rs::fmac_bc<15>(da[15], lr_[2], da[2]);
                        rs::fmac_bc<4>(da[4], lr_[3], da[3]); rs::fmac_bc<5>(da[5], lr_[3], da[3]); rs::fmac_bc<6>(da[6], lr_[3], da[3]); rs::fmac_bc<7>(da[7], lr_[3], da[3]); rs::fmac_bc<8>(da[8], lr_[3], da[3]); rs::fmac_bc<9>(da[9], lr_[3], da[3]); rs::fmac_bc<10>(da[10], lr_[3], da[3]); rs::fmac_bc<11>(da[11], lr_[3], da[3]); rs::fmac_bc<12>(da[12], lr_[3], da[3]); rs::fmac_bc<13>(da[13], lr_[3], da[3]); rs::fmac_bc<14>(da[14], lr_[3], da[3]); rs::fmac_bc<15>(da[15], lr_[3], da[3]);
                        rs::fmac_bc<5>(da[5], lr_[4], da[4]); rs::fmac_bc<6>(da[6], lr_[4], da[4]); rs::fmac_bc<7>(da[7], lr_[4], da[4]); rs::fmac_bc<8>(da[8], lr_[4], da[4]); rs::fmac_bc<9>(da[9], lr_[4], da[4]); rs::fmac_bc<10>(da[10], lr_[4], da[4]); rs::fmac_bc<11>(da[11], lr_[4], da[4]); rs::fmac_bc<12>(da[12], lr_[4], da[4]); rs::fmac_bc<13>(da[13], lr_[4], da[4]); rs::fmac_bc<14>(da[14], lr_[4], da[4]); rs::fmac_bc<15>(da[15], lr_[4], da[4]);
                        rs::fmac_bc<6>(da[6], lr_[5], da[5]); rs::fmac_bc<7>(da[7], lr_[5], da[5]); rs::fmac_bc<8>(da[8], lr_[5], da[5]); rs::fmac_bc<9>(da[9], lr_[5], da[5]); rs::fmac_bc<10>(da[10], lr_[5], da[5]); rs::fmac_bc<11>(da[11], lr_[5], da[5]); rs::fmac_bc<12>(da[12], lr_[5], da[5]); rs::fmac_bc<13>(da[13], lr_[5], da[5]); rs::fmac_bc<14>(da[14], lr_[5], da[5]); rs::fmac_bc<15>(da[15], lr_[5], da[5]);
                        rs::fmac_bc<7>(da[7], lr_[6], da[6]); rs::fmac_bc<8>(da[8], lr_[6], da[6]); rs::fmac_bc<9>(da[9], lr_[6], da[6]); rs::fmac_bc<10>(da[10], lr_[6], da[6]); rs::fmac_bc<11>(da[11], lr_[6], da[6]); rs::fmac_bc<12>(da[12], lr_[6], da[6]); rs::fmac_bc<13>(da[13], lr_[6], da[6]); rs::fmac_bc<14>(da[14], lr_[6], da[6]); rs::fmac_bc<15>(da[15], lr_[6], da[6]);
                        rs::fmac_bc<8>(da[8], lr_[7], da[7]); rs::fmac_bc<9>(da[9], lr_[7], da[7]); rs::fmac_bc<10>(da[10], lr_[7], da[7]); rs::fmac_bc<11>(da[11], lr_[7], da[7]); rs::fmac_bc<12>(da[12], lr_[7], da[7]); rs::fmac_bc<13>(da[13], lr_[7], da[7]); rs::fmac_bc<14>(da[14], lr_[7], da[7]); rs::fmac_bc<15>(da[15], lr_[7], da[7]);
                        rs::fmac_bc<9>(da[9], lr_[8], da[8]); rs::fmac_bc<10>(da[10], lr_[8], da[8]); rs::fmac_bc<11>(da[11], lr_[8], da[8]); rs::fmac_bc<12>(da[12], lr_[8], da[8]); rs::fmac_bc<13>(da[13], lr_[8], da[8]); rs::fmac_bc<14>(da[14], lr_[8], da[8]); rs::fmac_bc<15>(da[15], lr_[8], da[8]);
                        rs::fmac_bc<10>(da[10], lr_[9], da[9]); rs::fmac_bc<11>(da[11], lr_[9], da[9]); rs::fmac_bc<12>(da[12], lr_[9], da[9]); rs::fmac_bc<13>(da[13], lr_[9], da[9]); rs::fmac_bc<14>(da[14], lr_[9], da[9]); rs::fmac_bc<15>(da[15], lr_[9], da[9]);
                        rs::fmac_bc<11>(da[11], lr_[10], da[10]); rs::fmac_bc<12>(da[12], lr_[10], da[10]); rs::fmac_bc<13>(da[13], lr_[10], da[10]); rs::fmac_bc<14>(da[14], lr_[10], da[10]); rs::fmac_bc<15>(da[15], lr_[10], da[10]);
                        rs::fmac_bc<12>(da[12], lr_[11], da[11]); rs::fmac_bc<13>(da[13], lr_[11], da[11]); rs::fmac_bc<14>(da[14], lr_[11], da[11]); rs::fmac_bc<15>(da[15], lr_[11], da[11]);
                        rs::fmac_bc<13>(da[13], lr_[12], da[12]); rs::fmac_bc<14>(da[14], lr_[12], da[12]); rs::fmac_bc<15>(da[15], lr_[12], da[12]);
                        rs::fmac_bc<14>(da[14], lr_[13], da[13]); rs::fmac_bc<15>(da[15], lr_[13], da[13]);
                        rs::fmac_bc<15>(da[15], lr_[14], da[14]);
                        const bf16x8 bu = hh ? pack_bf8(da[8], da[9], da[10], da[11], da[12], da[13], da[14], da[15]) : pack_bf8(da[0], da[1], da[2], da[3], da[4], da[5], da[6], da[7]);
                        D = __builtin_amdgcn_mfma_f32_32x32x16_bf16(am, bu, D, 0, 0, 0);
                        LAS float* yb = (LAS float*)(lds + O_YB + (c & 1) * 4096);
#pragma unroll
                        for (int r = 8; r < 16; ++r) yb[((r & 3) + 8 * ((r >> 2) - 2) + 4 * hh) * 64 + 32 * hf + l31] = D[r];
                        ST0 = __builtin_amdgcn_mfma_f32_32x32x16_bf16(bk0a, bu, ST0, 0, 0, 0); ST0 = __builtin_amdgcn_mfma_f32_32x32x16_bf16(bk0b, bv, ST0, 0, 0, 0);
                        ST1 = __builtin_amdgcn_mfma_f32_32x32x16_bf16(bk1a, bu, ST1, 0, 0, 0); ST1 = __builtin_amdgcn_mfma_f32_32x32x16_bf16(bk1b, bv, ST1, 0, 0, 0);
#pragma unroll
                        for (int g4 = 0; g4 < 4; ++g4) { const f32x4 g0 = gq0[g4], g1 = gq1[g4];
#pragma unroll
                            for (int i_ = 0; i_ < 4; ++i_) { ST0[4 * g4 + i_] *= g0[i_]; ST1[4 * g4 + i_] *= g1[i_]; } }
                    }
                }
            } else if (wid == 1) {
                const int c = n - 1;
                if (c >= 0 && c < NCH) {
                    LAS unsigned char* sl = lds + (c % 3) * SLOT;
                    f32x16 Lm = {};
                    const LAS unsigned char* ap = sl + O_BK + l31 * P_BK + hh * 16; const LAS unsigned char* bp = sl + O_AR + l31 * P_AR + hh * 16;
#pragma unroll
                    for (int q = 0; q < 4; ++q) Lm = __builtin_amdgcn_mfma_f32_32x32x16_bf16(*(const LAS bf16x8*)(ap + 32 * q), *(const LAS bf16x8*)(bp + 32 * q), Lm, 0, 0, 0);
                    const int tp = l31, tq = tp & 15; const bool isr = tp >= 16;
                    LAS float* lab = (LAS float*)(sl + O_LAB);
                    float lo[8], hi[8];
#pragma unroll
                    for (int r = 0; r < 8; ++r) { const int s_ = (r & 3) + 8 * (r >> 2) + 4 * hh; const bool keep = isr ? (s_ <= tq) : (s_ < tq);
                        lo[r] = keep ? Lm[r] : 0.f; hi[r] = keep ? Lm[8 + r] : 0.f; }
                    if (!isr) {
#pragma unroll
                        for (int r = 0; r < 8; ++r) lab[((r & 3) + 8 * (r >> 2) + 4 * hh) * 16 + tp] = lo[r]; }
                    { u32x2 w0, w1; w0.x = isr ? cvtpk(lo[0], lo[1]) : 0u; w0.y = isr ? cvtpk(lo[2], lo[3]) : 0u; w1.x = isr ? cvtpk(lo[4], lo[5]) : 0u; w1.y = isr ? cvtpk(lo[6], lo[7]) : 0u;
                      LAS unsigned char* mp = sl + O_MRB + tp * P_MRB + hh * 8; *(LAS u32x2*)(mp) = w0; *(LAS u32x2*)(mp + 16) = w1; }
                    { u32x2 w0, w1; w0.x = cvtpk(hi[0], hi[1]); w0.y = cvtpk(hi[2], hi[3]); w1.x = cvtpk(hi[4], hi[5]); w1.y = cvtpk(hi[6], hi[7]);
                      LAS unsigned char* qp = sl + O_AR + tp * P_AR + 128 + hh * 8; *(LAS u32x2*)(qp) = w0; *(LAS u32x2*)(qp + 16) = w1; }
                }
            } else if (e1) {
                if ((n & 1) != epar) { if (n + 1 < NCH) { RS_LOAD(n + 1); asm volatile("s_waitcnt vmcnt(0)" ::: "memory"); RS_STAGE(); } }
                else if (n < NCH) {
                    LAS unsigned char* sl = lds + (n % 3) * SLOT;
                    float g = 1.0f; float xw[16], xk[16], xr[16];
                    const s16x4 q0 = RS_GET4(3, 0), q1 = RS_GET4(3, 4), q2 = RS_GET4(3, 8), q3 = RS_GET4(3, 12);
#pragma unroll
                    for (int t_ = 0; t_ < M; t_ += 4) { const s16x4 qa = RS_GET4(0, t_), qb = RS_GET4(1, t_), qc = RS_GET4(2, t_); RS_UNP4(xw, t_, qa); RS_UNP4(xk, t_, qb); RS_UNP4(xr, t_, qc); }
#pragma unroll
                    for (int t_ = 0; t_ < M; ++t_) { const float gp = g; g *= xw[t_];
                        const unsigned w_ = cvtpk(-xk[t_] * gp, xr[t_] * g);
                        *(LAS unsigned short*)(sl + O_AR + t_ * P_AR + cpos) = (unsigned short)w_;
                        *(LAS unsigned short*)(sl + O_AR + (16 + t_) * P_AR + cpos) = (unsigned short)(w_ >> 16); }
                    *(LAS float*)(sl + O_GAM + 4 * lane) = g;
                    {
                        const u32x2 d0 = __builtin_bit_cast(u32x2, q0), d1 = __builtin_bit_cast(u32x2, q1), d2 = __builtin_bit_cast(u32x2, q2), d3 = __builtin_bit_cast(u32x2, q3);
                        u32x4 v0, v1; v0.x = d0.x; v0.y = d0.y; v0.z = d1.x; v0.w = d1.y; v1.x = d2.x; v1.y = d2.y; v1.z = d3.x; v1.w = d3.y;
                        *(LAS u32x4*)(sl + O_VT + lane * P_VT) = v0; *(LAS u32x4*)(sl + O_VT + lane * P_VT + 16) = v1; }
                }
            } else if (e2) {
                if ((n & 1) != epar) { if (n + 1 < NCH) { RS_LOAD(n + 1); asm volatile("s_waitcnt vmcnt(0)" ::: "memory"); RS_STAGE(); } }
                else if (n < NCH) {
                    LAS unsigned char* sl = lds + (n % 3) * SLOT;
                    float g = 1.0f; float bq[16], kq[16], xw[16], xa[16];
#pragma unroll
                    for (int t_ = 0; t_ < M; t_ += 4) { const s16x4 qa = RS_GET4(0, t_), qb = RS_GET4(2, t_), qc = RS_GET4(1, t_), qd = RS_GET4(3, t_); RS_UNP4(xw, t_, qa); RS_UNP4(xa, t_, qb); RS_UNP4(bq, t_, qc); RS_UNP4(kq, t_, qd); }
#pragma unroll
                    for (int t_ = 0; t_ < M; ++t_) { g *= xw[t_]; const float rg = __builtin_amdgcn_rcpf(g); const float al = xa[t_];
                        bq[t_] = bq[t_] * al * rg; kq[t_] = kq[t_] * (1.0f + (al - 1.0f) * kaj) * rg;
                        const unsigned w_ = cvtpk(bq[t_], kq[t_]);
                        *(LAS unsigned short*)(sl + O_BK + t_ * P_BK + cpos) = (unsigned short)w_;
                        *(LAS unsigned short*)(sl + O_BK + (16 + t_) * P_BK + cpos) = (unsigned short)(w_ >> 16); }
                    LAS unsigned char* tp_ = sl + O_BKT + lane * P_BKT;
                    *(LAS bf16x8*)(tp_) = pack_bf8(bq[0], bq[1], bq[2], bq[3], bq[4], bq[5], bq[6], bq[7]); *(LAS bf16x8*)(tp_ + 16) = pack_bf8(bq[8], bq[9], bq[10], bq[11], bq[12], bq[13], bq[14], bq[15]);
                    *(LAS bf16x8*)(tp_ + 32) = pack_bf8(kq[0], kq[1], kq[2], kq[3], kq[4], kq[5], kq[6], kq[7]); *(LAS bf16x8*)(tp_ + 48) = pack_bf8(kq[8], kq[9], kq[10], kq[11], kq[12], kq[13], kq[14], kq[15]);
                }
            } else {
                const int c = n - 3;
                if (wid == 4)
                if (c >= 0 && c < NCH) { const LAS float* yb = (const LAS float*)(lds + O_YB + (c & 1) * 4096); const int t_ = lane >> 2, q_ = lane & 3;
                    const f32x4 y0 = *(const LAS f32x4*)(yb + t_ * 64 + 16 * q_), y1 = *(const LAS f32x4*)(yb + t_ * 64 + 16 * q_ + 4), y2 = *(const LAS f32x4*)(yb + t_ * 64 + 16 * q_ + 8), y3 = *(const LAS f32x4*)(yb + t_ * 64 + 16 * q_ + 12);
                    u32x4 w, w2; w.x = cvt_pk_bf16(y0[0], y0[1]); w.y = cvt_pk_bf16(y0[2], y0[3]); w.z = cvt_pk_bf16(y1[0], y1[1]); w.w = cvt_pk_bf16(y1[2], y1[3]);
                    w2.x = cvt_pk_bf16(y2[0], y2[1]); w2.y = cvt_pk_bf16(y2[2], y2[3]); w2.z = cvt_pk_bf16(y3[0], y3[1]); w2.w = cvt_pk_bf16(y3[2], y3[3]);
                    bf16_t* yp = YS + ((size_t)d * MTOK + RS_ROW(c, t_)) * 1024 + h * 64 + 16 * q_; *(u32x4*)yp = w; *(u32x4*)(yp + 8) = w2; }
#if SCAN_CONVERT
                if (n < NCH) { const int cw = (wid == 7) ? 1 : 0; const int piece = (bx * 2 + cw) + n * (G * 2);
                    if (piece < MOE_PIECES) convert_moe_piece(A, l, (LAS float*)(lds + O_CV + 32768 + cw * 4352), lane, piece); }
#endif
            }
            asm volatile("s_waitcnt lgkmcnt(0)" ::: "memory");
            __builtin_amdgcn_s_barrier();
            asm volatile("" ::: "memory");
        }
#undef RS_LOAD
#undef RS_STAGE
#undef RS_GET
#undef RS_GET4
#undef RS_UNP4
#undef RS_ROW
    }
}

__device__ __forceinline__ void phase_attn(ArgsP A, int l, LAS unsigned char* lds, int tid, int bx, int G) {
    const bf16_t* PROJ = (const bf16_t*)(A->ws + WS_PROJ); bf16_t* MIX = (bf16_t*)(A->ws + WS_MIX);
    float s1 = 0.f, s2 = 0.f;
    for (int i = 0; i < 64; ++i) { s1 += ((const float*)A->in[I_LQ1])[l * 64 + i] * ((const float*)A->in[I_LK1])[l * 64 + i]; s2 += ((const float*)A->in[I_LQ2])[l * 64 + i] * ((const float*)A->in[I_LK2])[l * 64 + i]; }
    const float lam_init = 0.8f - 0.6f * expf(-0.3f * (float)l);
    const float lam = expf(s1) - expf(s2) + lam_init;
    unsigned* ctl = (unsigned*)(A->ws + WS_CTL);
    LAS int* uslot = (LAS int*)(lds + LDS_MISC + 2304);
    const int myx = (int)(xb_xcc_id() & 7u);
    for (int qi = 0; qi < 8; ++qi) {
        const int x = (myx + qi) & 7;
        for (;;) {
            if (tid == 0) *uslot = (int)__hip_atomic_fetch_add(ctl + CW_AQ + (l * 8 + x) * 64, 1u, __ATOMIC_RELAXED, __HIP_MEMORY_SCOPE_AGENT);
            __syncthreads();
            const int k = __builtin_amdgcn_readfirstlane(*uslot);
            __syncthreads();
            if (k >= 128) break;
            const int bh = 4 * x + (k >> 5), qb = k & 31;
            const int b = bh >> 3, h = bh & 7;
            const bf16_t* Qb = PROJ + ((size_t)b * SEQ + qb * 128) * NPROJP + h * 128;
            const bf16_t* Kh = PROJ + ((size_t)b * SEQ) * NPROJP + 1024 + h * 128;
            const bf16_t* Vh = PROJ + ((size_t)b * SEQ) * NPROJP + 2048 + h * 128;
            unsigned char* Ob = (unsigned char*)MIX + (((size_t)b * SEQ + qb * 128) * DM + h * 128) * (WOUT_FP8 ? 1 : 2);
            attn::attn_unit2(Qb, Kh, Vh, Ob, lam, 1.0f - lam_init, (const float*)A->in[I_SUBG] + l * 128, (char*)lds, tid);
        }
    }
}

__device__ __forceinline__ void phase_post(ArgsP A, int l, int lane, int wave, int bx, int G) {
    const bf16_t* SHR = (const bf16_t*)(A->ws + WS_SHR); const bf16_t* DYN = (const bf16_t*)(A->ws + WS_DYN); const bf16_t* YS = (const bf16_t*)(A->ws + WS_YS);
    bf16_t* MIX = (bf16_t*)(A->ws + WS_MIX);
    const int gw = bx * 8 + wave, NGW = G * 8, c = 16 * lane;
    float kav[16], rkv[16], gng[16], gnb[16];
#pragma unroll
    for (int j = 0; j < 16; ++j) { kav[j] = ((const float*)A->in[I_KA])[l * 1024 + c + j]; rkv[j] = ((const float*)A->in[I_RK])[l * 1024 + c + j];
        gng[j] = ((const float*)A->in[I_GNG])[l * 1024 + c + j]; gnb[j] = ((const float*)A->in[I_GNB])[l * 1024 + c + j]; }
    for (int row = gw; row < MTOK; row += NGW) {
        float y[16], t[16], r[16], k[16], v[16], a0[16], a1[16], g[16];
#define LD16(dst, ptr) do { float lo_[8], hi_[8]; unpack8(*(const u32x4*)(ptr), lo_); unpack8(*(const u32x4*)((ptr) + 8), hi_); _Pragma("unroll") for (int j_ = 0; j_ < 8; ++j_) { dst[j_] = lo_[j_]; dst[8 + j_] = hi_[j_]; } } while (0)
        LD16(y, YS + (size_t)row * 1024 + c); LD16(t, YS + ((size_t)MTOK + row) * 1024 + c);
        LD16(r, SHR + (size_t)row * 4096 + c); LD16(k, SHR + (size_t)row * 4096 + 1024 + c); LD16(v, SHR + (size_t)row * 4096 + 2048 + c);
        LD16(a0, DYN + (size_t)row * NDYN + 2048 + c); LD16(a1, DYN + (size_t)row * NDYN + 3072 + c); LD16(g, DYN + (size_t)row * NDYN + 4096 + c);
#undef LD16
        float s = 0.f, bo = 0.f;
#pragma unroll
        for (int j = 0; j < 16; ++j) { y[j] += t[j]; s += y[j]; bo += r[j] * (k[j] * (2.0f + (a0[j] + a1[j] - 2.0f) * kav[j])) * rkv[j]; }
        s += __shfl_xor(s, 1); s += __shfl_xor(s, 2); bo += __shfl_xor(bo, 1); bo += __shfl_xor(bo, 2);
        const float mean = s * (1.0f / 64.0f); float q = 0.f;
#pragma unroll
        for (int j = 0; j < 16; ++j) { y[j] -= mean; q += y[j] * y[j]; }
        q += __shfl_xor(q, 1); q += __shfl_xor(q, 2);
        const float rstd = 1.0f / sqrtf(q * (1.0f / 64.0f) + 64e-5f);
        float o[16];
#pragma unroll
        for (int j = 0; j < 16; ++j) o[j] = (y[j] * rstd * gng[j] + gnb[j] + bo * v[j]) * g[j];
        float o0[8], o1[8];
#pragma unroll
        for (int j = 0; j < 8; ++j) { o0[j] = o[j]; o1[j] = o[8 + j]; }
        if (WOUT_FP8) {
#pragma unroll
            for (int j = 0; j < 8; ++j) { o0[j] *= MIXSC; o1[j] *= MIXSC; }
            unsigned char* mp = (unsigned char*)MIX + (size_t)row * DM + 1024 + c; *(u32x2*)mp = pack8_fp8(o0); *(u32x2*)(mp + 8) = pack8_fp8(o1); }
        else { *(u32x4*)(MIX + (size_t)row * DM + 1024 + c) = pack8(o0); *(u32x4*)(MIX + (size_t)row * DM + 1024 + c + 8) = pack8(o1); }
    }
}

constexpr int NPL = 11, NPHASE = 1 + DEPTH * NPL + 1;
#ifndef ONLY_PHASE
#define ONLY_PHASE -1
#endif
#define PH_ON(k) (ONLY_PHASE < 0 || ONLY_PHASE == (k))
#ifndef REPEAT_PHASE
#define REPEAT_PHASE -1
#endif
#define REP(k, cond) for (int rep_ = 0; rep_ < ((REPEAT_PHASE == (k) && (cond)) ? 2 : 1); ++rep_)
__global__ void __launch_bounds__(512, 2) fwd(Args args) {
    extern __shared__ __attribute__((aligned(16))) unsigned char lds_raw[];
    LAS unsigned char* lds = (LAS unsigned char*)lds_raw;
    const int tid = threadIdx.x, lane = tid & 63, wave = __builtin_amdgcn_readfirstlane(tid >> 6), bx = blockIdx.x, G = gridDim.x;
    if (tid < 4) ((LAS unsigned*)(lds + LDS_MISC))[tid] = 0u;
    __syncthreads();
#if MK_PER_PHASE
#define GRID_BAR() do { } while (0)
#else
    XcdBarrier bar = xcd_barrier_post((unsigned*)(args.ws + WS_CTL) + CW_BAR, (volatile LAS unsigned*)(lds + LDS_MISC));
#define GRID_BAR() xcd_barrier(bar, phase_tid(wave))
#endif
    const int lo = args.ph_lo, hi = args.ph_hi;
#define IN(k) (lo <= (k) && (k) < hi)
#define SEAM(k) do { if (IN(k) && IN((k) + 1)) GRID_BAR(); } while (0)
    if (PH_ON(0) && IN(0)) REP(0, true) { asm volatile("; MARK_PHASE_0"); ArgsP A = phase_args(); const int tl = phase_tid(wave), ll = tl & 63, wl = __builtin_amdgcn_readfirstlane(tl >> 6); phase_prologue(A, lds, tl, ll, wl, bx, G); } SEAM(0);
    for (int l = 0; l < DEPTH; ++l) {
        const int p0 = 1 + l * NPL;
        if (PH_ON(1) && IN(p0 + 0)) REP(1, l == 0) { asm volatile("; MARK_PHASE_1"); ArgsP A = phase_args(); const int tl = phase_tid(wave), ll = tl & 63, wl = __builtin_amdgcn_readfirstlane(tl >> 6); if (l == 0) phase_norm1<0>(A, l, lds, tl, ll, wl, bx, G); else phase_norm1<1>(A, l, lds, tl, ll, wl, bx, G); } SEAM(p0 + 0);
        if (PH_ON(2) && IN(p0 + 1)) REP(2, true) {
            asm volatile("; MARK_PHASE_2"); ArgsP A = phase_args(); const int tl = phase_tid(wave), ll = tl & 63, wl = __builtin_amdgcn_readfirstlane(tl >> 6); unsigned char* ws = A->ws;
            int kk_ = DM; asm volatile("" : "+s"(kk_));
            pg8::Gemm g{(const bf16_t*)(ws + WS_H), (const bf16_t*)(ws + WS_WIN + (size_t)l * NPROJP * DM * (PROJ_FP8 ? 1 : 2)), kk_, 0, nullptr, 0};
            pg8::StaticOrder S; S.init(MTOK, NPROJP, G, bx);
            pg8::EpiProj E{(bf16_t*)(ws + WS_PROJ), (const float*)(ws + WS_ROPE), PROJ_FP8 ? 1.0f / WSC_IN : 1.0f};
            pg8::gemm_phase<pg8::EpiProj, pg8::StaticOrder, false, PROJ_FP8 != 0>(lds, g, S, E, tl);
        } SEAM(p0 + 1);
        if (PH_ON(3) && IN(p0 + 2)) REP(3, true) { asm volatile("; MARK_PHASE_3"); ArgsP A = phase_args(); const int tl = phase_tid(wave), ll = tl & 63, wl = __builtin_amdgcn_readfirstlane(tl >> 6); phase_prep(A, l, ll, wl, bx, G); } SEAM(p0 + 2);
        if (PH_ON(4) && IN(p0 + 3)) REP(4, true) {
            asm volatile("; MARK_PHASE_4"); ArgsP A = phase_args(); const int tl = phase_tid(wave), ll = tl & 63, wl = __builtin_amdgcn_readfirstlane(tl >> 6); unsigned char* ws = A->ws;
            int kla = KLA; asm volatile("" : "+s"(kla));
            int ntw = 2; asm volatile("" : "+s"(ntw));
            pg8::Gemm g{(const bf16_t*)(ws + WS_LA), (const bf16_t*)(ws + WS_LW) + (size_t)l * NDYN * KLA, kla, 0, nullptr, ntw};
            pg8::DynOrder S; S.init(MTOK, NDYN, G, bx);
            pg8::EpiDyn E{(bf16_t*)(ws + WS_DYN), (const float*)A->in[I_DW0] + l * 2048, (const float*)A->in[I_A0] + l * 2048};
            pg8::gemm_phase<pg8::EpiDyn, pg8::DynOrder, false>(lds, g, S, E, tl);
        } SEAM(p0 + 3);
        if (PH_ON(5) && IN(p0 + 4)) REP(5, true) { asm volatile("; MARK_PHASE_5"); ArgsP A = phase_args(); const int tl = phase_tid(wave), ll = tl & 63, wl = __builtin_amdgcn_readfirstlane(tl >> 6); phase_scan(A, l, lds, tl, bx, G); }
#if MK_PER_PHASE
        SEAM(p0 + 4);
#endif
        if (PH_ON(6) && IN(p0 + 5)) REP(6, true) { asm volatile("; MARK_PHASE_6"); ArgsP A = phase_args(); const int tl = phase_tid(wave), ll = tl & 63, wl = __builtin_amdgcn_readfirstlane(tl >> 6); phase_attn(A, l, lds, tl, bx, G); } SEAM(p0 + 5);
        if (PH_ON(7) && IN(p0 + 6)) REP(7, true) { asm volatile("; MARK_PHASE_7"); ArgsP A = phase_args(); const int tl = phase_tid(wave), ll = tl & 63, wl = __builtin_amdgcn_readfirstlane(tl >> 6); phase_post(A, l, ll, wl, bx, G); } SEAM(p0 + 6);
        if (PH_ON(8) && IN(p0 + 7)) REP(8, l == 0) {
            asm volatile("; MARK_PHASE_8"); ArgsP A = phase_args(); const int tl = phase_tid(wave), ll = tl & 63, wl = __builtin_amdgcn_readfirstlane(tl >> 6); unsigned char* ws = A->ws;
            int kk_ = DM; asm volatile("" : "+s"(kk_));
            pg8::Gemm g{(const bf16_t*)(ws + WS_MIX), (const bf16_t*)(ws + WS_WOUT + (size_t)l * DM * DM * (WOUT_FP8 ? 1 : 2)), kk_, 0, nullptr, 0};
            pg8::StaticOrder S; S.init(MTOK, DM, G, bx);
            pg8::EpiRes E{l == 0 ? (const float*)A->in[I_X] : (const float*)nullptr, (bf16_t*)(ws + WS_X), (const float*)(ws + WS_MOD) + (size_t)l * 4 * NMOD + 2 * DM, WOUT_FP8 ? 1.0f / (WSC_O * MIXSC) : 1.0f};
            pg8::gemm_phase<pg8::EpiRes, pg8::StaticOrder, false, WOUT_FP8 != 0>(lds, g, S, E, tl);
        } SEAM(p0 + 7);
        if (PH_ON(9) && IN(p0 + 8)) REP(9, true) { asm volatile("; MARK_PHASE_9"); ArgsP A = phase_args(); const int tl = phase_tid(wave), ll = tl & 63, wl = __builtin_amdgcn_readfirstlane(tl >> 6); phase_norm2_router(A, l, lds, tl, ll, wl, bx, G, rep_); } SEAM(p0 + 8);
        if (PH_ON(10) && IN(p0 + 9)) REP(10, true) {
            asm volatile("; MARK_PHASE_10"); ArgsP A = phase_args(); const int tl = phase_tid(wave), ll = tl & 63, wl = __builtin_amdgcn_readfirstlane(tl >> 6); unsigned char* ws = A->ws;
            load_moe_table(A, l, lds, tl);
            int kk_ = DM; asm volatile("" : "+s"(kk_));
            pg8::Gemm g{(const bf16_t*)(ws + WS_H), (const bf16_t*)(ws + WS_WGU), kk_, (size_t)2048 * DM, (const int*)(ws + WS_TOKL), 0};
            pg8::MoeOrder S{(const LAS int*)(lds + LDS_MISC + 64), (const LAS int*)(lds + LDS_MISC + 192), G, bx, __builtin_amdgcn_readfirstlane(((const LAS int*)(lds + LDS_MISC + 64))[16])};
            pg8::EpiGlu E{ws + WS_ACT, 1.0f / WSC_GU};
            pg8::gemm_phase<pg8::EpiGlu, pg8::MoeOrder, true, true>(lds, g, S, E, tl);
        } SEAM(p0 + 9);
        if (PH_ON(11) && IN(p0 + 10)) REP(11, true) {
            asm volatile("; MARK_PHASE_11"); ArgsP A = phase_args(); const int tl = phase_tid(wave), ll = tl & 63, wl = __builtin_amdgcn_readfirstlane(tl >> 6); unsigned char* ws = A->ws;
            load_moe_table(A, l, lds, tl);
            int kk_ = DFF; asm volatile("" : "+s"(kk_));
            pg8::Gemm g{(const bf16_t*)(ws + WS_ACT), (const bf16_t*)(ws + WS_WD), kk_, (size_t)DM * DFF, nullptr, 0};
            pg8::MoeOrder S{(const LAS int*)(lds + LDS_MISC + 64), (const LAS int*)(lds + LDS_MISC + 192), G, bx, __builtin_amdgcn_readfirstlane(((const LAS int*)(lds + LDS_MISC + 64))[16])};
            pg8::EpiY E{ws + WS_Y, YSC / WSC_D};
            pg8::gemm_phase<pg8::EpiY, pg8::MoeOrder, false, true>(lds, g, S, E, tl);
        } SEAM(p0 + 10);
    }
    if (PH_ON(12) && IN(NPHASE - 1)) { asm volatile("; MARK_PHASE_12"); ArgsP A = phase_args(); const int tl = phase_tid(wave), ll = tl & 63, wl = __builtin_amdgcn_readfirstlane(tl >> 6); phase_norm1<2>(A, DEPTH, lds, tl, ll, wl, bx, G); }
#undef IN
#undef SEAM
}

extern "C" void kernel_launch(void* const* d_in, const int* in_sizes, int n_in, void* d_out, int out_size, void* d_ws, size_t ws_size, hipStream_t stream) {
    static int grid = 0;
    if (grid == 0) {
        if (n_in != 31 || out_size != MTOK * DM || ws_size < WS_END) { fprintf(stderr, "kernel_launch: unexpected shapes (n_in %d out %d ws %zu, need %zu)\n", n_in, out_size, ws_size, (size_t)WS_END); grid = -1; return; }
        int dev = 0, cus = 0;
        if (hipGetDevice(&dev) != hipSuccess || hipDeviceGetAttribute(&cus, hipDeviceAttributeMultiprocessorCount, dev) != hipSuccess) { grid = -1; return; }
        if (hipFuncSetAttribute((const void*)fwd, hipFuncAttributeMaxDynamicSharedMemorySize, LDS_BYTES) != hipSuccess) { fprintf(stderr, "kernel_launch: hipFuncSetAttribute failed\n"); grid = -1; return; }
        int per_cu = 0;
        if (hipOccupancyMaxActiveBlocksPerMultiprocessor(&per_cu, (const void*)fwd, 512, LDS_BYTES) != hipSuccess || per_cu < 1) fprintf(stderr, "kernel_launch: occupancy query says %d\n", per_cu);
        (void)hipGetLastError();
        grid = cus;
    }
    if (grid < 0) return;
    (void)hipMemsetAsync((char*)d_ws + WS_CTL, 0, CTL_BYTES, stream);
    Args a{};
    for (int i = 0; i < 31; ++i) a.in[i] = d_in[i];
    a.out = (float*)d_out; a.ws = (unsigned char*)d_ws;
#if MK_PER_PHASE
    for (int p = 0; p < NPHASE; ++p) { a.ph_lo = p; a.ph_hi = p + 1; hipLaunchKernelGGL(fwd, dim3(grid), dim3(512), LDS_BYTES, stream, a); }
#else
    a.ph_lo = 0; a.ph_hi = NPHASE; hipLaunchKernelGGL(fwd, dim3(grid), dim3(512), LDS_BYTES, stream, a);
#endif
    const hipError_t le = hipPeekAtLastError();
    if (le != hipSuccess) fprintf(stderr, "kernel_launch: launch failed: %s\n", hipGetErrorName(le));
}
```
